# Optimizing an MI355X kernel written in HIP

```python
import jax, jax.numpy as jnp
from jax import lax
import numpy as np

D_MODEL = 2048
BATCH = 4
SEQ = 4096
DEPTH = 4

CHUNK = 64
N_META = 16
Q_BLOCK = 128
ROPE_THETA = 10000.0
EPS = 1e-6

HEAD_DIM = 128
A_WIDTH = (3 * D_MODEL) // 8
B_WIDTH = (3 * D_MODEL) // 8
C_WIDTH = D_MODEL - A_WIDTH - B_WIDTH
D_MIX = A_WIDTH + B_WIDTH + C_WIDTH
A_HEADS = A_WIDTH // HEAD_DIM
IDX_HEADS = 16
IDX_DIM = 64
TOPK_MAX = 256
B_HEADS = B_WIDTH // HEAD_DIM
C_DV = 128
C_HEADS = C_WIDTH // C_DV
C_DK = C_DV // 2
C_GATE_RANK = 16
C_TAU = 16.0
N_GROUPS = 4
EXP_PER_GROUP = 8
N_EXPERTS = N_GROUPS * EXP_PER_GROUP
EXP_TOPK = 2
D_EXPERT = 512

IN_SPLITS = (A_WIDTH, HEAD_DIM, HEAD_DIM, IDX_HEADS * IDX_DIM, IDX_DIM, IDX_HEADS,
             B_WIDTH, B_WIDTH, B_WIDTH, B_HEADS,
             C_HEADS * C_DK, C_HEADS * C_DK, C_WIDTH, C_GATE_RANK, C_WIDTH)
D_IN = (A_WIDTH + 2 * HEAD_DIM + IDX_HEADS * IDX_DIM + IDX_DIM + IDX_HEADS
        + 3 * B_WIDTH + B_HEADS + 2 * C_HEADS * C_DK + 2 * C_WIDTH + C_GATE_RANK)

kernel_name = "hybrid_chunk_causal_dsa_fox_gla_hmoe"


def _rms(x, g):
    xf = x.astype(jnp.float32)
    y = xf * lax.rsqrt(jnp.mean(xf * xf, axis=-1, keepdims=True) + EPS)
    return (y * g.astype(jnp.float32)).astype(x.dtype)


def _rope_tables(T, dim):
    pos = jnp.arange(T, dtype=jnp.float32)
    inv = 1.0 / (ROPE_THETA ** (jnp.arange(0, dim, 2, dtype=jnp.float32) / dim))
    ang = pos[:, None] * inv[None, :]
    return jnp.cos(ang), jnp.sin(ang)


def _rope(x, cos, sin):
    half = x.shape[-1] // 2
    shape = (1, cos.shape[0]) + (1,) * (x.ndim - 3) + (half,)
    c = cos.reshape(shape).astype(x.dtype)
    s = sin.reshape(shape).astype(x.dtype)
    x1, x2 = x[..., :half], x[..., half:]
    return jnp.concatenate([x1 * c - x2 * s, x2 * c + x1 * s], axis=-1)


def _chunk_of(p):
    return jnp.where(p < N_META, 0, 1 + (p - N_META) // CHUNK)


def _split_cols(z, sizes):
    out, off = [], 0
    for s in sizes:
        out.append(z[..., off:off + s])
        off += s
    return out


def _to_blocks(a, nb):
    pad = nb * Q_BLOCK - a.shape[1]
    a = jnp.pad(a, [(0, 0), (0, pad)] + [(0, 0)] * (a.ndim - 2))
    return jnp.moveaxis(a.reshape((a.shape[0], nb, Q_BLOCK) + a.shape[2:]), 1, 0)


def _from_blocks(o, T):
    o = jnp.moveaxis(o, 0, 1)
    return o.reshape((o.shape[0], o.shape[1] * o.shape[2]) + o.shape[3:])[:, :T]


def _dsa_attention(q, k, v, iq, ik, iw, k_top):
    n_batch, T, H, DH = q.shape
    nb = -(-T // Q_BLOCK)
    key_chunk = _chunk_of(jnp.arange(T, dtype=jnp.int32))
    qpos = jnp.arange(nb * Q_BLOCK, dtype=jnp.int32).reshape(nb, Q_BLOCK)

    def block(args):
        qb, iqb, iwb, qp = args
        rel = jax.nn.relu(jnp.einsum('bqhd,bsd->bqhs', iqb, ik) * IDX_DIM ** -0.5)
        score = jnp.einsum('bqh,bqhs->bqs', iwb, rel).astype(jnp.float32)
        admissible = key_chunk[None, :] <= _chunk_of(qp)[:, None]
        score = jnp.where(admissible[None], score, -jnp.inf)
        top_val, top_idx = lax.top_k(score, k_top)
        valid = jnp.isfinite(top_val)
        k_sel = jax.vmap(lambda kb, ib: kb[ib])(k, top_idx)
        v_sel = jax.vmap(lambda vb, ib: vb[ib])(v, top_idx)
        logits = jnp.einsum('bqhd,bqkd->bhqk', qb, k_sel).astype(jnp.float32) * DH ** -0.5
        logits = jnp.where(valid[:, None], logits, -jnp.inf)
        p = jax.nn.softmax(logits, axis=-1).astype(v.dtype)
        return jnp.einsum('bhqk,bqkd->bqhd', p, v_sel)

    out = lax.map(block, (_to_blocks(q, nb), _to_blocks(iq, nb), _to_blocks(iw, nb), qpos))
    return _from_blocks(out, T)


def _forgetting_attention(q, k, v, log_f):
    n_batch, T, H, DH = q.shape
    nb = -(-T // Q_BLOCK)
    F = jnp.cumsum(log_f, axis=1)
    F_keys = jnp.transpose(F, (0, 2, 1))
    kpos = jnp.arange(T, dtype=jnp.int32)
    qpos = jnp.arange(nb * Q_BLOCK, dtype=jnp.int32).reshape(nb, Q_BLOCK)

    def block(args):
        qb, Fq, qp = args
        logits = jnp.einsum('bqhd,bshd->bhqs', qb, k).astype(jnp.float32) * DH ** -0.5
        logits = logits + jnp.transpose(Fq, (0, 2, 1))[..., None] - F_keys[:, :, None, :]
        logits = jnp.where(kpos[None, :] <= qp[:, None], logits, -jnp.inf)
        p = jax.nn.softmax(logits, axis=-1).astype(v.dtype)
        return jnp.einsum('bhqs,bshd->bqhd', p, v)

    out = lax.map(block, (_to_blocks(q, nb), _to_blocks(F, nb), qpos))
    return _from_blocks(out, T)


def _gla(q, k, v, log_a):
    n_batch, T, H, DK = q.shape
    DV = v.shape[-1]
    front = (-N_META) % CHUNK
    back = (-(T + front)) % CHUNK
    n_chunks = (T + front + back) // CHUNK

    def to_chunks(a):
        a = jnp.pad(a, [(0, 0), (front, back), (0, 0), (0, 0)])
        return jnp.moveaxis(a.reshape(n_batch, n_chunks, CHUNK, H, a.shape[-1]), 1, 0)

    tri = jnp.tril(jnp.ones((CHUNK, CHUNK), dtype=bool))[None, :, :, None, None]

    def step(S, inp):
        qc, kc, vc, gc = (t.astype(jnp.float32) for t in inp)
        b = jnp.cumsum(gc, axis=1)
        decay = jnp.exp(jnp.where(tri, b[:, :, None] - b[:, None, :], -jnp.inf))
        scores = jnp.einsum('bijhd,bjhd->bhij', qc[:, :, None] * decay, kc)
        o = (jnp.einsum('bhij,bjhv->bihv', scores, vc)
             + jnp.einsum('bihd,bhdv->bihv', qc * jnp.exp(b), S))
        b_last = b[:, -1]
        S = (jnp.exp(b_last)[..., None] * S
             + jnp.einsum('bjhd,bjhv->bhdv', kc * jnp.exp(b_last[:, None] - b), vc))
        return S, o

    S0 = jnp.zeros((n_batch, H, DK, DV), jnp.float32)
    _, o = lax.scan(step, S0, (to_chunks(q), to_chunks(k), to_chunks(v), to_chunks(log_a)))
    o = jnp.moveaxis(o, 0, 1).reshape(n_batch, n_chunks * CHUNK, H, DV)
    return o[:, front:front + T].astype(v.dtype)


def _hier_moe(u, wg, bg, we, be, w1, w3, w2):
    g_prob = jax.nn.softmax((u @ wg).astype(jnp.float32) + bg.astype(jnp.float32), axis=-1)
    g_p, g_i = lax.top_k(g_prob, 1)
    e_logits = ((u @ we).astype(jnp.float32) + be.astype(jnp.float32)).reshape(
        u.shape[:-1] + (N_GROUPS, EXP_PER_GROUP))
    e_logits = jnp.sum(e_logits * jax.nn.one_hot(g_i[..., 0], N_GROUPS, dtype=jnp.float32)[..., None], axis=-2)
    e_prob = jax.nn.softmax(e_logits, axis=-1)
    e_p, e_i = lax.top_k(e_prob, EXP_TOPK)
    e_p = e_p / jnp.sum(e_p, axis=-1, keepdims=True)
    expert_id = g_i * EXP_PER_GROUP + e_i
    weight = g_p * e_p
    gate = jnp.sum(jax.nn.one_hot(expert_id, N_EXPERTS, dtype=jnp.float32) * weight[..., None],
                   axis=-2).astype(u.dtype)
    y = jnp.zeros_like(u)
    for e in range(N_EXPERTS):
        hid = jax.nn.silu(u @ w1[e]) * (u @ w3[e])
        y = y + gate[..., e:e + 1] * (hid @ w2[e])
    return y


def setup_inputs(seed: int = 0) -> dict:
    key = jax.random.key(seed)
    ks = jax.random.split(key, 21)
    L, D = DEPTH, D_MODEL
    f32 = jnp.float32

    def nrm(k, shape, scale):
        return jax.random.normal(k, shape, f32) * scale

    def gain(k, shape):
        return 1.0 + 0.02 * jax.random.normal(k, shape, f32)

    res_scale = (2.0 * DEPTH) ** -0.5
    return {
        "x": nrm(ks[0], (BATCH, SEQ, D), 1.0),
        "meta": nrm(ks[1], (N_META, D), 1.0),
        "norm_mix_g": gain(ks[2], (L, D)),
        "norm_ffn_g": gain(ks[3], (L, D)),
        "w_in": nrm(ks[4], (L, D, D_IN), D ** -0.5),
        "a_qn_g": gain(ks[5], (L, HEAD_DIM)),
        "a_kn_g": gain(ks[6], (L, HEAD_DIM)),
        "b_qn_g": gain(ks[7], (L, HEAD_DIM)),
        "b_kn_g": gain(ks[8], (L, HEAD_DIM)),
        "b_f_bias": jax.random.uniform(ks[9], (L, B_HEADS), f32, 1.0, 4.0),
        "c_gate_w2": nrm(ks[10], (L, C_GATE_RANK, C_HEADS * C_DK), C_GATE_RANK ** -0.5),
        "c_gate_b": nrm(ks[11], (L, C_HEADS * C_DK), 0.1),
        "c_on_g": gain(ks[12], (L, C_DV)),
        "w_out": nrm(ks[13], (L, D_MIX, D), D_MIX ** -0.5 * res_scale),
        "r_group_w": nrm(ks[14], (L, D, N_GROUPS), D ** -0.5),
        "r_group_b": nrm(ks[15], (L, N_GROUPS), 0.01),
        "r_exp_w": nrm(ks[16], (L, D, N_EXPERTS), D ** -0.5),
        "r_exp_b": nrm(ks[17], (L, N_EXPERTS), 0.01),
        "e_w1": nrm(ks[18], (L, N_EXPERTS, D, D_EXPERT), D ** -0.5),
        "e_w3": nrm(ks[19], (L, N_EXPERTS, D, D_EXPERT), D ** -0.5),
        "e_w2": nrm(ks[20], (L, N_EXPERTS, D_EXPERT, D), D_EXPERT ** -0.5 * res_scale),
    }


def reference(x, meta, norm_mix_g, norm_ffn_g, w_in, a_qn_g, a_kn_g, b_qn_g, b_kn_g, b_f_bias,
              c_gate_w2, c_gate_b, c_on_g, w_out, r_group_w, r_group_b, r_exp_w, r_exp_b,
              e_w1, e_w3, e_w2):
    n_batch, n_seq, d = x.shape
    T = n_seq + N_META
    k_top = min(TOPK_MAX, n_seq // 4)
    cos, sin = _rope_tables(T, HEAD_DIM)
    icos, isin = _rope_tables(T, IDX_DIM)
    h = jnp.concatenate(
        [jnp.broadcast_to(meta[None].astype(x.dtype), (n_batch, N_META, d)), x], axis=1)
    for l in range(DEPTH):
        u = _rms(h, norm_mix_g[l])
        z = u @ w_in[l]
        (aq, ak, av, iq, ik, iw, bq, bk, bv, bf, cq, ck, cv, cr, cg) = _split_cols(z, IN_SPLITS)

        aq = _rope(_rms(aq.reshape(n_batch, T, A_HEADS, HEAD_DIM), a_qn_g[l]), cos, sin)
        ak = _rope(_rms(ak, a_kn_g[l]), cos, sin)
        iq = _rope(iq.reshape(n_batch, T, IDX_HEADS, IDX_DIM), icos, isin)
        ik = _rope(ik, icos, isin)
        oa = _dsa_attention(aq, ak, av, iq, ik, iw * IDX_HEADS ** -0.5, k_top)

        bq = _rms(bq.reshape(n_batch, T, B_HEADS, HEAD_DIM), b_qn_g[l])
        bk = _rms(bk.reshape(n_batch, T, B_HEADS, HEAD_DIM), b_kn_g[l])
        log_f = jax.nn.log_sigmoid(bf.astype(jnp.float32) + b_f_bias[l].astype(jnp.float32))
        ob = _forgetting_attention(bq, bk, bv.reshape(n_batch, T, B_HEADS, HEAD_DIM), log_f)

        log_a = jax.nn.log_sigmoid((cr @ c_gate_w2[l] + c_gate_b[l]).astype(jnp.float32)) / C_TAU
        oc = _gla(cq.reshape(n_batch, T, C_HEADS, C_DK) * C_DK ** -0.5,
                  ck.reshape(n_batch, T, C_HEADS, C_DK),
                  cv.reshape(n_batch, T, C_HEADS, C_DV),
                  log_a.reshape(n_batch, T, C_HEADS, C_DK))
        oc = _rms(oc, c_on_g[l]) * jax.nn.silu(cg.reshape(n_batch, T, C_HEADS, C_DV))

        mixed = jnp.concatenate([oa.reshape(n_batch, T, A_WIDTH),
                                 ob.reshape(n_batch, T, B_WIDTH),
                                 oc.reshape(n_batch, T, C_WIDTH)], axis=-1)
        h = h + mixed @ w_out[l]

        u = _rms(h, norm_ffn_g[l])
        h = h + _hier_moe(u, r_group_w[l], r_group_b[l], r_exp_w[l], r_exp_b[l],
                          e_w1[l], e_w3[l], e_w2[l])
    return h[:, N_META:]
```

```cpp
#include <hip/hip_runtime.h>
#include <cstdio>
#include <cstdint>

#ifndef MK_N_LAUNCHES
#define MK_N_LAUNCHES 0
#endif

#define GAS __attribute__((address_space(1)))
#define LAS __attribute__((address_space(3)))
typedef unsigned short bf16;
typedef unsigned u32x4 __attribute__((ext_vector_type(4)));
typedef unsigned u32x2 __attribute__((ext_vector_type(2)));
typedef float f32x4 __attribute__((ext_vector_type(4)));
typedef float f32x2 __attribute__((ext_vector_type(2)));
typedef float f32x16 __attribute__((ext_vector_type(16)));
typedef short bf16x8 __attribute__((ext_vector_type(8)));
typedef short s16x4 __attribute__((ext_vector_type(4)));
#define LDS_WAIT() asm volatile("s_waitcnt lgkmcnt(0)" ::: "memory")
#define VM_WAIT() asm volatile("s_waitcnt vmcnt(0)" ::: "memory")

constexpr int NB = 4, SEQ = 4096, NMETA = 16, TT = SEQ + NMETA;
constexpr int PADF = 48, TP = 4160;
constexpr int R = NB * TP;
constexpr int DM = 2048, DEPTH = 4;
constexpr int DIN = 5990, DINP = 6144;
constexpr int NEXP = 32, DEXP = 512;
constexpr float EPS = 1e-6f;
constexpr int C_AQ = 0, C_AK = 768, C_AV = 896, C_IQ = 1024, C_BQ = 2048, C_BK = 2816, C_BV = 3584, C_CQ = 4352, C_CK = 4608, C_CV = 4864, C_CG = 5376, C_IK = 5888;
constexpr int S_IK = 0, S_IW = 64, S_BF = 80, S_CR = 86;

constexpr size_t al256(size_t x) { return (x + 255) & ~(size_t)255; }
constexpr size_t WS_CTL = 0, CTL_ZERO_BYTES = 1u << 20;
constexpr size_t WS_COS128 = WS_CTL + CTL_ZERO_BYTES;
constexpr size_t WS_SIN128 = WS_COS128 + al256((size_t)TT * 64 * 4);
constexpr size_t WS_COS64 = WS_SIN128 + al256((size_t)TT * 64 * 4);
constexpr size_t WS_SIN64 = WS_COS64 + al256((size_t)TT * 32 * 4);
constexpr size_t WS_WIN = WS_SIN64 + al256((size_t)TT * 32 * 4);
constexpr size_t SZ_WIN = (size_t)DINP * DM * 2;
constexpr size_t WS_WOUT = WS_WIN + DEPTH * SZ_WIN;
constexpr size_t SZ_WOUT = (size_t)DM * DM * 2;
constexpr size_t WS_W13 = WS_WOUT + DEPTH * SZ_WOUT;
constexpr size_t SZ_W13E = (size_t)1024 * DM * 2, SZ_W13 = NEXP * SZ_W13E;
constexpr size_t WS_W2 = WS_W13 + DEPTH * SZ_W13;
constexpr size_t SZ_W2E = (size_t)DM * DEXP * 2, SZ_W2 = NEXP * SZ_W2E;
constexpr size_t WS_WR = WS_W2 + DEPTH * SZ_W2;
constexpr size_t SZ_WR = (size_t)2 * 48 * DM * 2;
constexpr size_t WS_H = WS_WR + DEPTH * SZ_WR;
constexpr size_t WS_U = WS_H + (size_t)R * DM * 4;
constexpr size_t WS_Z = WS_U + (size_t)R * DM * 2;
constexpr size_t WS_ZS = WS_Z + (size_t)R * DINP * 2;
constexpr size_t WS_LA = WS_ZS + (size_t)R * 256 * 4;
constexpr size_t WS_MIX = WS_LA + (size_t)R * 256 * 4;
constexpr int HID_TILES = 168;
constexpr size_t WS_HID = WS_MIX + (size_t)R * DM * 2;
constexpr size_t WS_Y0 = WS_HID + (size_t)HID_TILES * 256 * DEXP * 2;
constexpr size_t WS_Y1 = WS_Y0 + (size_t)R * DM * 2;
constexpr size_t WS_KV = WS_Y1 + (size_t)R * DM * 2;
constexpr size_t WS_DVEC = WS_KV + (size_t)16 * 65 * 64 * 128 * 4;
constexpr size_t WS_SS = WS_DVEC + al256((size_t)16 * 65 * 64 * 4);
constexpr size_t WS_LIST = WS_SS + (size_t)16 * 66 * 64 * 128 * 4;
constexpr size_t WS_GATE = WS_LIST + (size_t)NEXP * R * 4;
constexpr size_t WS_END = WS_GATE + (size_t)R * 2 * 4;

constexpr int CW_BAR = 4096;
constexpr int CW_CNT = 16384;
constexpr int CW_QUEUE = 20480;

constexpr int RING_BYTES = 131072;
constexpr int MOETAB_OFF = 131072;
constexpr int LDSCTL_OFF = 143360, MISC_OFF = LDSCTL_OFF + 320;
constexpr int LDS_BYTES = 147456;

__device__ __forceinline__ unsigned cvtpk(float lo, float hi) { unsigned r; asm volatile("v_cvt_pk_bf16_f32 %0, %1, %2" : "=v"(r) : "v"(lo), "v"(hi)); return r; }
__device__ __forceinline__ float bf2f(unsigned short b) { return __uint_as_float(((unsigned)b) << 16); }
__device__ __forceinline__ float bflo(unsigned w) { return __uint_as_float(w << 16); }
__device__ __forceinline__ float bfhi(unsigned w) { return __uint_as_float(w & 0xffff0000u); }
__device__ __forceinline__ bf16 f2bf(float f) { return (bf16)(cvtpk(f, 0.f) & 0xffffu); }
__device__ __forceinline__ float wave_sum(float v) {
#pragma unroll
    for (int o = 1; o < 64; o <<= 1) v += __shfl_xor(v, o);
    return v;
}
__device__ __forceinline__ f32x4 zero4() { float z = 0.f; asm volatile("" : "+v"(z)); return (f32x4){z, z, z, z}; }
__device__ __forceinline__ float logsigmoidf(float x) { return fminf(x, 0.f) - log1pf(expf(-fabsf(x))); }
__device__ __forceinline__ float siluf(float x) { return x / (1.f + __expf(-x)); }

#define XB_TMO      128
#define XB_XCNT(j)  (256  + 64 * (j))
#define XB_XSUB(j)  (1280 + 64 * (j))
#define XB_XGEN(j)  (2304 + 64 * (j))
#define XB_TOP      3328
#define XB_TOPGEN   3392
#define XCD_BAR_WORDS 3456
#define XB_SPIN_CAP (1u << 18)
__device__ __forceinline__ unsigned xb_ld(unsigned* p)              { return __hip_atomic_load(p, __ATOMIC_RELAXED, __HIP_MEMORY_SCOPE_AGENT); }
__device__ __forceinline__ unsigned xb_add(unsigned* p, unsigned v) { return __hip_atomic_fetch_add(p, v, __ATOMIC_RELAXED, __HIP_MEMORY_SCOPE_AGENT); }
__device__ __forceinline__ unsigned xb_xcc_id() { return (unsigned)__builtin_amdgcn_s_getreg((3 << 11) | 20) & 0xFu; }
#define XB_SPIN(cond, bar) do { unsigned _sp = 0; while (cond) { __builtin_amdgcn_s_sleep(1); \
    if ((++_sp & 255u) == 0u) { if (xb_ld(&(bar)[XB_TMO])) break; if (_sp > XB_SPIN_CAP) { atomicAdd(&(bar)[XB_TMO], 1u); break; } } } } while (0)
struct XcdBarrier { unsigned* bar; unsigned x; volatile LAS unsigned* st; };
__device__ __forceinline__ XcdBarrier xcd_barrier_post(unsigned* bar, volatile LAS unsigned* st) {
    XcdBarrier b; b.bar = bar; b.x = xb_xcc_id(); b.st = st;
    if (threadIdx.x == 0) (void)xb_add(&bar[XB_XCNT(b.x)], 1u);
    return b;
}
__device__ __forceinline__ void xcd_barrier_complete(unsigned* bar, unsigned x, unsigned& nloc, unsigned& nx) {
    const unsigned G = gridDim.x * gridDim.y * gridDim.z;
    unsigned sum, cnt, mine, sp = 0u;
    for (;;) {
        sum = 0u; cnt = 0u; mine = 0u;
#pragma unroll
        for (unsigned j = 0; j < 16; ++j) { const unsigned c = xb_ld(&bar[XB_XCNT(j)]); sum += c; cnt += (c > 0u) ? 1u : 0u; mine = (j == x) ? c : mine; }
        if (sum == G) break;
        __builtin_amdgcn_s_sleep(1);
        if ((++sp & 255u) == 0u) { if (xb_ld(&bar[XB_TMO])) break; if (sp > XB_SPIN_CAP) { atomicAdd(&bar[XB_TMO], 1u); break; } }
    }
    nloc = mine > 0u ? mine : 1u; nx = cnt > 0u ? cnt : 1u;
}
__device__ __forceinline__ void xcd_barrier(const XcdBarrier& b) {
    asm volatile("s_waitcnt vmcnt(0)" ::: "memory");
    __syncthreads();
    if (threadIdx.x == 0) {
        unsigned* bar = b.bar; unsigned bx = b.x;
        asm volatile("" : "+s"(bar), "+s"(bx));
        __builtin_amdgcn_s_waitcnt(0);
        unsigned nloc = b.st[0], nx = b.st[1];
        if (nloc == 0u) { xcd_barrier_complete(bar, bx, nloc, nx); b.st[0] = nloc; b.st[1] = nx; }
        const unsigned old = xb_add(&bar[XB_XSUB(bx)], 1u);
        const unsigned gen = old / nloc;
        if (old + 1u == (gen + 1u) * nloc) {
            __builtin_amdgcn_fence(__ATOMIC_RELEASE, "agent");
            asm volatile("s_waitcnt vmcnt(0)" ::: "memory");
            const unsigned og = xb_add(&bar[XB_TOP], 1u);
            const unsigned tg = og / nx;
            if (og + 1u == (tg + 1u) * nx) xb_add(&bar[XB_TOPGEN], 1u);
            else XB_SPIN(xb_ld(&bar[XB_TOPGEN]) == tg, bar);
            __builtin_amdgcn_fence(__ATOMIC_ACQUIRE, "agent");
            xb_add(&bar[XB_XGEN(bx)], 1u);
            asm volatile("s_waitcnt vmcnt(0)" ::: "memory");
        } else {
            XB_SPIN(xb_ld(&bar[XB_XGEN(bx)]) == gen, bar);
            __builtin_amdgcn_fence(__ATOMIC_ACQUIRE, "agent");
            asm volatile("s_waitcnt vmcnt(0)" ::: "memory");
        }
    }
    __syncthreads();
}

namespace pg8 {
constexpr int BM = 256, BK = 64, HALF = 128, HTB = HALF * BK * 2, STAGE_BYTES = 8 * HTB;
__host__ __device__ __forceinline__ int lds_byte(int r, int c) { const int st = (r >> 4) * 2 + (c >> 5), rr = r & 15, cc = c & 31, ob = rr * 64 + cc * 2; return st * 1024 + (ob ^ (((ob >> 9) & 1) << 5)); }
__host__ __device__ __forceinline__ void stage_rc(int b, int& Rr, int& C) { const int st = b / 1024, sb = b % 1024, swz = sb ^ (((sb >> 9) & 1) << 5); Rr = (st >> 1) * 16 + swz / 64; C = (st & 1) * 32 + (swz % 64) / 2; }
__host__ __device__ __forceinline__ int perm32(int rho) { const int n = rho >> 4, i = rho & 15; return 8 * (i >> 2) + 4 * n + (i & 3); }
struct Unit { int pm, pn, e, r0; };

template <class Epi, class Prob>
__device__ __forceinline__ void gemm_phase(LAS unsigned char* lds, const Prob& P, const Epi& E) {
    int tid = threadIdx.x; asm volatile("" : "+v"(tid));
    const int wid = __builtin_amdgcn_readfirstlane(tid >> 6), lane = tid & 63, wr = wid >> 2, wc = wid & 3, fr = lane & 15, fq = lane >> 4;
    const int K = P.K, nt = K / BK;
    unsigned voffB;
    { int Rr, C; stage_rc(tid * 16, Rr, C); const int Rb = Epi::PERM ? ((Rr & ~31) + perm32(Rr & 31)) : Rr; voffB = (unsigned)(Rb * K + C) * 2u; }
    const size_t hstep = (size_t)HALF * K * 2, qstepB = (size_t)64 * K * 2;
    const unsigned ldsw = (unsigned)wid * 1024u;
    const int aoff = lds_byte(wr * 64 + fr, fq * 8), boff = lds_byte(wc * 32 + fr, fq * 8);
#define PG8_SA(b, h) (((b) * 2 + (h)) * HTB)
#define PG8_SB(b, h) ((4 + (b) * 2 + (h)) * HTB)
#define PG8_STAGE1(bufoff, gbase, voff, qstep) do { _Pragma("unroll") for (int _i = 0; _i < 2; ++_i) \
        __builtin_amdgcn_global_load_lds((const unsigned*)((const char*)(gbase) + (size_t)_i * (qstep) + (voff)), (LAS unsigned*)(lds + (bufoff) + ldsw + _i * 8192), 16, 0, 0); } while (0)
#define PG8_STAGE2(bufoff, gbase, voff) do { _Pragma("unroll") for (int _i = 0; _i < 2; ++_i) \
        __builtin_amdgcn_global_load_lds((const unsigned*)((const char*)(gbase) + (voff)[_i]), (LAS unsigned*)(lds + (bufoff) + ldsw + _i * 8192), 16, 0, 0); } while (0)
#define PG8_STB(bufoff, gbase) PG8_STAGE1(bufoff, gbase, voffB, qstepB)
#define PG8_STA(bufoff, gbase, h) do { if constexpr (GA) PG8_STAGE2(bufoff, gbase, ao[h]); else PG8_STAGE1(bufoff, (gbase) + (size_t)(h) * hstepA, ao[0][0], qstepA); } while (0)
#define PG8_LDA(dst, b, h) do { _Pragma("unroll") for (int m = 0; m < 4; ++m) _Pragma("unroll") for (int k = 0; k < 2; ++k) dst[m][k] = *(const LAS bf16x8*)(lds + PG8_SA(b, h) + aoff + m * 2048 + k * 1024); } while (0)
#define PG8_LDB(dst, b, h) do { _Pragma("unroll") for (int n = 0; n < 2; ++n) _Pragma("unroll") for (int k = 0; k < 2; ++k) dst[n][k] = *(const LAS bf16x8*)(lds + PG8_SB(b, h) + boff + n * 2048 + k * 1024); } while (0)
#define PG8_MMA(ai, bj, At, Bt) do { __builtin_amdgcn_s_setprio(1); _Pragma("unroll") for (int m = 0; m < 4; ++m) _Pragma("unroll") for (int n = 0; n < 2; ++n) _Pragma("unroll") for (int k = 0; k < 2; ++k) \
        acc[ai][bj][m][n] = __builtin_amdgcn_mfma_f32_16x16x32_bf16(Bt[n][k], At[m][k], acc[ai][bj][m][n], 0, 0, 0); __builtin_amdgcn_s_setprio(0); } while (0)
#define PG8_WAIT_V(n) asm volatile("s_waitcnt vmcnt(" #n ")" ::: "memory")
#define PG8_WAIT_L(n) asm volatile("s_waitcnt lgkmcnt(" #n ")" ::: "memory")
#define PG8_BAR __builtin_amdgcn_s_barrier()
#define PG8_SCHED __builtin_amdgcn_sched_barrier(0)
    Unit cur, nxt; int ui = 0;
    if (!P.next(0, cur)) return;
    constexpr bool GA = Prob::GATHER;
    unsigned ao[2][2]; const size_t hstepA = (size_t)HALF * P.lda * 2, qstepA = (size_t)64 * P.lda * 2;
    const char* cA = P.abase();
    if constexpr (GA) P.aoffs(cur, tid, ao);
    else { ao[0][0] = P.aoffs0(tid); cA += P.aunit(cur); }
    const char* cB = P.bptr(cur);
    const size_t kstep = (size_t)(BK * 2);
    PG8_STB(PG8_SB(0, 0), cB); PG8_STB(PG8_SB(0, 1), cB + hstep); PG8_STA(PG8_SA(0, 0), cA, 0); PG8_STA(PG8_SA(0, 1), cA, 1);
    if (wr == 1) PG8_BAR;
    PG8_WAIT_V(2); PG8_BAR;
    PG8_STB(PG8_SB(1, 0), cB + kstep); PG8_STA(PG8_SA(1, 0), cA + kstep, 0); PG8_STB(PG8_SB(1, 1), cB + hstep + kstep);
    PG8_WAIT_V(6); PG8_BAR;
    f32x4 acc[2][2][4][2];
#pragma unroll
    for (int a = 0; a < 2; ++a)
#pragma unroll
        for (int b = 0; b < 2; ++b)
#pragma unroll
            for (int m = 0; m < 4; ++m)
#pragma unroll
                for (int n = 0; n < 2; ++n) acc[a][b][m][n] = zero4();
    bf16x8 At[4][2], B0[2][2], B1[2][2];
    for (;;) {
        const bool has_next = P.next(ui + 1, nxt);
        const char* nB = has_next ? P.bptr(nxt) : cB;
        const char* nA = (has_next && !GA) ? P.abase() + P.aunit(nxt) : cA;
        for (int t = 0; t < nt; t += 2) {
            const bool last = (t == nt - 2);
            const char* a1 = cA + (size_t)(t + 1) * kstep;
            const char* a2 = last ? nA : cA + (size_t)(t + 2) * kstep; const char* b2 = last ? nB : cB + (size_t)(t + 2) * kstep;
            const char* a3 = a2 + kstep; const char* b3 = b2 + kstep;
            PG8_LDB(B0, 0, 0); PG8_LDB(B1, 0, 1); PG8_SCHED; PG8_LDA(At, 0, 0); PG8_STA(PG8_SA(1, 1), a1, 1);
            if constexpr (GA) { if (last && has_next) P.aoffs(nxt, tid, ao); }
            PG8_WAIT_V(8); PG8_WAIT_L(0); PG8_BAR; PG8_MMA(0, 0, At, B0); PG8_MMA(0, 1, At, B1); PG8_BAR; PG8_SCHED;
            PG8_LDA(At, 0, 1); PG8_STB(PG8_SB(0, 0), b2); PG8_STB(PG8_SB(0, 1), b2 + hstep); PG8_STA(PG8_SA(0, 0), a2, 0);
            PG8_WAIT_V(8); PG8_WAIT_L(0); PG8_BAR; PG8_MMA(1, 0, At, B0); PG8_MMA(1, 1, At, B1); PG8_BAR; PG8_SCHED;
            PG8_LDB(B0, 1, 0); PG8_LDB(B1, 1, 1); PG8_SCHED; PG8_LDA(At, 1, 0); PG8_STA(PG8_SA(0, 1), a2, 1);
            PG8_WAIT_V(8); PG8_WAIT_L(0); PG8_BAR; PG8_MMA(0, 0, At, B0); PG8_MMA(0, 1, At, B1); PG8_BAR; PG8_SCHED;
            PG8_LDA(At, 1, 1); PG8_STB(PG8_SB(1, 0), b3); PG8_STB(PG8_SB(1, 1), b3 + hstep); PG8_STA(PG8_SA(1, 0), a3, 0);
            PG8_WAIT_V(8); PG8_WAIT_L(0); PG8_BAR; PG8_MMA(1, 0, At, B0); PG8_MMA(1, 1, At, B1); PG8_BAR; PG8_SCHED;
        }
        if (wr == 0) PG8_BAR;
        { int tz = threadIdx.x; asm volatile("" : "+v"(tz)); const int wz = tz >> 6, lz = tz & 63; E(acc, cur, wz >> 2, wz & 3, lz & 15, lz >> 4); }
        if (!has_next) break;
#pragma unroll
        for (int a = 0; a < 2; ++a)
#pragma unroll
            for (int b = 0; b < 2; ++b)
#pragma unroll
                for (int m = 0; m < 4; ++m)
#pragma unroll
                    for (int n = 0; n < 2; ++n) acc[a][b][m][n] = zero4();
        cur = nxt; cB = nB; cA = nA; ++ui;
        if (wr == 1) PG8_BAR;
    }
    PG8_WAIT_V(0);
    PG8_BAR;
#undef PG8_SA
#undef PG8_STAGE1
#undef PG8_STAGE2
#undef PG8_STB
#undef PG8_STA
#undef PG8_SB
#undef PG8_LDA
#undef PG8_LDB
#undef PG8_MMA
#undef PG8_WAIT_V
#undef PG8_WAIT_L
#undef PG8_BAR
#undef PG8_SCHED
}

struct DenseProb {
    int K; const char* A; const char* Bt; int nM, nN, nwg, G, c;
    __device__ __forceinline__ void init(const void* A_, const void* Bt_, int M, int N, int K_, int G_, int c_) { A = (const char*)A_; Bt = (const char*)Bt_; K = K_; lda = K_; nM = M / BM; nN = N / BM; nwg = nM * nN; G = G_; c = c_; }
    __device__ __forceinline__ bool next(int i, Unit& u) const {
        const int L = i * G + c; if (L >= nwg) return false;
        int wgid = L; { const int q = nwg / 8, r = nwg % 8, xcd = wgid % 8, off = wgid / 8; wgid = (xcd < r ? xcd * (q + 1) : r * (q + 1) + (xcd - r) * q) + off; }
        const int nig = 8 * nN, gid = wgid / nig, fm = gid * 8, gsz = (nM - fm) < 8 ? (nM - fm) : 8;
        u.pm = fm + ((wgid % nig) % gsz); u.pn = (wgid % nig) / gsz; u.e = 0; u.r0 = 0; return true;
    }
    static constexpr bool GATHER = false; int lda;
    __device__ __forceinline__ const char* abase() const { return A; }
    __device__ __forceinline__ size_t aunit(const Unit& u) const { return (size_t)u.pm * BM * K * 2; }
    __device__ __forceinline__ unsigned aoffs0(int tid) const { int Rr, C; stage_rc(tid * 16, Rr, C); return (unsigned)(Rr * K + C) * 2u; }
    __device__ __forceinline__ void aoffs(const Unit&, int, unsigned (&)[2][2]) const {}
    __device__ __forceinline__ const char* bptr(const Unit& u) const { return Bt + (size_t)u.pn * BM * K * 2; }
};
struct MoeTab { int e[176]; int r0[176]; int cnt[32]; int ntiles; };
template <bool UP> struct MoeProb {
    int K; const char* A; const char* W; const unsigned* list; const LAS MoeTab* tab; int G, c;
    __device__ __forceinline__ bool next(int i, Unit& u) const {
        constexpr int NPN = UP ? 4 : 8;
        const int L = i * G + c; if (L >= __builtin_amdgcn_readfirstlane(tab->ntiles) * NPN) return false;
        const int tile = L / NPN; u.pm = tile; u.pn = L % NPN; u.e = __builtin_amdgcn_readfirstlane(tab->e[tile]); u.r0 = __builtin_amdgcn_readfirstlane(tab->r0[tile]); return true;
    }
    static constexpr bool GATHER = UP; int lda;
    __device__ __forceinline__ const char* abase() const { return A; }
    __device__ __forceinline__ size_t aunit(const Unit& u) const { return (size_t)u.pm * BM * DEXP * 2; }
    __device__ __forceinline__ unsigned aoffs0(int tid) const { int Rr, C; stage_rc(tid * 16, Rr, C); return (unsigned)(Rr * DEXP + C) * 2u; }
    __device__ __forceinline__ void aoffs(const Unit& u, int tid_, unsigned (&o)[2][2]) const {
        int tid = tid_; asm volatile("" : "+v"(tid));
        const int n = __builtin_amdgcn_readfirstlane(tab->cnt[u.e]);
#pragma unroll
        for (int i = 0; i < 2; ++i) { int Rr, C; stage_rc(tid * 16 + i * 8192, Rr, C);
#pragma unroll
            for (int h = 0; h < 2; ++h) { const int li = u.r0 + h * HALF + Rr;
                const unsigned row = (li < n) ? (list[(size_t)u.e * R + li] >> 1) : (unsigned)PADF;
                o[h][i] = (row * (unsigned)DM + (unsigned)C) * 2u; } }
    }
    __device__ __forceinline__ const char* bptr(const Unit& u) const { return W + (size_t)u.e * (UP ? SZ_W13E : SZ_W2E) + (size_t)u.pn * BM * K * 2; }
};

struct EpiInProj {
    static constexpr bool PERM = true;
    bf16* Z; float* ZS;
    __device__ __forceinline__ void operator()(const f32x4 (&acc)[2][2][4][2], const Unit& u, int wr, int wc, int fr, int fq) const {
        const int row0 = u.pm * BM + wr * 64 + fr;
        if (u.pn < 23) {
            const int col0 = u.pn * BM + wc * 32 + 8 * fq;
#pragma unroll
            for (int ai = 0; ai < 2; ++ai)
#pragma unroll
                for (int m = 0; m < 4; ++m) { bf16* rowp = Z + (size_t)(row0 + ai * HALF + m * 16) * DINP + col0;
#pragma unroll
                    for (int bj = 0; bj < 2; ++bj) { const f32x4 v0 = acc[ai][bj][m][0], v1 = acc[ai][bj][m][1];
                        u32x4 w; w.x = cvtpk(v0[0], v0[1]); w.y = cvtpk(v0[2], v0[3]); w.z = cvtpk(v1[0], v1[1]); w.w = cvtpk(v1[2], v1[3]);
                        *(u32x4*)(rowp + bj * HALF) = w; } }
        } else {
            const int col0 = wc * 32 + 8 * fq;
#pragma unroll
            for (int ai = 0; ai < 2; ++ai)
#pragma unroll
                for (int m = 0; m < 4; ++m) { float* rowp = ZS + (size_t)(row0 + ai * HALF + m * 16) * 256 + col0;
#pragma unroll
                    for (int bj = 0; bj < 2; ++bj) { *(f32x4*)(rowp + bj * HALF) = acc[ai][bj][m][0]; *(f32x4*)(rowp + bj * HALF + 4) = acc[ai][bj][m][1]; } }
        }
    }
};
struct EpiOutProj {
    static constexpr bool PERM = false;
    float* H;
    __device__ __forceinline__ void operator()(const f32x4 (&acc)[2][2][4][2], const Unit& u, int wr, int wc, int fr, int fq) const {
        const int row0 = u.pm * BM + wr * 64 + fr, col0 = u.pn * BM + wc * 32 + 4 * fq;
#pragma unroll
        for (int ai = 0; ai < 2; ++ai)
#pragma unroll
            for (int m = 0; m < 4; ++m) { float* rowp = H + (size_t)(row0 + ai * HALF + m * 16) * DM + col0;
                f32x4 hv[2][2];
#pragma unroll
                for (int bj = 0; bj < 2; ++bj)
#pragma unroll
                    for (int n = 0; n < 2; ++n) hv[bj][n] = *(const f32x4*)(rowp + bj * HALF + n * 16);
#pragma unroll
                for (int bj = 0; bj < 2; ++bj)
#pragma unroll
                    for (int n = 0; n < 2; ++n) *(f32x4*)(rowp + bj * HALF + n * 16) = hv[bj][n] + acc[ai][bj][m][n]; }
    }
};
struct EpiMoeUp {
    static constexpr bool PERM = true;
    bf16* HID;
    __device__ __forceinline__ void operator()(const f32x4 (&acc)[2][2][4][2], const Unit& u, int wr, int wc, int fr, int fq) const {
        const int row0 = u.pm * BM + wr * 64 + fr, col0 = (u.pn * BM + wc * 32 + 8 * fq) >> 1;
#pragma unroll
        for (int ai = 0; ai < 2; ++ai)
#pragma unroll
            for (int m = 0; m < 4; ++m) { bf16* rowp = HID + (size_t)(row0 + ai * HALF + m * 16) * DEXP + col0;
#pragma unroll
                for (int bj = 0; bj < 2; ++bj) { const f32x4 a = acc[ai][bj][m][0], b = acc[ai][bj][m][1];
                    u32x2 w; w.x = cvtpk(siluf(a[0]) * b[0], siluf(a[1]) * b[1]); w.y = cvtpk(siluf(a[2]) * b[2], siluf(a[3]) * b[3]);
                    *(u32x2*)(rowp + bj * (HALF / 2)) = w; }
                asm volatile("" ::: "memory"); }
    }
};
struct EpiMoeDown {
    static constexpr bool PERM = true;
    bf16* Y0; bf16* Y1; const unsigned* list; const float* gate; const LAS MoeTab* tab;
    __device__ __forceinline__ void operator()(const f32x4 (&acc)[2][2][4][2], const Unit& u, int wr, int wc, int fr, int fq) const {
        const int n = __builtin_amdgcn_readfirstlane(tab->cnt[u.e]); const int col0 = u.pn * BM + wc * 32 + 8 * fq;
#pragma unroll
        for (int ai = 0; ai < 2; ++ai)
#pragma unroll
            for (int m = 0; m < 4; ++m) { const int li = u.r0 + ai * HALF + wr * 64 + m * 16 + fr;
                if (li < n) { const unsigned ent = list[(size_t)u.e * R + li]; const float g = gate[ent];
                    bf16* rowp = Y0 + (size_t)(ent & 1u) * ((size_t)R * DM) + (size_t)(ent >> 1) * DM + col0;
#pragma unroll
                    for (int bj = 0; bj < 2; ++bj) { const f32x4 v0 = acc[ai][bj][m][0] * g, v1 = acc[ai][bj][m][1] * g;
                        u32x4 w; w.x = cvtpk(v0[0], v0[1]); w.y = cvtpk(v0[2], v0[3]); w.z = cvtpk(v1[0], v1[1]); w.w = cvtpk(v1[2], v1[3]);
                        *(u32x4*)(rowp + bj * HALF) = w; } } }
    }
};
}

namespace fox {
constexpr int D = 128, NW = 8, QBLK = 32, KVBLK = 64, QB = NW * QBLK;
constexpr int SHM_V = KVBLK * D * 2, SHM_K = KVBLK * D * 2;
constexpr int LDS_BODY = 2 * SHM_V + 2 * SHM_K + NW * 64 * 4;
constexpr int BIAS_OFF = LDS_BODY;
constexpr int SCAN_OFF = BIAS_OFF + TP * 4;
constexpr int LDQ = DINP, LDO = DM;
constexpr float SCALE = 0.08838834764831845f, THR = 8.f;
constexpr int WBIG = 1 << 28;
#define KSWZ(row, colB) ((row) * 256 + ((colB) ^ (((row) & 7) << 4)))
#define SBAR() __builtin_amdgcn_sched_barrier(0)
__device__ __forceinline__ int v_st(int k, int c) { const int kk = (k & ~0xC) | ((k & 4) << 1) | ((k & 8) >> 1); return ((kk >> 3) * 4 + (c >> 5)) * 512 + ((kk & 7) * 32 + (c & 31)) * 2; }
__device__ __forceinline__ int v_rd_base(int lane) { return ((lane & 3) << 3) | (((lane >> 2) & 3) << 6) | (((lane >> 4) & 1) << 5) | (((lane >> 5) & 1) << 8); }
constexpr int v_rd_off(int d0, int ks, int half) { return d0 * 512 + ks * 4096 + half * 2048; }
__device__ __forceinline__ int crow(int r, int hi) { return (r & 3) + 8 * (r >> 2) + 4 * hi; }
__device__ __forceinline__ bf16x8 load8(const bf16* p) { return *reinterpret_cast<const bf16x8*>(p); }
__device__ __forceinline__ void mask_tile(f32x16& p0, f32x16& p1, int dq, unsigned W) {
    const float NEG = -__builtin_inff();
#pragma unroll
    for (int r = 0; r < 16; ++r) {
        const int c = (r & 3) + 8 * (r >> 2);
        if ((unsigned)(dq - c) >= W) p0[r] = NEG;
        if ((unsigned)(dq - c - 32) >= W) p1[r] = NEG;
    }
}
__device__ __forceinline__ void partialSM(f32x16& p0, f32x16& p1, float& m_reg, float& mn, float& alpha) {
    float pmax = p0[0]; for (int r = 1; r < 16; ++r) pmax = fmaxf(pmax, p0[r]); for (int r = 0; r < 16; ++r) pmax = fmaxf(pmax, p1[r]);
    { auto rr = __builtin_amdgcn_permlane32_swap(__float_as_uint(pmax), __float_as_uint(pmax), false, false);
      pmax = fmaxf(__uint_as_float(rr[0]), __uint_as_float(rr[1])); }
    constexpr float C2 = 1.4426950408889634f * SCALE;
    if (__builtin_expect(__all((pmax - m_reg) * SCALE <= THR), 1)) { mn = m_reg; alpha = 1.f; }
    else { mn = fmaxf(m_reg, pmax); alpha = __builtin_amdgcn_exp2f((m_reg - mn) * C2); m_reg = mn; }
    const float mnL = -mn * C2;
    for (int r = 0; r < 16; ++r) p0[r] = fmaf(p0[r], C2, mnL); for (int r = 0; r < 16; ++r) p1[r] = fmaf(p1[r], C2, mnL);
    for (int r = 0; r < 16; ++r) p0[r] = __builtin_amdgcn_exp2f(p0[r]);
}
__device__ __forceinline__ void finishSM(f32x16& p0, f32x16& p1, float alpha, float& l_reg, bf16x8& pa0, bf16x8& pa1, bf16x8& pa2, bf16x8& pa3) {
    for (int r = 0; r < 16; ++r) p1[r] = __builtin_amdgcn_exp2f(p1[r]);
    float ps = 0; for (int r = 0; r < 16; ++r) ps += p0[r]; for (int r = 0; r < 16; ++r) ps += p1[r];
    { auto rr = __builtin_amdgcn_permlane32_swap(__float_as_uint(ps), __float_as_uint(ps), false, false);
      ps = __uint_as_float(rr[0]) + __uint_as_float(rr[1]); }
    l_reg = l_reg * alpha + ps;
#define PK4(P, B_, OUT) do { unsigned a0 = cvtpk(P[B_+0], P[B_+1]), a1 = cvtpk(P[B_+2], P[B_+3]);                          \
        unsigned b0 = cvtpk(P[B_+4], P[B_+5]), b1 = cvtpk(P[B_+6], P[B_+7]);                                             \
        auto r0 = __builtin_amdgcn_permlane32_swap(a0, b0, false, false); auto r1 = __builtin_amdgcn_permlane32_swap(a1, b1, false, false); \
        u32x4 w = {r0[0], r1[0], r0[1], r1[1]}; OUT = *reinterpret_cast<bf16x8*>(&w); } while (0)
    PK4(p0, 0, pa0); PK4(p0, 8, pa1); PK4(p1, 0, pa2); PK4(p1, 8, pa3);
#undef PK4
}
template <int KB>
__device__ __forceinline__ void qkt(f32x16& p0, f32x16& p1, const char* K_lds, const float* biask  , int r32, int hi, const bf16x8* qr) {
#pragma unroll
    for (int a = 0; a < 4; ++a) { const f32x4 b0 = *(const f32x4*)(biask + 8 * a), b1 = *(const f32x4*)(biask + 32 + 8 * a);
#pragma unroll
        for (int j = 0; j < 4; ++j) { p0[4 * a + j] = b0[j]; p1[4 * a + j] = b1[j]; } }
    const char* kb[4];
#pragma unroll
    for (int dd = 0; dd < 4; ++dd) kb[dd] = K_lds + KB * SHM_K + KSWZ(r32, (dd * 16 + hi * 8) * 2);
#pragma unroll
    for (int d0 = 0; d0 < 8; ++d0) { const char* a = kb[d0 & 3] + (d0 >> 2) * 128;
        bf16x8 b0 = *reinterpret_cast<const bf16x8*>(a);
        bf16x8 b1 = *reinterpret_cast<const bf16x8*>(a + 32 * 256);
        p0 = __builtin_amdgcn_mfma_f32_32x32x16_bf16(b0, qr[d0], p0, 0, 0, 0);
        p1 = __builtin_amdgcn_mfma_f32_32x32x16_bf16(b1, qr[d0], p1, 0, 0, 0); }
}
template <int VB>
__device__ __forceinline__ void pv_tile(f32x16* o, int vb0, bf16x8 pa0, bf16x8 pa1, bf16x8 pa2, bf16x8 pa3) {
#define TRRD(dst, off) asm volatile("ds_read_b64_tr_b16 %0, %1 offset:%2" : "=&v"(dst) : "v"(vb0), "i"(off) : "memory")
#define PV_D0(d0) do { s16x4 l0, l1, l2, l3, h0, h1, h2, h3; constexpr int b_ = VB * SHM_V + v_rd_off(d0, 0, 0); \
        TRRD(l0, b_); TRRD(h0, b_ + 2048); TRRD(l1, b_ + 4096); TRRD(h1, b_ + 6144); TRRD(l2, b_ + 8192); TRRD(h2, b_ + 10240); TRRD(l3, b_ + 12288); TRRD(h3, b_ + 14336); \
        asm volatile("s_waitcnt lgkmcnt(0)" ::: "memory"); SBAR();   \
        o[d0] = __builtin_amdgcn_mfma_f32_32x32x16_bf16(pa0, (bf16x8){l0[0], l0[1], l0[2], l0[3], h0[0], h0[1], h0[2], h0[3]}, o[d0], 0, 0, 0);   \
        o[d0] = __builtin_amdgcn_mfma_f32_32x32x16_bf16(pa1, (bf16x8){l1[0], l1[1], l1[2], l1[3], h1[0], h1[1], h1[2], h1[3]}, o[d0], 0, 0, 0);   \
        o[d0] = __builtin_amdgcn_mfma_f32_32x32x16_bf16(pa2, (bf16x8){l2[0], l2[1], l2[2], l2[3], h2[0], h2[1], h2[2], h2[3]}, o[d0], 0, 0, 0);   \
        o[d0] = __builtin_amdgcn_mfma_f32_32x32x16_bf16(pa3, (bf16x8){l3[0], l3[1], l3[2], l3[3], h3[0], h3[1], h3[2], h3[3]}, o[d0], 0, 0, 0); } while (0)
    PV_D0(0); PV_D0(1); PV_D0(2); PV_D0(3);
#undef PV_D0
#undef TRRD
}
struct BlockRef { const bf16* Q; const bf16* K; const bf16* V; bf16* O; int P0; };
struct Seam { bf16x8 qr[8]; bf16x8 st_v0, st_v1, st_k0, st_k1; };
#define ROW(p, k0, rr) ((p) + (unsigned)(((k0) + (rr)) * LDQ + sc))
#define VMW() asm volatile("s_waitcnt vmcnt(0)" ::: "memory")
#define VMWN(n) asm volatile("s_waitcnt vmcnt(%0)" :: "i"(n) : "memory")
#define SLOAD_H(Kp, Vp, k0) do { S.st_v0 = load8(ROW(Vp, k0, sr)); S.st_v1 = load8(ROW(Vp, k0, 32 + sr));              \
                         S.st_k0 = load8(ROW(Kp, k0, sr)); S.st_k1 = load8(ROW(Kp, k0, 32 + sr)); } while (0)
#define SWRITE_HK(bf) do { *(bf16x8*)(K_lds + (bf) * SHM_K + kws) = S.st_k0; *(bf16x8*)(K_lds + (bf) * SHM_K + kws + 32 * 256) = S.st_k1; } while (0)
#define SWRITE_HV(bf) do { *(bf16x8*)(V_lds + (bf) * SHM_V + vst0) = S.st_v0; *(bf16x8*)(V_lds + (bf) * SHM_V + vst1) = S.st_v1; } while (0)
#define SWRITE_H(bf) do { SWRITE_HV(bf); SWRITE_HK(bf); } while (0)
__device__ __forceinline__ void prime(const BlockRef& cur, char* lds, Seam& S) {
    int tid = threadIdx.x; asm volatile("" : "+v"(tid));
    const int wid = __builtin_amdgcn_readfirstlane(tid >> 6), lane = tid & 63, r32 = lane & 31, hi = lane >> 5;
    const int sr = tid >> 4, sc = (tid & 15) * 8, kws = KSWZ(sr, sc * 2); char* K_lds = lds + 2 * SHM_V;
    const int kb0 = 0;
    for (int d0 = 0; d0 < 8; ++d0) S.qr[d0] = load8(cur.Q + (unsigned)((wid * QBLK + r32) * LDQ + d0 * 16 + hi * 8));
    SLOAD_H(cur.K, cur.V, kb0); VMW(); SWRITE_HK(0);
    __syncthreads();
}
__device__ __forceinline__ void block(const BlockRef& cur, const BlockRef& nxt, int skv, char* lds, Seam& S) {
    constexpr int W = WBIG;
    int tid = threadIdx.x; asm volatile("" : "+v"(tid));
    const int wid = __builtin_amdgcn_readfirstlane(tid >> 6), lane = tid & 63, r32 = lane & 31, hi = lane >> 5;
    const int j_lo = 0;
    int j_hi = (cur.P0 + QB - 1) / KVBLK + 1; if (j_hi > skv / KVBLK) j_hi = skv / KVBLK;
    const int NT = j_hi - j_lo;
    const int kbn = 0;
    const int qlo = cur.P0 + wid * QBLK, qm = qlo + r32 - 4 * hi;
    char* V_lds = lds; char* K_lds = lds + 2 * SHM_V;
    float* ws = (float*)(lds + 2 * SHM_V + 2 * SHM_K) + wid * 64; float* li_l = ws, * al_l = ws + 32;
    const float* biasb = (const float*)(lds + BIAS_OFF) + 4 * hi;
    float m_reg = -1e30f, l_reg = 0; f32x16 o[4] = {};
    const int sr = tid >> 4, sc = (tid & 15) * 8, vst0 = v_st(sr, sc), vst1 = v_st(32 + sr, sc), kws = KSWZ(sr, sc * 2);
    const int vb0 = (int)(uintptr_t)V_lds + v_rd_base(lane);
    const bf16* Kh = cur.K; const bf16* Vh = cur.V;
#define RESC(a) do { if (__any((a) < 1.f)) { if (hi == 0) al_l[r32] = (a); asm volatile("s_waitcnt lgkmcnt(0)" ::: "memory");              \
                     for (int d_ = 0; d_ < 4; ++d_) for (int r = 0; r < 16; ++r) o[d_][r] *= al_l[crow(r, hi)]; } } while (0)
#define KBASE(t) ((j_lo + (t)) * KVBLK)
#define MASKT(P0_, P1_, t) do { const int kb_ = KBASE(t); if (kb_ + KVBLK - 1 > qlo) mask_tile(P0_, P1_, qm - kb_, (unsigned)W); } while (0)
    constexpr int NQL = 8;
#define SEAM_K0() do { VMWN(NQL); SWRITE_HK(0); SBAR(); } while (0)
    f32x16 pA0, pA1, pB0, pB1; float mnA, mnB, alA, alB; bf16x8 pa0, pa1, pa2, pa3;
    SWRITE_HV(0); SBAR();
    if (NT > 1) { SLOAD_H(Kh, Vh, KBASE(1)); }
    SBAR(); qkt<0>(pA0, pA1, K_lds, biasb + KBASE(0), r32, hi, S.qr);
    MASKT(pA0, pA1, 0); partialSM(pA0, pA1, m_reg, mnA, alA);
    if (NT > 1) { VMW(); SWRITE_H(1); }
    __syncthreads();
#define HALF_STEP(PX0, PX1, mnX, alX, PY0, PY1, alY, t, KB, VB, SB) do {                                                      \
        SBAR(); qkt<KB>(PX0, PX1, K_lds, biasb + KBASE(t), r32, hi, S.qr);                                             \
        finishSM(PY0, PY1, alY, l_reg, pa0, pa1, pa2, pa3); SBAR();                                                           \
        if ((t) + 1 < NT) { SLOAD_H(Kh, Vh, KBASE((t) + 1)); SBAR(); }                                               \
        pv_tile<VB>(o, vb0, pa0, pa1, pa2, pa3); MASKT(PX0, PX1, (t)); partialSM(PX0, PX1, m_reg, mnX, alX);                                        \
        __syncthreads();                                                                                                      \
        if ((t) + 1 < NT) { VMW(); SWRITE_H(SB); }                                                                          \
        RESC(alX); __syncthreads(); } while (0)
    for (int t = 1; t + 1 < NT; t += 2) {
        HALF_STEP(pB0, pB1, mnB, alB, pA0, pA1, alA, t, 1, 0, 0);
        HALF_STEP(pA0, pA1, mnA, alA, pB0, pB1, alB, t + 1, 0, 1, 1);
    }
    const bool even = (NT & 1) == 0;
    if (even) { SBAR(); qkt<1>(pB0, pB1, K_lds, biasb + KBASE(NT - 1), r32, hi, S.qr); SBAR(); }
    SLOAD_H(nxt.K, nxt.V, kbn); SBAR();
#pragma unroll
    for (int d0 = 0; d0 < 8; ++d0) S.qr[d0] = load8(nxt.Q + (unsigned)((wid * QBLK + r32) * LDQ + d0 * 16 + hi * 8));
    SBAR();
    finishSM(pA0, pA1, alA, l_reg, pa0, pa1, pa2, pa3); SBAR();
    pv_tile<0>(o, vb0, pa0, pa1, pa2, pa3);
    if (even) { MASKT(pB0, pB1, NT - 1); partialSM(pB0, pB1, m_reg, mnB, alB); __syncthreads(); RESC(alB);
        finishSM(pB0, pB1, alB, l_reg, pa0, pa1, pa2, pa3); SBAR(); pv_tile<1>(o, vb0, pa0, pa1, pa2, pa3); }
    SBAR(); SEAM_K0();
    if (hi == 0) li_l[r32] = l_reg; asm volatile("s_waitcnt lgkmcnt(0)" ::: "memory");
    float rli[16];
#pragma unroll
    for (int r = 0; r < 16; ++r) rli[r] = __builtin_amdgcn_rcpf(li_l[crow(r, hi)]);
    bf16* Ow = cur.O + (unsigned)(wid * QBLK * LDO);
#pragma unroll
    for (int r = 0; r < 16; ++r) { const int orow = crow(r, hi);
#pragma unroll
        for (int d0 = 0; d0 < 4; ++d0) { const float v = o[d0][r] * rli[r];
            const float vn = __shfl_xor(v, 1);
            if ((r32 & 1) == 0) *(unsigned*)(Ow + (unsigned)(orow * LDO + d0 * 32 + r32)) = cvtpk(v, vn); } }
    __syncthreads();
#undef RESC
#undef KBASE
#undef MASKT
#undef SEAM_K0
#undef HALF_STEP
}
#undef ROW
#undef VMW
#undef VMWN
#undef SLOAD_H
#undef SWRITE_HK
#undef SWRITE_HV
#undef SWRITE_H

__device__ __forceinline__ void build_bias(char* lds, const float* zs_b  , int h) {
    int tid = threadIdx.x; asm volatile("" : "+v"(tid));
    const int lane = tid & 63, wid = tid >> 6;
    float* bias = (float*)(lds + BIAS_OFF); float* wsum = (float*)(lds + SCAN_OFF);
    float loc[9]; float s = 0.f;
#pragma unroll
    for (int k = 0; k < 9; ++k) { const int t = tid * 9 + k; const float x = (t < TT) ? zs_b[(size_t)(PADF + t) * 256 + S_BF + h] : 0.f; s += x; loc[k] = s; }
    float incl = s;
#pragma unroll
    for (int o = 1; o < 64; o <<= 1) { const float y = __shfl_up(incl, o); if (lane >= o) incl += y; }
    if (lane == 63) wsum[wid] = incl;
    __syncthreads();
    float woff = 0.f;
    for (int w = 0; w < wid; ++w) woff += wsum[w];
    const float excl = woff + incl - s;
    constexpr float INVS = 1.0f / SCALE;
#pragma unroll
    for (int k = 0; k < 9; ++k) { const int t = tid * 9 + k; if (t < TT) bias[PADF + t] = -(excl + loc[k]) * INVS; }
    if (tid < PADF) bias[tid] = -__builtin_inff();
    __syncthreads();
}
__device__ __forceinline__ void item(char* lds, const bf16* Z, const float* ZS, bf16* MIX, int it) {
    const int bh = it >> 3, x = it & 7, b = bh / 6, h = bh % 6;
    build_bias(lds, ZS + (size_t)b * TP * 256, h);
    const bf16* zb = Z + (size_t)b * TP * DINP;
    BlockRef b0, b1;
    b0.K = b1.K = zb + C_BK + h * 128; b0.V = b1.V = zb + C_BV + h * 128;
    const int q0 = 64 + 256 * x, q1 = 64 + 256 * (15 - x);
    b0.Q = zb + (size_t)q0 * DINP + C_BQ + h * 128; b1.Q = zb + (size_t)q1 * DINP + C_BQ + h * 128;
    b0.O = MIX + (size_t)(b * TP + q0) * DM + 768 + h * 128; b1.O = MIX + (size_t)(b * TP + q1) * DM + 768 + h * 128;
    b0.P0 = q0; b1.P0 = q1;
    Seam S;
    prime(b0, lds, S);
    block(b0, b1, TP, lds, S);
    block(b1, b1, TP, lds, S);
}
__device__ __forceinline__ void meta_unit(const bf16* Z, const float* ZS, bf16* MIX, int b) {
    int tid = threadIdx.x; asm volatile("" : "+v"(tid));
    const int lane = tid & 63, wid = tid >> 6;
    for (int task = wid; task < 96; task += 8) {
        const int h = task >> 4, m = task & 15;
        const size_t rq = (size_t)b * TP + PADF + m;
        const unsigned qw = *(const unsigned*)(Z + rq * DINP + C_BQ + h * 128 + 2 * lane);
        const float q0 = bflo(qw), q1 = bfhi(qw);
        float lg[16]; float F = 0.f, Fk[16];
#pragma unroll
        for (int k = 0; k < 16; ++k) { F += ZS[((size_t)b * TP + PADF + k) * 256 + S_BF + h]; Fk[k] = F; }
        float Fm = 0.f;
#pragma unroll
        for (int k = 0; k < 16; ++k) if (k == m) Fm = Fk[k];
        float mx = -1e30f;
#pragma unroll
        for (int k = 0; k < 16; ++k) { const size_t rk = (size_t)b * TP + PADF + k;
            const unsigned kw = *(const unsigned*)(Z + rk * DINP + C_BK + h * 128 + 2 * lane);
            const float d = wave_sum(q0 * bflo(kw) + q1 * bfhi(kw));
            lg[k] = (k <= m) ? d * SCALE + Fm - Fk[k] : -__builtin_inff(); mx = fmaxf(mx, lg[k]); }
        float sum = 0.f, o0 = 0.f, o1 = 0.f;
#pragma unroll
        for (int k = 0; k < 16; ++k) { const float p = __expf(lg[k] - mx); sum += p;
            const size_t rk = (size_t)b * TP + PADF + k;
            const unsigned vw = *(const unsigned*)(Z + rk * DINP + C_BV + h * 128 + 2 * lane);
            o0 += p * bflo(vw); o1 += p * bfhi(vw); }
        const float inv = 1.f / sum;
        *(unsigned*)(MIX + rq * DM + 768 + h * 128 + 2 * lane) = cvtpk(o0 * inv, o1 * inv);
    }
}
}

namespace dsa {
constexpr int NQ = 8, SCW = TP;
constexpr int SC_BYTES = NQ * SCW * 4;
constexpr int IDX_OFF = SC_BYTES;
constexpr int LDS_NEED = SC_BYTES + NQ * 256 * 2;
constexpr int KTOP = 256;
__device__ __forceinline__ unsigned sortable(float f) { const unsigned u = __float_as_uint(f); return (u >> 31) ? ~u : (u | 0x80000000u); }
__device__ __forceinline__ unsigned mbcnt(unsigned long long m) { return __builtin_amdgcn_mbcnt_hi((unsigned)(m >> 32), __builtin_amdgcn_mbcnt_lo((unsigned)m, 0u)); }
__device__ __forceinline__ unsigned off_b(unsigned row, unsigned ch) { return 256u * row + 16u * (ch ^ (((row & 3) << 2) | ((row >> 2) & 3))); }

__device__ __forceinline__ void unit(LAS unsigned char* lds, const bf16* Z, const float* ZS, bf16* MIX, int b, int c, int sub) {
    int tid = threadIdx.x; asm volatile("" : "+v"(tid));
    const int lane = tid & 63, wave = __builtin_amdgcn_readfirstlane(tid >> 6), g = lane >> 4, c16 = lane & 15;
    const int v0 = 64 * c + 8 * sub;
    const size_t rb = (size_t)b * TP;
    LAS float* sc = (LAS float*)lds;
    {
        bf16x8 A[NQ][2]; f32x4 wq[NQ];
#pragma unroll
        for (int qi = 0; qi < NQ; ++qi) { const size_t qrow = rb + v0 + qi; const bf16* zq = Z + qrow * DINP + C_IQ + c16 * 64 + 8 * g;
            A[qi][0] = *(const bf16x8*)zq; A[qi][1] = *(const bf16x8*)(zq + 32);
            wq[qi] = *(const f32x4*)(ZS + qrow * 256 + S_IW + 4 * g); }
        const int ntile = 4 * (c + 1);
        for (int t = wave; t < ntile; t += 8) {
            const int key = 16 * t + c16; const bf16* zk = Z + (rb + key) * DINP + C_IK + 8 * g;
            const bf16x8 B0 = *(const bf16x8*)zk, B1 = *(const bf16x8*)(zk + 32);
#pragma unroll
            for (int qi = 0; qi < NQ; ++qi) {
                f32x4 d = __builtin_amdgcn_mfma_f32_16x16x32_bf16(A[qi][0], B0, zero4(), 0, 0, 0);
                d = __builtin_amdgcn_mfma_f32_16x16x32_bf16(A[qi][1], B1, d, 0, 0, 0);
                float s = wq[qi][0] * fmaxf(d[0], 0.f) + wq[qi][1] * fmaxf(d[1], 0.f) + wq[qi][2] * fmaxf(d[2], 0.f) + wq[qi][3] * fmaxf(d[3], 0.f);
                s += __shfl_xor(s, 16); s += __shfl_xor(s, 32);
                if (lane < 16) sc[qi * SCW + key] = (key >= PADF) ? s : -__builtin_inff();
            }
        }
    }
    __syncthreads();
    const int n = 64 * (c + 1), nreal = n - PADF, ngrp = c + 1;
    LAS unsigned short* idx = (LAS unsigned short*)(lds + IDX_OFF) + wave * 256;
    LAS float* myc = sc + wave * SCW;
    int nsel;
    if (nreal <= KTOP) { nsel = nreal; for (int s = lane; s < nsel; s += 64) idx[s] = (unsigned short)(PADF + s); }
    else {
        unsigned key[65];
#pragma unroll
        for (int j = 0; j < 65; ++j) key[j] = (j < ngrp) ? sortable(myc[64 * j + lane]) : 0u;
        unsigned tau = 0u;
        for (int bit = 31; bit >= 0; --bit) {
            const unsigned cand = tau | (1u << bit); int cnt = 0;
#pragma unroll
            for (int j = 0; j < 65; ++j) if (j < ngrp) cnt += __popcll(__ballot(key[j] >= cand));
            if (cnt >= KTOP) tau = cand;
        }
        int cgt = 0;
#pragma unroll
        for (int j = 0; j < 65; ++j) if (j < ngrp) cgt += __popcll(__ballot(key[j] > tau));
        int eq_rem = KTOP - cgt, run = 0;
#pragma unroll
        for (int j = 0; j < 65; ++j) if (j < ngrp) {
            const bool gt = key[j] > tau, eq = key[j] == tau;
            const unsigned long long m_eq = __ballot(eq);
            const bool take = gt || (eq && (int)mbcnt(m_eq) < eq_rem);
            const unsigned long long m = __ballot(take);
            if (take) idx[run + (int)mbcnt(m)] = (unsigned short)(64 * j + lane);
            run += __popcll(m); const int ne = __popcll(m_eq); eq_rem -= (ne < eq_rem) ? ne : eq_rem;
        }
        nsel = KTOP;
    }
    LDS_WAIT();
    {
        const size_t qrow = rb + v0 + wave;
        bf16x8 Bq[4];
#pragma unroll
        for (int kd = 0; kd < 4; ++kd) { Bq[kd] = (bf16x8){0, 0, 0, 0, 0, 0, 0, 0}; if (c16 < 6) Bq[kd] = *(const bf16x8*)(Z + qrow * DINP + C_AQ + c16 * 128 + 32 * kd + 8 * g); }
        f32x4 Dl[8][2];
        const int srow = 8 * (c16 >> 2) + (c16 & 3);
#pragma unroll
        for (int ks = 0; ks < 8; ++ks) {
            int s0 = 32 * ks + srow, s1 = s0 + 4; s0 = s0 < nsel ? s0 : nsel - 1; s1 = s1 < nsel ? s1 : nsel - 1;
            const bf16* ka0 = Z + (rb + idx[s0]) * DINP + C_AK + 8 * g; const bf16* ka1 = Z + (rb + idx[s1]) * DINP + C_AK + 8 * g;
            f32x4 d0 = zero4(), d1 = zero4();
#pragma unroll
            for (int kd = 0; kd < 4; ++kd) { const bf16x8 a0 = *(const bf16x8*)(ka0 + 32 * kd), a1 = *(const bf16x8*)(ka1 + 32 * kd);
                d0 = __builtin_amdgcn_mfma_f32_16x16x32_bf16(a0, Bq[kd], d0, 0, 0, 0); d1 = __builtin_amdgcn_mfma_f32_16x16x32_bf16(a1, Bq[kd], d1, 0, 0, 0); }
            Dl[ks][0] = d0; Dl[ks][1] = d1;
        }
        constexpr float C2 = 0.08838834764831845f * 1.4426950408889634f;
        float mx = -1e30f;
#pragma unroll
        for (int ks = 0; ks < 8; ++ks)
#pragma unroll
            for (int tt = 0; tt < 2; ++tt)
#pragma unroll
                for (int r = 0; r < 4; ++r) { const int slot = 32 * ks + 8 * g + 4 * tt + r; float x = Dl[ks][tt][r] * C2; x = (slot < nsel) ? x : -__builtin_inff(); Dl[ks][tt][r] = x; mx = fmaxf(mx, x); }
        mx = fmaxf(mx, __shfl_xor(mx, 16)); mx = fmaxf(mx, __shfl_xor(mx, 32));
        float sum = 0.f;
#pragma unroll
        for (int ks = 0; ks < 8; ++ks)
#pragma unroll
            for (int tt = 0; tt < 2; ++tt)
#pragma unroll
                for (int r = 0; r < 4; ++r) { const float p = __builtin_amdgcn_exp2f(Dl[ks][tt][r] - mx); Dl[ks][tt][r] = p; sum += p; }
        sum += __shfl_xor(sum, 16); sum += __shfl_xor(sum, 32);
        LAS unsigned char* stg = (LAS unsigned char*)myc;
        const unsigned stg_addr = (unsigned)(uintptr_t)stg;
        f32x4 O[8];
#pragma unroll
        for (int dt = 0; dt < 8; ++dt) O[dt] = zero4();
        const unsigned q4 = (unsigned)c16 >> 2, p4 = (unsigned)c16 & 3;
#pragma unroll
        for (int ks = 0; ks < 8; ++ks) {
#pragma unroll
            for (int i = 0; i < 8; ++i) { const int piece = lane + 64 * i, rowi = piece >> 4, ch = piece & 15; int s = 32 * ks + rowi; s = s < nsel ? s : nsel - 1;
                const u32x4 vv = *(const u32x4*)(Z + (rb + idx[s]) * DINP + C_AV + ch * 8);
                *(LAS u32x4*)(stg + off_b((unsigned)rowi, (unsigned)ch)) = vv; }
            LDS_WAIT();
            u32x4 pw; pw.x = cvtpk(Dl[ks][0][0], Dl[ks][0][1]); pw.y = cvtpk(Dl[ks][0][2], Dl[ks][0][3]); pw.z = cvtpk(Dl[ks][1][0], Dl[ks][1][1]); pw.w = cvtpk(Dl[ks][1][2], Dl[ks][1][3]);
            const bf16x8 Bp = *reinterpret_cast<const bf16x8*>(&pw);
#pragma unroll
            for (int dt = 0; dt < 8; ++dt) {
                s16x4 lo, hi2;
                const unsigned a_lo = stg_addr + off_b(8u * g + q4, 2u * dt + (p4 >> 1)) + 8u * (p4 & 1), a_hi = stg_addr + off_b(8u * g + 4u + q4, 2u * dt + (p4 >> 1)) + 8u * (p4 & 1);
                asm volatile("ds_read_b64_tr_b16 %0, %2\n\tds_read_b64_tr_b16 %1, %3\n\ts_waitcnt lgkmcnt(0)" : "=&v"(lo), "=&v"(hi2) : "v"(a_lo), "v"(a_hi) : "memory");
                const bf16x8 Af = (bf16x8){lo[0], lo[1], lo[2], lo[3], hi2[0], hi2[1], hi2[2], hi2[3]};
                O[dt] = __builtin_amdgcn_mfma_f32_16x16x32_bf16(Af, Bp, O[dt], 0, 0, 0);
            }
        }
        if (c16 < 6) { const float inv = 1.f / sum; bf16* op = MIX + qrow * DM + c16 * 128 + 4 * g;
#pragma unroll
            for (int dt = 0; dt < 8; ++dt) { u32x2 w; w.x = cvtpk(O[dt][0] * inv, O[dt][1] * inv); w.y = cvtpk(O[dt][2] * inv, O[dt][3] * inv); *(u32x2*)(op + 16 * dt) = w; } }
    }
    __syncthreads();
}
}

namespace gla {
constexpr int LDT = 72;
constexpr int L_BL = 0;
constexpr int L_SEG = L_BL + 16384;
constexpr int L_QH = L_SEG + 2048;
constexpr int L_KH = L_QH + 64 * LDT * 2;
constexpr int L_SC = L_KH + 64 * LDT * 2;
constexpr int L_VT = L_SC + 64 * LDT * 2;
constexpr int L_ST = L_VT + 128 * LDT * 2;
constexpr int L_O = L_ST + 128 * LDT * 2;
constexpr int LDS_NEED = L_O + 64 * 132 * 4;
__device__ __forceinline__ bf16x8 ldfrag(const LAS bf16* base, int row, int k0) { return *(const LAS bf16x8*)(base + row * LDT + k0); }

__device__ __forceinline__ void cum_decay(LAS unsigned char* lds, const float* LA, size_t row0, int hd, bool chunk0) {
    int tid = threadIdx.x; asm volatile("" : "+v"(tid));
    const int d = tid & 63, seg = tid >> 6;
    LAS float* bl = (LAS float*)(lds + L_BL); LAS float* sg = (LAS float*)(lds + L_SEG);
    float v[8]; float s = 0.f;
#pragma unroll
    for (int k = 0; k < 8; ++k) { const int i = 8 * seg + k; float x = LA[(row0 + i) * 256 + hd * 64 + d]; if (chunk0 && i < PADF) x = 0.f; s += x; v[k] = s; }
    sg[seg * 64 + d] = s;
    __syncthreads();
    float off = 0.f;
    for (int w = 0; w < seg; ++w) off += sg[w * 64 + d];
#pragma unroll
    for (int k = 0; k < 8; ++k) bl[(8 * seg + k) * 64 + d] = v[k] + off;
    __syncthreads();
}
__device__ __forceinline__ void load_vT(LAS unsigned char* lds, const bf16* Z, size_t row0, int hd) {
    int tid = threadIdx.x; asm volatile("" : "+v"(tid)); LAS bf16* vT = (LAS bf16*)(lds + L_VT);
#pragma unroll
    for (int it = 0; it < 2; ++it) { const int pc = tid + 512 * it, i = pc >> 4, e0 = (pc & 15) * 8;
        const u32x4 w = *(const u32x4*)(Z + (row0 + i) * DINP + C_CV + hd * 128 + e0);
        const unsigned ww[4] = {w.x, w.y, w.z, w.w};
#pragma unroll
        for (int k = 0; k < 4; ++k) { vT[(e0 + 2 * k) * LDT + i] = (bf16)(ww[k] & 0xffffu); vT[(e0 + 2 * k + 1) * LDT + i] = (bf16)(ww[k] >> 16); } }
}
__device__ __forceinline__ void step1(LAS unsigned char* lds, const bf16* Z, const float* LA, float* KV, float* DVEC, int b, int c) {
    int tid = threadIdx.x; asm volatile("" : "+v"(tid));
    const int lane = tid & 63, wave = tid >> 6, g = lane >> 4, c16 = lane & 15;
    const size_t row0 = (size_t)b * TP + 64 * c;
    LAS float* bl = (LAS float*)(lds + L_BL); LAS bf16* kdT = (LAS bf16*)(lds + L_QH); LAS bf16* vT = (LAS bf16*)(lds + L_VT);
    for (int hd = 0; hd < 4; ++hd) {
        cum_decay(lds, LA, row0, hd, c == 0);
        { const int i = tid >> 3, d0 = (tid & 7) * 8;
          const u32x4 w = *(const u32x4*)(Z + (row0 + i) * DINP + C_CK + hd * 64 + d0); const unsigned ww[4] = {w.x, w.y, w.z, w.w};
#pragma unroll
          for (int k = 0; k < 8; ++k) { const int d = d0 + k; const float kk = (k & 1) ? bfhi(ww[k >> 1]) : bflo(ww[k >> 1]);
              kdT[d * LDT + i] = f2bf(kk * __expf(bl[63 * 64 + d] - bl[i * 64 + d])); } }
        load_vT(lds, Z, row0, hd);
        __syncthreads();
        const int bh = b * 4 + hd;
        float* kvp = KV + ((size_t)bh * 65 + c) * 8192;
#pragma unroll
        for (int dt = 0; dt < 4; ++dt) { f32x4 acc = zero4();
#pragma unroll
            for (int ks = 0; ks < 2; ++ks) acc = __builtin_amdgcn_mfma_f32_16x16x32_bf16(ldfrag(kdT, 16 * dt + c16, 32 * ks + 8 * g), ldfrag(vT, 16 * wave + c16, 32 * ks + 8 * g), acc, 0, 0, 0);
#pragma unroll
            for (int r = 0; r < 4; ++r) kvp[(16 * dt + 4 * g + r) * 128 + 16 * wave + c16] = acc[r]; }
        if (tid < 64) DVEC[((size_t)bh * 65 + c) * 64 + tid] = __expf(bl[63 * 64 + tid]);
        __syncthreads();
    }
}
__device__ __forceinline__ void step2(const float* KV, const float* DVEC, float* SS, int u) {
    int tid = threadIdx.x; asm volatile("" : "+v"(tid));
    const int bh = u >> 2, idx = (u & 3) * 2048 + tid * 4, d = idx >> 7;
    f32x4 S = zero4();
    *(f32x4*)(SS + ((size_t)bh * 66) * 8192 + idx) = S;
#pragma unroll 4
    for (int c = 0; c < 64; ++c) {
        const f32x4 kv = *(const f32x4*)(KV + ((size_t)bh * 65 + c) * 8192 + idx); const float dv = DVEC[((size_t)bh * 65 + c) * 64 + d];
        S = S * dv + kv;
        *(f32x4*)(SS + ((size_t)bh * 66 + c + 1) * 8192 + idx) = S;
    }
}
__device__ __forceinline__ void step3(LAS unsigned char* lds, const bf16* Z, const float* LA, const float* SS, const float* gon, bf16* MIX, int b, int c) {
    int tid = threadIdx.x; asm volatile("" : "+v"(tid));
    const int lane = tid & 63, wave = tid >> 6, g = lane >> 4, c16 = lane & 15;
    const size_t row0 = (size_t)b * TP + 64 * c;
    LAS float* bl = (LAS float*)(lds + L_BL); LAS bf16* qh = (LAS bf16*)(lds + L_QH); LAS bf16* kh = (LAS bf16*)(lds + L_KH); LAS bf16* scb = (LAS bf16*)(lds + L_SC);
    LAS bf16* vT = (LAS bf16*)(lds + L_VT); LAS bf16* sT = (LAS bf16*)(lds + L_ST); LAS float* ol = (LAS float*)(lds + L_O);
    for (int hd = 0; hd < 4; ++hd) {
        const int bh = b * 4 + hd;
        cum_decay(lds, LA, row0, hd, c == 0);
        { const int i = tid >> 3, d0 = (tid & 7) * 8;
          const u32x4 wq = *(const u32x4*)(Z + (row0 + i) * DINP + C_CQ + hd * 64 + d0), wk = *(const u32x4*)(Z + (row0 + i) * DINP + C_CK + hd * 64 + d0);
          const unsigned q4[4] = {wq.x, wq.y, wq.z, wq.w}, k4[4] = {wk.x, wk.y, wk.z, wk.w};
          unsigned oq[4], ok[4];
#pragma unroll
          for (int k = 0; k < 4; ++k) { const float b0 = bl[i * 64 + d0 + 2 * k], b1 = bl[i * 64 + d0 + 2 * k + 1];
              oq[k] = cvtpk(bflo(q4[k]) * 0.125f * __expf(b0), bfhi(q4[k]) * 0.125f * __expf(b1));
              ok[k] = cvtpk(bflo(k4[k]) * __expf(-b0), bfhi(k4[k]) * __expf(-b1)); }
          *(LAS u32x4*)(qh + i * LDT + d0) = (u32x4){oq[0], oq[1], oq[2], oq[3]};
          *(LAS u32x4*)(kh + i * LDT + d0) = (u32x4){ok[0], ok[1], ok[2], ok[3]}; }
        load_vT(lds, Z, row0, hd);
        { const float* sp = SS + ((size_t)bh * 66 + c) * 8192;
#pragma unroll
          for (int it = 0; it < 4; ++it) { const int pc = tid + 512 * it, d = pc >> 5, e0 = (pc & 31) * 4; const f32x4 s4 = *(const f32x4*)(sp + d * 128 + e0);
#pragma unroll
              for (int k = 0; k < 4; ++k) sT[(e0 + k) * LDT + d] = f2bf(s4[k]); } }
        __syncthreads();
        { const int it = wave & 3;
#pragma unroll
          for (int jj = 0; jj < 2; ++jj) { const int jt = 2 * (wave >> 2) + jj; f32x4 acc = zero4();
              if (jt <= it) {
#pragma unroll
                  for (int ks = 0; ks < 2; ++ks) acc = __builtin_amdgcn_mfma_f32_16x16x32_bf16(ldfrag(qh, 16 * it + c16, 32 * ks + 8 * g), ldfrag(kh, 16 * jt + c16, 32 * ks + 8 * g), acc, 0, 0, 0); }
#pragma unroll
              for (int r = 0; r < 4; ++r) { const int i = 16 * it + 4 * g + r, j = 16 * jt + c16; scb[i * LDT + j] = f2bf((j <= i) ? acc[r] : 0.f); } } }
        __syncthreads();
#pragma unroll
        for (int it = 0; it < 4; ++it) { f32x4 acc = zero4();
#pragma unroll
            for (int ks = 0; ks < 2; ++ks) acc = __builtin_amdgcn_mfma_f32_16x16x32_bf16(ldfrag(scb, 16 * it + c16, 32 * ks + 8 * g), ldfrag(vT, 16 * wave + c16, 32 * ks + 8 * g), acc, 0, 0, 0);
#pragma unroll
            for (int ks = 0; ks < 2; ++ks) acc = __builtin_amdgcn_mfma_f32_16x16x32_bf16(ldfrag(qh, 16 * it + c16, 32 * ks + 8 * g), ldfrag(sT, 16 * wave + c16, 32 * ks + 8 * g), acc, 0, 0, 0);
#pragma unroll
            for (int r = 0; r < 4; ++r) ol[(16 * it + 4 * g + r) * 132 + 16 * wave + c16] = acc[r]; }
        __syncthreads();
#pragma unroll
        for (int k = 0; k < 8; ++k) { const int i = 8 * wave + k; const float x0 = ol[i * 132 + 2 * lane], x1 = ol[i * 132 + 2 * lane + 1];
            const float ss = wave_sum(x0 * x0 + x1 * x1); const float rstd = 1.0f / sqrtf(ss * (1.f / 128.f) + EPS);
            if (!(c == 0 && i < PADF)) { const unsigned gw = *(const unsigned*)(Z + (row0 + i) * DINP + C_CG + hd * 128 + 2 * lane);
                const float y0 = x0 * rstd * gon[2 * lane] * siluf(bflo(gw)), y1 = x1 * rstd * gon[2 * lane + 1] * siluf(bfhi(gw));
                *(unsigned*)(MIX + (row0 + i) * DM + 1536 + hd * 128 + 2 * lane) = cvtpk(y0, y1); } }
        __syncthreads();
    }
}
}

struct Frame {
    LAS unsigned char* lds; char* ldsg;
    int tid, lane, wave, G, bid;
};
constexpr int PTAB_OFF = LDSCTL_OFF + 1024, P_OUT = 21, P_WS = 22;
__device__ __forceinline__ unsigned char* gptr(const Frame& F, int k) {
    const LAS unsigned* t = (const LAS unsigned*)(F.lds + PTAB_OFF) + 2 * k;
    const unsigned lo = __builtin_amdgcn_readfirstlane(t[0]), hi = __builtin_amdgcn_readfirstlane(t[1]);
    return (unsigned char*)(((unsigned long long)hi << 32) | lo);
}
#define WS() gptr(F, P_WS)
#define INP(k) ((const float*)gptr(F, (k)))
#define CTL() ((unsigned*)(gptr(F, P_WS) + WS_CTL))
__device__ __forceinline__ int inmap(int n) {
    if (n < 2048) return n;
    if (n < 2112) return C_IK + (n - 2048);
    if (n < 2128) return C_IK + S_IW + (n - 2112);
    if (n < 4432) return C_BQ + (n - 2128);
    if (n < 4438) return C_IK + S_BF + (n - 4432);
    if (n < 4950) return C_CQ + (n - 4438);
    if (n < 5462) return C_CV + (n - 4950);
    if (n < 5478) return C_IK + S_CR + (n - 5462);
    return C_CG + (n - 5478);
}
template <int MAP>
__device__ __forceinline__ void transpose_item(const float* W, int K, int N, bf16* WT, LAS float* scr, int item, int lane) {
    const int nblk = (N + 31) / 32, kb = item / nblk, nb = item % nblk, k0 = 64 * kb, n0 = 32 * nb;
    const int nl = n0 + (lane & 31);
#pragma unroll 8
    for (int i = 0; i < 32; ++i) { const int kk = 2 * i + (lane >> 5); scr[kk * 33 + (lane & 31)] = (nl < N) ? W[(size_t)(k0 + kk) * N + nl] : 0.f; }
    LDS_WAIT(); asm volatile("" ::: "memory");
    const int c = lane & 7;
#pragma unroll
    for (int j = 0; j < 4; ++j) { const int n = (lane >> 3) + 8 * j; const LAS float* s = scr + (8 * c) * 33 + n;
        u32x4 o; o.x = cvtpk(s[0 * 33], s[1 * 33]); o.y = cvtpk(s[2 * 33], s[3 * 33]); o.z = cvtpk(s[4 * 33], s[5 * 33]); o.w = cvtpk(s[6 * 33], s[7 * 33]);
        const int ng = n0 + n;
        if (ng < N) { int row = ng; if (MAP == 1) row = inmap(ng); if (MAP == 2) row = 8 * (ng >> 2) + (ng & 3); if (MAP == 3) row = 8 * (ng >> 2) + 4 + (ng & 3);
            *(u32x4*)(WT + (size_t)row * K + k0 + 8 * c) = o; } }
    LDS_WAIT(); asm volatile("" ::: "memory");
}
__device__ __forceinline__ void sincos_d(double ang, float& c, float& s) {
    const double q = __builtin_rint(ang * 0.63661977236758134308);
    double r = __builtin_fma(-q, 1.5707963267948966, ang); r = __builtin_fma(-q, 6.123233995736766e-17, r);
    const double r2 = r * r;
    const double sp = r + r * r2 * (-1.0 / 6 + r2 * (1.0 / 120 + r2 * (-1.0 / 5040 + r2 * (1.0 / 362880 + r2 * (-1.0 / 39916800 + r2 * (1.0 / 6227020800.0))))));
    const double cp = 1.0 + r2 * (-0.5 + r2 * (1.0 / 24 + r2 * (-1.0 / 720 + r2 * (1.0 / 40320 + r2 * (-1.0 / 3628800 + r2 * (1.0 / 479001600.0))))));
    const int n = (int)((long long)q & 3);
    const double sv = (n == 0) ? sp : (n == 1) ? cp : (n == 2) ? -sp : -cp;
    const double cv = (n == 0) ? cp : (n == 1) ? -sp : (n == 2) ? -cp : sp;
    c = (float)cv; s = (float)sv;
}
__device__ __forceinline__ void p_prologue(Frame& F, const float* w_in, const float* w_out, const float* e_w1, const float* e_w3, const float* e_w2, const float* rgw, const float* rew, const float* g2) {
    int htid = threadIdx.x; asm volatile("" : "+v"(htid)); const int h_lane = htid & 63, h_wave = __builtin_amdgcn_readfirstlane(htid >> 6);
    LAS float* scr = (LAS float*)(F.lds + h_wave * 16384);
    const int gw = F.bid * 8 + h_wave, NGW = F.G * 8;
    unsigned char* ws = WS();
    constexpr int I_IN = 32 * 188, I_OUT = 32 * 64, I_W1 = NEXP * 32 * 16, I_W2 = NEXP * 8 * 64, I_L = I_IN + I_OUT + 2 * I_W1 + I_W2;
    for (int it = gw; it < DEPTH * I_L; it += NGW) {
        const int l = it / I_L; int r = it % I_L;
        if (r < I_IN) { transpose_item<1>(w_in + (size_t)l * DM * DIN, DM, DIN, (bf16*)(ws + WS_WIN + l * SZ_WIN), scr, r, h_lane); continue; } r -= I_IN;
        if (r < I_OUT) { transpose_item<0>(w_out + (size_t)l * DM * DM, DM, DM, (bf16*)(ws + WS_WOUT + l * SZ_WOUT), scr, r, h_lane); continue; } r -= I_OUT;
        if (r < I_W1) { const int e = r / 512; transpose_item<2>(e_w1 + ((size_t)l * NEXP + e) * DM * DEXP, DM, DEXP, (bf16*)(ws + WS_W13 + l * SZ_W13 + e * SZ_W13E), scr, r % 512, h_lane); continue; } r -= I_W1;
        if (r < I_W1) { const int e = r / 512; transpose_item<3>(e_w3 + ((size_t)l * NEXP + e) * DM * DEXP, DM, DEXP, (bf16*)(ws + WS_W13 + l * SZ_W13 + e * SZ_W13E), scr, r % 512, h_lane); continue; } r -= I_W1;
        { const int e = r / 512; transpose_item<0>(e_w2 + ((size_t)l * NEXP + e) * DEXP * DM, DEXP, DM, (bf16*)(ws + WS_W2 + l * SZ_W2 + e * SZ_W2E), scr, r % 512, h_lane); }
    }
    const int gt = F.bid * 512 + htid, NGT = F.G * 512;
    for (int i = gt; i < DEPTH * 154 * (DM / 8); i += NGT) { const int l = i / (154 * 256), rr = (i / 256) % 154, ch = i % 256;
        *(u32x4*)((bf16*)(ws + WS_WIN + l * SZ_WIN) + (size_t)(DIN + rr) * DM + ch * 8) = (u32x4){0u, 0u, 0u, 0u}; }
    for (int i = gt; i < TT * 64; i += NGT) { const int t = i >> 6, k = i & 63; double inv = 1.0; for (int j = 0; j < k; ++j) inv *= 0.86596432336006535;
        float c, s; sincos_d((double)t * inv, c, s); ((float*)(ws + WS_COS128))[i] = c; ((float*)(ws + WS_SIN128))[i] = s; }
    for (int i = gt; i < TT * 32; i += NGT) { const int t = i >> 5, k = i & 31; double inv = 1.0; for (int j = 0; j < k; ++j) inv *= 0.74989420933245583;
        float c, s; sincos_d((double)t * inv, c, s); ((float*)(ws + WS_COS64))[i] = c; ((float*)(ws + WS_SIN64))[i] = s; }
    for (int i = gt; i < NB * PADF * (DM / 8); i += NGT) { const int b = i / (PADF * 256), rr = (i / 256) % PADF, ch = i % 256; const size_t row = (size_t)b * TP + rr;
        *(u32x4*)((bf16*)(ws + WS_U) + row * DM + ch * 8) = (u32x4){0u, 0u, 0u, 0u}; *(u32x4*)((bf16*)(ws + WS_MIX) + row * DM + ch * 8) = (u32x4){0u, 0u, 0u, 0u}; }
    for (int i = gt; i < NB * PADF * 64; i += NGT) { const int b = i / (PADF * 64), rr = (i / 64) % PADF, ch = i % 64; const size_t row = (size_t)b * TP + rr;
        *(f32x4*)((float*)(ws + WS_LA) + row * 256 + ch * 4) = zero4(); }
    for (int i = gt; i < DEPTH * 48 * DM; i += NGT) { const int l = i / (48 * DM), n = (i / DM) % 48, k = i % DM;
        float w = 0.f; if (n < 4) w = rgw[((size_t)l * DM + k) * 4 + n]; else if (n < 36) w = rew[((size_t)l * DM + k) * 32 + (n - 4)];
        w *= g2[(size_t)l * DM + k];
        const bf16 hi = f2bf(w); const bf16 lo = f2bf(w - bf2f(hi));
        bf16* wr = (bf16*)(ws + WS_WR + l * SZ_WR); wr[(size_t)n * DM + k] = hi; wr[(size_t)(48 + n) * DM + k] = lo; }
}
__device__ __forceinline__ void p_norm1(Frame& F, int l, const float* xin, const float* meta, const float* gain) {
    int htid = threadIdx.x; asm volatile("" : "+v"(htid)); const int h_lane = htid & 63, h_wave = __builtin_amdgcn_readfirstlane(htid >> 6);
    const int gw = F.bid * 8 + h_wave, NGW = F.G * 8, lane = h_lane;
    float* H = (float*)(WS() + WS_H); bf16* U = (bf16*)(WS() + WS_U); const bf16* Y0 = (const bf16*)(WS() + WS_Y0); const bf16* Y1 = (const bf16*)(WS() + WS_Y1);
    for (int row = gw; row < R; row += NGW) {
        const int b = row / TP, v = row % TP;
        float* hr = H + (size_t)row * DM;
        if (v < PADF) { if (l == 0) {
#pragma unroll
                for (int j = 0; j < 8; ++j) *(f32x4*)(hr + 4 * (lane + 64 * j)) = zero4(); }
            continue; }
        const int t = v - PADF;
        f32x4 x[8]; float ss = 0.f;
#pragma unroll
        for (int j = 0; j < 8; ++j) { const int col = 4 * (lane + 64 * j);
            if (l == 0) { const float* src = (t < NMETA) ? meta + (size_t)t * DM : xin + ((size_t)b * SEQ + (t - NMETA)) * DM; x[j] = *(const f32x4*)(src + col); }
            else { x[j] = *(const f32x4*)(hr + col); const u32x2 a = *(const u32x2*)(Y0 + (size_t)row * DM + col), c = *(const u32x2*)(Y1 + (size_t)row * DM + col);
                x[j][0] += bflo(a.x) + bflo(c.x); x[j][1] += bfhi(a.x) + bfhi(c.x); x[j][2] += bflo(a.y) + bflo(c.y); x[j][3] += bfhi(a.y) + bfhi(c.y); }
            *(f32x4*)(hr + col) = x[j];
            ss += x[j][0] * x[j][0] + x[j][1] * x[j][1] + x[j][2] * x[j][2] + x[j][3] * x[j][3]; }
        ss = wave_sum(ss); const float rstd = 1.0f / sqrtf(ss * (1.f / DM) + EPS);
#pragma unroll
        for (int j = 0; j < 8; ++j) { const int col = 4 * (lane + 64 * j); const f32x4 gg = *(const f32x4*)(gain + col);
            u32x2 w; w.x = cvtpk(x[j][0] * rstd * gg[0], x[j][1] * rstd * gg[1]); w.y = cvtpk(x[j][2] * rstd * gg[2], x[j][3] * rstd * gg[3]);
            *(u32x2*)(U + (size_t)row * DM + col) = w; }
    }
}
__device__ __forceinline__ void p_final(Frame& F) {
    int htid = threadIdx.x; asm volatile("" : "+v"(htid)); const int h_lane = htid & 63, h_wave = __builtin_amdgcn_readfirstlane(htid >> 6);
    const int gw = F.bid * 8 + h_wave, NGW = F.G * 8, lane = h_lane;
    const float* H = (const float*)(WS() + WS_H); const bf16* Y0 = (const bf16*)(WS() + WS_Y0); const bf16* Y1 = (const bf16*)(WS() + WS_Y1);
    for (int o = gw; o < NB * SEQ; o += NGW) { const int b = o / SEQ, i = o % SEQ; const size_t row = (size_t)b * TP + PADF + NMETA + i;
#pragma unroll
        for (int j = 0; j < 8; ++j) { const int col = 4 * (lane + 64 * j); f32x4 x = *(const f32x4*)(H + row * DM + col);
            const u32x2 a = *(const u32x2*)(Y0 + row * DM + col), c = *(const u32x2*)(Y1 + row * DM + col);
            x[0] += bflo(a.x) + bflo(c.x); x[1] += bfhi(a.x) + bfhi(c.x); x[2] += bflo(a.y) + bflo(c.y); x[3] += bfhi(a.y) + bfhi(c.y);
            *(f32x4*)(((float*)gptr(F, P_OUT)) + (size_t)o * DM + col) = x; } }
}
__device__ __forceinline__ void unpack8(const u32x4 w, float (&x)[8]) { x[0] = bflo(w.x); x[1] = bfhi(w.x); x[2] = bflo(w.y); x[3] = bfhi(w.y); x[4] = bflo(w.z); x[5] = bfhi(w.z); x[6] = bflo(w.w); x[7] = bfhi(w.w); }
__device__ __forceinline__ u32x4 pack8f(const float (&x)[8]) { u32x4 w; w.x = cvtpk(x[0], x[1]); w.y = cvtpk(x[2], x[3]); w.z = cvtpk(x[4], x[5]); w.w = cvtpk(x[6], x[7]); return w; }
__device__ __forceinline__ void head128(bf16* p, const float* gain, bool rope, bool store, const float* cs, const float* sn, int lane) {
    const int c16 = lane & 15;
    float x[8]; unpack8(*(const u32x4*)p, x);
    float ss = 0.f;
#pragma unroll
    for (int e = 0; e < 8; ++e) ss += x[e] * x[e];
    ss += __shfl_xor(ss, 1); ss += __shfl_xor(ss, 2); ss += __shfl_xor(ss, 4); ss += __shfl_xor(ss, 8);
    const float rstd = 1.0f / sqrtf(ss * (1.f / 128.f) + EPS);
#pragma unroll
    for (int e = 0; e < 8; ++e) x[e] = x[e] * rstd * gain[8 * c16 + e];
    const int i0 = 8 * (c16 & 7);
#pragma unroll
    for (int e = 0; e < 8; ++e) { const float pr = __shfl_xor(x[e], 8); const float c = cs[i0 + e], s = sn[i0 + e];
        const float y = (c16 < 8) ? x[e] * c - pr * s : x[e] * c + pr * s; if (rope) x[e] = y; }
    if (store) *(u32x4*)p = pack8f(x);
}
struct PostP { const float *gaq, *gak, *gbq, *gbk, *fbias, *w2, *gb; };
__device__ __forceinline__ void post_row(Frame& F, const PostP& pp, int row) {
    int htid = threadIdx.x; asm volatile("" : "+v"(htid)); const int h_lane = htid & 63, h_wave = __builtin_amdgcn_readfirstlane(htid >> 6);
    const int lane = h_lane, v = row % TP;
    if (v < PADF) return;
    const int t = v - PADF;
    bf16* zr = (bf16*)(WS() + WS_Z) + (size_t)row * DINP; float* zs = (float*)(WS() + WS_ZS) + (size_t)row * 256;
    const float* c128 = (const float*)(WS() + WS_COS128) + t * 64; const float* s128 = (const float*)(WS() + WS_SIN128) + t * 64;
    const float* c64 = (const float*)(WS() + WS_COS64) + t * 32; const float* s64 = (const float*)(WS() + WS_SIN64) + t * 32;
    const float* gaq = pp.gaq; const float* gak = pp.gak; const float* gbq = pp.gbq; const float* gbk = pp.gbk;
    head128(zr + 8 * lane, gaq, true, true, c128, s128, lane);
    head128(zr + 512 + 8 * lane, lane < 32 ? gaq : gak, true, lane < 48, c128, s128, lane);
#pragma unroll
    for (int j = 0; j < 2; ++j) { bf16* p = zr + C_IQ + 512 * j + 8 * lane; float x[8]; unpack8(*(const u32x4*)p, x); const int i0 = 8 * (lane & 3);
#pragma unroll
        for (int e = 0; e < 8; ++e) { const float pr = __shfl_xor(x[e], 4); const float c = c64[i0 + e], s = s64[i0 + e]; x[e] = (lane & 4) ? x[e] * c + pr * s : x[e] * c - pr * s; }
        *(u32x4*)p = pack8f(x); }
    head128(zr + C_BQ + 8 * lane, gbq, false, true, c128, s128, lane);
    head128(zr + C_BQ + 512 + 8 * lane, lane < 32 ? gbq : gbk, false, true, c128, s128, lane);
    head128(zr + C_BQ + 1024 + 8 * lane, gbk, false, true, c128, s128, lane);
    { const float x = zs[S_IK + lane]; const float pr = __shfl_xor(x, 32); const int i = lane & 31; const float c = c64[i], s = s64[i];
      const float y = (lane < 32) ? x * c - pr * s : x * c + pr * s; const float yn = __shfl_xor(y, 1);
      if ((lane & 1) == 0) *(unsigned*)(zr + C_IK + lane) = cvtpk(y, yn); }
    const float iwv = (lane < 16) ? zs[S_IW + lane] * 0.03125f : 0.f;
    const float lf = (lane < 6) ? logsigmoidf(zs[S_BF + lane] + pp.fbias[lane]) : 0.f;
    float cr[16];
#pragma unroll
    for (int r = 0; r < 16; ++r) cr[r] = zs[S_CR + r];
    const float* w2 = pp.w2; const float* gb = pp.gb; float* la = (float*)(WS() + WS_LA) + (size_t)row * 256;
#pragma unroll
    for (int i = 0; i < 4; ++i) { const int n = lane + 64 * i; float a = gb[n];
#pragma unroll
        for (int r = 0; r < 16; ++r) a += cr[r] * w2[r * 256 + n];
        la[n] = logsigmoidf(a) * (1.f / 16.f); }
    if (lane < 16) zs[S_IW + lane] = iwv;
    if (lane < 6) zs[S_BF + lane] = lf;
}
constexpr int N2_LOGIT = 0, N2_RSTD = 64 * 48 * 4;
__device__ __forceinline__ void norm2_tile(Frame& F, int l, int tile, const float* gain, const float* bg, const float* be) {
    int htid = threadIdx.x; asm volatile("" : "+v"(htid)); const int h_lane = htid & 63, h_wave = __builtin_amdgcn_readfirstlane(htid >> 6);
    const int lane = h_lane, wave = h_wave, g = lane >> 4, c16 = lane & 15;
    const size_t row0 = (size_t)tile * 64;
    const float* H = (const float*)(WS() + WS_H); bf16* U = (bf16*)(WS() + WS_U);
    LAS float* lg = (LAS float*)(F.lds + N2_LOGIT); LAS float* rs = (LAS float*)(F.lds + N2_RSTD);
#pragma unroll 1
    for (int k = 0; k < 8; ++k) { const size_t row = row0 + 8 * wave + k; const int v = (int)(row % TP);
        if (v < PADF) { if (lane == 0) rs[8 * wave + k] = 0.f; continue; }
        f32x4 x[8]; float ss = 0.f;
#pragma unroll
        for (int j = 0; j < 8; ++j) { x[j] = *(const f32x4*)(H + row * DM + 4 * (lane + 64 * j)); ss += x[j][0] * x[j][0] + x[j][1] * x[j][1] + x[j][2] * x[j][2] + x[j][3] * x[j][3]; }
        ss = wave_sum(ss); const float rstd = 1.0f / sqrtf(ss * (1.f / DM) + EPS);
        if (lane == 0) rs[8 * wave + k] = rstd;
#pragma unroll
        for (int j = 0; j < 8; ++j) { const int col = 4 * (lane + 64 * j); const f32x4 gg = *(const f32x4*)(gain + col);
            u32x2 w; w.x = cvtpk(x[j][0] * rstd * gg[0], x[j][1] * rstd * gg[1]); w.y = cvtpk(x[j][2] * rstd * gg[2], x[j][3] * rstd * gg[3]);
            *(u32x2*)(U + row * DM + col) = w; } }
    if (wave < 4) {
        const bf16* wr = (const bf16*)(WS() + WS_WR + l * SZ_WR);
        f32x4 acc[3] = {zero4(), zero4(), zero4()};
        const float* hrow = H + (row0 + 16 * wave + c16) * DM + 8 * g;
#pragma unroll 2
        for (int ks = 0; ks < 64; ++ks) {
            const f32x4 a = *(const f32x4*)(hrow + 32 * ks), b = *(const f32x4*)(hrow + 32 * ks + 4);
            u32x4 hw; hw.x = cvtpk(a[0], a[1]); hw.y = cvtpk(a[2], a[3]); hw.z = cvtpk(b[0], b[1]); hw.w = cvtpk(b[2], b[3]);
            u32x4 lw; lw.x = cvtpk(a[0] - bflo(hw.x), a[1] - bfhi(hw.x)); lw.y = cvtpk(a[2] - bflo(hw.y), a[3] - bfhi(hw.y));
            lw.z = cvtpk(b[0] - bflo(hw.z), b[1] - bfhi(hw.z)); lw.w = cvtpk(b[2] - bflo(hw.w), b[3] - bfhi(hw.w));
            const bf16x8 Ah = *reinterpret_cast<const bf16x8*>(&hw), Al = *reinterpret_cast<const bf16x8*>(&lw);
#pragma unroll
            for (int ct = 0; ct < 3; ++ct) { const bf16* wp = wr + (size_t)(16 * ct + c16) * DM + 32 * ks + 8 * g;
                const bf16x8 Bh = *(const bf16x8*)wp, Bl = *(const bf16x8*)(wp + (size_t)48 * DM);
                acc[ct] = __builtin_amdgcn_mfma_f32_16x16x32_bf16(Ah, Bh, acc[ct], 0, 0, 0);
                acc[ct] = __builtin_amdgcn_mfma_f32_16x16x32_bf16(Ah, Bl, acc[ct], 0, 0, 0);
                acc[ct] = __builtin_amdgcn_mfma_f32_16x16x32_bf16(Al, Bh, acc[ct], 0, 0, 0); } }
#pragma unroll
        for (int ct = 0; ct < 3; ++ct)
#pragma unroll
            for (int r = 0; r < 4; ++r) lg[(16 * wave + 4 * g + r) * 48 + 16 * ct + c16] = acc[ct][r];
    }
    __syncthreads();
    if (htid < 64) { const size_t row = row0 + htid; const int v = (int)(row % TP);
        if (v >= PADF) {
            const float rstd = rs[htid];
            float gl[4]; int gi = 0; float gm = -1e30f;
#pragma unroll
            for (int j = 0; j < 4; ++j) { gl[j] = lg[htid * 48 + j] * rstd + bg[j]; if (gl[j] > gm) { gm = gl[j]; gi = j; } }
            float gs = 0.f;
#pragma unroll
            for (int j = 0; j < 4; ++j) gs += expf(gl[j] - gm);
            const float gp = 1.f / gs;
            float el[8]; int e0 = 0, e1 = 0; float m0 = -1e30f, m1 = -1e30f;
#pragma unroll
            for (int j = 0; j < 8; ++j) { float x = 0.f;
#pragma unroll
                for (int q = 0; q < 4; ++q) if (q == gi) x = lg[htid * 48 + 4 + 8 * q + j] * rstd + be[8 * q + j];
                el[j] = x; }
#pragma unroll
            for (int j = 0; j < 8; ++j) { if (el[j] > m0) { m1 = m0; e1 = e0; m0 = el[j]; e0 = j; } else if (el[j] > m1) { m1 = el[j]; e1 = j; } }
            const float w1r = expf(m1 - m0); const float p0 = 1.f / (1.f + w1r), p1 = w1r / (1.f + w1r);
            unsigned* cnt = CTL() + CW_CNT + 64 * l; unsigned* list = (unsigned*)(WS() + WS_LIST); float* gate = (float*)(WS() + WS_GATE);
            const int x0 = gi * 8 + e0, x1 = gi * 8 + e1;
            const unsigned i0 = atomicAdd(cnt + x0, 1u), i1 = atomicAdd(cnt + x1, 1u);
            list[(size_t)x0 * R + i0] = (unsigned)row * 2u; list[(size_t)x1 * R + i1] = (unsigned)row * 2u + 1u;
            gate[row * 2] = gp * p0; gate[row * 2 + 1] = gp * p1;
        } }
    __syncthreads();
}
__device__ __forceinline__ void build_moetab(Frame& F, int l) {
    int htid = threadIdx.x; asm volatile("" : "+v"(htid)); const int h_lane = htid & 63, h_wave = __builtin_amdgcn_readfirstlane(htid >> 6);
    LAS pg8::MoeTab* tab = (LAS pg8::MoeTab*)(F.lds + MOETAB_OFF);
    if (htid == 0) { int t = 0; const unsigned* cnt = CTL() + CW_CNT + 64 * l;
        for (int e = 0; e < NEXP; ++e) { const int n = (int)__hip_atomic_load(cnt + e, __ATOMIC_RELAXED, __HIP_MEMORY_SCOPE_AGENT); tab->cnt[e] = n;
            for (int j = 0; j * 256 < n && t < 176; ++j) { tab->e[t] = e; tab->r0[t] = j * 256; ++t; } }
        tab->ntiles = t; }
    __syncthreads();
}

#define INPARG(i) args_in_dyn(args, (i))
constexpr int NPH = 2 + 9 * DEPTH;
struct Args { const float* in[21]; float* out; unsigned char* ws; int ph_lo, ph_hi; };
__device__ __forceinline__ const float* args_in_dyn(const Args& a, int i) { const float* p = a.in[0];
#pragma unroll
    for (int k = 1; k < 21; ++k) p = (i == k) ? a.in[k] : p;
    return p; }
__global__ void __launch_bounds__(512, 2) fwd_kernel(Args args) {
    extern __shared__ __attribute__((aligned(16))) unsigned char lds_raw[];
    Frame F;
    F.lds = (LAS unsigned char*)lds_raw; F.ldsg = (char*)lds_raw;
    F.tid = threadIdx.x; F.lane = F.tid & 63; F.wave = __builtin_amdgcn_readfirstlane(F.tid >> 6);
    F.G = gridDim.x; F.bid = blockIdx.x;
    if (F.tid < 23) { const unsigned long long v = (F.tid < 21) ? (unsigned long long)INPARG(F.tid) : (F.tid == 21 ? (unsigned long long)args.out : (unsigned long long)args.ws);
        LAS unsigned* t = (LAS unsigned*)(F.lds + PTAB_OFF) + 2 * F.tid; t[0] = (unsigned)v; t[1] = (unsigned)(v >> 32); }
    volatile LAS unsigned* MISC = (volatile LAS unsigned*)(F.lds + MISC_OFF);
    for (int u = F.tid; u < 256; u += 512) ((LAS unsigned*)(F.lds + LDSCTL_OFF))[u] = 0u;
    __syncthreads();
    const int lo = args.ph_lo, hi = args.ph_hi;
    const bool multi = (hi - lo) > 1;
    XcdBarrier bar; bar.bar = (unsigned*)(CTL() + CW_BAR); bar.x = 0; bar.st = nullptr;
    if (multi) bar = xcd_barrier_post((unsigned*)(CTL() + CW_BAR), MISC + 8);
#ifndef PHM
#define PHM 0xFFFF
#endif
#define IN(k) (lo <= (k) && (k) < hi)
#define SEAM(k) do { if (IN(k) && IN((k) + 1)) xcd_barrier(bar); } while (0)
#define Z ((bf16*)(WS() + WS_Z))
#define ZS ((float*)(WS() + WS_ZS))
#define MIX ((bf16*)(WS() + WS_MIX))
#define U ((bf16*)(WS() + WS_U))
#define LA ((float*)(WS() + WS_LA))
#define KV ((float*)(WS() + WS_KV))
#define DVEC ((float*)(WS() + WS_DVEC))
#define SS ((float*)(WS() + WS_SS))

    if (IN(0) && (PHM & 1)) { p_prologue(F, INP(4), INP(13), INP(18), INP(19), INP(20), INP(14), INP(16), INP(3)); } SEAM(0);

    for (int l = 0; l < DEPTH; ++l) {
        const int pb = 1 + 9 * l;
        if (IN(pb + 0) && (PHM & 2)) { p_norm1(F, l, INP(0), INP(1), INP(2) + (size_t)l * DM); } SEAM(pb + 0);
        if (IN(pb + 1) && (PHM & 4)) {
            pg8::DenseProb P; P.init(U, WS() + WS_WIN + l * SZ_WIN, R, DINP, DM, F.G, F.bid);
            pg8::EpiInProj E{Z, ZS};
            pg8::gemm_phase(F.lds, P, E);
        } SEAM(pb + 1);
        if (IN(pb + 2) && (PHM & 8)) {
            PostP pp{INP(5) + l * 128, INP(6) + l * 128, INP(7) + l * 128, INP(8) + l * 128, INP(9) + l * 6, INP(10) + (size_t)l * 16 * 256, INP(11) + l * 256};
            for (int tile = F.bid; tile < R / 64; tile += F.G) {
#pragma unroll 1
                for (int k = 0; k < 8; ++k) post_row(F, pp, tile * 64 + 8 * __builtin_amdgcn_readfirstlane((int)(threadIdx.x >> 6)) + k);
                VM_WAIT(); __syncthreads();
                gla::step1(F.lds, Z, LA, KV, DVEC, tile / 65, tile % 65);
            }
        } SEAM(pb + 2);
        if (IN(pb + 3) && (PHM & 16)) {
#ifndef MIXM
#define MIXM 15
#endif
            if ((MIXM & 1) && F.bid < 64) gla::step2(KV, DVEC, SS, F.bid);
            if (MIXM & 2) { for (int it = F.G - 1 - F.bid; it < 192; it += F.G) fox::item(F.ldsg, Z, ZS, MIX, it); }
            if ((MIXM & 4) && F.bid < NB) fox::meta_unit(Z, ZS, MIX, F.bid);
            __syncthreads();
            for (; MIXM & 8;) {
                if (threadIdx.x == 0) MISC[0] = atomicAdd(CTL() + CW_QUEUE + 64 * l, 1u);
                __syncthreads();
                const int q = (int)MISC[0];
                __syncthreads();
                if (q >= 65 * 32) break;
                const int c = 64 - q / 32, b = (q % 32) / 8, sub = q % 8;
                if (c == 0 && sub < 6) continue;
                dsa::unit(F.lds, Z, ZS, MIX, b, c, sub);
            }
        } SEAM(pb + 3);
        if (IN(pb + 4) && (PHM & 32)) {
            for (int tile = F.bid; tile < R / 64; tile += F.G) gla::step3(F.lds, Z, LA, SS, INP(12) + l * 128, MIX, tile / 65, tile % 65);
        } SEAM(pb + 4);
        if (IN(pb + 5) && (PHM & 64)) {
            pg8::DenseProb P; P.init(MIX, WS() + WS_WOUT + l * SZ_WOUT, R, DM, DM, F.G, F.bid);
            pg8::EpiOutProj E{(float*)(WS() + WS_H)};
            pg8::gemm_phase(F.lds, P, E);
        } SEAM(pb + 5);
        if (IN(pb + 6) && (PHM & 128)) {
            for (int tile = F.bid; tile < R / 64; tile += F.G) norm2_tile(F, l, tile, INP(3) + (size_t)l * DM, INP(15) + l * 4, INP(17) + l * 32);
        } SEAM(pb + 6);
        if (IN(pb + 7) && (PHM & 256)) {
            build_moetab(F, l);
            pg8::MoeProb<true> P; P.K = DM; P.lda = DM; P.A = (const char*)U; P.W = (const char*)(WS() + WS_W13 + l * SZ_W13); P.list = (const unsigned*)(WS() + WS_LIST);
            P.tab = (const LAS pg8::MoeTab*)(F.lds + MOETAB_OFF); P.G = F.G; P.c = F.bid;
            pg8::EpiMoeUp E{(bf16*)(WS() + WS_HID)};
            pg8::gemm_phase(F.lds, P, E);
        } SEAM(pb + 7);
        if (IN(pb + 8) && (PHM & 512)) {
            build_moetab(F, l);
            pg8::MoeProb<false> P; P.K = DEXP; P.lda = DEXP; P.A = (const char*)(WS() + WS_HID); P.W = (const char*)(WS() + WS_W2 + l * SZ_W2); P.list = (const unsigned*)(WS() + WS_LIST);
            P.tab = (const LAS pg8::MoeTab*)(F.lds + MOETAB_OFF); P.G = F.G; P.c = F.bid;
            pg8::EpiMoeDown E{(bf16*)(WS() + WS_Y0), (bf16*)(WS() + WS_Y1), (const unsigned*)(WS() + WS_LIST), (const float*)(WS() + WS_GATE), (const LAS pg8::MoeTab*)(F.lds + MOETAB_OFF)};
            pg8::gemm_phase(F.lds, P, E);
        } SEAM(pb + 8);
    }
    if (IN(NPH - 1) && (PHM & 1024)) p_final(F);
#undef IN
#undef SEAM
#undef Z
#undef ZS
#undef MIX
#undef U
#undef LA
#undef KV
#undef DVEC
#undef SS
}

extern "C" void kernel_launch(void* const* d_in, const int* in_sizes, int n_in, void* d_out, int out_size, void* d_ws, size_t ws_size, hipStream_t stream) {
    static int grid = 0;
    if (grid == 0) {
        if (n_in != 21 || out_size != NB * SEQ * DM || ws_size < WS_END) { fprintf(stderr, "kernel_launch: unexpected shapes (n_in %d out %d ws %zu need %zu)\n", n_in, out_size, ws_size, (size_t)WS_END); grid = -1; return; }
        int dev = 0, cus = 0, per_cu = 0;
        if (hipGetDevice(&dev) != hipSuccess || hipDeviceGetAttribute(&cus, hipDeviceAttributeMultiprocessorCount, dev) != hipSuccess) { grid = -1; return; }
        if (hipFuncSetAttribute((const void*)fwd_kernel, hipFuncAttributeMaxDynamicSharedMemorySize, LDS_BYTES) != hipSuccess) { fprintf(stderr, "kernel_launch: hipFuncSetAttribute failed\n"); grid = -1; return; }
        if (hipOccupancyMaxActiveBlocksPerMultiprocessor(&per_cu, (const void*)fwd_kernel, 512, LDS_BYTES) != hipSuccess || per_cu < 1) fprintf(stderr, "kernel_launch: occupancy query says %d\n", per_cu);
        (void)hipGetLastError();
        grid = cus;
    }
    if (grid < 0) return;
    (void)hipMemsetAsync((char*)d_ws + WS_CTL, 0, CTL_ZERO_BYTES, stream);
    Args a{};
    for (int i = 0; i < 21; ++i) a.in[i] = (const float*)d_in[i];
    a.out = (float*)d_out; a.ws = (unsigned char*)d_ws;
#if MK_N_LAUNCHES == 1
    a.ph_lo = 0; a.ph_hi = NPH;
    hipLaunchKernelGGL(fwd_kernel, dim3(grid), dim3(512), LDS_BYTES, stream, a);
#else
    for (int p = 0; p < NPH; ++p) { a.ph_lo = p; a.ph_hi = p + 1; hipLaunchKernelGGL(fwd_kernel, dim3(grid), dim3(512), LDS_BYTES, stream, a); }
#endif
}
```

```cpp
#include <hip/hip_runtime.h>
#include <cstdio>
#include <cstdint>

#ifndef MK_N_LAUNCHES
#define MK_N_LAUNCHES 1
#endif

#define GAS __attribute__((address_space(1)))
#define LAS __attribute__((address_space(3)))
typedef unsigned short bf16;
typedef unsigned u32x4 __attribute__((ext_vector_type(4)));
typedef unsigned u32x2 __attribute__((ext_vector_type(2)));
typedef float f32x4 __attribute__((ext_vector_type(4)));
typedef float f32x2 __attribute__((ext_vector_type(2)));
typedef float f32x16 __attribute__((ext_vector_type(16)));
typedef short bf16x8 __attribute__((ext_vector_type(8)));
typedef short s16x4 __attribute__((ext_vector_type(4)));
#define LDS_WAIT() asm volatile("s_waitcnt lgkmcnt(0)" ::: "memory")
#define VM_WAIT() asm volatile("s_waitcnt vmcnt(0)" ::: "memory")

constexpr int NB = 4, SEQ = 4096, NMETA = 16, TT = SEQ + NMETA;
constexpr int PADF = 48, TP = 4160;
constexpr int R = NB * TP;
constexpr int DM = 2048, DEPTH = 4;
constexpr int DIN = 5990, DINP = 6144;
constexpr int NEXP = 32, DEXP = 512;
constexpr float EPS = 1e-6f;
constexpr int C_AQ = 0, C_AK = 768, C_AV = 896, C_IQ = 1024, C_BQ = 2048, C_BK = 2816, C_BV = 3584, C_CQ = 4352, C_CK = 4608, C_CV = 4864, C_CG = 5376, C_IK = 5888;
constexpr int S_IK = 0, S_IW = 64, S_BF = 80, S_CR = 86;

constexpr size_t al256(size_t x) { return (x + 255) & ~(size_t)255; }
constexpr size_t WS_CTL = 0, CTL_ZERO_BYTES = 1u << 20;
constexpr size_t WS_COS128 = WS_CTL + CTL_ZERO_BYTES;
constexpr size_t WS_SIN128 = WS_COS128 + al256((size_t)TT * 64 * 4);
constexpr size_t WS_COS64 = WS_SIN128 + al256((size_t)TT * 64 * 4);
constexpr size_t WS_SIN64 = WS_COS64 + al256((size_t)TT * 32 * 4);
constexpr size_t WS_WIN = WS_SIN64 + al256((size_t)TT * 32 * 4);
constexpr size_t SZ_WIN = (size_t)DINP * DM * 2;
constexpr size_t WS_WOUT = WS_WIN + DEPTH * SZ_WIN;
constexpr size_t SZ_WOUT = (size_t)DM * DM * 2;
constexpr size_t WS_W13 = WS_WOUT + DEPTH * SZ_WOUT;
constexpr size_t SZ_W13E = (size_t)1024 * DM * 2, SZ_W13 = NEXP * SZ_W13E;
constexpr size_t WS_W2 = WS_W13 + DEPTH * SZ_W13;
constexpr size_t SZ_W2E = (size_t)DM * DEXP * 2, SZ_W2 = NEXP * SZ_W2E;
constexpr size_t WS_WR = WS_W2 + DEPTH * SZ_W2;
constexpr size_t SZ_WR = (size_t)2 * 48 * DM * 2;
constexpr size_t WS_H = WS_WR + DEPTH * SZ_WR;
constexpr size_t WS_U = WS_H + (size_t)R * DM * 4;
constexpr size_t WS_Z = WS_U + (size_t)R * DM * 2;
constexpr size_t WS_ZS = WS_Z + (size_t)R * DINP * 2;
constexpr size_t WS_LA = WS_ZS + (size_t)R * 256 * 4;
constexpr size_t WS_MIX = WS_LA + (size_t)R * 256 * 4;
constexpr int HID_TILES = 168;
constexpr size_t WS_HID = WS_MIX + (size_t)R * DM * 2;
constexpr size_t WS_Y0 = WS_HID + (size_t)HID_TILES * 256 * DEXP * 2;
constexpr size_t WS_Y1 = WS_Y0 + (size_t)R * DM * 2;
constexpr size_t WS_KV = WS_Y1 + (size_t)R * DM * 2;
constexpr size_t WS_DVEC = WS_KV + (size_t)16 * 65 * 64 * 128 * 4;
constexpr size_t WS_SS = WS_DVEC + al256((size_t)16 * 65 * 64 * 4);
constexpr size_t WS_LIST = WS_SS + (size_t)16 * 66 * 64 * 128 * 4;
constexpr size_t WS_GATE = WS_LIST + (size_t)NEXP * R * 4;
constexpr size_t WS_IKC = WS_GATE + (size_t)R * 2 * 4;
constexpr size_t WS_KAC = WS_IKC + (size_t)R * 64 * 2;
constexpr size_t WS_VAC = WS_KAC + (size_t)R * 128 * 2;
constexpr size_t WS_END = WS_VAC + (size_t)R * 128 * 2;

constexpr int CW_BAR = 4096;
constexpr int CW_CNT = 16384;
constexpr int CW_QUEUE = 20480;

constexpr int RING_BYTES = 131072;
constexpr int MOETAB_OFF = 131072;
constexpr int LDSCTL_OFF = 143360, MISC_OFF = LDSCTL_OFF + 320;
constexpr int LDS_BYTES = 147456;

constexpr int WAVETAB_OFF = LDSCTL_OFF + 1536;
__device__ __forceinline__ int get_tid() {
    const unsigned slot = (unsigned)__builtin_amdgcn_s_getreg((5 << 11) | 4) & 63u;
    const unsigned w = *(volatile LAS unsigned*)(uintptr_t)(WAVETAB_OFF + 4 * slot);
    unsigned lane; asm volatile("v_mbcnt_lo_u32_b32 %0, -1, 0\n\tv_mbcnt_hi_u32_b32 %0, -1, %0" : "=v"(lane));
    return (int)((unsigned)__builtin_amdgcn_readfirstlane(w) * 64u + lane);
}
__device__ __forceinline__ unsigned cvtpk(float lo, float hi) { unsigned r; asm volatile("v_cvt_pk_bf16_f32 %0, %1, %2" : "=v"(r) : "v"(lo), "v"(hi)); return r; }
__device__ __forceinline__ float bf2f(unsigned short b) { return __uint_as_float(((unsigned)b) << 16); }
__device__ __forceinline__ float bflo(unsigned w) { return __uint_as_float(w << 16); }
__device__ __forceinline__ float bfhi(unsigned w) { return __uint_as_float(w & 0xffff0000u); }
__device__ __forceinline__ bf16 f2bf(float f) { return (bf16)(cvtpk(f, 0.f) & 0xffffu); }
__device__ __forceinline__ float wave_sum(float v) {
#pragma unroll
    for (int o = 1; o < 64; o <<= 1) v += __shfl_xor(v, o);
    return v;
}
__device__ __forceinline__ f32x4 zero4() { float z = 0.f; asm volatile("" : "+v"(z)); return (f32x4){z, z, z, z}; }
__device__ __forceinline__ float logsigmoidf(float x) { const float e = __builtin_amdgcn_exp2f(-fabsf(x) * 1.4426950408889634f); return fminf(x, 0.f) - __builtin_amdgcn_logf(1.0f + e) * 0.6931471805599453f; }
__device__ __forceinline__ float fexp_(float x) { return __builtin_amdgcn_exp2f(x * 1.4426950408889634f); }
__device__ __forceinline__ float rsqrt_(float x) { return __builtin_amdgcn_rsqf(x); }
__device__ __forceinline__ float siluf(float x) { return x * __builtin_amdgcn_rcpf(1.f + __builtin_amdgcn_exp2f(-x * 1.4426950408889634f)); }

#define XB_TMO      128
#define XB_XCNT(j)  (256  + 64 * (j))
#define XB_XSUB(j)  (1280 + 64 * (j))
#define XB_XGEN(j)  (2304 + 64 * (j))
#define XB_TOP      3328
#define XB_TOPGEN   3392
#define XCD_BAR_WORDS 3456
#define XB_SPIN_CAP (1u << 18)
__device__ __forceinline__ unsigned xb_ld(unsigned* p)              { return __hip_atomic_load(p, __ATOMIC_RELAXED, __HIP_MEMORY_SCOPE_AGENT); }
__device__ __forceinline__ unsigned xb_add(unsigned* p, unsigned v) { return __hip_atomic_fetch_add(p, v, __ATOMIC_RELAXED, __HIP_MEMORY_SCOPE_AGENT); }
__device__ __forceinline__ unsigned xb_xcc_id() { return (unsigned)__builtin_amdgcn_s_getreg((3 << 11) | 20) & 0xFu; }
#define XB_SPIN(cond, bar) do { unsigned _sp = 0; while (cond) { __builtin_amdgcn_s_sleep(1); \
    if ((++_sp & 255u) == 0u) { if (xb_ld(&(bar)[XB_TMO])) break; if (_sp > XB_SPIN_CAP) { atomicAdd(&(bar)[XB_TMO], 1u); break; } } } } while (0)
struct XcdBarrier { unsigned* bar; unsigned x; volatile LAS unsigned* st; };
__device__ __forceinline__ XcdBarrier xcd_barrier_post(unsigned* bar, volatile LAS unsigned* st) {
    XcdBarrier b; b.bar = bar; b.x = xb_xcc_id(); b.st = st;
    if (get_tid() == 0) (void)xb_add(&bar[XB_XCNT(b.x)], 1u);
    return b;
}
__device__ __forceinline__ void xcd_barrier_complete(unsigned* bar, unsigned x, unsigned& nloc, unsigned& nx) {
    const unsigned G = gridDim.x * gridDim.y * gridDim.z;
    unsigned sum, cnt, mine, sp = 0u;
    for (;;) {
        sum = 0u; cnt = 0u; mine = 0u;
#pragma unroll
        for (unsigned j = 0; j < 16; ++j) { const unsigned c = xb_ld(&bar[XB_XCNT(j)]); sum += c; cnt += (c > 0u) ? 1u : 0u; mine = (j == x) ? c : mine; }
        if (sum == G) break;
        __builtin_amdgcn_s_sleep(1);
        if ((++sp & 255u) == 0u) { if (xb_ld(&bar[XB_TMO])) break; if (sp > XB_SPIN_CAP) { atomicAdd(&bar[XB_TMO], 1u); break; } }
    }
    nloc = mine > 0u ? mine : 1u; nx = cnt > 0u ? cnt : 1u;
}
__device__ __forceinline__ void xcd_barrier(const XcdBarrier& b) {
    asm volatile("s_waitcnt vmcnt(0)" ::: "memory");
    __syncthreads();
    if (get_tid() == 0) {
        unsigned* bar = b.bar; unsigned bx = b.x;
        asm volatile("" : "+s"(bar), "+s"(bx));
        __builtin_amdgcn_s_waitcnt(0);
        unsigned nloc = b.st[0], nx = b.st[1];
        if (nloc == 0u) { xcd_barrier_complete(bar, bx, nloc, nx); b.st[0] = nloc; b.st[1] = nx; }
        const unsigned old = xb_add(&bar[XB_XSUB(bx)], 1u);
        const unsigned gen = old / nloc;
        if (old + 1u == (gen + 1u) * nloc) {
            __builtin_amdgcn_fence(__ATOMIC_RELEASE, "agent");
            asm volatile("s_waitcnt vmcnt(0)" ::: "memory");
            const unsigned og = xb_add(&bar[XB_TOP], 1u);
            const unsigned tg = og / nx;
            if (og + 1u == (tg + 1u) * nx) xb_add(&bar[XB_TOPGEN], 1u);
            else XB_SPIN(xb_ld(&bar[XB_TOPGEN]) == tg, bar);
            __builtin_amdgcn_fence(__ATOMIC_ACQUIRE, "agent");
            xb_add(&bar[XB_XGEN(bx)], 1u);
            asm volatile("s_waitcnt vmcnt(0)" ::: "memory");
        } else {
            XB_SPIN(xb_ld(&bar[XB_XGEN(bx)]) == gen, bar);
            __builtin_amdgcn_fence(__ATOMIC_ACQUIRE, "agent");
            asm volatile("s_waitcnt vmcnt(0)" ::: "memory");
        }
    }
    __syncthreads();
}

namespace pg8 {
constexpr int BM = 256, BK = 64, HALF = 128, HTB = HALF * BK * 2, STAGE_BYTES = 8 * HTB;
__host__ __device__ __forceinline__ int lds_byte(int r, int c) { const int st = (r >> 4) * 2 + (c >> 5), rr = r & 15, cc = c & 31, ob = rr * 64 + cc * 2; return st * 1024 + (ob ^ (((ob >> 9) & 1) << 5)); }
__host__ __device__ __forceinline__ void stage_rc(int b, int& Rr, int& C) { const int st = b / 1024, sb = b % 1024, swz = sb ^ (((sb >> 9) & 1) << 5); Rr = (st >> 1) * 16 + swz / 64; C = (st & 1) * 32 + (swz % 64) / 2; }
__host__ __device__ __forceinline__ int perm32(int rho) { const int n = rho >> 4, i = rho & 15; return 8 * (i >> 2) + 4 * n + (i & 3); }
struct Unit { int pm, pn, e, r0; };

template <class Epi, class Prob>
__device__ __forceinline__ void gemm_phase(LAS unsigned char* lds, const Prob& P, const Epi& E) {
    int tid = get_tid();
    const int wid = __builtin_amdgcn_readfirstlane(tid >> 6), lane = tid & 63, wr = wid >> 2, wc = wid & 3, fr = lane & 15, fq = lane >> 4;
    const int K = P.K, nt = K / BK;
    unsigned voffB;
    { int Rr, C; stage_rc(tid * 16, Rr, C); const int Rb = Epi::PERM ? ((Rr & ~31) + perm32(Rr & 31)) : Rr; voffB = (unsigned)(Rb * K + C) * 2u; }
    const size_t hstep = (size_t)HALF * K * 2, qstepB = (size_t)64 * K * 2;
    const unsigned ldsw = (unsigned)wid * 1024u;
    const int aoff = lds_byte(wr * 64 + fr, fq * 8), boff = lds_byte(wc * 32 + fr, fq * 8);
#define PG8_SA(b, h) (((b) * 2 + (h)) * HTB)
#define PG8_SB(b, h) ((4 + (b) * 2 + (h)) * HTB)
#define PG8_STAGE1(bufoff, gbase, voff, qstep) do { _Pragma("unroll") for (int _i = 0; _i < 2; ++_i) \
        __builtin_amdgcn_global_load_lds((const unsigned*)((const char*)(gbase) + (size_t)_i * (qstep) + (voff)), (LAS unsigned*)(lds + (bufoff) + ldsw + _i * 8192), 16, 0, 0); } while (0)
#define PG8_STAGE2(bufoff, gbase, voff) do { _Pragma("unroll") for (int _i = 0; _i < 2; ++_i) \
        __builtin_amdgcn_global_load_lds((const unsigned*)((const char*)(gbase) + (voff)[_i]), (LAS unsigned*)(lds + (bufoff) + ldsw + _i * 8192), 16, 0, 0); } while (0)
#define PG8_STB(bufoff, gbase) PG8_STAGE1(bufoff, gbase, voffB, qstepB)
#define PG8_STA(bufoff, gbase, h) do { if constexpr (GA) PG8_STAGE2(bufoff, gbase, ao[h]); else PG8_STAGE1(bufoff, (gbase) + (size_t)(h) * hstepA, ao[0][0], qstepA); } while (0)
#define PG8_LDA(dst, b, h) do { _Pragma("unroll") for (int m = 0; m < 4; ++m) _Pragma("unroll") for (int k = 0; k < 2; ++k) dst[m][k] = *(const LAS bf16x8*)(lds + PG8_SA(b, h) + aoff + m * 2048 + k * 1024); } while (0)
#define PG8_LDB(dst, b, h) do { _Pragma("unroll") for (int n = 0; n < 2; ++n) _Pragma("unroll") for (int k = 0; k < 2; ++k) dst[n][k] = *(const LAS bf16x8*)(lds + PG8_SB(b, h) + boff + n * 2048 + k * 1024); } while (0)
#define PG8_MMA(ai, bj, At, Bt) do { __builtin_amdgcn_s_setprio(1); _Pragma("unroll") for (int m = 0; m < 4; ++m) _Pragma("unroll") for (int n = 0; n < 2; ++n) _Pragma("unroll") for (int k = 0; k < 2; ++k) \
        acc[ai][bj][m][n] = __builtin_amdgcn_mfma_f32_16x16x32_bf16(Bt[n][k], At[m][k], acc[ai][bj][m][n], 0, 0, 0); __builtin_amdgcn_s_setprio(0); } while (0)
#define PG8_WAIT_V(n) asm volatile("s_waitcnt vmcnt(" #n ")" ::: "memory")
#define PG8_WAIT_L(n) asm volatile("s_waitcnt lgkmcnt(" #n ")" ::: "memory")
#define PG8_BAR __builtin_amdgcn_s_barrier()
#define PG8_SCHED __builtin_amdgcn_sched_barrier(0)
    Unit cur, nxt; int ui = 0;
    if (!P.next(0, cur)) return;
    constexpr bool GA = Prob::GATHER;
    unsigned ao[2][2]; const size_t hstepA = (size_t)HALF * P.lda * 2, qstepA = (size_t)64 * P.lda * 2;
    const char* cA = P.abase();
    if constexpr (GA) P.aoffs(cur, tid, ao);
    else { ao[0][0] = P.aoffs0(tid); cA += P.aunit(cur); }
    const char* cB = P.bptr(cur);
    const size_t kstep = (size_t)(BK * 2);
    PG8_STB(PG8_SB(0, 0), cB); PG8_STB(PG8_SB(0, 1), cB + hstep); PG8_STA(PG8_SA(0, 0), cA, 0); PG8_STA(PG8_SA(0, 1), cA, 1);
    if (wr == 1) PG8_BAR;
    PG8_WAIT_V(2); PG8_BAR;
    PG8_STB(PG8_SB(1, 0), cB + kstep); PG8_STA(PG8_SA(1, 0), cA + kstep, 0); PG8_STB(PG8_SB(1, 1), cB + hstep + kstep);
    PG8_WAIT_V(6); PG8_BAR;
    f32x4 acc[2][2][4][2];
#pragma unroll
    for (int a = 0; a < 2; ++a)
#pragma unroll
        for (int b = 0; b < 2; ++b)
#pragma unroll
            for (int m = 0; m < 4; ++m)
#pragma unroll
                for (int n = 0; n < 2; ++n) acc[a][b][m][n] = zero4();
    bf16x8 At[4][2], B0[2][2], B1[2][2];
    for (;;) {
        const bool has_next = P.next(ui + 1, nxt);
        const char* nB = has_next ? P.bptr(nxt) : cB;
        const char* nA = (has_next && !GA) ? P.abase() + P.aunit(nxt) : cA;
        for (int t = 0; t < nt; t += 2) {
            const bool last = (t == nt - 2);
            const char* a1 = cA + (size_t)(t + 1) * kstep;
            const char* a2 = last ? nA : cA + (size_t)(t + 2) * kstep; const char* b2 = last ? nB : cB + (size_t)(t + 2) * kstep;
            const char* a3 = a2 + kstep; const char* b3 = b2 + kstep;
            PG8_LDB(B0, 0, 0); PG8_LDB(B1, 0, 1); PG8_SCHED; PG8_LDA(At, 0, 0); PG8_STA(PG8_SA(1, 1), a1, 1);
            if constexpr (GA) { if (last && has_next) P.aoffs(nxt, tid, ao); }
            PG8_WAIT_V(8); PG8_WAIT_L(0); PG8_BAR; PG8_MMA(0, 0, At, B0); PG8_MMA(0, 1, At, B1); PG8_BAR; PG8_SCHED;
            PG8_LDA(At, 0, 1); PG8_STB(PG8_SB(0, 0), b2); PG8_STB(PG8_SB(0, 1), b2 + hstep); PG8_STA(PG8_SA(0, 0), a2, 0);
            PG8_WAIT_V(8); PG8_WAIT_L(0); PG8_BAR; PG8_MMA(1, 0, At, B0); PG8_MMA(1, 1, At, B1); PG8_BAR; PG8_SCHED;
            PG8_LDB(B0, 1, 0); PG8_LDB(B1, 1, 1); PG8_SCHED; PG8_LDA(At, 1, 0); PG8_STA(PG8_SA(0, 1), a2, 1);
            PG8_WAIT_V(8); PG8_WAIT_L(0); PG8_BAR; PG8_MMA(0, 0, At, B0); PG8_MMA(0, 1, At, B1); PG8_BAR; PG8_SCHED;
            PG8_LDA(At, 1, 1); PG8_STB(PG8_SB(1, 0), b3); PG8_STB(PG8_SB(1, 1), b3 + hstep); PG8_STA(PG8_SA(1, 0), a3, 0);
            PG8_WAIT_V(8); PG8_WAIT_L(0); PG8_BAR; PG8_MMA(1, 0, At, B0); PG8_MMA(1, 1, At, B1); PG8_BAR; PG8_SCHED;
        }
        if (wr == 0) PG8_BAR;
        { const int tz = get_tid(); const int wz = tz >> 6, lz = tz & 63; E(acc, cur, wz >> 2, wz & 3, lz & 15, lz >> 4); }
        if (!has_next) break;
#pragma unroll
        for (int a = 0; a < 2; ++a)
#pragma unroll
            for (int b = 0; b < 2; ++b)
#pragma unroll
                for (int m = 0; m < 4; ++m)
#pragma unroll
                    for (int n = 0; n < 2; ++n) acc[a][b][m][n] = zero4();
        cur = nxt; cB = nB; cA = nA; ++ui;
        if (wr == 1) PG8_BAR;
    }
    PG8_WAIT_V(0);
    PG8_BAR;
#undef PG8_SA
#undef PG8_STAGE1
#undef PG8_STAGE2
#undef PG8_STB
#undef PG8_STA
#undef PG8_SB
#undef PG8_LDA
#undef PG8_LDB
#undef PG8_MMA
#undef PG8_WAIT_V
#undef PG8_WAIT_L
#undef PG8_BAR
#undef PG8_SCHED
}

struct DenseProb {
    int K; const char* A; const char* Bt; int nM, nN, nwg, G, c;
    __device__ __forceinline__ void init(const void* A_, const void* Bt_, int M, int N, int K_, int G_, int c_) { A = (const char*)A_; Bt = (const char*)Bt_; K = K_; lda = K_; nM = M / BM; nN = N / BM; nwg = nM * nN; G = G_; c = c_; }
    __device__ __forceinline__ bool next(int i, Unit& u) const {
        const int L = i * G + c; if (L >= nwg) return false;
        int wgid = L; { const int q = nwg / 8, r = nwg % 8, xcd = wgid % 8, off = wgid / 8; wgid = (xcd < r ? xcd * (q + 1) : r * (q + 1) + (xcd - r) * q) + off; }
        const int nig = 8 * nN, gid = wgid / nig, fm = gid * 8, gsz = (nM - fm) < 8 ? (nM - fm) : 8;
        u.pm = fm + ((wgid % nig) % gsz); u.pn = (wgid % nig) / gsz; u.e = 0; u.r0 = 0; return true;
    }
    static constexpr bool GATHER = false; int lda;
    __device__ __forceinline__ const char* abase() const { return A; }
    __device__ __forceinline__ size_t aunit(const Unit& u) const { return (size_t)u.pm * BM * K * 2; }
    __device__ __forceinline__ unsigned aoffs0(int tid) const { int Rr, C; stage_rc(tid * 16, Rr, C); return (unsigned)(Rr * K + C) * 2u; }
    __device__ __forceinline__ void aoffs(const Unit&, int, unsigned (&)[2][2]) const {}
    __device__ __forceinline__ const char* bptr(const Unit& u) const { return Bt + (size_t)u.pn * BM * K * 2; }
};
struct MoeTab { int e[176]; int r0[176]; int cnt[32]; int ntiles; };
template <bool UP> struct MoeProb {
    int K; const char* A; const char* W; const unsigned* list; const LAS MoeTab* tab; int G, c;
    __device__ __forceinline__ bool next(int i, Unit& u) const {
        constexpr int NPN = UP ? 4 : 8;
        const int L = i * G + c; if (L >= __builtin_amdgcn_readfirstlane(tab->ntiles) * NPN) return false;
        const int tile = L / NPN; u.pm = tile; u.pn = L % NPN; u.e = __builtin_amdgcn_readfirstlane(tab->e[tile]); u.r0 = __builtin_amdgcn_readfirstlane(tab->r0[tile]); return true;
    }
    static constexpr bool GATHER = UP; int lda;
    __device__ __forceinline__ const char* abase() const { return A; }
    __device__ __forceinline__ size_t aunit(const Unit& u) const { return (size_t)u.pm * BM * DEXP * 2; }
    __device__ __forceinline__ unsigned aoffs0(int tid) const { int Rr, C; stage_rc(tid * 16, Rr, C); return (unsigned)(Rr * DEXP + C) * 2u; }
    __device__ __forceinline__ void aoffs(const Unit& u, int tid_, unsigned (&o)[2][2]) const {
        int tid = get_tid(); (void)tid_;
        const int n = __builtin_amdgcn_readfirstlane(tab->cnt[u.e]);
#pragma unroll
        for (int i = 0; i < 2; ++i) { int Rr, C; stage_rc(tid * 16 + i * 8192, Rr, C);
#pragma unroll
            for (int h = 0; h < 2; ++h) { const int li = u.r0 + h * HALF + Rr;
                const unsigned row = (li < n) ? (list[(size_t)u.e * R + li] >> 1) : (unsigned)PADF;
                o[h][i] = (row * (unsigned)DM + (unsigned)C) * 2u; } }
    }
    __device__ __forceinline__ const char* bptr(const Unit& u) const { return W + (size_t)u.e * (UP ? SZ_W13E : SZ_W2E) + (size_t)u.pn * BM * K * 2; }
};

struct EpiInProj {
    static constexpr bool PERM = true;
    bf16* Z; float* ZS;
    __device__ __forceinline__ void operator()(const f32x4 (&acc)[2][2][4][2], const Unit& u, int wr, int wc, int fr, int fq) const {
        const int row0 = u.pm * BM + wr * 64 + fr;
        if (u.pn < 23) {
            const int col0 = u.pn * BM + wc * 32 + 8 * fq;
#pragma unroll
            for (int ai = 0; ai < 2; ++ai)
#pragma unroll
                for (int m = 0; m < 4; ++m) { bf16* rowp = Z + (size_t)(row0 + ai * HALF + m * 16) * DINP + col0;
#pragma unroll
                    for (int bj = 0; bj < 2; ++bj) { const f32x4 v0 = acc[ai][bj][m][0], v1 = acc[ai][bj][m][1];
                        u32x4 w; w.x = cvtpk(v0[0], v0[1]); w.y = cvtpk(v0[2], v0[3]); w.z = cvtpk(v1[0], v1[1]); w.w = cvtpk(v1[2], v1[3]);
                        *(u32x4*)(rowp + bj * HALF) = w; } }
        } else {
            const int col0 = wc * 32 + 8 * fq;
#pragma unroll
            for (int ai = 0; ai < 2; ++ai)
#pragma unroll
                for (int m = 0; m < 4; ++m) { float* rowp = ZS + (size_t)(row0 + ai * HALF + m * 16) * 256 + col0;
#pragma unroll
                    for (int bj = 0; bj < 2; ++bj) { *(f32x4*)(rowp + bj * HALF) = acc[ai][bj][m][0]; *(f32x4*)(rowp + bj * HALF + 4) = acc[ai][bj][m][1]; } }
        }
    }
};
struct EpiOutProj {
    static constexpr bool PERM = false;
    float* H;
    __device__ __forceinline__ void operator()(const f32x4 (&acc)[2][2][4][2], const Unit& u, int wr, int wc, int fr, int fq) const {
        const int row0 = u.pm * BM + wr * 64 + fr, col0 = u.pn * BM + wc * 32 + 4 * fq;
#pragma unroll
        for (int ai = 0; ai < 2; ++ai)
#pragma unroll
            for (int m = 0; m < 4; ++m) { float* rowp = H + (size_t)(row0 + ai * HALF + m * 16) * DM + col0;
                f32x4 hv[2][2];
#pragma unroll
                for (int bj = 0; bj < 2; ++bj)
#pragma unroll
                    for (int n = 0; n < 2; ++n) hv[bj][n] = *(const f32x4*)(rowp + bj * HALF + n * 16);
#pragma unroll
                for (int bj = 0; bj < 2; ++bj)
#pragma unroll
                    for (int n = 0; n < 2; ++n) *(f32x4*)(rowp + bj * HALF + n * 16) = hv[bj][n] + acc[ai][bj][m][n]; }
    }
};
struct EpiMoeUp {
    static constexpr bool PERM = true;
    bf16* HID;
    __device__ __forceinline__ void operator()(const f32x4 (&acc)[2][2][4][2], const Unit& u, int wr, int wc, int fr, int fq) const {
        const int row0 = u.pm * BM + wr * 64 + fr, col0 = (u.pn * BM + wc * 32 + 8 * fq) >> 1;
#pragma unroll
        for (int ai = 0; ai < 2; ++ai)
#pragma unroll
            for (int m = 0; m < 4; ++m) { bf16* rowp = HID + (size_t)(row0 + ai * HALF + m * 16) * DEXP + col0;
#pragma unroll
                for (int bj = 0; bj < 2; ++bj) { const f32x4 a = acc[ai][bj][m][0], b = acc[ai][bj][m][1];
                    u32x2 w; w.x = cvtpk(siluf(a[0]) * b[0], siluf(a[1]) * b[1]); w.y = cvtpk(siluf(a[2]) * b[2], siluf(a[3]) * b[3]);
                    *(u32x2*)(rowp + bj * (HALF / 2)) = w; }
                asm volatile("" ::: "memory"); }
    }
};
struct EpiMoeDown {
    static constexpr bool PERM = true;
    bf16* Y0; bf16* Y1; const unsigned* list; const float* gate; const LAS MoeTab* tab;
    __device__ __forceinline__ void operator()(const f32x4 (&acc)[2][2][4][2], const Unit& u, int wr, int wc, int fr, int fq) const {
        const int n = __builtin_amdgcn_readfirstlane(tab->cnt[u.e]); const int col0 = u.pn * BM + wc * 32 + 8 * fq;
#pragma unroll
        for (int ai = 0; ai < 2; ++ai)
#pragma unroll
            for (int m = 0; m < 4; ++m) { const int li = u.r0 + ai * HALF + wr * 64 + m * 16 + fr;
                if (li < n) { const unsigned ent = list[(size_t)u.e * R + li]; const float g = gate[ent];
                    bf16* rowp = Y0 + (size_t)(ent & 1u) * ((size_t)R * DM) + (size_t)(ent >> 1) * DM + col0;
#pragma unroll
                    for (int bj = 0; bj < 2; ++bj) { const f32x4 v0 = acc[ai][bj][m][0] * g, v1 = acc[ai][bj][m][1] * g;
                        u32x4 w; w.x = cvtpk(v0[0], v0[1]); w.y = cvtpk(v0[2], v0[3]); w.z = cvtpk(v1[0], v1[1]); w.w = cvtpk(v1[2], v1[3]);
                        *(u32x4*)(rowp + bj * HALF) = w; } } }
    }
};
}

namespace fox {
constexpr int D = 128, NW = 8, QBLK = 32, KVBLK = 64, QB = NW * QBLK;
constexpr int SHM_V = KVBLK * D * 2, SHM_K = KVBLK * D * 2;
constexpr int LDS_BODY = 2 * SHM_V + 2 * SHM_K + NW * 64 * 4;
constexpr int BIAS_OFF = LDS_BODY;
constexpr int SCAN_OFF = BIAS_OFF + TP * 4;
constexpr int LDQ = DINP, LDO = DM;
constexpr float SCALE = 0.08838834764831845f, THR = 8.f;
constexpr int WBIG = 1 << 28;
#define KSWZ(row, colB) ((row) * 256 + ((colB) ^ (((row) & 7) << 4)))
#define SBAR() __builtin_amdgcn_sched_barrier(0)
__device__ __forceinline__ int v_st(int k, int c) { const int kk = (k & ~0xC) | ((k & 4) << 1) | ((k & 8) >> 1); return ((kk >> 3) * 4 + (c >> 5)) * 512 + ((kk & 7) * 32 + (c & 31)) * 2; }
__device__ __forceinline__ int v_rd_base(int lane) { return ((lane & 3) << 3) | (((lane >> 2) & 3) << 6) | (((lane >> 4) & 1) << 5) | (((lane >> 5) & 1) << 8); }
constexpr int v_rd_off(int d0, int ks, int half) { return d0 * 512 + ks * 4096 + half * 2048; }
__device__ __forceinline__ int crow(int r, int hi) { return (r & 3) + 8 * (r >> 2) + 4 * hi; }
__device__ __forceinline__ bf16x8 load8(const bf16* p) { return *reinterpret_cast<const bf16x8*>(p); }
__device__ __forceinline__ void mask_tile(f32x16& p0, f32x16& p1, int dq, unsigned W) {
    const float NEG = -__builtin_inff();
#pragma unroll
    for (int r = 0; r < 16; ++r) {
        const int c = (r & 3) + 8 * (r >> 2);
        if ((unsigned)(dq - c) >= W) p0[r] = NEG;
        if ((unsigned)(dq - c - 32) >= W) p1[r] = NEG;
    }
}
__device__ __forceinline__ void partialSM(f32x16& p0, f32x16& p1, float& m_reg, float& mn, float& alpha) {
    float pmax = p0[0]; for (int r = 1; r < 16; ++r) pmax = fmaxf(pmax, p0[r]); for (int r = 0; r < 16; ++r) pmax = fmaxf(pmax, p1[r]);
    { auto rr = __builtin_amdgcn_permlane32_swap(__float_as_uint(pmax), __float_as_uint(pmax), false, false);
      pmax = fmaxf(__uint_as_float(rr[0]), __uint_as_float(rr[1])); }
    constexpr float C2 = 1.4426950408889634f * SCALE;
    if (__builtin_expect(__all((pmax - m_reg) * SCALE <= THR), 1)) { mn = m_reg; alpha = 1.f; }
    else { mn = fmaxf(m_reg, pmax); alpha = __builtin_amdgcn_exp2f((m_reg - mn) * C2); m_reg = mn; }
    const float mnL = -mn * C2;
    for (int r = 0; r < 16; ++r) p0[r] = fmaf(p0[r], C2, mnL); for (int r = 0; r < 16; ++r) p1[r] = fmaf(p1[r], C2, mnL);
    for (int r = 0; r < 16; ++r) p0[r] = __builtin_amdgcn_exp2f(p0[r]);
}
__device__ __forceinline__ void finishSM(f32x16& p0, f32x16& p1, float alpha, float& l_reg, bf16x8& pa0, bf16x8& pa1, bf16x8& pa2, bf16x8& pa3) {
    for (int r = 0; r < 16; ++r) p1[r] = __builtin_amdgcn_exp2f(p1[r]);
    float ps = 0; for (int r = 0; r < 16; ++r) ps += p0[r]; for (int r = 0; r < 16; ++r) ps += p1[r];
    { auto rr = __builtin_amdgcn_permlane32_swap(__float_as_uint(ps), __float_as_uint(ps), false, false);
      ps = __uint_as_float(rr[0]) + __uint_as_float(rr[1]); }
    l_reg = l_reg * alpha + ps;
#define PK4(P, B_, OUT) do { unsigned a0 = cvtpk(P[B_+0], P[B_+1]), a1 = cvtpk(P[B_+2], P[B_+3]);                          \
        unsigned b0 = cvtpk(P[B_+4], P[B_+5]), b1 = cvtpk(P[B_+6], P[B_+7]);                                             \
        auto r0 = __builtin_amdgcn_permlane32_swap(a0, b0, false, false); auto r1 = __builtin_amdgcn_permlane32_swap(a1, b1, false, false); \
        u32x4 w = {r0[0], r1[0], r0[1], r1[1]}; OUT = *reinterpret_cast<bf16x8*>(&w); } while (0)
    PK4(p0, 0, pa0); PK4(p0, 8, pa1); PK4(p1, 0, pa2); PK4(p1, 8, pa3);
#undef PK4
}
template <int KB>
__device__ __forceinline__ void qkt(f32x16& p0, f32x16& p1, const char* K_lds, const float* biask  , int r32, int hi, const bf16x8* qr) {
#pragma unroll
    for (int a = 0; a < 4; ++a) { const f32x4 b0 = *(const f32x4*)(biask + 8 * a), b1 = *(const f32x4*)(biask + 32 + 8 * a);
#pragma unroll
        for (int j = 0; j < 4; ++j) { p0[4 * a + j] = b0[j]; p1[4 * a + j] = b1[j]; } }
    const char* kb[4];
#pragma unroll
    for (int dd = 0; dd < 4; ++dd) kb[dd] = K_lds + KB * SHM_K + KSWZ(r32, (dd * 16 + hi * 8) * 2);
#pragma unroll
    for (int d0 = 0; d0 < 8; ++d0) { const char* a = kb[d0 & 3] + (d0 >> 2) * 128;
        bf16x8 b0 = *reinterpret_cast<const bf16x8*>(a);
        bf16x8 b1 = *reinterpret_cast<const bf16x8*>(a + 32 * 256);
        p0 = __builtin_amdgcn_mfma_f32_32x32x16_bf16(b0, qr[d0], p0, 0, 0, 0);
        p1 = __builtin_amdgcn_mfma_f32_32x32x16_bf16(b1, qr[d0], p1, 0, 0, 0); }
}
template <int VB>
__device__ __forceinline__ void pv_tile(f32x16* o, int vb0, bf16x8 pa0, bf16x8 pa1, bf16x8 pa2, bf16x8 pa3) {
#define TRRD(dst, off) asm volatile("ds_read_b64_tr_b16 %0, %1 offset:%2" : "=&v"(dst) : "v"(vb0), "i"(off) : "memory")
#define PV_D0(d0) do { s16x4 l0, l1, l2, l3, h0, h1, h2, h3; constexpr int b_ = VB * SHM_V + v_rd_off(d0, 0, 0); \
        TRRD(l0, b_); TRRD(h0, b_ + 2048); TRRD(l1, b_ + 4096); TRRD(h1, b_ + 6144); TRRD(l2, b_ + 8192); TRRD(h2, b_ + 10240); TRRD(l3, b_ + 12288); TRRD(h3, b_ + 14336); \
        asm volatile("s_waitcnt lgkmcnt(0)" ::: "memory"); SBAR();   \
        o[d0] = __builtin_amdgcn_mfma_f32_32x32x16_bf16(pa0, (bf16x8){l0[0], l0[1], l0[2], l0[3], h0[0], h0[1], h0[2], h0[3]}, o[d0], 0, 0, 0);   \
        o[d0] = __builtin_amdgcn_mfma_f32_32x32x16_bf16(pa1, (bf16x8){l1[0], l1[1], l1[2], l1[3], h1[0], h1[1], h1[2], h1[3]}, o[d0], 0, 0, 0);   \
        o[d0] = __builtin_amdgcn_mfma_f32_32x32x16_bf16(pa2, (bf16x8){l2[0], l2[1], l2[2], l2[3], h2[0], h2[1], h2[2], h2[3]}, o[d0], 0, 0, 0);   \
        o[d0] = __builtin_amdgcn_mfma_f32_32x32x16_bf16(pa3, (bf16x8){l3[0], l3[1], l3[2], l3[3], h3[0], h3[1], h3[2], h3[3]}, o[d0], 0, 0, 0); } while (0)
    PV_D0(0); PV_D0(1); PV_D0(2); PV_D0(3);
#undef PV_D0
#undef TRRD
}
struct BlockRef { const bf16* Q; const bf16* K; const bf16* V; bf16* O; int P0; };
struct Seam { bf16x8 qr[8]; bf16x8 st_v0, st_v1, st_k0, st_k1; };
#define ROW(p, k0, rr) ((p) + (unsigned)(((k0) + (rr)) * LDQ + sc))
#define VMW() asm volatile("s_waitcnt vmcnt(0)" ::: "memory")
#define VMWN(n) asm volatile("s_waitcnt vmcnt(%0)" :: "i"(n) : "memory")
#define SLOAD_H(Kp, Vp, k0) do { S.st_v0 = load8(ROW(Vp, k0, sr)); S.st_v1 = load8(ROW(Vp, k0, 32 + sr));              \
                         S.st_k0 = load8(ROW(Kp, k0, sr)); S.st_k1 = load8(ROW(Kp, k0, 32 + sr)); } while (0)
#define SWRITE_HK(bf) do { *(bf16x8*)(K_lds + (bf) * SHM_K + kws) = S.st_k0; *(bf16x8*)(K_lds + (bf) * SHM_K + kws + 32 * 256) = S.st_k1; } while (0)
#define SWRITE_HV(bf) do { *(bf16x8*)(V_lds + (bf) * SHM_V + vst0) = S.st_v0; *(bf16x8*)(V_lds + (bf) * SHM_V + vst1) = S.st_v1; } while (0)
#define SWRITE_H(bf) do { SWRITE_HV(bf); SWRITE_HK(bf); } while (0)
__device__ __forceinline__ void prime(const BlockRef& cur, char* lds, Seam& S) {
    int tid = get_tid();
    const int wid = __builtin_amdgcn_readfirstlane(tid >> 6), lane = tid & 63, r32 = lane & 31, hi = lane >> 5;
    const int sr = tid >> 4, sc = (tid & 15) * 8, kws = KSWZ(sr, sc * 2); char* K_lds = lds + 2 * SHM_V;
    const int kb0 = 0;
    for (int d0 = 0; d0 < 8; ++d0) S.qr[d0] = load8(cur.Q + (unsigned)((wid * QBLK + r32) * LDQ + d0 * 16 + hi * 8));
    SLOAD_H(cur.K, cur.V, kb0); VMW(); SWRITE_HK(0);
    __syncthreads();
}
__device__ __forceinline__ void block(const BlockRef& cur, const BlockRef& nxt, int skv, char* lds, Seam& S) {
    constexpr int W = WBIG;
    int tid = get_tid();
    const int wid = __builtin_amdgcn_readfirstlane(tid >> 6), lane = tid & 63, r32 = lane & 31, hi = lane >> 5;
    const int j_lo = 0;
    int j_hi = (cur.P0 + QB - 1) / KVBLK + 1; if (j_hi > skv / KVBLK) j_hi = skv / KVBLK;
    const int NT = j_hi - j_lo;
    const int kbn = 0;
    const int qlo = cur.P0 + wid * QBLK, qm = qlo + r32 - 4 * hi;
    char* V_lds = lds; char* K_lds = lds + 2 * SHM_V;
    float* ws = (float*)(lds + 2 * SHM_V + 2 * SHM_K) + wid * 64; float* li_l = ws, * al_l = ws + 32;
    const float* biasb = (const float*)(lds + BIAS_OFF) + 4 * hi;
    float m_reg = -1e30f, l_reg = 0; f32x16 o[4] = {};
    const int sr = tid >> 4, sc = (tid & 15) * 8, vst0 = v_st(sr, sc), vst1 = v_st(32 + sr, sc), kws = KSWZ(sr, sc * 2);
    const int vb0 = (int)(uintptr_t)V_lds + v_rd_base(lane);
    const bf16* Kh = cur.K; const bf16* Vh = cur.V;
#define RESC(a) do { if (__any((a) < 1.f)) { if (hi == 0) al_l[r32] = (a); asm volatile("s_waitcnt lgkmcnt(0)" ::: "memory");              \
                     for (int d_ = 0; d_ < 4; ++d_) for (int r = 0; r < 16; ++r) o[d_][r] *= al_l[crow(r, hi)]; } } while (0)
#define KBASE(t) ((j_lo + (t)) * KVBLK)
#define MASKT(P0_, P1_, t) do { const int kb_ = KBASE(t); if (kb_ + KVBLK - 1 > qlo) mask_tile(P0_, P1_, qm - kb_, (unsigned)W); } while (0)
    constexpr int NQL = 8;
#define SEAM_K0() do { VMWN(NQL); SWRITE_HK(0); SBAR(); } while (0)
    f32x16 pA0, pA1, pB0, pB1; float mnA, mnB, alA, alB; bf16x8 pa0, pa1, pa2, pa3;
    SWRITE_HV(0); SBAR();
    if (NT > 1) { SLOAD_H(Kh, Vh, KBASE(1)); }
    SBAR(); qkt<0>(pA0, pA1, K_lds, biasb + KBASE(0), r32, hi, S.qr);
    MASKT(pA0, pA1, 0); partialSM(pA0, pA1, m_reg, mnA, alA);
    if (NT > 1) { VMW(); SWRITE_H(1); }
    __syncthreads();
#define HALF_STEP(PX0, PX1, mnX, alX, PY0, PY1, alY, t, KB, VB, SB) do {                                                      \
        SBAR(); qkt<KB>(PX0, PX1, K_lds, biasb + KBASE(t), r32, hi, S.qr);                                             \
        finishSM(PY0, PY1, alY, l_reg, pa0, pa1, pa2, pa3); SBAR();                                                           \
        if ((t) + 1 < NT) { SLOAD_H(Kh, Vh, KBASE((t) + 1)); SBAR(); }                                               \
        pv_tile<VB>(o, vb0, pa0, pa1, pa2, pa3); MASKT(PX0, PX1, (t)); partialSM(PX0, PX1, m_reg, mnX, alX);                                        \
        __syncthreads();                                                                                                      \
        if ((t) + 1 < NT) { VMW(); SWRITE_H(SB); }                                                                          \
        RESC(alX); __syncthreads(); } while (0)
    for (int t = 1; t + 1 < NT; t += 2) {
        HALF_STEP(pB0, pB1, mnB, alB, pA0, pA1, alA, t, 1, 0, 0);
        HALF_STEP(pA0, pA1, mnA, alA, pB0, pB1, alB, t + 1, 0, 1, 1);
    }
    const bool even = (NT & 1) == 0;
    if (even) { SBAR(); qkt<1>(pB0, pB1, K_lds, biasb + KBASE(NT - 1), r32, hi, S.qr); SBAR(); }
    SLOAD_H(nxt.K, nxt.V, kbn); SBAR();
#pragma unroll
    for (int d0 = 0; d0 < 8; ++d0) S.qr[d0] = load8(nxt.Q + (unsigned)((wid * QBLK + r32) * LDQ + d0 * 16 + hi * 8));
    SBAR();
    finishSM(pA0, pA1, alA, l_reg, pa0, pa1, pa2, pa3); SBAR();
    pv_tile<0>(o, vb0, pa0, pa1, pa2, pa3);
    if (even) { MASKT(pB0, pB1, NT - 1); partialSM(pB0, pB1, m_reg, mnB, alB); __syncthreads(); RESC(alB);
        finishSM(pB0, pB1, alB, l_reg, pa0, pa1, pa2, pa3); SBAR(); pv_tile<1>(o, vb0, pa0, pa1, pa2, pa3); }
    SBAR(); SEAM_K0();
    if (hi == 0) li_l[r32] = l_reg; asm volatile("s_waitcnt lgkmcnt(0)" ::: "memory");
    float rli[16];
#pragma unroll
    for (int r = 0; r < 16; ++r) rli[r] = __builtin_amdgcn_rcpf(li_l[crow(r, hi)]);
    bf16* Ow = cur.O + (unsigned)(wid * QBLK * LDO);
#pragma unroll
    for (int r = 0; r < 16; ++r) { const int orow = crow(r, hi);
#pragma unroll
        for (int d0 = 0; d0 < 4; ++d0) { const float v = o[d0][r] * rli[r];
            const float vn = __shfl_xor(v, 1);
            if ((r32 & 1) == 0) *(unsigned*)(Ow + (unsigned)(orow * LDO + d0 * 32 + r32)) = cvtpk(v, vn); } }
    __syncthreads();
#undef RESC
#undef KBASE
#undef MASKT
#undef SEAM_K0
#undef HALF_STEP
}
#undef ROW
#undef VMW
#undef VMWN
#undef SLOAD_H
#undef SWRITE_HK
#undef SWRITE_HV
#undef SWRITE_H

__device__ __forceinline__ void build_bias(char* lds, const float* zs_b  , int h) {
    int tid = get_tid();
    const int lane = tid & 63, wid = tid >> 6;
    float* bias = (float*)(lds + BIAS_OFF); float* wsum = (float*)(lds + SCAN_OFF);
    float loc[9]; float s = 0.f;
#pragma unroll
    for (int k = 0; k < 9; ++k) { const int t = tid * 9 + k; const float x = (t < TT) ? zs_b[(size_t)(PADF + t) * 256 + S_BF + h] : 0.f; s += x; loc[k] = s; }
    float incl = s;
#pragma unroll
    for (int o = 1; o < 64; o <<= 1) { const float y = __shfl_up(incl, o); if (lane >= o) incl += y; }
    if (lane == 63) wsum[wid] = incl;
    __syncthreads();
    float woff = 0.f;
    for (int w = 0; w < wid; ++w) woff += wsum[w];
    const float excl = woff + incl - s;
    constexpr float INVS = 1.0f / SCALE;
#pragma unroll
    for (int k = 0; k < 9; ++k) { const int t = tid * 9 + k; if (t < TT) bias[PADF + t] = -(excl + loc[k]) * INVS; }
    if (tid < PADF) bias[tid] = -__builtin_inff();
    __syncthreads();
}
__device__ __forceinline__ void item(char* lds, const bf16* Z, const float* ZS, bf16* MIX, int it) {
    const int bh = it >> 3, x = it & 7, b = bh / 6, h = bh % 6;
    build_bias(lds, ZS + (size_t)b * TP * 256, h);
    const bf16* zb = Z + (size_t)b * TP * DINP;
    BlockRef b0, b1;
    b0.K = b1.K = zb + C_BK + h * 128; b0.V = b1.V = zb + C_BV + h * 128;
    const int q0 = 64 + 256 * x, q1 = 64 + 256 * (15 - x);
    b0.Q = zb + (size_t)q0 * DINP + C_BQ + h * 128; b1.Q = zb + (size_t)q1 * DINP + C_BQ + h * 128;
    b0.O = MIX + (size_t)(b * TP + q0) * DM + 768 + h * 128; b1.O = MIX + (size_t)(b * TP + q1) * DM + 768 + h * 128;
    b0.P0 = q0; b1.P0 = q1;
    Seam S;
    prime(b0, lds, S);
    block(b0, b1, TP, lds, S);
    block(b1, b1, TP, lds, S);
}
__device__ __forceinline__ void meta_unit(const bf16* Z, const float* ZS, bf16* MIX, int b) {
    int tid = get_tid();
    const int lane = tid & 63, wid = tid >> 6;
    for (int task = wid; task < 96; task += 8) {
        const int h = task >> 4, m = task & 15;
        const size_t rq = (size_t)b * TP + PADF + m;
        const unsigned qw = *(const unsigned*)(Z + rq * DINP + C_BQ + h * 128 + 2 * lane);
        const float q0 = bflo(qw), q1 = bfhi(qw);
        float lg[16]; float F = 0.f, Fk[16];
#pragma unroll
        for (int k = 0; k < 16; ++k) { F += ZS[((size_t)b * TP + PADF + k) * 256 + S_BF + h]; Fk[k] = F; }
        float Fm = 0.f;
#pragma unroll
        for (int k = 0; k < 16; ++k) if (k == m) Fm = Fk[k];
        float mx = -1e30f;
#pragma unroll
        for (int k = 0; k < 16; ++k) { const size_t rk = (size_t)b * TP + PADF + k;
            const unsigned kw = *(const unsigned*)(Z + rk * DINP + C_BK + h * 128 + 2 * lane);
            const float d = wave_sum(q0 * bflo(kw) + q1 * bfhi(kw));
            lg[k] = (k <= m) ? d * SCALE + Fm - Fk[k] : -__builtin_inff(); mx = fmaxf(mx, lg[k]); }
        float sum = 0.f, o0 = 0.f, o1 = 0.f;
#pragma unroll
        for (int k = 0; k < 16; ++k) { const float p = fexp_(lg[k] - mx); sum += p;
            const size_t rk = (size_t)b * TP + PADF + k;
            const unsigned vw = *(const unsigned*)(Z + rk * DINP + C_BV + h * 128 + 2 * lane);
            o0 += p * bflo(vw); o1 += p * bfhi(vw); }
        const float inv = 1.f / sum;
        *(unsigned*)(MIX + rq * DM + 768 + h * 128 + 2 * lane) = cvtpk(o0 * inv, o1 * inv);
    }
}
}

namespace dsa {
constexpr int NQ = 8, SCW = TP;
constexpr int SC_BYTES = NQ * SCW * 4;
constexpr int IDX_OFF = SC_BYTES;
constexpr int LDS_NEED = SC_BYTES + NQ * 256 * 2;
constexpr int KTOP = 256;
__device__ __forceinline__ unsigned sortable(float f) { const unsigned u = __float_as_uint(f); return (u >> 31) ? ~u : (u | 0x80000000u); }
__device__ __forceinline__ unsigned mbcnt(unsigned long long m) { return __builtin_amdgcn_mbcnt_hi((unsigned)(m >> 32), __builtin_amdgcn_mbcnt_lo((unsigned)m, 0u)); }
__device__ __forceinline__ unsigned off_b(unsigned row, unsigned ch) { return 256u * row + 16u * (ch ^ (((row & 3) << 2) | ((row >> 2) & 3))); }

template <int NG>
__device__ __forceinline__ void select_topk(const LAS float* myc, LAS unsigned short* idx, int lane) {
    unsigned key[NG];
#pragma unroll
    for (int j = 0; j < NG; ++j) key[j] = sortable(myc[64 * j + lane]);
    unsigned tau = 0u;
    for (int bit = 31; bit >= 0; --bit) {
        const unsigned cand = tau | (1u << bit); int cnt = 0;
#pragma unroll
        for (int j = 0; j < NG; ++j) cnt += __popcll(__ballot(key[j] >= cand));
        if (cnt >= KTOP) tau = cand;
        if (cnt == KTOP) break;
    }
    int cgt = 0;
#pragma unroll
    for (int j = 0; j < NG; ++j) cgt += __popcll(__ballot(key[j] > tau));
    int eq_rem = KTOP - cgt, run = 0;
#pragma unroll
    for (int j = 0; j < NG; ++j) {
        const bool gt = key[j] > tau, eq = key[j] == tau;
        const unsigned long long m_eq = __ballot(eq);
        const bool take = gt || (eq && (int)mbcnt(m_eq) < eq_rem);
        const unsigned long long m = __ballot(take);
        if (take) idx[run + (int)mbcnt(m)] = (unsigned short)(64 * j + lane);
        run += __popcll(m); const int ne = __popcll(m_eq); eq_rem -= (ne < eq_rem) ? ne : eq_rem;
    }
}
__device__ __forceinline__ void unit(LAS unsigned char* lds, const bf16* Z, const float* ZS, const bf16* IKC, const bf16* KAC, const bf16* VAC, bf16* MIX, int b, int c, int sub) {
    int tid = get_tid();
    const int lane = tid & 63, wave = __builtin_amdgcn_readfirstlane(tid >> 6), g = lane >> 4, c16 = lane & 15;
    const int v0 = 64 * c + 8 * sub;
    const size_t rb = (size_t)b * TP;
    LAS float* sc = (LAS float*)lds;
    {
        bf16x8 A[NQ][2];
#pragma unroll
        for (int qi = 0; qi < NQ; ++qi) { const bf16* zq = Z + (rb + v0 + qi) * DINP + C_IQ + c16 * 64 + 8 * g;
            A[qi][0] = *(const bf16x8*)zq; A[qi][1] = *(const bf16x8*)(zq + 32); }
        u32x4 Aw[4];
        { const f32x4 w4 = *(const f32x4*)(ZS + (rb + v0 + (c16 & 7)) * 256 + S_IW + 4 * g);
          const unsigned w01 = cvtpk(w4[0], w4[1]), w23 = cvtpk(w4[2], w4[3]);
#pragma unroll
          for (int s2 = 0; s2 < 4; ++s2) { const bool ev = (c16 == 2 * s2), od = (c16 == 2 * s2 + 1);
              Aw[s2] = (u32x4){ev ? w01 : 0u, ev ? w23 : 0u, od ? w01 : 0u, od ? w23 : 0u}; } }
        const int ntile = 4 * (c + 1);
        const bf16* ikb = IKC + rb * 64 + c16 * 64 + 8 * g;
        int t = wave;
        bf16x8 B0 = *(const bf16x8*)(ikb + (size_t)t * 1024), B1 = *(const bf16x8*)(ikb + (size_t)t * 1024 + 32);
        for (; t < ntile; t += 8) {
            const int tn = (t + 8 < ntile) ? t + 8 : t;
            const bf16x8 N0 = *(const bf16x8*)(ikb + (size_t)tn * 1024), N1 = *(const bf16x8*)(ikb + (size_t)tn * 1024 + 32);
            f32x4 d[NQ];
#pragma unroll
            for (int qi = 0; qi < NQ; ++qi) { d[qi] = __builtin_amdgcn_mfma_f32_16x16x32_bf16(A[qi][0], B0, zero4(), 0, 0, 0);
                d[qi] = __builtin_amdgcn_mfma_f32_16x16x32_bf16(A[qi][1], B1, d[qi], 0, 0, 0); }
            f32x4 D2 = zero4();
#pragma unroll
            for (int s2 = 0; s2 < 4; ++s2) { const f32x4 x = d[2 * s2], y = d[2 * s2 + 1];
                u32x4 rw; rw.x = cvtpk(fmaxf(x[0], 0.f), fmaxf(x[1], 0.f)); rw.y = cvtpk(fmaxf(x[2], 0.f), fmaxf(x[3], 0.f)); rw.z = cvtpk(fmaxf(y[0], 0.f), fmaxf(y[1], 0.f)); rw.w = cvtpk(fmaxf(y[2], 0.f), fmaxf(y[3], 0.f));
                D2 = __builtin_amdgcn_mfma_f32_16x16x32_bf16(*reinterpret_cast<const bf16x8*>(&Aw[s2]), *reinterpret_cast<const bf16x8*>(&rw), D2, 0, 0, 0); }
            const int key = 16 * t + c16;
            if (g < 2) {
#pragma unroll
                for (int r = 0; r < 4; ++r) sc[(4 * g + r) * SCW + key] = (key >= PADF) ? D2[r] : -__builtin_inff(); }
            B0 = N0; B1 = N1;
        }
    }
    { const int n_ = 64 * (c + 1), ng_ = (c + 1 <= 16) ? 16 : (c + 1 <= 32 ? 32 : (c + 1 <= 48 ? 48 : 65));
      for (int i = n_ + tid; i < 64 * ng_; i += 512) {
#pragma unroll
          for (int qi = 0; qi < NQ; ++qi) sc[qi * SCW + i] = -__builtin_inff(); } }
    __syncthreads();
    const int n = 64 * (c + 1), nreal = n - PADF, ngrp = c + 1;
    LAS unsigned short* idx = (LAS unsigned short*)(lds + IDX_OFF) + wave * 256;
    LAS float* myc = sc + wave * SCW;
    int nsel;
    if (nreal <= KTOP) { nsel = nreal; for (int s = lane; s < nsel; s += 64) idx[s] = (unsigned short)(PADF + s); }
    else { nsel = KTOP;
        if (ngrp <= 16) select_topk<16>(myc, idx, lane); else if (ngrp <= 32) select_topk<32>(myc, idx, lane);
        else if (ngrp <= 48) select_topk<48>(myc, idx, lane); else select_topk<65>(myc, idx, lane); }
    LDS_WAIT();
    {
        const size_t qrow = rb + v0 + wave;
        bf16x8 Bq[4];
#pragma unroll
        for (int kd = 0; kd < 4; ++kd) { Bq[kd] = (bf16x8){0, 0, 0, 0, 0, 0, 0, 0}; if (c16 < 6) Bq[kd] = *(const bf16x8*)(Z + qrow * DINP + C_AQ + c16 * 128 + 32 * kd + 8 * g); }
        f32x4 Dl[8][2];
        const int srow = 8 * (c16 >> 2) + (c16 & 3);
        const bf16* kab = KAC + rb * 128 + 8 * g;
        bf16x8 Ka[2][8];
#define DSA_KLOAD(buf, ks_) do { int s0_ = 32 * (ks_) + srow, s1_ = s0_ + 4; s0_ = s0_ < nsel ? s0_ : nsel - 1; s1_ = s1_ < nsel ? s1_ : nsel - 1; \
            const bf16* k0_ = kab + (size_t)idx[s0_] * 128; const bf16* k1_ = kab + (size_t)idx[s1_] * 128; \
            _Pragma("unroll") for (int kd = 0; kd < 4; ++kd) { Ka[buf][kd] = *(const bf16x8*)(k0_ + 32 * kd); Ka[buf][4 + kd] = *(const bf16x8*)(k1_ + 32 * kd); } } while (0)
        DSA_KLOAD(0, 0);
#pragma unroll
        for (int ks = 0; ks < 8; ++ks) {
            if (ks + 1 < 8) DSA_KLOAD((ks + 1) & 1, ks + 1);
            f32x4 d0 = zero4(), d1 = zero4();
#pragma unroll
            for (int kd = 0; kd < 4; ++kd) { d0 = __builtin_amdgcn_mfma_f32_16x16x32_bf16(Ka[ks & 1][kd], Bq[kd], d0, 0, 0, 0); d1 = __builtin_amdgcn_mfma_f32_16x16x32_bf16(Ka[ks & 1][4 + kd], Bq[kd], d1, 0, 0, 0); }
            Dl[ks][0] = d0; Dl[ks][1] = d1;
        }
#undef DSA_KLOAD
        constexpr float C2 = 0.08838834764831845f * 1.4426950408889634f;
        float mx = -1e30f;
#pragma unroll
        for (int ks = 0; ks < 8; ++ks)
#pragma unroll
            for (int tt = 0; tt < 2; ++tt)
#pragma unroll
                for (int r = 0; r < 4; ++r) { const int slot = 32 * ks + 8 * g + 4 * tt + r; float x = Dl[ks][tt][r] * C2; x = (slot < nsel) ? x : -__builtin_inff(); Dl[ks][tt][r] = x; mx = fmaxf(mx, x); }
        mx = fmaxf(mx, __shfl_xor(mx, 16)); mx = fmaxf(mx, __shfl_xor(mx, 32));
        float sum = 0.f;
#pragma unroll
        for (int ks = 0; ks < 8; ++ks)
#pragma unroll
            for (int tt = 0; tt < 2; ++tt)
#pragma unroll
                for (int r = 0; r < 4; ++r) { const float p = __builtin_amdgcn_exp2f(Dl[ks][tt][r] - mx); Dl[ks][tt][r] = p; sum += p; }
        sum += __shfl_xor(sum, 16); sum += __shfl_xor(sum, 32);
        LAS unsigned char* stg = (LAS unsigned char*)myc;
        const unsigned stg_addr = (unsigned)(uintptr_t)stg;
        f32x4 O[8];
#pragma unroll
        for (int dt = 0; dt < 8; ++dt) O[dt] = zero4();
        const unsigned q4 = (unsigned)c16 >> 2, p4 = (unsigned)c16 & 3;
        const unsigned rd_base = stg_addr + (8u * g + q4) * 256u + 8u * p4;
        const bf16* vab = VAC + rb * 128 + (lane & 15) * 8;
        u32x4 Vr[8];
#define DSA_VLOAD(ks_) do { _Pragma("unroll") for (int i = 0; i < 8; ++i) { int s_ = 32 * (ks_) + (lane >> 4) + 4 * i; s_ = s_ < nsel ? s_ : nsel - 1; Vr[i] = *(const u32x4*)(vab + (size_t)idx[s_] * 128); } } while (0)
        DSA_VLOAD(0);
#pragma unroll
        for (int ks = 0; ks < 8; ++ks) {
            LAS unsigned char* sb = stg + (ks & 1) * 8192;
#pragma unroll
            for (int i = 0; i < 8; ++i) *(LAS u32x4*)(sb + ((lane >> 4) + 4 * i) * 256 + (lane & 15) * 16) = Vr[i];
            if (ks + 1 < 8) DSA_VLOAD(ks + 1);
            u32x4 pw; pw.x = cvtpk(Dl[ks][0][0], Dl[ks][0][1]); pw.y = cvtpk(Dl[ks][0][2], Dl[ks][0][3]); pw.z = cvtpk(Dl[ks][1][0], Dl[ks][1][1]); pw.w = cvtpk(Dl[ks][1][2], Dl[ks][1][3]);
            const bf16x8 Bp = *reinterpret_cast<const bf16x8*>(&pw);
            const unsigned ra = rd_base + (ks & 1) * 8192u;
            s16x4 l0, l1, l2, l3, l4, l5, l6, l7, h0, h1, h2, h3, h4, h5, h6, h7;
            asm volatile("s_waitcnt lgkmcnt(0)\n\t"
                "ds_read_b64_tr_b16 %0, %16\n\tds_read_b64_tr_b16 %8, %16 offset:1024\n\t"
                "ds_read_b64_tr_b16 %1, %16 offset:32\n\tds_read_b64_tr_b16 %9, %16 offset:1056\n\t"
                "ds_read_b64_tr_b16 %2, %16 offset:64\n\tds_read_b64_tr_b16 %10, %16 offset:1088\n\t"
                "ds_read_b64_tr_b16 %3, %16 offset:96\n\tds_read_b64_tr_b16 %11, %16 offset:1120\n\t"
                "ds_read_b64_tr_b16 %4, %16 offset:128\n\tds_read_b64_tr_b16 %12, %16 offset:1152\n\t"
                "ds_read_b64_tr_b16 %5, %16 offset:160\n\tds_read_b64_tr_b16 %13, %16 offset:1184\n\t"
                "ds_read_b64_tr_b16 %6, %16 offset:192\n\tds_read_b64_tr_b16 %14, %16 offset:1216\n\t"
                "ds_read_b64_tr_b16 %7, %16 offset:224\n\tds_read_b64_tr_b16 %15, %16 offset:1248\n\t"
                "s_waitcnt lgkmcnt(0)"
                : "=&v"(l0), "=&v"(l1), "=&v"(l2), "=&v"(l3), "=&v"(l4), "=&v"(l5), "=&v"(l6), "=&v"(l7), "=&v"(h0), "=&v"(h1), "=&v"(h2), "=&v"(h3), "=&v"(h4), "=&v"(h5), "=&v"(h6), "=&v"(h7)
                : "v"(ra) : "memory");
#define DSA_PV(dt, lo, hi2) O[dt] = __builtin_amdgcn_mfma_f32_16x16x32_bf16((bf16x8){lo[0], lo[1], lo[2], lo[3], hi2[0], hi2[1], hi2[2], hi2[3]}, Bp, O[dt], 0, 0, 0)
            DSA_PV(0, l0, h0); DSA_PV(1, l1, h1); DSA_PV(2, l2, h2); DSA_PV(3, l3, h3); DSA_PV(4, l4, h4); DSA_PV(5, l5, h5); DSA_PV(6, l6, h6); DSA_PV(7, l7, h7);
#undef DSA_PV
        }
#undef DSA_VLOAD
        if (c16 < 6) { const float inv = 1.f / sum; bf16* op = MIX + qrow * DM + c16 * 128 + 4 * g;
#pragma unroll
            for (int dt = 0; dt < 8; ++dt) { u32x2 w; w.x = cvtpk(O[dt][0] * inv, O[dt][1] * inv); w.y = cvtpk(O[dt][2] * inv, O[dt][3] * inv); *(u32x2*)(op + 16 * dt) = w; } }
    }
    __syncthreads();
}
}

namespace gla {
constexpr int LDT = 72;
constexpr int L_BL = 0;
constexpr int L_SEG = L_BL + 16384;
constexpr int L_QH = L_SEG + 2048;
constexpr int L_KH = L_QH + 64 * LDT * 2;
constexpr int L_SC = L_KH + 64 * LDT * 2;
constexpr int L_VT = L_SC + 64 * LDT * 2;
constexpr int L_ST = L_VT + 128 * LDT * 2;
constexpr int L_O = L_ST + 128 * LDT * 2;
constexpr int LDS_NEED = L_O + 64 * 132 * 4;
__device__ __forceinline__ bf16x8 ldfrag(const LAS bf16* base, int row, int k0) { return *(const LAS bf16x8*)(base + row * LDT + k0); }

__device__ __forceinline__ void cum_decay(LAS unsigned char* lds, const float* LA, size_t row0, int hd, bool chunk0) {
    int tid = get_tid();
    const int d = tid & 63, seg = tid >> 6;
    LAS float* bl = (LAS float*)(lds + L_BL); LAS float* sg = (LAS float*)(lds + L_SEG);
    float v[8]; float s = 0.f;
#pragma unroll
    for (int k = 0; k < 8; ++k) { const int i = 8 * seg + k; float x = LA[(row0 + i) * 256 + hd * 64 + d]; if (chunk0 && i < PADF) x = 0.f; s += x; v[k] = s; }
    sg[seg * 64 + d] = s;
    __syncthreads();
    float off = 0.f;
    for (int w = 0; w < seg; ++w) off += sg[w * 64 + d];
#pragma unroll
    for (int k = 0; k < 8; ++k) bl[(8 * seg + k) * 64 + d] = v[k] + off;
    __syncthreads();
}
__device__ __forceinline__ void load_vT(LAS unsigned char* lds, const bf16* Z, size_t row0, int hd) {
    int tid = get_tid(); LAS bf16* vT = (LAS bf16*)(lds + L_VT);
#pragma unroll
    for (int it = 0; it < 2; ++it) { const int pc = tid + 512 * it, i = pc >> 4, e0 = (pc & 15) * 8;
        const u32x4 w = *(const u32x4*)(Z + (row0 + i) * DINP + C_CV + hd * 128 + e0);
        const unsigned ww[4] = {w.x, w.y, w.z, w.w};
#pragma unroll
        for (int k = 0; k < 4; ++k) { vT[(e0 + 2 * k) * LDT + i] = (bf16)(ww[k] & 0xffffu); vT[(e0 + 2 * k + 1) * LDT + i] = (bf16)(ww[k] >> 16); } }
}
__device__ __forceinline__ void step1(LAS unsigned char* lds, const bf16* Z, const float* ZS, float* LA, const float* w2, const float* gb, float* KV, float* DVEC, int b, int c, int hd) {
    int tid = get_tid();
    const int lane = tid & 63, wave = tid >> 6, g = lane >> 4, c16 = lane & 15;
    const size_t row0 = (size_t)b * TP + 64 * c;
    LAS float* bl = (LAS float*)(lds + L_BL); LAS float* sg = (LAS float*)(lds + L_SEG); LAS bf16* kdT = (LAS bf16*)(lds + L_QH); LAS bf16* vT = (LAS bf16*)(lds + L_VT);
    LAS float* crs = (LAS float*)(lds + L_O);
    if (tid < 256) { const int i = tid >> 2; *(LAS f32x4*)(crs + i * 16 + 4 * (tid & 3)) = *(const f32x4*)(ZS + (row0 + i) * 256 + S_CR + 4 * (tid & 3)); }
    __syncthreads();
    { const int d = tid & 63, seg = tid >> 6, n = hd * 64 + d;
      float wc[16];
#pragma unroll
      for (int r = 0; r < 16; ++r) wc[r] = w2[r * 256 + n];
      const float gbn = gb[n];
      float v[8]; float s = 0.f;
#pragma unroll
      for (int k = 0; k < 8; ++k) { const int i = 8 * seg + k; float a = gbn;
#pragma unroll
          for (int r = 0; r < 16; ++r) a += crs[i * 16 + r] * wc[r];
          float x = logsigmoidf(a) * (1.f / 16.f); if (c == 0 && i < PADF) x = 0.f;
          LA[(row0 + i) * 256 + n] = x; s += x; v[k] = s; }
      sg[seg * 64 + d] = s;
      __syncthreads();
      float off = 0.f;
      for (int w = 0; w < seg; ++w) off += sg[w * 64 + d];
#pragma unroll
      for (int k = 0; k < 8; ++k) bl[(8 * seg + k) * 64 + d] = v[k] + off; }
    __syncthreads();
    { const int i = tid >> 3, d0 = (tid & 7) * 8;
      const u32x4 w = *(const u32x4*)(Z + (row0 + i) * DINP + C_CK + hd * 64 + d0); const unsigned ww[4] = {w.x, w.y, w.z, w.w};
#pragma unroll
      for (int k = 0; k < 8; ++k) { const int d = d0 + k; const float kk = (k & 1) ? bfhi(ww[k >> 1]) : bflo(ww[k >> 1]);
          kdT[d * LDT + i] = f2bf(kk * fexp_(bl[63 * 64 + d] - bl[i * 64 + d])); } }
    load_vT(lds, Z, row0, hd);
    __syncthreads();
    const int bh = b * 4 + hd;
    float* kvp = KV + ((size_t)bh * 65 + c) * 8192;
#pragma unroll
    for (int dt = 0; dt < 4; ++dt) { f32x4 acc = zero4();
#pragma unroll
        for (int ks = 0; ks < 2; ++ks) acc = __builtin_amdgcn_mfma_f32_16x16x32_bf16(ldfrag(kdT, 16 * dt + c16, 32 * ks + 8 * g), ldfrag(vT, 16 * wave + c16, 32 * ks + 8 * g), acc, 0, 0, 0);
#pragma unroll
        for (int r = 0; r < 4; ++r) kvp[(16 * dt + 4 * g + r) * 128 + 16 * wave + c16] = acc[r]; }
    if (tid < 64) DVEC[((size_t)bh * 65 + c) * 64 + tid] = fexp_(bl[63 * 64 + tid]);
    __syncthreads();
}
__device__ __forceinline__ void step2(const float* KV, const float* DVEC, float* SS, int u) {
    int tid = get_tid();
    const int bh = u >> 2, idx = (u & 3) * 2048 + tid * 4, d = idx >> 7;
    f32x4 S = zero4();
    *(f32x4*)(SS + ((size_t)bh * 66) * 8192 + idx) = S;
#pragma unroll 4
    for (int c = 0; c < 64; ++c) {
        const f32x4 kv = *(const f32x4*)(KV + ((size_t)bh * 65 + c) * 8192 + idx); const float dv = DVEC[((size_t)bh * 65 + c) * 64 + d];
        S = S * dv + kv;
        *(f32x4*)(SS + ((size_t)bh * 66 + c + 1) * 8192 + idx) = S;
    }
}
__device__ __forceinline__ void step3(LAS unsigned char* lds, const bf16* Z, const float* LA, const float* SS, const float* gon, bf16* MIX, int b, int c, int hd) {
    int tid = get_tid();
    const int lane = tid & 63, wave = tid >> 6, g = lane >> 4, c16 = lane & 15;
    const size_t row0 = (size_t)b * TP + 64 * c;
    LAS float* bl = (LAS float*)(lds + L_BL); LAS bf16* qh = (LAS bf16*)(lds + L_QH); LAS bf16* kh = (LAS bf16*)(lds + L_KH); LAS bf16* scb = (LAS bf16*)(lds + L_SC);
    LAS bf16* vT = (LAS bf16*)(lds + L_VT); LAS bf16* sT = (LAS bf16*)(lds + L_ST); LAS float* ol = (LAS float*)(lds + L_O);
    {
        const int bh = b * 4 + hd;
        cum_decay(lds, LA, row0, hd, c == 0);
        { const int i = tid >> 3, d0 = (tid & 7) * 8;
          const u32x4 wq = *(const u32x4*)(Z + (row0 + i) * DINP + C_CQ + hd * 64 + d0), wk = *(const u32x4*)(Z + (row0 + i) * DINP + C_CK + hd * 64 + d0);
          const unsigned q4[4] = {wq.x, wq.y, wq.z, wq.w}, k4[4] = {wk.x, wk.y, wk.z, wk.w};
          unsigned oq[4], ok[4];
#pragma unroll
          for (int k = 0; k < 4; ++k) { const float b0 = bl[i * 64 + d0 + 2 * k], b1 = bl[i * 64 + d0 + 2 * k + 1];
              oq[k] = cvtpk(bflo(q4[k]) * 0.125f * fexp_(b0), bfhi(q4[k]) * 0.125f * fexp_(b1));
              ok[k] = cvtpk(bflo(k4[k]) * fexp_(-b0), bfhi(k4[k]) * fexp_(-b1)); }
          *(LAS u32x4*)(qh + i * LDT + d0) = (u32x4){oq[0], oq[1], oq[2], oq[3]};
          *(LAS u32x4*)(kh + i * LDT + d0) = (u32x4){ok[0], ok[1], ok[2], ok[3]}; }
        load_vT(lds, Z, row0, hd);
        { const float* sp = SS + ((size_t)bh * 66 + c) * 8192;
#pragma unroll
          for (int it = 0; it < 4; ++it) { const int pc = tid + 512 * it, d = pc >> 5, e0 = (pc & 31) * 4; const f32x4 s4 = *(const f32x4*)(sp + d * 128 + e0);
#pragma unroll
              for (int k = 0; k < 4; ++k) sT[(e0 + k) * LDT + d] = f2bf(s4[k]); } }
        __syncthreads();
        { const int it = wave & 3;
#pragma unroll
          for (int jj = 0; jj < 2; ++jj) { const int jt = 2 * (wave >> 2) + jj; f32x4 acc = zero4();
              if (jt <= it) {
#pragma unroll
                  for (int ks = 0; ks < 2; ++ks) acc = __builtin_amdgcn_mfma_f32_16x16x32_bf16(ldfrag(qh, 16 * it + c16, 32 * ks + 8 * g), ldfrag(kh, 16 * jt + c16, 32 * ks + 8 * g), acc, 0, 0, 0); }
#pragma unroll
              for (int r = 0; r < 4; ++r) { const int i = 16 * it + 4 * g + r, j = 16 * jt + c16; scb[i * LDT + j] = f2bf((j <= i) ? acc[r] : 0.f); } } }
        __syncthreads();
#pragma unroll
        for (int it = 0; it < 4; ++it) { f32x4 acc = zero4();
#pragma unroll
            for (int ks = 0; ks < 2; ++ks) acc = __builtin_amdgcn_mfma_f32_16x16x32_bf16(ldfrag(scb, 16 * it + c16, 32 * ks + 8 * g), ldfrag(vT, 16 * wave + c16, 32 * ks + 8 * g), acc, 0, 0, 0);
#pragma unroll
            for (int ks = 0; ks < 2; ++ks) acc = __builtin_amdgcn_mfma_f32_16x16x32_bf16(ldfrag(qh, 16 * it + c16, 32 * ks + 8 * g), ldfrag(sT, 16 * wave + c16, 32 * ks + 8 * g), acc, 0, 0, 0);
#pragma unroll
            for (int r = 0; r < 4; ++r) ol[(16 * it + 4 * g + r) * 132 + 16 * wave + c16] = acc[r]; }
        __syncthreads();
#pragma unroll
        for (int k = 0; k < 8; ++k) { const int i = 8 * wave + k; const float x0 = ol[i * 132 + 2 * lane], x1 = ol[i * 132 + 2 * lane + 1];
            const float ss = wave_sum(x0 * x0 + x1 * x1); const float rstd = rsqrt_(ss * (1.f / 128.f) + EPS);
            if (!(c == 0 && i < PADF)) { const unsigned gw = *(const unsigned*)(Z + (row0 + i) * DINP + C_CG + hd * 128 + 2 * lane);
                const float y0 = x0 * rstd * gon[2 * lane] * siluf(bflo(gw)), y1 = x1 * rstd * gon[2 * lane + 1] * siluf(bfhi(gw));
                *(unsigned*)(MIX + (row0 + i) * DM + 1536 + hd * 128 + 2 * lane) = cvtpk(y0, y1); } }
        __syncthreads();
    }
}
}

struct Frame {
    LAS unsigned char* lds; char* ldsg;
    int tid, lane, wave, G, bid;
};
constexpr int PTAB_OFF = LDSCTL_OFF + 1024, P_OUT = 21, P_WS = 22;
__device__ __forceinline__ unsigned char* gptr(const Frame& F, int k) {
    const LAS unsigned* t = (const LAS unsigned*)(F.lds + PTAB_OFF) + 2 * k;
    const unsigned lo = __builtin_amdgcn_readfirstlane(t[0]), hi = __builtin_amdgcn_readfirstlane(t[1]);
    return (unsigned char*)(((unsigned long long)hi << 32) | lo);
}
#define WS() gptr(F, P_WS)
#define INP(k) ((const float*)gptr(F, (k)))
#define CTL() ((unsigned*)(gptr(F, P_WS) + WS_CTL))
__device__ __forceinline__ int inmap(int n) {
    if (n < 2048) return n;
    if (n < 2112) return C_IK + (n - 2048);
    if (n < 2128) return C_IK + S_IW + (n - 2112);
    if (n < 4432) return C_BQ + (n - 2128);
    if (n < 4438) return C_IK + S_BF + (n - 4432);
    if (n < 4950) return C_CQ + (n - 4438);
    if (n < 5462) return C_CV + (n - 4950);
    if (n < 5478) return C_IK + S_CR + (n - 5462);
    return C_CG + (n - 5478);
}
template <int MAP, int LW>
__device__ __forceinline__ void transpose_item(const float* W, int K, int N, bf16* WT, LAS float* scr, int item, int lane) {
    constexpr int PITCH = 68, LPR = 64 / LW  , RPI = 64 / LPR  , NI = 64 / RPI;
    const int nblk = (N + 63) / 64, kb = item / nblk, nb = item % nblk, k0 = 64 * kb, n0 = 64 * nb;
    const int cl = LW * (lane % LPR), rl = lane / LPR;
    const float* src = W + (size_t)(k0 + rl) * N + n0 + cl;
    const bool inb = (n0 + cl) < N;
    if constexpr (LW == 4) { f32x4 v[NI];
#pragma unroll
        for (int i = 0; i < NI; ++i) v[i] = inb ? *(const f32x4*)(src + (size_t)(RPI * i) * N) : (f32x4){0.f, 0.f, 0.f, 0.f};
#pragma unroll
        for (int i = 0; i < NI; ++i) *(LAS f32x4*)(scr + (rl + RPI * i) * PITCH + cl) = v[i];
    } else { f32x2 v[NI];
#pragma unroll
        for (int i = 0; i < NI; ++i) v[i] = inb ? *(const f32x2*)(src + (size_t)(RPI * i) * N) : (f32x2){0.f, 0.f};
#pragma unroll
        for (int i = 0; i < NI; ++i) *(LAS f32x2*)(scr + (rl + RPI * i) * PITCH + cl) = v[i];
    }
    LDS_WAIT(); asm volatile("" ::: "memory");
    const int ng = n0 + lane;
    int row = ng; if (MAP == 1) row = inmap(ng < N ? ng : 0); if (MAP == 2) row = 8 * (ng >> 2) + (ng & 3); if (MAP == 3) row = 8 * (ng >> 2) + 4 + (ng & 3);
    bf16* dst = WT + (size_t)row * K + k0;
#pragma unroll
    for (int kc = 0; kc < 8; ++kc) { const LAS float* sp = scr + (8 * kc) * PITCH + lane;
        u32x4 o; o.x = cvtpk(sp[0 * PITCH], sp[1 * PITCH]); o.y = cvtpk(sp[2 * PITCH], sp[3 * PITCH]); o.z = cvtpk(sp[4 * PITCH], sp[5 * PITCH]); o.w = cvtpk(sp[6 * PITCH], sp[7 * PITCH]);
        if (ng < N) *(u32x4*)(dst + 8 * kc) = o; }
    LDS_WAIT(); asm volatile("" ::: "memory");
}
__device__ __forceinline__ void sincos_d(double ang, float& c, float& s) {
    const double q = __builtin_rint(ang * 0.63661977236758134308);
    double r = __builtin_fma(-q, 1.5707963267948966, ang); r = __builtin_fma(-q, 6.123233995736766e-17, r);
    const double r2 = r * r;
    const double sp = r + r * r2 * (-1.0 / 6 + r2 * (1.0 / 120 + r2 * (-1.0 / 5040 + r2 * (1.0 / 362880 + r2 * (-1.0 / 39916800 + r2 * (1.0 / 6227020800.0))))));
    const double cp = 1.0 + r2 * (-0.5 + r2 * (1.0 / 24 + r2 * (-1.0 / 720 + r2 * (1.0 / 40320 + r2 * (-1.0 / 3628800 + r2 * (1.0 / 479001600.0))))));
    const int n = (int)((long long)q & 3);
    const double sv = (n == 0) ? sp : (n == 1) ? cp : (n == 2) ? -sp : -cp;
    const double cv = (n == 0) ? cp : (n == 1) ? -sp : (n == 2) ? -cp : sp;
    c = (float)cv; s = (float)sv;
}
__device__ __forceinline__ void p_prologue(Frame& F, const float* w_in, const float* w_out, const float* e_w1, const float* e_w3, const float* e_w2, const float* rgw, const float* rew, const float* g2) {
    int htid = get_tid(); const int h_lane = htid & 63, h_wave = __builtin_amdgcn_readfirstlane(htid >> 6);
    LAS float* scr = (LAS float*)(F.lds + h_wave * 17408);
    const int gw = F.bid * 8 + h_wave, NGW = F.G * 8;
    unsigned char* ws = WS();
    constexpr int I_IN = 32 * 94, I_OUT = 32 * 32, I_W1 = NEXP * 32 * 8, I_W2 = NEXP * 8 * 32, I_L = I_IN + I_OUT + 2 * I_W1 + I_W2;
    for (int it = gw; it < DEPTH * I_L; it += NGW) {
        const int l = it / I_L; int r = it % I_L;
        if (r < I_IN) { transpose_item<1, 2>(w_in + (size_t)l * DM * DIN, DM, DIN, (bf16*)(ws + WS_WIN + l * SZ_WIN), scr, r, h_lane); continue; } r -= I_IN;
        if (r < I_OUT) { transpose_item<0, 4>(w_out + (size_t)l * DM * DM, DM, DM, (bf16*)(ws + WS_WOUT + l * SZ_WOUT), scr, r, h_lane); continue; } r -= I_OUT;
        if (r < I_W1) { const int e = r / 256; transpose_item<2, 4>(e_w1 + ((size_t)l * NEXP + e) * DM * DEXP, DM, DEXP, (bf16*)(ws + WS_W13 + l * SZ_W13 + e * SZ_W13E), scr, r % 256, h_lane); continue; } r -= I_W1;
        if (r < I_W1) { const int e = r / 256; transpose_item<3, 4>(e_w3 + ((size_t)l * NEXP + e) * DM * DEXP, DM, DEXP, (bf16*)(ws + WS_W13 + l * SZ_W13 + e * SZ_W13E), scr, r % 256, h_lane); continue; } r -= I_W1;
        { const int e = r / 256; transpose_item<0, 4>(e_w2 + ((size_t)l * NEXP + e) * DEXP * DM, DEXP, DM, (bf16*)(ws + WS_W2 + l * SZ_W2 + e * SZ_W2E), scr, r % 256, h_lane); }
    }
    const int gt = F.bid * 512 + htid, NGT = F.G * 512;
    for (int i = gt; i < DEPTH * 154 * (DM / 8); i += NGT) { const int l = i / (154 * 256), rr = (i / 256) % 154, ch = i % 256;
        *(u32x4*)((bf16*)(ws + WS_WIN + l * SZ_WIN) + (size_t)(DIN + rr) * DM + ch * 8) = (u32x4){0u, 0u, 0u, 0u}; }
    for (int i = gt; i < TT * 64; i += NGT) { const int t = i >> 6, k = i & 63; double inv = 1.0; for (int j = 0; j < k; ++j) inv *= 0.86596432336006535;
        float c, s; sincos_d((double)t * inv, c, s); ((float*)(ws + WS_COS128))[i] = c; ((float*)(ws + WS_SIN128))[i] = s; }
    for (int i = gt; i < TT * 32; i += NGT) { const int t = i >> 5, k = i & 31; double inv = 1.0; for (int j = 0; j < k; ++j) inv *= 0.74989420933245583;
        float c, s; sincos_d((double)t * inv, c, s); ((float*)(ws + WS_COS64))[i] = c; ((float*)(ws + WS_SIN64))[i] = s; }
    for (int i = gt; i < NB * PADF * (DM / 8); i += NGT) { const int b = i / (PADF * 256), rr = (i / 256) % PADF, ch = i % 256; const size_t row = (size_t)b * TP + rr;
        *(u32x4*)((bf16*)(ws + WS_U) + row * DM + ch * 8) = (u32x4){0u, 0u, 0u, 0u}; *(u32x4*)((bf16*)(ws + WS_MIX) + row * DM + ch * 8) = (u32x4){0u, 0u, 0u, 0u}; }
    for (int i = gt; i < NB * PADF * 64; i += NGT) { const int b = i / (PADF * 64), rr = (i / 64) % PADF, ch = i % 64; const size_t row = (size_t)b * TP + rr;
        *(f32x4*)((float*)(ws + WS_LA) + row * 256 + ch * 4) = zero4(); }
    for (int i = gt; i < DEPTH * 48 * DM; i += NGT) { const int l = i / (48 * DM), n = (i / DM) % 48, k = i % DM;
        float w = 0.f; if (n < 4) w = rgw[((size_t)l * DM + k) * 4 + n]; else if (n < 36) w = rew[((size_t)l * DM + k) * 32 + (n - 4)];
        w *= g2[(size_t)l * DM + k];
        const bf16 hi = f2bf(w); const bf16 lo = f2bf(w - bf2f(hi));
        bf16* wr = (bf16*)(ws + WS_WR + l * SZ_WR); wr[(size_t)n * DM + k] = hi; wr[(size_t)(48 + n) * DM + k] = lo; }
}
__device__ __forceinline__ void p_norm1(Frame& F, int l, const float* xin, const float* meta, const float* gain, size_t woff) {
    int htid = get_tid(); const int h_lane = htid & 63, h_wave = __builtin_amdgcn_readfirstlane(htid >> 6);
    const int gw = F.bid * 8 + h_wave, NGW = F.G * 8, lane = h_lane;
    float* H = (float*)(WS() + WS_H); bf16* U = (bf16*)(WS() + WS_U); const bf16* Y0 = (const bf16*)(WS() + WS_Y0); const bf16* Y1 = (const bf16*)(WS() + WS_Y1);
    for (int row = gw; row < R; row += NGW) {
        const int b = row / TP, v = row % TP;
        float* hr = H + (size_t)row * DM;
        if (v < PADF) { if (l == 0) {
#pragma unroll
                for (int j = 0; j < 8; ++j) *(f32x4*)(hr + 4 * (lane + 64 * j)) = zero4(); }
            continue; }
        const int t = v - PADF;
        f32x4 x[8]; float ss = 0.f;
#pragma unroll
        for (int j = 0; j < 8; ++j) { const int col = 4 * (lane + 64 * j);
            if (l == 0) { const float* src = (t < NMETA) ? meta + (size_t)t * DM : xin + ((size_t)b * SEQ + (t - NMETA)) * DM; x[j] = *(const f32x4*)(src + col); }
            else { x[j] = *(const f32x4*)(hr + col); const u32x2 a = *(const u32x2*)(Y0 + (size_t)row * DM + col), c = *(const u32x2*)(Y1 + (size_t)row * DM + col);
                x[j][0] += bflo(a.x) + bflo(c.x); x[j][1] += bfhi(a.x) + bfhi(c.x); x[j][2] += bflo(a.y) + bflo(c.y); x[j][3] += bfhi(a.y) + bfhi(c.y); }
            *(f32x4*)((char*)(hr + col) + woff) = x[j];
            ss += x[j][0] * x[j][0] + x[j][1] * x[j][1] + x[j][2] * x[j][2] + x[j][3] * x[j][3]; }
        ss = wave_sum(ss); const float rstd = rsqrt_(ss * (1.f / DM) + EPS);
#pragma unroll
        for (int j = 0; j < 8; ++j) { const int col = 4 * (lane + 64 * j); const f32x4 gg = *(const f32x4*)(gain + col);
            u32x2 w; w.x = cvtpk(x[j][0] * rstd * gg[0], x[j][1] * rstd * gg[1]); w.y = cvtpk(x[j][2] * rstd * gg[2], x[j][3] * rstd * gg[3]);
            *(u32x2*)((char*)(U + (size_t)row * DM + col) + woff) = w; }
    }
}
__device__ __forceinline__ void p_final(Frame& F) {
#ifdef PROBE_MASK
    float probe_delta = 0.f;
    { const volatile LAS unsigned long long* st = (const volatile LAS unsigned long long*)(F.lds + LDSCTL_OFF + 2048); unsigned long long tk = 0;
      for (int pz = 0; pz < 2 + 9 * DEPTH - 1; ++pz) { const int ty = (pz == 0) ? 0 : 1 + (pz - 1) % 9, ly = (pz == 0) ? 0 : (pz - 1) / 9;
          if (((PROBE_MASK >> ty) & 1) && ((PROBE_LAYERS >> ly) & 1)) tk += st[pz + 1] - st[pz]; }
      probe_delta = (PROBE_CONST) + (PROBE_ALPHA) * 0.01f * (float)tk; }
#endif
    int htid = get_tid(); const int h_lane = htid & 63, h_wave = __builtin_amdgcn_readfirstlane(htid >> 6);
    const int gw = F.bid * 8 + h_wave, NGW = F.G * 8, lane = h_lane;
    const float* H = (const float*)(WS() + WS_H); const bf16* Y0 = (const bf16*)(WS() + WS_Y0); const bf16* Y1 = (const bf16*)(WS() + WS_Y1);
    for (int o = gw; o < NB * SEQ; o += NGW) { const int b = o / SEQ, i = o % SEQ; const size_t row = (size_t)b * TP + PADF + NMETA + i;
#pragma unroll
        for (int j = 0; j < 8; ++j) { const int col = 4 * (lane + 64 * j); f32x4 x = *(const f32x4*)(H + row * DM + col);
            const u32x2 a = *(const u32x2*)(Y0 + row * DM + col), c = *(const u32x2*)(Y1 + row * DM + col);
            x[0] += bflo(a.x) + bflo(c.x); x[1] += bfhi(a.x) + bfhi(c.x); x[2] += bflo(a.y) + bflo(c.y); x[3] += bfhi(a.y) + bfhi(c.y);
#ifdef PROBE_MASK
            x = x + probe_delta;
#endif
            *(f32x4*)(((float*)gptr(F, P_OUT)) + (size_t)o * DM + col) = x; } }
}
__device__ __forceinline__ void unpack8(const u32x4 w, float (&x)[8]) { x[0] = bflo(w.x); x[1] = bfhi(w.x); x[2] = bflo(w.y); x[3] = bfhi(w.y); x[4] = bflo(w.z); x[5] = bfhi(w.z); x[6] = bflo(w.w); x[7] = bfhi(w.w); }
__device__ __forceinline__ u32x4 pack8f(const float (&x)[8]) { u32x4 w; w.x = cvtpk(x[0], x[1]); w.y = cvtpk(x[2], x[3]); w.z = cvtpk(x[4], x[5]); w.w = cvtpk(x[6], x[7]); return w; }
__device__ __forceinline__ void head128x(const bf16* p, bf16* dst, const float* gain, bool rope, bool raw, const float* cs, const float* sn, int lane) {
    const int c16 = lane & 15;
    const u32x4 w0 = *(const u32x4*)p;
    float x[8]; unpack8(w0, x);
    float ss = 0.f;
#pragma unroll
    for (int e = 0; e < 8; ++e) ss += x[e] * x[e];
    ss += __shfl_xor(ss, 1); ss += __shfl_xor(ss, 2); ss += __shfl_xor(ss, 4); ss += __shfl_xor(ss, 8);
    const float rstd = rsqrt_(ss * (1.f / 128.f) + EPS);
#pragma unroll
    for (int e = 0; e < 8; ++e) x[e] = x[e] * rstd * gain[8 * c16 + e];
    const int i0 = 8 * (c16 & 7);
#pragma unroll
    for (int e = 0; e < 8; ++e) { const float pr = __shfl_xor(x[e], 8); const float c = cs[i0 + e], s = sn[i0 + e];
        const float y = (c16 < 8) ? x[e] * c - pr * s : x[e] * c + pr * s; if (rope) x[e] = y; }
    *(u32x4*)dst = raw ? w0 : pack8f(x);
}
__device__ __forceinline__ void head128(bf16* p, const float* gain, bool rope, bool store, const float* cs, const float* sn, int lane, size_t woff = 0) {
    const int c16 = lane & 15;
    float x[8]; unpack8(*(const u32x4*)p, x);
    float ss = 0.f;
#pragma unroll
    for (int e = 0; e < 8; ++e) ss += x[e] * x[e];
    ss += __shfl_xor(ss, 1); ss += __shfl_xor(ss, 2); ss += __shfl_xor(ss, 4); ss += __shfl_xor(ss, 8);
    const float rstd = rsqrt_(ss * (1.f / 128.f) + EPS);
#pragma unroll
    for (int e = 0; e < 8; ++e) x[e] = x[e] * rstd * gain[8 * c16 + e];
    const int i0 = 8 * (c16 & 7);
#pragma unroll
    for (int e = 0; e < 8; ++e) { const float pr = __shfl_xor(x[e], 8); const float c = cs[i0 + e], s = sn[i0 + e];
        const float y = (c16 < 8) ? x[e] * c - pr * s : x[e] * c + pr * s; if (rope) x[e] = y; }
    if (store) *(u32x4*)((char*)p + woff) = pack8f(x);
}
struct PostP { const float *gaq, *gak, *gbq, *gbk, *fbias, *w2, *gb; };
__device__ __forceinline__ void post_row(Frame& F, const PostP& pp, int row, size_t woff) {
    int htid = get_tid(); const int h_lane = htid & 63, h_wave = __builtin_amdgcn_readfirstlane(htid >> 6);
    const int lane = h_lane, v = row % TP;
    if (v < PADF) return;
    const int t = v - PADF;
    bf16* zr = (bf16*)(WS() + WS_Z) + (size_t)row * DINP; float* zs = (float*)(WS() + WS_ZS) + (size_t)row * 256;
    const float* c128 = (const float*)(WS() + WS_COS128) + t * 64; const float* s128 = (const float*)(WS() + WS_SIN128) + t * 64;
    const float* c64 = (const float*)(WS() + WS_COS64) + t * 32; const float* s64 = (const float*)(WS() + WS_SIN64) + t * 32;
    const float* gaq = pp.gaq; const float* gak = pp.gak; const float* gbq = pp.gbq; const float* gbk = pp.gbk;
    head128(zr + 8 * lane, gaq, true, true, c128, s128, lane, woff);
    { bf16* kac = (bf16*)(WS() + WS_KAC) + (size_t)row * 128; bf16* vac = (bf16*)(WS() + WS_VAC) + (size_t)row * 128;
      bf16* dstp = (lane < 32) ? (bf16*)((char*)(zr + 512 + 8 * lane) + woff) : (lane < 48 ? kac + 8 * (lane - 32) : vac + 8 * (lane - 48));
      head128x(zr + 512 + 8 * lane, dstp, lane < 32 ? gaq : gak, true, lane >= 48, c128, s128, lane); }
#pragma unroll
    for (int j = 0; j < 2; ++j) { bf16* p = zr + C_IQ + 512 * j + 8 * lane; float x[8]; unpack8(*(const u32x4*)p, x); const int i0 = 8 * (lane & 3);
#pragma unroll
        for (int e = 0; e < 8; ++e) { const float pr = __shfl_xor(x[e], 4); const float c = c64[i0 + e], s = s64[i0 + e]; x[e] = (lane & 4) ? x[e] * c + pr * s : x[e] * c - pr * s; }
        *(u32x4*)((char*)p + woff) = pack8f(x); }
    head128(zr + C_BQ + 8 * lane, gbq, false, true, c128, s128, lane, woff);
    head128(zr + C_BQ + 512 + 8 * lane, lane < 32 ? gbq : gbk, false, true, c128, s128, lane, woff);
    head128(zr + C_BQ + 1024 + 8 * lane, gbk, false, true, c128, s128, lane, woff);
    { const float x = zs[S_IK + lane]; const float pr = __shfl_xor(x, 32); const int i = lane & 31; const float c = c64[i], s = s64[i];
      const float y = (lane < 32) ? x * c - pr * s : x * c + pr * s; const float yn = __shfl_xor(y, 1);
      if ((lane & 1) == 0) *(unsigned*)((bf16*)(WS() + WS_IKC) + (size_t)row * 64 + lane) = cvtpk(y, yn); }
    const float iwv = (lane < 16) ? zs[S_IW + lane] * 0.03125f : 0.f;
    const float lf = (lane < 6) ? logsigmoidf(zs[S_BF + lane] + pp.fbias[lane]) : 0.f;
    if (lane < 16) *(float*)((char*)(zs + S_IW + lane) + woff) = iwv;
    if (lane < 6) *(float*)((char*)(zs + S_BF + lane) + woff) = lf;
}
__device__ __forceinline__ void p_norm2(Frame& F, int l, const float* gain, const float* bg, const float* be, bool dup) {
    int htid = get_tid(); const int lane = htid & 63, wave = __builtin_amdgcn_readfirstlane(htid >> 6), g = lane >> 4, c16 = lane & 15;
    const int gw = F.bid * 8 + wave, NGW = F.G * 8;
    const float* H = (const float*)(WS() + WS_H); bf16* U = (bf16*)(WS() + WS_U);
    LAS float* lg = (LAS float*)(F.lds + wave * 4096); LAS float* rs = lg + 768;
    for (int rt = gw; rt < R / 16; rt += NGW) {
        const size_t row0 = (size_t)rt * 16; if ((int)(row0 % TP) < PADF) continue;
        const bf16* wr = (const bf16*)(WS() + WS_WR + l * SZ_WR);
        f32x4 acc[3] = {zero4(), zero4(), zero4()};
        const float* hrow = H + (row0 + c16) * DM + 8 * g;
        const bf16* wp0 = wr + (size_t)c16 * DM + 8 * g;
        float ss = 0.f;
#pragma unroll 4
        for (int ks = 0; ks < 64; ++ks) {
            const f32x4 a = *(const f32x4*)(hrow + 32 * ks), b = *(const f32x4*)(hrow + 32 * ks + 4);
            ss += (a[0] * a[0] + a[1] * a[1]) + (a[2] * a[2] + a[3] * a[3]) + (b[0] * b[0] + b[1] * b[1]) + (b[2] * b[2] + b[3] * b[3]);
            u32x4 hw; hw.x = cvtpk(a[0], a[1]); hw.y = cvtpk(a[2], a[3]); hw.z = cvtpk(b[0], b[1]); hw.w = cvtpk(b[2], b[3]);
            u32x4 lw; lw.x = cvtpk(a[0] - bflo(hw.x), a[1] - bfhi(hw.x)); lw.y = cvtpk(a[2] - bflo(hw.y), a[3] - bfhi(hw.y));
            lw.z = cvtpk(b[0] - bflo(hw.z), b[1] - bfhi(hw.z)); lw.w = cvtpk(b[2] - bflo(hw.w), b[3] - bfhi(hw.w));
            const bf16x8 Ah = *reinterpret_cast<const bf16x8*>(&hw), Al = *reinterpret_cast<const bf16x8*>(&lw);
#pragma unroll
            for (int ct = 0; ct < 3; ++ct) { const bf16* wp = wp0 + (size_t)(16 * ct) * DM + 32 * ks;
                const bf16x8 Bh = *(const bf16x8*)wp, Bl = *(const bf16x8*)(wp + (size_t)48 * DM);
                acc[ct] = __builtin_amdgcn_mfma_f32_16x16x32_bf16(Ah, Bh, acc[ct], 0, 0, 0);
                acc[ct] = __builtin_amdgcn_mfma_f32_16x16x32_bf16(Ah, Bl, acc[ct], 0, 0, 0);
                acc[ct] = __builtin_amdgcn_mfma_f32_16x16x32_bf16(Al, Bh, acc[ct], 0, 0, 0); } }
        ss += __shfl_xor(ss, 16); ss += __shfl_xor(ss, 32);
        if (g == 0) rs[c16] = rsqrt_(ss * (1.f / DM) + EPS);
#pragma unroll
        for (int ct = 0; ct < 3; ++ct)
#pragma unroll
            for (int r = 0; r < 4; ++r) lg[(4 * g + r) * 48 + 16 * ct + c16] = acc[ct][r];
        LDS_WAIT();
        if (lane < 16) { const size_t row = row0 + lane;
            const float rstd = rs[lane];
            float gl[4]; int gi = 0; float gm = -1e30f;
#pragma unroll
            for (int j = 0; j < 4; ++j) { gl[j] = lg[lane * 48 + j] * rstd + bg[j]; if (gl[j] > gm) { gm = gl[j]; gi = j; } }
            float gs = 0.f;
#pragma unroll
            for (int j = 0; j < 4; ++j) gs += fexp_(gl[j] - gm);
            const float gp = 1.f / gs;
            float el[8]; int e0 = 0, e1 = 0; float m0 = -1e30f, m1 = -1e30f;
#pragma unroll
            for (int j = 0; j < 8; ++j) el[j] = lg[lane * 48 + 4 + 8 * gi + j] * rstd + be[8 * gi + j];
#pragma unroll
            for (int j = 0; j < 8; ++j) { if (el[j] > m0) { m1 = m0; e1 = e0; m0 = el[j]; e0 = j; } else if (el[j] > m1) { m1 = el[j]; e1 = j; } }
            const float w1r = fexp_(m1 - m0); const float p0 = 1.f / (1.f + w1r), p1 = w1r / (1.f + w1r);
            unsigned* cnt = CTL() + CW_CNT + 1024 * l + (dup ? 16 : 0); unsigned* list = (unsigned*)(WS() + (dup ? WS_END : WS_LIST)); float* gate = (float*)(WS() + WS_GATE);
            const int x0 = gi * 8 + e0, x1 = gi * 8 + e1;
            const unsigned i0 = atomicAdd(cnt + 32 * x0, 1u), i1 = atomicAdd(cnt + 32 * x1, 1u);
            list[(size_t)x0 * R + i0] = (unsigned)row * 2u; list[(size_t)x1 * R + i1] = (unsigned)row * 2u + 1u;
            gate[row * 2] = gp * p0; gate[row * 2 + 1] = gp * p1; }
        LDS_WAIT();
    }
    for (int row = gw; row < R; row += NGW) { if ((row % TP) < PADF) continue;
        f32x4 x[8]; float ss = 0.f;
#pragma unroll
        for (int j = 0; j < 8; ++j) { x[j] = *(const f32x4*)(H + (size_t)row * DM + 4 * (lane + 64 * j)); ss += x[j][0] * x[j][0] + x[j][1] * x[j][1] + x[j][2] * x[j][2] + x[j][3] * x[j][3]; }
        ss = wave_sum(ss); const float rstd = rsqrt_(ss * (1.f / DM) + EPS);
#pragma unroll
        for (int j = 0; j < 8; ++j) { const int col = 4 * (lane + 64 * j); const f32x4 gg = *(const f32x4*)(gain + col);
            u32x2 w; w.x = cvtpk(x[j][0] * rstd * gg[0], x[j][1] * rstd * gg[1]); w.y = cvtpk(x[j][2] * rstd * gg[2], x[j][3] * rstd * gg[3]);
            *(u32x2*)(U + (size_t)row * DM + col) = w; } }
}
__device__ __forceinline__ void build_moetab(Frame& F, int l) {
    int htid = get_tid(); const int h_lane = htid & 63, h_wave = __builtin_amdgcn_readfirstlane(htid >> 6);
    LAS pg8::MoeTab* tab = (LAS pg8::MoeTab*)(F.lds + MOETAB_OFF);
    if (htid == 0) { int t = 0; const unsigned* cnt = CTL() + CW_CNT + 1024 * l;
        for (int e = 0; e < NEXP; ++e) { const int n = (int)__hip_atomic_load(cnt + 32 * e, __ATOMIC_RELAXED, __HIP_MEMORY_SCOPE_AGENT); tab->cnt[e] = n;
            for (int j = 0; j * 256 < n && t < 176; ++j) { tab->e[t] = e; tab->r0[t] = j * 256; ++t; } }
        tab->ntiles = t; }
    __syncthreads();
}

#define INPARG(i) args_in_dyn(args, (i))
constexpr int NPH = 2 + 9 * DEPTH;
struct Args { const float* in[21]; float* out; unsigned char* ws; int ph_lo, ph_hi; };
#define PHASE_FN static __device__ __forceinline__
#define MKFRAME Frame F; F.lds = lds; F.ldsg = (char*)lds; F.tid = 0; F.lane = 0; F.wave = 0; F.G = (int)gridDim.x; F.bid = (int)blockIdx.x
#define Z ((bf16*)(WS() + WS_Z))
#define ZS ((float*)(WS() + WS_ZS))
#define MIX ((bf16*)(WS() + WS_MIX))
#define U ((bf16*)(WS() + WS_U))
#define LA ((float*)(WS() + WS_LA))
#define KV ((float*)(WS() + WS_KV))
#define DVEC ((float*)(WS() + WS_DVEC))
#define SS ((float*)(WS() + WS_SS))
PHASE_FN void ph_prologue(LAS unsigned char* lds) { MKFRAME; p_prologue(F, INP(4), INP(13), INP(18), INP(19), INP(20), INP(14), INP(16), INP(3)); }
PHASE_FN void ph_norm1(LAS unsigned char* lds, int l, size_t woff) { MKFRAME; p_norm1(F, l, INP(0), INP(1), INP(2) + (size_t)l * DM, woff); }
PHASE_FN void ph_inproj(LAS unsigned char* lds, int l) { MKFRAME;
    pg8::DenseProb P; P.init(U, WS() + WS_WIN + l * SZ_WIN, R, DINP, DM, F.G, F.bid);
    pg8::EpiInProj E{Z, ZS};
    pg8::gemm_phase(F.lds, P, E);
}
PHASE_FN void ph_post(LAS unsigned char* lds, int l, size_t woff) { MKFRAME;
    PostP pp{INP(5) + l * 128, INP(6) + l * 128, INP(7) + l * 128, INP(8) + l * 128, INP(9) + l * 6, INP(10) + (size_t)l * 16 * 256, INP(11) + l * 256};
    for (int u = F.bid; u < (R / 64) * 4; u += F.G) gla::step1(F.lds, Z, ZS, LA, INP(10) + (size_t)l * 16 * 256, INP(11) + l * 256, KV, DVEC, (u >> 2) / 65, (u >> 2) % 65, u & 3);
    { const int gw = F.bid * 8 + (get_tid() >> 6);
      for (int row = gw; row < R; row += F.G * 8) post_row(F, pp, row, woff); }
}
#ifndef MIXM
#define MIXM 15
#endif
PHASE_FN void ph_mix(LAS unsigned char* lds, int l, int rep) { MKFRAME;
    volatile LAS unsigned* MISC = (volatile LAS unsigned*)(F.lds + MISC_OFF);
    if ((MIXM & 1) && F.bid < 64) gla::step2(KV, DVEC, SS, F.bid);
    if (MIXM & 2) { for (int it = F.G - 1 - F.bid; it < 192; it += F.G) fox::item(F.ldsg, Z, ZS, MIX, it); }
    if ((MIXM & 4) && F.bid < NB) fox::meta_unit(Z, ZS, MIX, F.bid);
    __syncthreads();
    for (; MIXM & 8;) {
        if (get_tid() == 0) MISC[0] = atomicAdd(CTL() + CW_QUEUE + 64 * l + 32 * rep, 1u);
        __syncthreads();
        const int q = (int)MISC[0];
        __syncthreads();
        if (q >= 65 * 32) break;
        const int c = 64 - q / 32, b = (q % 32) / 8, sub = q % 8;
        if (c == 0 && sub < 6) continue;
        dsa::unit(F.lds, Z, ZS, (const bf16*)(WS() + WS_IKC), (const bf16*)(WS() + WS_KAC), (const bf16*)(WS() + WS_VAC), MIX, b, c, sub);
    }
}
PHASE_FN void ph_gla3(LAS unsigned char* lds, int l) { MKFRAME;
    for (int u = F.bid; u < (R / 64) * 4; u += F.G) gla::step3(F.lds, Z, LA, SS, INP(12) + l * 128, MIX, (u >> 2) / 65, (u >> 2) % 65, u & 3);
}
PHASE_FN void ph_outproj(LAS unsigned char* lds, int l, size_t woff) { MKFRAME;
    pg8::DenseProb P; P.init(MIX, WS() + WS_WOUT + l * SZ_WOUT, R, DM, DM, F.G, F.bid);
    pg8::EpiOutProj E{(float*)(WS() + WS_H + woff)};
    pg8::gemm_phase(F.lds, P, E);
}
PHASE_FN void ph_norm2(LAS unsigned char* lds, int l, bool dup) { MKFRAME;
    p_norm2(F, l, INP(3) + (size_t)l * DM, INP(15) + l * 4, INP(17) + l * 32, dup);
}
PHASE_FN void ph_moeup(LAS unsigned char* lds, int l) { MKFRAME;
    build_moetab(F, l);
    pg8::MoeProb<true> P; P.K = DM; P.lda = DM; P.A = (const char*)U; P.W = (const char*)(WS() + WS_W13 + l * SZ_W13); P.list = (const unsigned*)(WS() + WS_LIST);
    P.tab = (const LAS pg8::MoeTab*)(F.lds + MOETAB_OFF); P.G = F.G; P.c = F.bid;
    pg8::EpiMoeUp E{(bf16*)(WS() + WS_HID)};
    pg8::gemm_phase(F.lds, P, E);
}
PHASE_FN void ph_moedown(LAS unsigned char* lds, int l) { MKFRAME;
    build_moetab(F, l);
    pg8::MoeProb<false> P; P.K = DEXP; P.lda = DEXP; P.A = (const char*)(WS() + WS_HID); P.W = (const char*)(WS() + WS_W2 + l * SZ_W2); P.list = (const unsigned*)(WS() + WS_LIST);
    P.tab = (const LAS pg8::MoeTab*)(F.lds + MOETAB_OFF); P.G = F.G; P.c = F.bid;
    pg8::EpiMoeDown E{(bf16*)(WS() + WS_Y0), (bf16*)(WS() + WS_Y1), (const unsigned*)(WS() + WS_LIST), (const float*)(WS() + WS_GATE), (const LAS pg8::MoeTab*)(F.lds + MOETAB_OFF)};
    pg8::gemm_phase(F.lds, P, E);
}
PHASE_FN void ph_final(LAS unsigned char* lds) { MKFRAME; p_final(F); }
#undef Z
#undef ZS
#undef MIX
#undef U
#undef LA
#undef KV
#undef DVEC
#undef SS

__device__ __forceinline__ const float* args_in_dyn(const Args& a, int i) { const float* p = a.in[0];
#pragma unroll
    for (int k = 1; k < 21; ++k) p = (i == k) ? a.in[k] : p;
    return p; }
__global__ void __launch_bounds__(512, 2) fwd_kernel(Args args) {
    extern __shared__ __attribute__((aligned(16))) unsigned char lds_raw[];
    LAS unsigned char* lds = (LAS unsigned char*)lds_raw;
    const int tid = threadIdx.x;
    if ((tid & 63) == 0) *(volatile LAS unsigned*)(uintptr_t)(WAVETAB_OFF + 4 * ((unsigned)__builtin_amdgcn_s_getreg((5 << 11) | 4) & 63u)) = (unsigned)tid >> 6;
    if (tid < 23) { const unsigned long long v = (tid < 21) ? (unsigned long long)INPARG(tid) : (tid == 21 ? (unsigned long long)args.out : (unsigned long long)args.ws);
        LAS unsigned* t = (LAS unsigned*)(lds + PTAB_OFF) + 2 * tid; t[0] = (unsigned)v; t[1] = (unsigned)(v >> 32); }
    volatile LAS unsigned* MISC = (volatile LAS unsigned*)(lds + MISC_OFF);
    for (int u = tid; u < 256; u += 512) ((LAS unsigned*)(lds + LDSCTL_OFF))[u] = 0u;
    __syncthreads();
    const int lo = args.ph_lo, hi = args.ph_hi;
    const bool multi = (hi - lo) > 1;
    unsigned* barw = (unsigned*)(args.ws + WS_CTL) + CW_BAR;
    XcdBarrier bar; bar.bar = barw; bar.x = 0; bar.st = nullptr;
    if (multi) bar = xcd_barrier_post(barw, MISC + 8);
#define IN(k) (lo <= (k) && (k) < hi)
#define SEAM(k) do { if (IN(k) && IN((k) + 1)) xcd_barrier(bar); } while (0)
#ifndef DUP_MASK
#define DUP_MASK 0
#endif
#define NREP(ty) (((DUP_MASK >> (ty)) & 1) ? 2 : 1)
#define REPBAR(rep, ty) do { if ((rep) + 1 < NREP(ty) && multi) xcd_barrier(bar); } while (0)
    constexpr size_t DUPOFF = (size_t)774000128;
    for (int rep = 0; rep < NREP(0); ++rep) { if (IN(0)) ph_prologue(lds); REPBAR(rep, 0); }
    SEAM(0);
    for (int l = 0; l < DEPTH; ++l) {
        const int pb = 1 + 9 * l;
        for (int rep = 0; rep < NREP(1); ++rep) { if (IN(pb + 0)) ph_norm1(lds, l, rep ? DUPOFF : 0); REPBAR(rep, 1); }   SEAM(pb + 0);
        for (int rep = 0; rep < NREP(2); ++rep) { if (IN(pb + 1)) ph_inproj(lds, l); REPBAR(rep, 2); }  SEAM(pb + 1);
        for (int rep = 0; rep < NREP(3); ++rep) { if (IN(pb + 2)) ph_post(lds, l, rep ? DUPOFF : 0); REPBAR(rep, 3); }    SEAM(pb + 2);
        for (int rep = 0; rep < NREP(4); ++rep) { if (IN(pb + 3)) ph_mix(lds, l, rep); REPBAR(rep, 4); }     SEAM(pb + 3);
        for (int rep = 0; rep < NREP(5); ++rep) { if (IN(pb + 4)) ph_gla3(lds, l); REPBAR(rep, 5); }    SEAM(pb + 4);
        for (int rep = 0; rep < NREP(6); ++rep) { if (IN(pb + 5)) ph_outproj(lds, l, rep ? DUPOFF : 0); REPBAR(rep, 6); } SEAM(pb + 5);
        for (int rep = 0; rep < NREP(7); ++rep) { if (IN(pb + 6)) ph_norm2(lds, l, rep != 0); REPBAR(rep, 7); }   SEAM(pb + 6);
        for (int rep = 0; rep < NREP(8); ++rep) { if (IN(pb + 7)) ph_moeup(lds, l); REPBAR(rep, 8); }   SEAM(pb + 7);
        for (int rep = 0; rep < NREP(9); ++rep) { if (IN(pb + 8)) ph_moedown(lds, l); REPBAR(rep, 9); } SEAM(pb + 8);
    }
    if (IN(NPH - 1)) ph_final(lds);
#undef IN
#undef SEAM
}

extern "C" void kernel_launch(void* const* d_in, const int* in_sizes, int n_in, void* d_out, int out_size, void* d_ws, size_t ws_size, hipStream_t stream) {
    static int grid = 0;
    if (grid == 0) {
        if (n_in != 21 || out_size != NB * SEQ * DM || ws_size < (DUP_MASK ? (size_t)2147483648u : WS_END)) { fprintf(stderr, "kernel_launch: unexpected shapes (n_in %d out %d ws %zu need %zu)\n", n_in, out_size, ws_size, (size_t)WS_END); grid = -1; return; }
        int dev = 0, cus = 0, per_cu = 0;
        if (hipGetDevice(&dev) != hipSuccess || hipDeviceGetAttribute(&cus, hipDeviceAttributeMultiprocessorCount, dev) != hipSuccess) { grid = -1; return; }
        if (hipFuncSetAttribute((const void*)fwd_kernel, hipFuncAttributeMaxDynamicSharedMemorySize, LDS_BYTES) != hipSuccess) { fprintf(stderr, "kernel_launch: hipFuncSetAttribute failed\n"); grid = -1; return; }
        if (hipOccupancyMaxActiveBlocksPerMultiprocessor(&per_cu, (const void*)fwd_kernel, 512, LDS_BYTES) != hipSuccess || per_cu < 1) fprintf(stderr, "kernel_launch: occupancy query says %d\n", per_cu);
        (void)hipGetLastError();
        grid = cus;
    }
    if (grid < 0) return;
    (void)hipMemsetAsync((char*)d_ws + WS_CTL, 0, CTL_ZERO_BYTES, stream);
    Args a{};
    for (int i = 0; i < 21; ++i) a.in[i] = (const float*)d_in[i];
    a.out = (float*)d_out; a.ws = (unsigned char*)d_ws;
#if MK_N_LAUNCHES == 1
    a.ph_lo = 0; a.ph_hi = NPH;
    hipLaunchKernelGGL(fwd_kernel, dim3(grid), dim3(512), LDS_BYTES, stream, a);
#else
    for (int p = 0; p < NPH; ++p) { a.ph_lo = p; a.ph_hi = p + 1; hipLaunchKernelGGL(fwd_kernel, dim3(grid), dim3(512), LDS_BYTES, stream, a); }
#endif
}
```

```cpp
#include <hip/hip_runtime.h>
#include <cstdio>
#include <cstdint>

#ifndef MK_N_LAUNCHES
#define MK_N_LAUNCHES 1
#endif

#define GAS __attribute__((address_space(1)))
#define LAS __attribute__((address_space(3)))
typedef unsigned short bf16;
typedef unsigned u32x4 __attribute__((ext_vector_type(4)));
typedef unsigned u32x2 __attribute__((ext_vector_type(2)));
typedef float f32x4 __attribute__((ext_vector_type(4)));
typedef float f32x2 __attribute__((ext_vector_type(2)));
typedef float f32x16 __attribute__((ext_vector_type(16)));
typedef short bf16x8 __attribute__((ext_vector_type(8)));
typedef short s16x4 __attribute__((ext_vector_type(4)));
#define LDS_WAIT() asm volatile("s_waitcnt lgkmcnt(0)" ::: "memory")
#define VM_WAIT() asm volatile("s_waitcnt vmcnt(0)" ::: "memory")

constexpr int NB = 4, SEQ = 4096, NMETA = 16, TT = SEQ + NMETA;
constexpr int PADF = 48, TP = 4160;
constexpr int R = NB * TP;
constexpr int DM = 2048, DEPTH = 4;
constexpr int DIN = 5990, DINP = 6144;
constexpr int NEXP = 32, DEXP = 512;
constexpr float EPS = 1e-6f;
constexpr int C_AQ = 0, C_AK = 768, C_AV = 896, C_IQ = 1024, C_BQ = 2048, C_BK = 2816, C_BV = 3584, C_CQ = 4352, C_CK = 4608, C_CV = 4864, C_CG = 5376, C_IK = 5888;
constexpr int S_IK = 0, S_IW = 64, S_BF = 80, S_CR = 86;

constexpr size_t al256(size_t x) { return (x + 255) & ~(size_t)255; }
constexpr size_t WS_CTL = 0, CTL_ZERO_BYTES = 1u << 20;
constexpr size_t WS_COS128 = WS_CTL + CTL_ZERO_BYTES;
constexpr size_t WS_SIN128 = WS_COS128 + al256((size_t)TT * 64 * 4);
constexpr size_t WS_COS64 = WS_SIN128 + al256((size_t)TT * 64 * 4);
constexpr size_t WS_SIN64 = WS_COS64 + al256((size_t)TT * 32 * 4);
constexpr size_t WS_WIN = WS_SIN64 + al256((size_t)TT * 32 * 4);
constexpr size_t SZ_WIN = (size_t)DINP * DM * 2;
constexpr size_t WS_WOUT = WS_WIN + DEPTH * SZ_WIN;
constexpr size_t SZ_WOUT = (size_t)DM * DM * 2;
constexpr size_t WS_W13 = WS_WOUT + DEPTH * SZ_WOUT;
constexpr size_t SZ_W13E = (size_t)1024 * DM * 2, SZ_W13 = NEXP * SZ_W13E;
constexpr size_t WS_W2 = WS_W13 + DEPTH * SZ_W13;
constexpr size_t SZ_W2E = (size_t)DM * DEXP * 2, SZ_W2 = NEXP * SZ_W2E;
constexpr size_t WS_WR = WS_W2 + DEPTH * SZ_W2;
constexpr size_t SZ_WR = (size_t)2 * 48 * DM * 2;
constexpr size_t WS_H = WS_WR + DEPTH * SZ_WR;
constexpr size_t WS_U = WS_H + (size_t)R * DM * 4;
constexpr size_t WS_Z = WS_U + (size_t)R * DM * 2;
constexpr size_t WS_ZS = WS_Z + (size_t)R * DINP * 2;
constexpr size_t WS_LA = WS_ZS + (size_t)R * 256 * 4;
constexpr size_t WS_MIX = WS_LA + (size_t)R * 256 * 4;
constexpr int HID_TILES = 168;
constexpr size_t WS_HID = WS_MIX + (size_t)R * DM * 2;
constexpr size_t WS_Y0 = WS_HID + (size_t)HID_TILES * 256 * DEXP * 2;
constexpr size_t WS_Y1 = WS_Y0 + (size_t)R * DM * 2;
constexpr size_t WS_KV = WS_Y1 + (size_t)R * DM * 2;
constexpr size_t WS_DVEC = WS_KV + (size_t)16 * 65 * 64 * 128 * 4;
constexpr size_t WS_SS = WS_DVEC + al256((size_t)16 * 65 * 64 * 4);
constexpr size_t WS_LIST = WS_SS + (size_t)16 * 66 * 64 * 128 * 4;
constexpr size_t WS_GATE = WS_LIST + (size_t)NEXP * R * 4;
constexpr size_t WS_IKC = WS_GATE + (size_t)R * 2 * 4;
constexpr size_t WS_KAC = WS_IKC + (size_t)R * 64 * 2;
constexpr size_t WS_VAC = WS_KAC + (size_t)R * 128 * 2;
constexpr size_t WS_END = WS_VAC + (size_t)R * 128 * 2;

constexpr int CW_BAR = 4096;
constexpr int CW_CNT = 16384;
constexpr int CW_QUEUE = 20480;

constexpr int RING_BYTES = 131072;
constexpr int MOETAB_OFF = 131072;
constexpr int LDSCTL_OFF = 143360, MISC_OFF = LDSCTL_OFF + 320;
constexpr int LDS_BYTES = 147456;

constexpr int WAVETAB_OFF = LDSCTL_OFF + 1536;
__device__ __forceinline__ int get_tid() {
    const unsigned slot = (unsigned)__builtin_amdgcn_s_getreg((5 << 11) | 4) & 63u;
    const unsigned w = *(volatile LAS unsigned*)(uintptr_t)(WAVETAB_OFF + 4 * slot);
    unsigned lane; asm volatile("v_mbcnt_lo_u32_b32 %0, -1, 0\n\tv_mbcnt_hi_u32_b32 %0, -1, %0" : "=v"(lane));
    return (int)((unsigned)__builtin_amdgcn_readfirstlane(w) * 64u + lane);
}
__device__ __forceinline__ unsigned cvtpk(float lo, float hi) { unsigned r; asm volatile("v_cvt_pk_bf16_f32 %0, %1, %2" : "=v"(r) : "v"(lo), "v"(hi)); return r; }
__device__ __forceinline__ float bf2f(unsigned short b) { return __uint_as_float(((unsigned)b) << 16); }
__device__ __forceinline__ float bflo(unsigned w) { return __uint_as_float(w << 16); }
__device__ __forceinline__ float bfhi(unsigned w) { return __uint_as_float(w & 0xffff0000u); }
__device__ __forceinline__ bf16 f2bf(float f) { return (bf16)(cvtpk(f, 0.f) & 0xffffu); }
__device__ __forceinline__ float wave_sum(float v) {
#pragma unroll
    for (int o = 1; o < 64; o <<= 1) v += __shfl_xor(v, o);
    return v;
}
__device__ __forceinline__ f32x4 zero4() { float z = 0.f; asm volatile("" : "+v"(z)); return (f32x4){z, z, z, z}; }
__device__ __forceinline__ float logsigmoidf(float x) { const float e = __builtin_amdgcn_exp2f(-fabsf(x) * 1.4426950408889634f); return fminf(x, 0.f) - __builtin_amdgcn_logf(1.0f + e) * 0.6931471805599453f; }
__device__ __forceinline__ float fexp_(float x) { return __builtin_amdgcn_exp2f(x * 1.4426950408889634f); }
__device__ __forceinline__ float rsqrt_(float x) { return __builtin_amdgcn_rsqf(x); }
__device__ __forceinline__ float siluf(float x) { return x * __builtin_amdgcn_rcpf(1.f + __builtin_amdgcn_exp2f(-x * 1.4426950408889634f)); }

#define XB_TMO      128
#define XB_XCNT(j)  (256  + 64 * (j))
#define XB_XSUB(j)  (1280 + 64 * (j))
#define XB_XGEN(j)  (2304 + 64 * (j))
#define XB_TOP      3328
#define XB_TOPGEN   3392
#define XCD_BAR_WORDS 3456
#define XB_SPIN_CAP (1u << 18)
__device__ __forceinline__ unsigned xb_ld(unsigned* p)              { return __hip_atomic_load(p, __ATOMIC_RELAXED, __HIP_MEMORY_SCOPE_AGENT); }
__device__ __forceinline__ unsigned xb_add(unsigned* p, unsigned v) { return __hip_atomic_fetch_add(p, v, __ATOMIC_RELAXED, __HIP_MEMORY_SCOPE_AGENT); }
__device__ __forceinline__ unsigned xb_xcc_id() { return (unsigned)__builtin_amdgcn_s_getreg((3 << 11) | 20) & 0xFu; }
#define XB_SPIN(cond, bar) do { unsigned _sp = 0; while (cond) { __builtin_amdgcn_s_sleep(1); \
    if ((++_sp & 255u) == 0u) { if (xb_ld(&(bar)[XB_TMO])) break; if (_sp > XB_SPIN_CAP) { atomicAdd(&(bar)[XB_TMO], 1u); break; } } } } while (0)
struct XcdBarrier { unsigned* bar; unsigned x; volatile LAS unsigned* st; };
__device__ __forceinline__ XcdBarrier xcd_barrier_post(unsigned* bar, volatile LAS unsigned* st) {
    XcdBarrier b; b.bar = bar; b.x = xb_xcc_id(); b.st = st;
    if (get_tid() == 0) (void)xb_add(&bar[XB_XCNT(b.x)], 1u);
    return b;
}
__device__ __forceinline__ void xcd_barrier_complete(unsigned* bar, unsigned x, unsigned& nloc, unsigned& nx) {
    const unsigned G = gridDim.x * gridDim.y * gridDim.z;
    unsigned sum, cnt, mine, sp = 0u;
    for (;;) {
        sum = 0u; cnt = 0u; mine = 0u;
#pragma unroll
        for (unsigned j = 0; j < 16; ++j) { const unsigned c = xb_ld(&bar[XB_XCNT(j)]); sum += c; cnt += (c > 0u) ? 1u : 0u; mine = (j == x) ? c : mine; }
        if (sum == G) break;
        __builtin_amdgcn_s_sleep(1);
        if ((++sp & 255u) == 0u) { if (xb_ld(&bar[XB_TMO])) break; if (sp > XB_SPIN_CAP) { atomicAdd(&bar[XB_TMO], 1u); break; } }
    }
    nloc = mine > 0u ? mine : 1u; nx = cnt > 0u ? cnt : 1u;
}
__device__ __forceinline__ void xcd_barrier(const XcdBarrier& b) {
    asm volatile("s_waitcnt vmcnt(0)" ::: "memory");
    __syncthreads();
    if (get_tid() == 0) {
        unsigned* bar = b.bar; unsigned bx = b.x;
        asm volatile("" : "+s"(bar), "+s"(bx));
        __builtin_amdgcn_s_waitcnt(0);
        unsigned nloc = b.st[0], nx = b.st[1];
        if (nloc == 0u) { xcd_barrier_complete(bar, bx, nloc, nx); b.st[0] = nloc; b.st[1] = nx; }
        const unsigned old = xb_add(&bar[XB_XSUB(bx)], 1u);
        const unsigned gen = old / nloc;
        if (old + 1u == (gen + 1u) * nloc) {
            __builtin_amdgcn_fence(__ATOMIC_RELEASE, "agent");
            asm volatile("s_waitcnt vmcnt(0)" ::: "memory");
            const unsigned og = xb_add(&bar[XB_TOP], 1u);
            const unsigned tg = og / nx;
            if (og + 1u == (tg + 1u) * nx) xb_add(&bar[XB_TOPGEN], 1u);
            else XB_SPIN(xb_ld(&bar[XB_TOPGEN]) == tg, bar);
            __builtin_amdgcn_fence(__ATOMIC_ACQUIRE, "agent");
            xb_add(&bar[XB_XGEN(bx)], 1u);
            asm volatile("s_waitcnt vmcnt(0)" ::: "memory");
        } else {
            XB_SPIN(xb_ld(&bar[XB_XGEN(bx)]) == gen, bar);
            __builtin_amdgcn_fence(__ATOMIC_ACQUIRE, "agent");
            asm volatile("s_waitcnt vmcnt(0)" ::: "memory");
        }
    }
    __syncthreads();
}

namespace pg8 {
constexpr int BM = 256, BK = 64, HALF = 128, HTB = HALF * BK * 2, STAGE_BYTES = 8 * HTB;
__host__ __device__ __forceinline__ int lds_byte(int r, int c) { const int st = (r >> 4) * 2 + (c >> 5), rr = r & 15, cc = c & 31, ob = rr * 64 + cc * 2; return st * 1024 + (ob ^ (((ob >> 9) & 1) << 5)); }
__host__ __device__ __forceinline__ void stage_rc(int b, int& Rr, int& C) { const int st = b / 1024, sb = b % 1024, swz = sb ^ (((sb >> 9) & 1) << 5); Rr = (st >> 1) * 16 + swz / 64; C = (st & 1) * 32 + (swz % 64) / 2; }
__host__ __device__ __forceinline__ int perm32(int rho) { const int n = rho >> 4, i = rho & 15; return 8 * (i >> 2) + 4 * n + (i & 3); }
struct Unit { int pm, pn, e, r0; };

template <class Epi, class Prob>
__device__ __forceinline__ void gemm_phase(LAS unsigned char* lds, const Prob& P, const Epi& E) {
    int tid = get_tid();
    const int wid = __builtin_amdgcn_readfirstlane(tid >> 6), lane = tid & 63, wr = wid >> 2, wc = wid & 3, fr = lane & 15, fq = lane >> 4;
    const int K = P.K, nt = K / BK;
    unsigned voffB;
    { int Rr, C; stage_rc(tid * 16, Rr, C); const int Rb = Epi::PERM ? ((Rr & ~31) + perm32(Rr & 31)) : Rr; voffB = (unsigned)(Rb * K + C) * 2u; }
    const size_t hstep = (size_t)HALF * K * 2, qstepB = (size_t)64 * K * 2;
    const unsigned ldsw = (unsigned)wid * 1024u;
    const int aoff = lds_byte(wr * 64 + fr, fq * 8), boff = lds_byte(wc * 32 + fr, fq * 8);
#define PG8_SA(b, h) (((b) * 2 + (h)) * HTB)
#define PG8_SB(b, h) ((4 + (b) * 2 + (h)) * HTB)
#define PG8_STAGE1(bufoff, gbase, voff, qstep) do { _Pragma("unroll") for (int _i = 0; _i < 2; ++_i) \
        __builtin_amdgcn_global_load_lds((const unsigned*)((const char*)(gbase) + (size_t)_i * (qstep) + (voff)), (LAS unsigned*)(lds + (bufoff) + ldsw + _i * 8192), 16, 0, 0); } while (0)
#define PG8_STAGE2(bufoff, gbase, voff) do { _Pragma("unroll") for (int _i = 0; _i < 2; ++_i) \
        __builtin_amdgcn_global_load_lds((const unsigned*)((const char*)(gbase) + (voff)[_i]), (LAS unsigned*)(lds + (bufoff) + ldsw + _i * 8192), 16, 0, 0); } while (0)
#define PG8_STB(bufoff, gbase) PG8_STAGE1(bufoff, gbase, voffB, qstepB)
#define PG8_STA(bufoff, gbase, h) do { if constexpr (GA) PG8_STAGE2(bufoff, gbase, ao[h]); else PG8_STAGE1(bufoff, (gbase) + (size_t)(h) * hstepA, ao[0][0], qstepA); } while (0)
#define PG8_LDA(dst, b, h) do { _Pragma("unroll") for (int m = 0; m < 4; ++m) _Pragma("unroll") for (int k = 0; k < 2; ++k) dst[m][k] = *(const LAS bf16x8*)(lds + PG8_SA(b, h) + aoff + m * 2048 + k * 1024); } while (0)
#define PG8_LDB(dst, b, h) do { _Pragma("unroll") for (int n = 0; n < 2; ++n) _Pragma("unroll") for (int k = 0; k < 2; ++k) dst[n][k] = *(const LAS bf16x8*)(lds + PG8_SB(b, h) + boff + n * 2048 + k * 1024); } while (0)
#define PG8_MMA(ai, bj, At, Bt) do { __builtin_amdgcn_s_setprio(1); _Pragma("unroll") for (int m = 0; m < 4; ++m) _Pragma("unroll") for (int n = 0; n < 2; ++n) _Pragma("unroll") for (int k = 0; k < 2; ++k) \
        acc[ai][bj][m][n] = __builtin_amdgcn_mfma_f32_16x16x32_bf16(Bt[n][k], At[m][k], acc[ai][bj][m][n], 0, 0, 0); __builtin_amdgcn_s_setprio(0); } while (0)
#define PG8_WAIT_V(n) asm volatile("s_waitcnt vmcnt(" #n ")" ::: "memory")
#define PG8_WAIT_L(n) asm volatile("s_waitcnt lgkmcnt(" #n ")" ::: "memory")
#define PG8_BAR __builtin_amdgcn_s_barrier()
#define PG8_SCHED __builtin_amdgcn_sched_barrier(0)
    Unit cur, nxt; int ui = 0;
    if (!P.next(0, cur)) return;
    constexpr bool GA = Prob::GATHER;
    unsigned ao[2][2]; const size_t hstepA = (size_t)HALF * P.lda * 2, qstepA = (size_t)64 * P.lda * 2;
    const char* cA = P.abase();
    if constexpr (GA) P.aoffs(cur, tid, ao);
    else { ao[0][0] = P.aoffs0(tid); cA += P.aunit(cur); }
    const char* cB = P.bptr(cur);
    const size_t kstep = (size_t)(BK * 2);
    PG8_STB(PG8_SB(0, 0), cB); PG8_STB(PG8_SB(0, 1), cB + hstep); PG8_STA(PG8_SA(0, 0), cA, 0); PG8_STA(PG8_SA(0, 1), cA, 1);
    if (wr == 1) PG8_BAR;
    PG8_WAIT_V(2); PG8_BAR;
    PG8_STB(PG8_SB(1, 0), cB + kstep); PG8_STA(PG8_SA(1, 0), cA + kstep, 0); PG8_STB(PG8_SB(1, 1), cB + hstep + kstep);
    PG8_WAIT_V(6); PG8_BAR;
    f32x4 acc[2][2][4][2];
#pragma unroll
    for (int a = 0; a < 2; ++a)
#pragma unroll
        for (int b = 0; b < 2; ++b)
#pragma unroll
            for (int m = 0; m < 4; ++m)
#pragma unroll
                for (int n = 0; n < 2; ++n) acc[a][b][m][n] = zero4();
    bf16x8 At[4][2], B0[2][2], B1[2][2];
    for (;;) {
        const bool has_next = P.next(ui + 1, nxt);
        const char* nB = has_next ? P.bptr(nxt) : cB;
        const char* nA = (has_next && !GA) ? P.abase() + P.aunit(nxt) : cA;
        for (int t = 0; t < nt; t += 2) {
            const bool last = (t == nt - 2);
            const char* a1 = cA + (size_t)(t + 1) * kstep;
            const char* a2 = last ? nA : cA + (size_t)(t + 2) * kstep; const char* b2 = last ? nB : cB + (size_t)(t + 2) * kstep;
            const char* a3 = a2 + kstep; const char* b3 = b2 + kstep;
            PG8_LDB(B0, 0, 0); PG8_LDB(B1, 0, 1); PG8_SCHED; PG8_LDA(At, 0, 0); PG8_STA(PG8_SA(1, 1), a1, 1);
            if constexpr (GA) { if (last && has_next) P.aoffs(nxt, tid, ao); }
            PG8_WAIT_V(8); PG8_WAIT_L(0); PG8_BAR; PG8_MMA(0, 0, At, B0); PG8_MMA(0, 1, At, B1); PG8_BAR; PG8_SCHED;
            PG8_LDA(At, 0, 1); PG8_STB(PG8_SB(0, 0), b2); PG8_STB(PG8_SB(0, 1), b2 + hstep); PG8_STA(PG8_SA(0, 0), a2, 0);
            PG8_WAIT_V(8); PG8_WAIT_L(0); PG8_BAR; PG8_MMA(1, 0, At, B0); PG8_MMA(1, 1, At, B1); PG8_BAR; PG8_SCHED;
            PG8_LDB(B0, 1, 0); PG8_LDB(B1, 1, 1); PG8_SCHED; PG8_LDA(At, 1, 0); PG8_STA(PG8_SA(0, 1), a2, 1);
            PG8_WAIT_V(8); PG8_WAIT_L(0); PG8_BAR; PG8_MMA(0, 0, At, B0); PG8_MMA(0, 1, At, B1); PG8_BAR; PG8_SCHED;
            PG8_LDA(At, 1, 1); PG8_STB(PG8_SB(1, 0), b3); PG8_STB(PG8_SB(1, 1), b3 + hstep); PG8_STA(PG8_SA(1, 0), a3, 0);
            PG8_WAIT_V(8); PG8_WAIT_L(0); PG8_BAR; PG8_MMA(1, 0, At, B0); PG8_MMA(1, 1, At, B1); PG8_BAR; PG8_SCHED;
        }
        if (wr == 0) PG8_BAR;
        { const int tz = get_tid(); const int wz = tz >> 6, lz = tz & 63; E(acc, cur, wz >> 2, wz & 3, lz & 15, lz >> 4); }
        if (!has_next) break;
#pragma unroll
        for (int a = 0; a < 2; ++a)
#pragma unroll
            for (int b = 0; b < 2; ++b)
#pragma unroll
                for (int m = 0; m < 4; ++m)
#pragma unroll
                    for (int n = 0; n < 2; ++n) acc[a][b][m][n] = zero4();
        cur = nxt; cB = nB; cA = nA; ++ui;
        if (wr == 1) PG8_BAR;
    }
    PG8_WAIT_V(0);
    PG8_BAR;
#undef PG8_SA
#undef PG8_STAGE1
#undef PG8_STAGE2
#undef PG8_STB
#undef PG8_STA
#undef PG8_SB
#undef PG8_LDA
#undef PG8_LDB
#undef PG8_MMA
#undef PG8_WAIT_V
#undef PG8_WAIT_L
#undef PG8_BAR
#undef PG8_SCHED
}

__host__ __device__ __forceinline__ int mrow(int pm) { return (pm >> 4) * TP + 64 + (pm & 15) * 256; }
struct DenseProb {
    int K; const char* A; const char* Bt; int nM, nN, nwg, G, c;
    __device__ __forceinline__ void init(const void* A_, const void* Bt_, int M, int N, int K_, int G_, int c_) { A = (const char*)A_; Bt = (const char*)Bt_; K = K_; lda = K_; nM = M / BM; nN = N / BM; nwg = nM * nN; G = G_; c = c_; }
    __device__ __forceinline__ bool next(int i, Unit& u) const {
        const int L = i * G + c; if (L >= nwg) return false;
        int wgid = L; { const int q = nwg / 8, r = nwg % 8, xcd = wgid % 8, off = wgid / 8; wgid = (xcd < r ? xcd * (q + 1) : r * (q + 1) + (xcd - r) * q) + off; }
        const int nig = 8 * nN, gid = wgid / nig, fm = gid * 8, gsz = (nM - fm) < 8 ? (nM - fm) : 8;
        u.pm = fm + ((wgid % nig) % gsz); u.pn = (wgid % nig) / gsz; u.e = 0; u.r0 = 0; return true;
    }
    static constexpr bool GATHER = false; int lda;
    __device__ __forceinline__ const char* abase() const { return A; }
    __device__ __forceinline__ size_t aunit(const Unit& u) const { return (size_t)mrow(u.pm) * K * 2; }
    __device__ __forceinline__ unsigned aoffs0(int tid) const { int Rr, C; stage_rc(tid * 16, Rr, C); return (unsigned)(Rr * K + C) * 2u; }
    __device__ __forceinline__ void aoffs(const Unit&, int, unsigned (&)[2][2]) const {}
    __device__ __forceinline__ const char* bptr(const Unit& u) const { return Bt + (size_t)u.pn * BM * K * 2; }
};
struct MoeTab { int e[176]; int r0[176]; int cnt[32]; int ntiles; };
template <bool UP> struct MoeProb {
    int K; const char* A; const char* W; const unsigned* list; const LAS MoeTab* tab; int G, c;
    __device__ __forceinline__ bool next(int i, Unit& u) const {
        constexpr int NPN = UP ? 4 : 8;
        const int L = i * G + c; if (L >= __builtin_amdgcn_readfirstlane(tab->ntiles) * NPN) return false;
        const int tile = L / NPN; u.pm = tile; u.pn = L % NPN; u.e = __builtin_amdgcn_readfirstlane(tab->e[tile]); u.r0 = __builtin_amdgcn_readfirstlane(tab->r0[tile]); return true;
    }
    static constexpr bool GATHER = UP; int lda;
    __device__ __forceinline__ const char* abase() const { return A; }
    __device__ __forceinline__ size_t aunit(const Unit& u) const { return (size_t)u.pm * BM * DEXP * 2; }
    __device__ __forceinline__ unsigned aoffs0(int tid) const { int Rr, C; stage_rc(tid * 16, Rr, C); return (unsigned)(Rr * DEXP + C) * 2u; }
    __device__ __forceinline__ void aoffs(const Unit& u, int tid_, unsigned (&o)[2][2]) const {
        int tid = get_tid(); (void)tid_;
        const int n = __builtin_amdgcn_readfirstlane(tab->cnt[u.e]);
#pragma unroll
        for (int i = 0; i < 2; ++i) { int Rr, C; stage_rc(tid * 16 + i * 8192, Rr, C);
#pragma unroll
            for (int h = 0; h < 2; ++h) { const int li = u.r0 + h * HALF + Rr;
                const unsigned row = (li < n) ? (list[(size_t)u.e * R + li] >> 1) : (unsigned)PADF;
                o[h][i] = (row * (unsigned)DM + (unsigned)C) * 2u; } }
    }
    __device__ __forceinline__ const char* bptr(const Unit& u) const { return W + (size_t)u.e * (UP ? SZ_W13E : SZ_W2E) + (size_t)u.pn * BM * K * 2; }
};

struct EpiInProj {
    static constexpr bool PERM = true;
    bf16* Z; float* ZS;
    __device__ __forceinline__ void operator()(const f32x4 (&acc)[2][2][4][2], const Unit& u, int wr, int wc, int fr, int fq) const {
        const int row0 = mrow(u.pm) + wr * 64 + fr;
        if (u.pn < 23) {
            const int col0 = u.pn * BM + wc * 32 + 8 * fq;
#pragma unroll
            for (int ai = 0; ai < 2; ++ai)
#pragma unroll
                for (int m = 0; m < 4; ++m) { bf16* rowp = Z + (size_t)(row0 + ai * HALF + m * 16) * DINP + col0;
#pragma unroll
                    for (int bj = 0; bj < 2; ++bj) { const f32x4 v0 = acc[ai][bj][m][0], v1 = acc[ai][bj][m][1];
                        u32x4 w; w.x = cvtpk(v0[0], v0[1]); w.y = cvtpk(v0[2], v0[3]); w.z = cvtpk(v1[0], v1[1]); w.w = cvtpk(v1[2], v1[3]);
                        *(u32x4*)(rowp + bj * HALF) = w; } }
        } else {
            const int col0 = wc * 32 + 8 * fq;
#pragma unroll
            for (int ai = 0; ai < 2; ++ai)
#pragma unroll
                for (int m = 0; m < 4; ++m) { float* rowp = ZS + (size_t)(row0 + ai * HALF + m * 16) * 256 + col0;
#pragma unroll
                    for (int bj = 0; bj < 2; ++bj) { *(f32x4*)(rowp + bj * HALF) = acc[ai][bj][m][0]; *(f32x4*)(rowp + bj * HALF + 4) = acc[ai][bj][m][1]; } }
        }
    }
};
struct EpiOutProj {
    static constexpr bool PERM = false;
    float* H;
    __device__ __forceinline__ void operator()(const f32x4 (&acc)[2][2][4][2], const Unit& u, int wr, int wc, int fr, int fq) const {
        const int row0 = mrow(u.pm) + wr * 64 + fr, col0 = u.pn * BM + wc * 32 + 4 * fq;
#pragma unroll
        for (int ai = 0; ai < 2; ++ai) { float* base = H + (size_t)(row0 + ai * HALF) * DM + col0;
            f32x4 hv[4][2][2];
#pragma unroll
            for (int m = 0; m < 4; ++m)
#pragma unroll
                for (int bj = 0; bj < 2; ++bj)
#pragma unroll
                    for (int n = 0; n < 2; ++n) hv[m][bj][n] = *(const f32x4*)(base + (size_t)(m * 16) * DM + bj * HALF + n * 16);
#pragma unroll
            for (int m = 0; m < 4; ++m)
#pragma unroll
                for (int bj = 0; bj < 2; ++bj)
#pragma unroll
                    for (int n = 0; n < 2; ++n) *(f32x4*)(base + (size_t)(m * 16) * DM + bj * HALF + n * 16) = hv[m][bj][n] + acc[ai][bj][m][n];
            asm volatile("" ::: "memory"); }
    }
};
struct EpiMoeUp {
    static constexpr bool PERM = true;
    bf16* HID;
    __device__ __forceinline__ void operator()(const f32x4 (&acc)[2][2][4][2], const Unit& u, int wr, int wc, int fr, int fq) const {
        const int row0 = u.pm * BM + wr * 64 + fr, col0 = (u.pn * BM + wc * 32 + 8 * fq) >> 1;
#pragma unroll
        for (int ai = 0; ai < 2; ++ai)
#pragma unroll
            for (int m = 0; m < 4; ++m) { bf16* rowp = HID + (size_t)(row0 + ai * HALF + m * 16) * DEXP + col0;
#pragma unroll
                for (int bj = 0; bj < 2; ++bj) { const f32x4 a = acc[ai][bj][m][0], b = acc[ai][bj][m][1];
                    u32x2 w; w.x = cvtpk(siluf(a[0]) * b[0], siluf(a[1]) * b[1]); w.y = cvtpk(siluf(a[2]) * b[2], siluf(a[3]) * b[3]);
                    *(u32x2*)(rowp + bj * (HALF / 2)) = w; }
                asm volatile("" ::: "memory"); }
    }
};
struct EpiMoeDown {
    static constexpr bool PERM = true;
    bf16* Y0; bf16* Y1; const unsigned* list; const float* gate; const LAS MoeTab* tab;
    __device__ __forceinline__ void operator()(const f32x4 (&acc)[2][2][4][2], const Unit& u, int wr, int wc, int fr, int fq) const {
        const int n = __builtin_amdgcn_readfirstlane(tab->cnt[u.e]); const int col0 = u.pn * BM + wc * 32 + 8 * fq;
#pragma unroll
        for (int ai = 0; ai < 2; ++ai)
#pragma unroll
            for (int m = 0; m < 4; ++m) { const int li = u.r0 + ai * HALF + wr * 64 + m * 16 + fr;
                if (li < n) { const unsigned ent = list[(size_t)u.e * R + li]; const float g = gate[ent];
                    bf16* rowp = Y0 + (size_t)(ent & 1u) * ((size_t)R * DM) + (size_t)(ent >> 1) * DM + col0;
#pragma unroll
                    for (int bj = 0; bj < 2; ++bj) { const f32x4 v0 = acc[ai][bj][m][0] * g, v1 = acc[ai][bj][m][1] * g;
                        u32x4 w; w.x = cvtpk(v0[0], v0[1]); w.y = cvtpk(v0[2], v0[3]); w.z = cvtpk(v1[0], v1[1]); w.w = cvtpk(v1[2], v1[3]);
                        *(u32x4*)(rowp + bj * HALF) = w; } } }
    }
};
}

template <int MODE>
__device__ __forceinline__ void skinny_gemm(LAS unsigned char* lds, const bf16* A, const bf16* Bt, int K, int N, int bid, bf16* Zo, float* ZSo, float* Ho) {
    const int tid = get_tid(), lane = tid & 63, wave = __builtin_amdgcn_readfirstlane(tid >> 6), g = lane >> 4, c16 = lane & 15;
    if (bid >= N / 32) return;
    const int ksw = K / 32 / 8;
    f32x4 acc[4][2];
#pragma unroll
    for (int rt = 0; rt < 4; ++rt) { acc[rt][0] = zero4(); acc[rt][1] = zero4(); }
    const bf16* ap = A + (size_t)(PADF + c16) * K + 8 * g; const bf16* bp = Bt + (size_t)(32 * bid + c16) * K + 8 * g;
#pragma unroll 2
    for (int kk = 0; kk < ksw; ++kk) { const int ks = wave * ksw + kk;
        bf16x8 a[4], b[2];
#pragma unroll
        for (int rt = 0; rt < 4; ++rt) a[rt] = *(const bf16x8*)(ap + (size_t)rt * TP * K + 32 * ks);
#pragma unroll
        for (int ct = 0; ct < 2; ++ct) b[ct] = *(const bf16x8*)(bp + (size_t)(16 * ct) * K + 32 * ks);
#pragma unroll
        for (int rt = 0; rt < 4; ++rt)
#pragma unroll
            for (int ct = 0; ct < 2; ++ct) acc[rt][ct] = __builtin_amdgcn_mfma_f32_16x16x32_bf16(a[rt], b[ct], acc[rt][ct], 0, 0, 0); }
    LAS float* red = (LAS float*)lds;
#pragma unroll
    for (int rt = 0; rt < 4; ++rt)
#pragma unroll
        for (int ct = 0; ct < 2; ++ct)
#pragma unroll
            for (int r = 0; r < 4; ++r) red[wave * 2048 + (16 * rt + 4 * g + r) * 32 + 16 * ct + c16] = acc[rt][ct][r];
    __syncthreads();
    { const int rr = tid >> 3, c4 = 4 * (tid & 7); f32x4 sum = *(LAS f32x4*)(red + rr * 32 + c4);
#pragma unroll
      for (int w = 1; w < 8; ++w) sum = sum + *(LAS f32x4*)(red + w * 2048 + rr * 32 + c4);
      const size_t row = (size_t)(rr >> 4) * TP + PADF + (rr & 15); const int col = 32 * bid + c4;
      if (MODE == 0) { if (col < C_IK) { u32x2 w2; w2.x = cvtpk(sum[0], sum[1]); w2.y = cvtpk(sum[2], sum[3]); *(u32x2*)(Zo + row * DINP + col) = w2; }
                       else *(f32x4*)(ZSo + row * 256 + (col - C_IK)) = sum; }
      else { float* hp = Ho + row * DM + col; *(f32x4*)hp = *(const f32x4*)hp + sum; } }
    __syncthreads();
}

namespace fox {
constexpr int D = 128, NW = 8, QBLK = 32, KVBLK = 64, QB = NW * QBLK;
constexpr int SHM_V = KVBLK * D * 2, SHM_K = KVBLK * D * 2;
constexpr int LDS_BODY = 2 * SHM_V + 2 * SHM_K + NW * 64 * 4;
constexpr int BIAS_OFF = LDS_BODY;
constexpr int SCAN_OFF = BIAS_OFF + TP * 4;
constexpr int LDQ = DINP, LDO = DM;
constexpr float SCALE = 0.08838834764831845f, THR = 8.f;
constexpr int WBIG = 1 << 28;
#define KSWZ(row, colB) ((row) * 256 + ((colB) ^ (((row) & 7) << 4)))
#define SBAR() __builtin_amdgcn_sched_barrier(0)
__device__ __forceinline__ int v_st(int k, int c) { const int kk = (k & ~0xC) | ((k & 4) << 1) | ((k & 8) >> 1); return ((kk >> 3) * 4 + (c >> 5)) * 512 + ((kk & 7) * 32 + (c & 31)) * 2; }
__device__ __forceinline__ int v_rd_base(int lane) { return ((lane & 3) << 3) | (((lane >> 2) & 3) << 6) | (((lane >> 4) & 1) << 5) | (((lane >> 5) & 1) << 8); }
constexpr int v_rd_off(int d0, int ks, int half) { return d0 * 512 + ks * 4096 + half * 2048; }
__device__ __forceinline__ int crow(int r, int hi) { return (r & 3) + 8 * (r >> 2) + 4 * hi; }
__device__ __forceinline__ bf16x8 load8(const bf16* p) { return *reinterpret_cast<const bf16x8*>(p); }
__device__ __forceinline__ void mask_tile(f32x16& p0, f32x16& p1, int dq, unsigned W) {
    const float NEG = -__builtin_inff();
#pragma unroll
    for (int r = 0; r < 16; ++r) {
        const int c = (r & 3) + 8 * (r >> 2);
        if ((unsigned)(dq - c) >= W) p0[r] = NEG;
        if ((unsigned)(dq - c - 32) >= W) p1[r] = NEG;
    }
}
__device__ __forceinline__ void partialSM(f32x16& p0, f32x16& p1, float& m_reg, float& mn, float& alpha) {
    float pmax = p0[0]; for (int r = 1; r < 16; ++r) pmax = fmaxf(pmax, p0[r]); for (int r = 0; r < 16; ++r) pmax = fmaxf(pmax, p1[r]);
    { auto rr = __builtin_amdgcn_permlane32_swap(__float_as_uint(pmax), __float_as_uint(pmax), false, false);
      pmax = fmaxf(__uint_as_float(rr[0]), __uint_as_float(rr[1])); }
    constexpr float C2 = 1.4426950408889634f * SCALE;
    if (__builtin_expect(__all((pmax - m_reg) * SCALE <= THR), 1)) { mn = m_reg; alpha = 1.f; }
    else { mn = fmaxf(m_reg, pmax); alpha = __builtin_amdgcn_exp2f((m_reg - mn) * C2); m_reg = mn; }
    const float mnL = -mn * C2;
    for (int r = 0; r < 16; ++r) p0[r] = fmaf(p0[r], C2, mnL); for (int r = 0; r < 16; ++r) p1[r] = fmaf(p1[r], C2, mnL);
    for (int r = 0; r < 16; ++r) p0[r] = __builtin_amdgcn_exp2f(p0[r]);
}
__device__ __forceinline__ void finishSM(f32x16& p0, f32x16& p1, float alpha, float& l_reg, bf16x8& pa0, bf16x8& pa1, bf16x8& pa2, bf16x8& pa3) {
    for (int r = 0; r < 16; ++r) p1[r] = __builtin_amdgcn_exp2f(p1[r]);
    float ps = 0; for (int r = 0; r < 16; ++r) ps += p0[r]; for (int r = 0; r < 16; ++r) ps += p1[r];
    { auto rr = __builtin_amdgcn_permlane32_swap(__float_as_uint(ps), __float_as_uint(ps), false, false);
      ps = __uint_as_float(rr[0]) + __uint_as_float(rr[1]); }
    l_reg = l_reg * alpha + ps;
#define PK4(P, B_, OUT) do { unsigned a0 = cvtpk(P[B_+0], P[B_+1]), a1 = cvtpk(P[B_+2], P[B_+3]);                          \
        unsigned b0 = cvtpk(P[B_+4], P[B_+5]), b1 = cvtpk(P[B_+6], P[B_+7]);                                             \
        auto r0 = __builtin_amdgcn_permlane32_swap(a0, b0, false, false); auto r1 = __builtin_amdgcn_permlane32_swap(a1, b1, false, false); \
        u32x4 w = {r0[0], r1[0], r0[1], r1[1]}; OUT = *reinterpret_cast<bf16x8*>(&w); } while (0)
    PK4(p0, 0, pa0); PK4(p0, 8, pa1); PK4(p1, 0, pa2); PK4(p1, 8, pa3);
#undef PK4
}
template <int KB>
__device__ __forceinline__ void qkt(f32x16& p0, f32x16& p1, const char* K_lds, const float* biask  , int r32, int hi, const bf16x8* qr) {
#pragma unroll
    for (int a = 0; a < 4; ++a) { const f32x4 b0 = *(const f32x4*)(biask + 8 * a), b1 = *(const f32x4*)(biask + 32 + 8 * a);
#pragma unroll
        for (int j = 0; j < 4; ++j) { p0[4 * a + j] = b0[j]; p1[4 * a + j] = b1[j]; } }
    const char* kb[4];
#pragma unroll
    for (int dd = 0; dd < 4; ++dd) kb[dd] = K_lds + KB * SHM_K + KSWZ(r32, (dd * 16 + hi * 8) * 2);
#pragma unroll
    for (int d0 = 0; d0 < 8; ++d0) { const char* a = kb[d0 & 3] + (d0 >> 2) * 128;
        bf16x8 b0 = *reinterpret_cast<const bf16x8*>(a);
        bf16x8 b1 = *reinterpret_cast<const bf16x8*>(a + 32 * 256);
        p0 = __builtin_amdgcn_mfma_f32_32x32x16_bf16(b0, qr[d0], p0, 0, 0, 0);
        p1 = __builtin_amdgcn_mfma_f32_32x32x16_bf16(b1, qr[d0], p1, 0, 0, 0); }
}
template <int VB>
__device__ __forceinline__ void pv_tile(f32x16* o, int vb0, bf16x8 pa0, bf16x8 pa1, bf16x8 pa2, bf16x8 pa3) {
#define TRRD(dst, off) asm volatile("ds_read_b64_tr_b16 %0, %1 offset:%2" : "=&v"(dst) : "v"(vb0), "i"(off) : "memory")
#define PV_D0(d0) do { s16x4 l0, l1, l2, l3, h0, h1, h2, h3; constexpr int b_ = VB * SHM_V + v_rd_off(d0, 0, 0); \
        TRRD(l0, b_); TRRD(h0, b_ + 2048); TRRD(l1, b_ + 4096); TRRD(h1, b_ + 6144); TRRD(l2, b_ + 8192); TRRD(h2, b_ + 10240); TRRD(l3, b_ + 12288); TRRD(h3, b_ + 14336); \
        asm volatile("s_waitcnt lgkmcnt(0)" ::: "memory"); SBAR();   \
        o[d0] = __builtin_amdgcn_mfma_f32_32x32x16_bf16(pa0, (bf16x8){l0[0], l0[1], l0[2], l0[3], h0[0], h0[1], h0[2], h0[3]}, o[d0], 0, 0, 0);   \
        o[d0] = __builtin_amdgcn_mfma_f32_32x32x16_bf16(pa1, (bf16x8){l1[0], l1[1], l1[2], l1[3], h1[0], h1[1], h1[2], h1[3]}, o[d0], 0, 0, 0);   \
        o[d0] = __builtin_amdgcn_mfma_f32_32x32x16_bf16(pa2, (bf16x8){l2[0], l2[1], l2[2], l2[3], h2[0], h2[1], h2[2], h2[3]}, o[d0], 0, 0, 0);   \
        o[d0] = __builtin_amdgcn_mfma_f32_32x32x16_bf16(pa3, (bf16x8){l3[0], l3[1], l3[2], l3[3], h3[0], h3[1], h3[2], h3[3]}, o[d0], 0, 0, 0); } while (0)
    PV_D0(0); PV_D0(1); PV_D0(2); PV_D0(3);
#undef PV_D0
#undef TRRD
}
struct BlockRef { const bf16* Q; const bf16* K; const bf16* V; bf16* O; int P0; };
struct Seam { bf16x8 qr[8]; bf16x8 st_v0, st_v1, st_k0, st_k1; };
#define ROW(p, k0, rr) ((p) + (unsigned)(((k0) + (rr)) * LDQ + sc))
#define VMW() asm volatile("s_waitcnt vmcnt(0)" ::: "memory")
#define VMWN(n) asm volatile("s_waitcnt vmcnt(%0)" :: "i"(n) : "memory")
#define SLOAD_H(Kp, Vp, k0) do { S.st_v0 = load8(ROW(Vp, k0, sr)); S.st_v1 = load8(ROW(Vp, k0, 32 + sr));              \
                         S.st_k0 = load8(ROW(Kp, k0, sr)); S.st_k1 = load8(ROW(Kp, k0, 32 + sr)); } while (0)
#define SWRITE_HK(bf) do { *(bf16x8*)(K_lds + (bf) * SHM_K + kws) = S.st_k0; *(bf16x8*)(K_lds + (bf) * SHM_K + kws + 32 * 256) = S.st_k1; } while (0)
#define SWRITE_HV(bf) do { *(bf16x8*)(V_lds + (bf) * SHM_V + vst0) = S.st_v0; *(bf16x8*)(V_lds + (bf) * SHM_V + vst1) = S.st_v1; } while (0)
#define SWRITE_H(bf) do { SWRITE_HV(bf); SWRITE_HK(bf); } while (0)
__device__ __forceinline__ void prime(const BlockRef& cur, char* lds, Seam& S) {
    int tid = get_tid();
    const int wid = __builtin_amdgcn_readfirstlane(tid >> 6), lane = tid & 63, r32 = lane & 31, hi = lane >> 5;
    const int sr = tid >> 4, sc = (tid & 15) * 8, kws = KSWZ(sr, sc * 2); char* K_lds = lds + 2 * SHM_V;
    const int kb0 = 0;
    for (int d0 = 0; d0 < 8; ++d0) S.qr[d0] = load8(cur.Q + (unsigned)((wid * QBLK + r32) * LDQ + d0 * 16 + hi * 8));
    SLOAD_H(cur.K, cur.V, kb0); VMW(); SWRITE_HK(0);
    __syncthreads();
}
__device__ __forceinline__ void block(const BlockRef& cur, const BlockRef& nxt, int skv, char* lds, Seam& S) {
    constexpr int W = WBIG;
    int tid = get_tid();
    const int wid = __builtin_amdgcn_readfirstlane(tid >> 6), lane = tid & 63, r32 = lane & 31, hi = lane >> 5;
    const int j_lo = 0;
    int j_hi = (cur.P0 + QB - 1) / KVBLK + 1; if (j_hi > skv / KVBLK) j_hi = skv / KVBLK;
    const int NT = j_hi - j_lo;
    const int kbn = 0;
    const int qlo = cur.P0 + wid * QBLK, qm = qlo + r32 - 4 * hi;
    char* V_lds = lds; char* K_lds = lds + 2 * SHM_V;
    float* ws = (float*)(lds + 2 * SHM_V + 2 * SHM_K) + wid * 64; float* li_l = ws, * al_l = ws + 32;
    const float* biasb = (const float*)(lds + BIAS_OFF) + 4 * hi;
    float m_reg = -1e30f, l_reg = 0; f32x16 o[4] = {};
    const int sr = tid >> 4, sc = (tid & 15) * 8, vst0 = v_st(sr, sc), vst1 = v_st(32 + sr, sc), kws = KSWZ(sr, sc * 2);
    const int vb0 = (int)(uintptr_t)V_lds + v_rd_base(lane);
    const bf16* Kh = cur.K; const bf16* Vh = cur.V;
#define RESC(a) do { if (__any((a) < 1.f)) { if (hi == 0) al_l[r32] = (a); asm volatile("s_waitcnt lgkmcnt(0)" ::: "memory");              \
                     for (int d_ = 0; d_ < 4; ++d_) for (int r = 0; r < 16; ++r) o[d_][r] *= al_l[crow(r, hi)]; } } while (0)
#define KBASE(t) ((j_lo + (t)) * KVBLK)
#define MASKT(P0_, P1_, t) do { const int kb_ = KBASE(t); if (kb_ + KVBLK - 1 > qlo) mask_tile(P0_, P1_, qm - kb_, (unsigned)W); } while (0)
    constexpr int NQL = 8;
#define SEAM_K0() do { VMWN(NQL); SWRITE_HK(0); SBAR(); } while (0)
    f32x16 pA0, pA1, pB0, pB1; float mnA, mnB, alA, alB; bf16x8 pa0, pa1, pa2, pa3;
    SWRITE_HV(0); SBAR();
    if (NT > 1) { SLOAD_H(Kh, Vh, KBASE(1)); }
    SBAR(); qkt<0>(pA0, pA1, K_lds, biasb + KBASE(0), r32, hi, S.qr);
    MASKT(pA0, pA1, 0); partialSM(pA0, pA1, m_reg, mnA, alA);
    if (NT > 1) { VMW(); SWRITE_H(1); }
    __syncthreads();
#define HALF_STEP(PX0, PX1, mnX, alX, PY0, PY1, alY, t, KB, VB, SB) do {                                                      \
        SBAR(); qkt<KB>(PX0, PX1, K_lds, biasb + KBASE(t), r32, hi, S.qr);                                             \
        finishSM(PY0, PY1, alY, l_reg, pa0, pa1, pa2, pa3); SBAR();                                                           \
        if ((t) + 1 < NT) { SLOAD_H(Kh, Vh, KBASE((t) + 1)); SBAR(); }                                               \
        pv_tile<VB>(o, vb0, pa0, pa1, pa2, pa3); MASKT(PX0, PX1, (t)); partialSM(PX0, PX1, m_reg, mnX, alX);                                        \
        __syncthreads();                                                                                                      \
        if ((t) + 1 < NT) { VMW(); SWRITE_H(SB); }                                                                          \
        RESC(alX); __syncthreads(); } while (0)
    for (int t = 1; t + 1 < NT; t += 2) {
        HALF_STEP(pB0, pB1, mnB, alB, pA0, pA1, alA, t, 1, 0, 0);
        HALF_STEP(pA0, pA1, mnA, alA, pB0, pB1, alB, t + 1, 0, 1, 1);
    }
    const bool even = (NT & 1) == 0;
    if (even) { SBAR(); qkt<1>(pB0, pB1, K_lds, biasb + KBASE(NT - 1), r32, hi, S.qr); SBAR(); }
    SLOAD_H(nxt.K, nxt.V, kbn); SBAR();
#pragma unroll
    for (int d0 = 0; d0 < 8; ++d0) S.qr[d0] = load8(nxt.Q + (unsigned)((wid * QBLK + r32) * LDQ + d0 * 16 + hi * 8));
    SBAR();
    finishSM(pA0, pA1, alA, l_reg, pa0, pa1, pa2, pa3); SBAR();
    pv_tile<0>(o, vb0, pa0, pa1, pa2, pa3);
    if (even) { MASKT(pB0, pB1, NT - 1); partialSM(pB0, pB1, m_reg, mnB, alB); __syncthreads(); RESC(alB);
        finishSM(pB0, pB1, alB, l_reg, pa0, pa1, pa2, pa3); SBAR(); pv_tile<1>(o, vb0, pa0, pa1, pa2, pa3); }
    SBAR(); SEAM_K0();
    if (hi == 0) li_l[r32] = l_reg; asm volatile("s_waitcnt lgkmcnt(0)" ::: "memory");
    float rli[16];
#pragma unroll
    for (int r = 0; r < 16; ++r) rli[r] = __builtin_amdgcn_rcpf(li_l[crow(r, hi)]);
    bf16* Ow = cur.O + (unsigned)(wid * QBLK * LDO);
#pragma unroll
    for (int r = 0; r < 16; ++r) { const int orow = crow(r, hi);
#pragma unroll
        for (int d0 = 0; d0 < 4; ++d0) { const float v = o[d0][r] * rli[r];
            const float vn = __shfl_xor(v, 1);
            if ((r32 & 1) == 0) *(unsigned*)(Ow + (unsigned)(orow * LDO + d0 * 32 + r32)) = cvtpk(v, vn); } }
    __syncthreads();
#undef RESC
#undef KBASE
#undef MASKT
#undef SEAM_K0
#undef HALF_STEP
}
#undef ROW
#undef VMW
#undef VMWN
#undef SLOAD_H
#undef SWRITE_HK
#undef SWRITE_HV
#undef SWRITE_H

__device__ __forceinline__ void build_bias(char* lds, const float* zs_b  , int h) {
    int tid = get_tid();
    const int lane = tid & 63, wid = tid >> 6;
    float* bias = (float*)(lds + BIAS_OFF); float* wsum = (float*)(lds + SCAN_OFF);
    float loc[9]; float s = 0.f;
#pragma unroll
    for (int k = 0; k < 9; ++k) { const int t = tid * 9 + k; const float x = (t < TT) ? zs_b[(size_t)(PADF + t) * 256 + S_BF + h] : 0.f; s += x; loc[k] = s; }
    float incl = s;
#pragma unroll
    for (int o = 1; o < 64; o <<= 1) { const float y = __shfl_up(incl, o); if (lane >= o) incl += y; }
    if (lane == 63) wsum[wid] = incl;
    __syncthreads();
    float woff = 0.f;
    for (int w = 0; w < wid; ++w) woff += wsum[w];
    const float excl = woff + incl - s;
    constexpr float INVS = 1.0f / SCALE;
#pragma unroll
    for (int k = 0; k < 9; ++k) { const int t = tid * 9 + k; if (t < TT) bias[PADF + t] = -(excl + loc[k]) * INVS; }
    if (tid < PADF) bias[tid] = -__builtin_inff();
    __syncthreads();
}
__device__ __forceinline__ void item(char* lds, const bf16* Z, const float* ZS, bf16* MIX, int it) {
    const int bh = it >> 3, x = it & 7, b = bh / 6, h = bh % 6;
    build_bias(lds, ZS + (size_t)b * TP * 256, h);
    const bf16* zb = Z + (size_t)b * TP * DINP;
    BlockRef b0, b1;
    b0.K = b1.K = zb + C_BK + h * 128; b0.V = b1.V = zb + C_BV + h * 128;
    const int q0 = 64 + 256 * x, q1 = 64 + 256 * (15 - x);
    b0.Q = zb + (size_t)q0 * DINP + C_BQ + h * 128; b1.Q = zb + (size_t)q1 * DINP + C_BQ + h * 128;
    b0.O = MIX + (size_t)(b * TP + q0) * DM + 768 + h * 128; b1.O = MIX + (size_t)(b * TP + q1) * DM + 768 + h * 128;
    b0.P0 = q0; b1.P0 = q1;
    Seam S;
    prime(b0, lds, S);
    block(b0, b1, TP, lds, S);
    block(b1, b1, TP, lds, S);
}
__device__ __forceinline__ void meta_unit(const bf16* Z, const float* ZS, bf16* MIX, int b) {
    int tid = get_tid();
    const int lane = tid & 63, wid = tid >> 6;
    for (int task = wid; task < 96; task += 8) {
        const int h = task >> 4, m = task & 15;
        const size_t rq = (size_t)b * TP + PADF + m;
        const unsigned qw = *(const unsigned*)(Z + rq * DINP + C_BQ + h * 128 + 2 * lane);
        const float q0 = bflo(qw), q1 = bfhi(qw);
        float lg[16]; float F = 0.f, Fk[16];
#pragma unroll
        for (int k = 0; k < 16; ++k) { F += ZS[((size_t)b * TP + PADF + k) * 256 + S_BF + h]; Fk[k] = F; }
        float Fm = 0.f;
#pragma unroll
        for (int k = 0; k < 16; ++k) if (k == m) Fm = Fk[k];
        float mx = -1e30f;
#pragma unroll
        for (int k = 0; k < 16; ++k) { const size_t rk = (size_t)b * TP + PADF + k;
            const unsigned kw = *(const unsigned*)(Z + rk * DINP + C_BK + h * 128 + 2 * lane);
            const float d = wave_sum(q0 * bflo(kw) + q1 * bfhi(kw));
            lg[k] = (k <= m) ? d * SCALE + Fm - Fk[k] : -__builtin_inff(); mx = fmaxf(mx, lg[k]); }
        float sum = 0.f, o0 = 0.f, o1 = 0.f;
#pragma unroll
        for (int k = 0; k < 16; ++k) { const float p = fexp_(lg[k] - mx); sum += p;
            const size_t rk = (size_t)b * TP + PADF + k;
            const unsigned vw = *(const unsigned*)(Z + rk * DINP + C_BV + h * 128 + 2 * lane);
            o0 += p * bflo(vw); o1 += p * bfhi(vw); }
        const float inv = 1.f / sum;
        *(unsigned*)(MIX + rq * DM + 768 + h * 128 + 2 * lane) = cvtpk(o0 * inv, o1 * inv);
    }
}
}

namespace dsa {
constexpr int NQ = 8, SCW = TP;
constexpr int SC_BYTES = NQ * SCW * 4;
constexpr int IDX_OFF = SC_BYTES;
constexpr int LDS_NEED = SC_BYTES + NQ * 256 * 2;
constexpr int KTOP = 256;
__device__ __forceinline__ unsigned sortable(float f) { const unsigned u = __float_as_uint(f); return (u >> 31) ? ~u : (u | 0x80000000u); }
__device__ __forceinline__ unsigned mbcnt(unsigned long long m) { return __builtin_amdgcn_mbcnt_hi((unsigned)(m >> 32), __builtin_amdgcn_mbcnt_lo((unsigned)m, 0u)); }
__device__ __forceinline__ unsigned off_b(unsigned row, unsigned ch) { return 256u * row + 16u * (ch ^ (((row & 3) << 2) | ((row >> 2) & 3))); }

template <int NG>
__device__ __forceinline__ void select_topk(const LAS float* myc, LAS unsigned short* idx, int lane) {
    unsigned key[NG];
#pragma unroll
    for (int j = 0; j < NG; ++j) key[j] = sortable(myc[64 * j + lane]);
    unsigned tau = 0u;
    for (int bit = 31; bit >= 0; --bit) {
        const unsigned cand = tau | (1u << bit); int cnt = 0;
#pragma unroll
        for (int j = 0; j < NG; ++j) cnt += __popcll(__ballot(key[j] >= cand));
        if (cnt >= KTOP) tau = cand;
        if (cnt == KTOP) break;
    }
    int cgt = 0;
#pragma unroll
    for (int j = 0; j < NG; ++j) cgt += __popcll(__ballot(key[j] > tau));
    int eq_rem = KTOP - cgt, run = 0;
#pragma unroll
    for (int j = 0; j < NG; ++j) {
        const bool gt = key[j] > tau, eq = key[j] == tau;
        const unsigned long long m_eq = __ballot(eq);
        const bool take = gt || (eq && (int)mbcnt(m_eq) < eq_rem);
        const unsigned long long m = __ballot(take);
        if (take) idx[run + (int)mbcnt(m)] = (unsigned short)(64 * j + lane);
        run += __popcll(m); const int ne = __popcll(m_eq); eq_rem -= (ne < eq_rem) ? ne : eq_rem;
    }
}
__device__ __forceinline__ void unit(LAS unsigned char* lds, const bf16* Z, const float* ZS, const bf16* IKC, const bf16* KAC, const bf16* VAC, bf16* MIX, int b, int c, int sub) {
    int tid = get_tid();
    const int lane = tid & 63, wave = __builtin_amdgcn_readfirstlane(tid >> 6), g = lane >> 4, c16 = lane & 15;
    const int v0 = 64 * c + 8 * sub;
    const size_t rb = (size_t)b * TP;
    LAS float* sc = (LAS float*)lds;
    {
        bf16x8 A[NQ][2];
#pragma unroll
        for (int qi = 0; qi < NQ; ++qi) { const bf16* zq = Z + (rb + v0 + qi) * DINP + C_IQ + c16 * 64 + 8 * g;
            A[qi][0] = *(const bf16x8*)zq; A[qi][1] = *(const bf16x8*)(zq + 32); }
        u32x4 Aw[4];
        { const f32x4 w4 = *(const f32x4*)(ZS + (rb + v0 + (c16 & 7)) * 256 + S_IW + 4 * g);
          const unsigned w01 = cvtpk(w4[0], w4[1]), w23 = cvtpk(w4[2], w4[3]);
#pragma unroll
          for (int s2 = 0; s2 < 4; ++s2) { const bool ev = (c16 == 2 * s2), od = (c16 == 2 * s2 + 1);
              Aw[s2] = (u32x4){ev ? w01 : 0u, ev ? w23 : 0u, od ? w01 : 0u, od ? w23 : 0u}; } }
        const int ntile = 4 * (c + 1);
        const bf16* ikb = IKC + rb * 64 + c16 * 64 + 8 * g;
        const f32x4 Z4 = {0.f, 0.f, 0.f, 0.f};
#define DSA_BLD(dst0, dst1, tt) do { const int t_ = (tt) < ntile ? (tt) : ntile - 1; dst0 = *(const bf16x8*)(ikb + (size_t)t_ * 1024); dst1 = *(const bf16x8*)(ikb + (size_t)t_ * 1024 + 32); } while (0)
#define DSA_TILE(B0_, B1_, tt) do { f32x4 d[NQ]; \
            _Pragma("unroll") for (int qi = 0; qi < NQ; ++qi) { d[qi] = __builtin_amdgcn_mfma_f32_16x16x32_bf16(A[qi][0], B0_, Z4, 0, 0, 0); \
                d[qi] = __builtin_amdgcn_mfma_f32_16x16x32_bf16(A[qi][1], B1_, d[qi], 0, 0, 0); } \
            f32x4 D2 = Z4; \
            _Pragma("unroll") for (int s2 = 0; s2 < 4; ++s2) { const f32x4 x = d[2 * s2], y = d[2 * s2 + 1]; \
                u32x4 rw; rw.x = cvtpk(fmaxf(x[0], 0.f), fmaxf(x[1], 0.f)); rw.y = cvtpk(fmaxf(x[2], 0.f), fmaxf(x[3], 0.f)); rw.z = cvtpk(fmaxf(y[0], 0.f), fmaxf(y[1], 0.f)); rw.w = cvtpk(fmaxf(y[2], 0.f), fmaxf(y[3], 0.f)); \
                D2 = __builtin_amdgcn_mfma_f32_16x16x32_bf16(*reinterpret_cast<const bf16x8*>(&Aw[s2]), *reinterpret_cast<const bf16x8*>(&rw), D2, 0, 0, 0); } \
            const int key = 16 * (tt) + c16; \
            if (g < 2) { _Pragma("unroll") for (int r = 0; r < 4; ++r) sc[(4 * g + r) * SCW + key] = (key >= PADF) ? D2[r] : -__builtin_inff(); } } while (0)
        bf16x8 Ba0, Ba1, Bb0, Bb1, Bc0, Bc1;
        int t = wave;
        DSA_BLD(Ba0, Ba1, t); DSA_BLD(Bb0, Bb1, t + 8);
        for (; t < ntile; t += 24) {
            DSA_BLD(Bc0, Bc1, t + 16); DSA_TILE(Ba0, Ba1, t);
            if (t + 8 >= ntile) break;
            DSA_BLD(Ba0, Ba1, t + 24); DSA_TILE(Bb0, Bb1, t + 8);
            if (t + 16 >= ntile) break;
            DSA_BLD(Bb0, Bb1, t + 32); DSA_TILE(Bc0, Bc1, t + 16);
        }
#undef DSA_BLD
#undef DSA_TILE
    }
    { const int n_ = 64 * (c + 1), ng_ = (c + 1 <= 16) ? 16 : (c + 1 <= 32 ? 32 : (c + 1 <= 48 ? 48 : 65));
      for (int i = n_ + tid; i < 64 * ng_; i += 512) {
#pragma unroll
          for (int qi = 0; qi < NQ; ++qi) sc[qi * SCW + i] = -__builtin_inff(); } }
    __syncthreads();
    const int n = 64 * (c + 1), nreal = n - PADF, ngrp = c + 1;
    LAS unsigned short* idx = (LAS unsigned short*)(lds + IDX_OFF) + wave * 256;
    LAS float* myc = sc + wave * SCW;
    int nsel;
    if (nreal <= KTOP) { nsel = nreal; for (int s = lane; s < nsel; s += 64) idx[s] = (unsigned short)(PADF + s); }
    else { nsel = KTOP;
        if (ngrp <= 16) select_topk<16>(myc, idx, lane); else if (ngrp <= 32) select_topk<32>(myc, idx, lane);
        else if (ngrp <= 48) select_topk<48>(myc, idx, lane); else select_topk<65>(myc, idx, lane); }
    LDS_WAIT();
    {
        const size_t qrow = rb + v0 + wave;
        bf16x8 Bq[4];
#pragma unroll
        for (int kd = 0; kd < 4; ++kd) { Bq[kd] = (bf16x8){0, 0, 0, 0, 0, 0, 0, 0}; if (c16 < 6) Bq[kd] = *(const bf16x8*)(Z + qrow * DINP + C_AQ + c16 * 128 + 32 * kd + 8 * g); }
        f32x4 Dl[8][2];
        const int srow = 8 * (c16 >> 2) + (c16 & 3);
        const bf16* kab = KAC + rb * 128 + 8 * g;
        bf16x8 Ka[3][8];
        const f32x4 Z4 = {0.f, 0.f, 0.f, 0.f};
#define DSA_KLOAD(buf, ks_) do { int s0_ = 32 * (ks_) + srow, s1_ = s0_ + 4; s0_ = s0_ < nsel ? s0_ : nsel - 1; s1_ = s1_ < nsel ? s1_ : nsel - 1; \
            const bf16* k0_ = kab + (size_t)idx[s0_] * 128; const bf16* k1_ = kab + (size_t)idx[s1_] * 128; \
            _Pragma("unroll") for (int kd = 0; kd < 4; ++kd) { Ka[buf][kd] = *(const bf16x8*)(k0_ + 32 * kd); Ka[buf][4 + kd] = *(const bf16x8*)(k1_ + 32 * kd); } } while (0)
        DSA_KLOAD(0, 0); DSA_KLOAD(1, 1);
#pragma unroll
        for (int ks = 0; ks < 8; ++ks) {
            if (ks + 2 < 8) DSA_KLOAD((ks + 2) % 3, ks + 2);
            f32x4 d0 = Z4, d1 = Z4;
#pragma unroll
            for (int kd = 0; kd < 4; ++kd) { d0 = __builtin_amdgcn_mfma_f32_16x16x32_bf16(Ka[ks % 3][kd], Bq[kd], d0, 0, 0, 0); d1 = __builtin_amdgcn_mfma_f32_16x16x32_bf16(Ka[ks % 3][4 + kd], Bq[kd], d1, 0, 0, 0); }
            Dl[ks][0] = d0; Dl[ks][1] = d1;
        }
#undef DSA_KLOAD
        constexpr float C2 = 0.08838834764831845f * 1.4426950408889634f;
        float mx = -1e30f;
#pragma unroll
        for (int ks = 0; ks < 8; ++ks)
#pragma unroll
            for (int tt = 0; tt < 2; ++tt)
#pragma unroll
                for (int r = 0; r < 4; ++r) { const int slot = 32 * ks + 8 * g + 4 * tt + r; float x = Dl[ks][tt][r] * C2; x = (slot < nsel) ? x : -__builtin_inff(); Dl[ks][tt][r] = x; mx = fmaxf(mx, x); }
        mx = fmaxf(mx, __shfl_xor(mx, 16)); mx = fmaxf(mx, __shfl_xor(mx, 32));
        float sum = 0.f;
#pragma unroll
        for (int ks = 0; ks < 8; ++ks)
#pragma unroll
            for (int tt = 0; tt < 2; ++tt)
#pragma unroll
                for (int r = 0; r < 4; ++r) { const float p = __builtin_amdgcn_exp2f(Dl[ks][tt][r] - mx); Dl[ks][tt][r] = p; sum += p; }
        sum += __shfl_xor(sum, 16); sum += __shfl_xor(sum, 32);
        LAS unsigned char* stg = (LAS unsigned char*)myc;
        const unsigned stg_addr = (unsigned)(uintptr_t)stg;
        f32x4 O[8];
#pragma unroll
        for (int dt = 0; dt < 8; ++dt) O[dt] = Z4;
        const unsigned q4 = (unsigned)c16 >> 2, p4 = (unsigned)c16 & 3;
        const unsigned rd_base = stg_addr + (8u * g + q4) * 256u + 8u * p4;
        const bf16* vab = VAC + rb * 128 + (lane & 15) * 8;
        u32x4 Vr[2][8];
#define DSA_VLOAD(buf, ks_) do { _Pragma("unroll") for (int i = 0; i < 8; ++i) { int s_ = 32 * (ks_) + (lane >> 4) + 4 * i; s_ = s_ < nsel ? s_ : nsel - 1; Vr[buf][i] = *(const u32x4*)(vab + (size_t)idx[s_] * 128); } } while (0)
        DSA_VLOAD(0, 0); DSA_VLOAD(1, 1);
#pragma unroll
        for (int ks = 0; ks < 8; ++ks) {
            LAS unsigned char* sb = stg + (ks & 1) * 8192;
#pragma unroll
            for (int i = 0; i < 8; ++i) *(LAS u32x4*)(sb + ((lane >> 4) + 4 * i) * 256 + (lane & 15) * 16) = Vr[ks & 1][i];
            if (ks + 2 < 8) DSA_VLOAD(ks & 1, ks + 2);
            u32x4 pw; pw.x = cvtpk(Dl[ks][0][0], Dl[ks][0][1]); pw.y = cvtpk(Dl[ks][0][2], Dl[ks][0][3]); pw.z = cvtpk(Dl[ks][1][0], Dl[ks][1][1]); pw.w = cvtpk(Dl[ks][1][2], Dl[ks][1][3]);
            const bf16x8 Bp = *reinterpret_cast<const bf16x8*>(&pw);
            const unsigned ra = rd_base + (ks & 1) * 8192u;
            s16x4 l0, l1, l2, l3, l4, l5, l6, l7, h0, h1, h2, h3, h4, h5, h6, h7;
            asm volatile("s_waitcnt lgkmcnt(0)\n\t"
                "ds_read_b64_tr_b16 %0, %16\n\tds_read_b64_tr_b16 %8, %16 offset:1024\n\t"
                "ds_read_b64_tr_b16 %1, %16 offset:32\n\tds_read_b64_tr_b16 %9, %16 offset:1056\n\t"
                "ds_read_b64_tr_b16 %2, %16 offset:64\n\tds_read_b64_tr_b16 %10, %16 offset:1088\n\t"
                "ds_read_b64_tr_b16 %3, %16 offset:96\n\tds_read_b64_tr_b16 %11, %16 offset:1120\n\t"
                "ds_read_b64_tr_b16 %4, %16 offset:128\n\tds_read_b64_tr_b16 %12, %16 offset:1152\n\t"
                "ds_read_b64_tr_b16 %5, %16 offset:160\n\tds_read_b64_tr_b16 %13, %16 offset:1184\n\t"
                "ds_read_b64_tr_b16 %6, %16 offset:192\n\tds_read_b64_tr_b16 %14, %16 offset:1216\n\t"
                "ds_read_b64_tr_b16 %7, %16 offset:224\n\tds_read_b64_tr_b16 %15, %16 offset:1248\n\t"
                "s_waitcnt lgkmcnt(0)"
                : "=&v"(l0), "=&v"(l1), "=&v"(l2), "=&v"(l3), "=&v"(l4), "=&v"(l5), "=&v"(l6), "=&v"(l7), "=&v"(h0), "=&v"(h1), "=&v"(h2), "=&v"(h3), "=&v"(h4), "=&v"(h5), "=&v"(h6), "=&v"(h7)
                : "v"(ra) : "memory");
#define DSA_PV(dt, lo, hi2) O[dt] = __builtin_amdgcn_mfma_f32_16x16x32_bf16((bf16x8){lo[0], lo[1], lo[2], lo[3], hi2[0], hi2[1], hi2[2], hi2[3]}, Bp, O[dt], 0, 0, 0)
            DSA_PV(0, l0, h0); DSA_PV(1, l1, h1); DSA_PV(2, l2, h2); DSA_PV(3, l3, h3); DSA_PV(4, l4, h4); DSA_PV(5, l5, h5); DSA_PV(6, l6, h6); DSA_PV(7, l7, h7);
#undef DSA_PV
        }
#undef DSA_VLOAD
        if (c16 < 6) { const float inv = 1.f / sum; bf16* op = MIX + qrow * DM + c16 * 128 + 4 * g;
#pragma unroll
            for (int dt = 0; dt < 8; ++dt) { u32x2 w; w.x = cvtpk(O[dt][0] * inv, O[dt][1] * inv); w.y = cvtpk(O[dt][2] * inv, O[dt][3] * inv); *(u32x2*)(op + 16 * dt) = w; } }
    }
    __syncthreads();
}
}

namespace gla {
constexpr int LDT = 72;
constexpr int L_BL = 0;
constexpr int L_SEG = L_BL + 16384;
constexpr int L_QH = L_SEG + 2048;
constexpr int L_KH = L_QH + 64 * LDT * 2;
constexpr int L_SC = L_KH + 64 * LDT * 2;
constexpr int L_VT = L_SC + 64 * LDT * 2;
constexpr int L_ST = L_VT + 128 * LDT * 2;
constexpr int L_O = L_ST + 128 * LDT * 2;
constexpr int LDS_NEED = L_O + 64 * 132 * 4;
__device__ __forceinline__ bf16x8 ldfrag(const LAS bf16* base, int row, int k0) { return *(const LAS bf16x8*)(base + row * LDT + k0); }

__device__ __forceinline__ void cum_decay(LAS unsigned char* lds, const float* LA, size_t row0, int hd, bool chunk0) {
    int tid = get_tid();
    const int d = tid & 63, seg = tid >> 6;
    LAS float* bl = (LAS float*)(lds + L_BL); LAS float* sg = (LAS float*)(lds + L_SEG);
    float v[8]; float s = 0.f;
#pragma unroll
    for (int k = 0; k < 8; ++k) { const int i = 8 * seg + k; float x = LA[(row0 + i) * 256 + hd * 64 + d]; if (chunk0 && i < PADF) x = 0.f; s += x; v[k] = s; }
    sg[seg * 64 + d] = s;
    __syncthreads();
    float off = 0.f;
    for (int w = 0; w < seg; ++w) off += sg[w * 64 + d];
#pragma unroll
    for (int k = 0; k < 8; ++k) bl[(8 * seg + k) * 64 + d] = v[k] + off;
    __syncthreads();
}
__device__ __forceinline__ void load_vT(LAS unsigned char* lds, const bf16* Z, size_t row0, int hd) {
    int tid = get_tid(); LAS bf16* vT = (LAS bf16*)(lds + L_VT);
#pragma unroll
    for (int it = 0; it < 2; ++it) { const int pc = tid + 512 * it, i = pc >> 4, e0 = (pc & 15) * 8;
        const u32x4 w = *(const u32x4*)(Z + (row0 + i) * DINP + C_CV + hd * 128 + e0);
        const unsigned ww[4] = {w.x, w.y, w.z, w.w};
#pragma unroll
        for (int k = 0; k < 4; ++k) { vT[(e0 + 2 * k) * LDT + i] = (bf16)(ww[k] & 0xffffu); vT[(e0 + 2 * k + 1) * LDT + i] = (bf16)(ww[k] >> 16); } }
}
__device__ __forceinline__ void step1(LAS unsigned char* lds, const bf16* Z, const float* ZS, float* LA, const float* w2, const float* gb, float* KV, float* DVEC, int b, int c, int hd) {
    int tid = get_tid();
    const int lane = tid & 63, wave = tid >> 6, g = lane >> 4, c16 = lane & 15;
    const size_t row0 = (size_t)b * TP + 64 * c;
    LAS float* bl = (LAS float*)(lds + L_BL); LAS float* sg = (LAS float*)(lds + L_SEG); LAS bf16* kdT = (LAS bf16*)(lds + L_QH); LAS bf16* vT = (LAS bf16*)(lds + L_VT);
    LAS float* crs = (LAS float*)(lds + L_O);
    if (tid < 256) { const int i = tid >> 2; *(LAS f32x4*)(crs + i * 16 + 4 * (tid & 3)) = *(const f32x4*)(ZS + (row0 + i) * 256 + S_CR + 4 * (tid & 3)); }
    __syncthreads();
    { const int d = tid & 63, seg = tid >> 6, n = hd * 64 + d;
      float wc[16];
#pragma unroll
      for (int r = 0; r < 16; ++r) wc[r] = w2[r * 256 + n];
      const float gbn = gb[n];
      float v[8]; float s = 0.f;
#pragma unroll
      for (int k = 0; k < 8; ++k) { const int i = 8 * seg + k; float a = gbn;
#pragma unroll
          for (int r = 0; r < 16; ++r) a += crs[i * 16 + r] * wc[r];
          float x = logsigmoidf(a) * (1.f / 16.f); if (c == 0 && i < PADF) x = 0.f;
          LA[(row0 + i) * 256 + n] = x; s += x; v[k] = s; }
      sg[seg * 64 + d] = s;
      __syncthreads();
      float off = 0.f;
      for (int w = 0; w < seg; ++w) off += sg[w * 64 + d];
#pragma unroll
      for (int k = 0; k < 8; ++k) bl[(8 * seg + k) * 64 + d] = v[k] + off; }
    __syncthreads();
    { const int i = tid >> 3, d0 = (tid & 7) * 8;
      const u32x4 w = *(const u32x4*)(Z + (row0 + i) * DINP + C_CK + hd * 64 + d0); const unsigned ww[4] = {w.x, w.y, w.z, w.w};
#pragma unroll
      for (int k = 0; k < 8; ++k) { const int d = d0 + k; const float kk = (k & 1) ? bfhi(ww[k >> 1]) : bflo(ww[k >> 1]);
          kdT[d * LDT + i] = f2bf(kk * fexp_(bl[63 * 64 + d] - bl[i * 64 + d])); } }
    load_vT(lds, Z, row0, hd);
    __syncthreads();
    const int bh = b * 4 + hd;
    float* kvp = KV + ((size_t)bh * 65 + c) * 8192;
#pragma unroll
    for (int dt = 0; dt < 4; ++dt) { f32x4 acc = zero4();
#pragma unroll
        for (int ks = 0; ks < 2; ++ks) acc = __builtin_amdgcn_mfma_f32_16x16x32_bf16(ldfrag(kdT, 16 * dt + c16, 32 * ks + 8 * g), ldfrag(vT, 16 * wave + c16, 32 * ks + 8 * g), acc, 0, 0, 0);
#pragma unroll
        for (int r = 0; r < 4; ++r) kvp[(16 * dt + 4 * g + r) * 128 + 16 * wave + c16] = acc[r]; }
    if (tid < 64) DVEC[((size_t)bh * 65 + c) * 64 + tid] = fexp_(bl[63 * 64 + tid]);
    __syncthreads();
}
__device__ __forceinline__ void step2(const float* KV, const float* DVEC, float* SS, int u) {
    int tid = get_tid();
    const int bh = u >> 2, idx = (u & 3) * 2048 + tid * 4, d = idx >> 7;
    f32x4 S = zero4();
    *(f32x4*)(SS + ((size_t)bh * 66) * 8192 + idx) = S;
#pragma unroll 4
    for (int c = 0; c < 64; ++c) {
        const f32x4 kv = *(const f32x4*)(KV + ((size_t)bh * 65 + c) * 8192 + idx); const float dv = DVEC[((size_t)bh * 65 + c) * 64 + d];
        S = S * dv + kv;
        *(f32x4*)(SS + ((size_t)bh * 66 + c + 1) * 8192 + idx) = S;
    }
}
__device__ __forceinline__ void step3(LAS unsigned char* lds, const bf16* Z, const float* LA, const float* SS, const float* gon, bf16* MIX, int b, int c, int hd) {
    int tid = get_tid();
    const int lane = tid & 63, wave = tid >> 6, g = lane >> 4, c16 = lane & 15;
    const size_t row0 = (size_t)b * TP + 64 * c;
    LAS float* bl = (LAS float*)(lds + L_BL); LAS bf16* qh = (LAS bf16*)(lds + L_QH); LAS bf16* kh = (LAS bf16*)(lds + L_KH); LAS bf16* scb = (LAS bf16*)(lds + L_SC);
    LAS bf16* vT = (LAS bf16*)(lds + L_VT); LAS bf16* sT = (LAS bf16*)(lds + L_ST); LAS float* ol = (LAS float*)(lds + L_O);
    {
        const int bh = b * 4 + hd;
        cum_decay(lds, LA, row0, hd, c == 0);
        { const int i = tid >> 3, d0 = (tid & 7) * 8;
          const u32x4 wq = *(const u32x4*)(Z + (row0 + i) * DINP + C_CQ + hd * 64 + d0), wk = *(const u32x4*)(Z + (row0 + i) * DINP + C_CK + hd * 64 + d0);
          const unsigned q4[4] = {wq.x, wq.y, wq.z, wq.w}, k4[4] = {wk.x, wk.y, wk.z, wk.w};
          unsigned oq[4], ok[4];
#pragma unroll
          for (int k = 0; k < 4; ++k) { const float b0 = bl[i * 64 + d0 + 2 * k], b1 = bl[i * 64 + d0 + 2 * k + 1];
              oq[k] = cvtpk(bflo(q4[k]) * 0.125f * fexp_(b0), bfhi(q4[k]) * 0.125f * fexp_(b1));
              ok[k] = cvtpk(bflo(k4[k]) * fexp_(-b0), bfhi(k4[k]) * fexp_(-b1)); }
          *(LAS u32x4*)(qh + i * LDT + d0) = (u32x4){oq[0], oq[1], oq[2], oq[3]};
          *(LAS u32x4*)(kh + i * LDT + d0) = (u32x4){ok[0], ok[1], ok[2], ok[3]}; }
        load_vT(lds, Z, row0, hd);
        { const float* sp = SS + ((size_t)bh * 66 + c) * 8192;
#pragma unroll
          for (int it = 0; it < 4; ++it) { const int pc = tid + 512 * it, d = pc >> 5, e0 = (pc & 31) * 4; const f32x4 s4 = *(const f32x4*)(sp + d * 128 + e0);
#pragma unroll
              for (int k = 0; k < 4; ++k) sT[(e0 + k) * LDT + d] = f2bf(s4[k]); } }
        __syncthreads();
        { const int it = wave & 3;
#pragma unroll
          for (int jj = 0; jj < 2; ++jj) { const int jt = 2 * (wave >> 2) + jj; f32x4 acc = zero4();
              if (jt <= it) {
#pragma unroll
                  for (int ks = 0; ks < 2; ++ks) acc = __builtin_amdgcn_mfma_f32_16x16x32_bf16(ldfrag(qh, 16 * it + c16, 32 * ks + 8 * g), ldfrag(kh, 16 * jt + c16, 32 * ks + 8 * g), acc, 0, 0, 0); }
#pragma unroll
              for (int r = 0; r < 4; ++r) { const int i = 16 * it + 4 * g + r, j = 16 * jt + c16; scb[i * LDT + j] = f2bf((j <= i) ? acc[r] : 0.f); } } }
        __syncthreads();
#pragma unroll
        for (int it = 0; it < 4; ++it) { f32x4 acc = zero4();
#pragma unroll
            for (int ks = 0; ks < 2; ++ks) acc = __builtin_amdgcn_mfma_f32_16x16x32_bf16(ldfrag(scb, 16 * it + c16, 32 * ks + 8 * g), ldfrag(vT, 16 * wave + c16, 32 * ks + 8 * g), acc, 0, 0, 0);
#pragma unroll
            for (int ks = 0; ks < 2; ++ks) acc = __builtin_amdgcn_mfma_f32_16x16x32_bf16(ldfrag(qh, 16 * it + c16, 32 * ks + 8 * g), ldfrag(sT, 16 * wave + c16, 32 * ks + 8 * g), acc, 0, 0, 0);
#pragma unroll
            for (int r = 0; r < 4; ++r) ol[(16 * it + 4 * g + r) * 132 + 16 * wave + c16] = acc[r]; }
        __syncthreads();
#pragma unroll
        for (int k = 0; k < 8; ++k) { const int i = 8 * wave + k; const float x0 = ol[i * 132 + 2 * lane], x1 = ol[i * 132 + 2 * lane + 1];
            const float ss = wave_sum(x0 * x0 + x1 * x1); const float rstd = rsqrt_(ss * (1.f / 128.f) + EPS);
            if (!(c == 0 && i < PADF)) { const unsigned gw = *(const unsigned*)(Z + (row0 + i) * DINP + C_CG + hd * 128 + 2 * lane);
                const float y0 = x0 * rstd * gon[2 * lane] * siluf(bflo(gw)), y1 = x1 * rstd * gon[2 * lane + 1] * siluf(bfhi(gw));
                *(unsigned*)(MIX + (row0 + i) * DM + 1536 + hd * 128 + 2 * lane) = cvtpk(y0, y1); } }
        __syncthreads();
    }
}
}

struct Frame {
    LAS unsigned char* lds; char* ldsg;
    int tid, lane, wave, G, bid;
};
constexpr int PTAB_OFF = LDSCTL_OFF + 1024, P_OUT = 21, P_WS = 22;
__device__ __forceinline__ unsigned char* gptr(const Frame& F, int k) {
    const LAS unsigned* t = (const LAS unsigned*)(F.lds + PTAB_OFF) + 2 * k;
    const unsigned lo = __builtin_amdgcn_readfirstlane(t[0]), hi = __builtin_amdgcn_readfirstlane(t[1]);
    return (unsigned char*)(GAS unsigned char*)(((unsigned long long)hi << 32) | lo);
}
#define WS() gptr(F, P_WS)
#define INP(k) ((const float*)gptr(F, (k)))
#define CTL() ((unsigned*)(gptr(F, P_WS) + WS_CTL))
__device__ __forceinline__ int inmap(int n) {
    if (n < 2048) return n;
    if (n < 2112) return C_IK + (n - 2048);
    if (n < 2128) return C_IK + S_IW + (n - 2112);
    if (n < 4432) return C_BQ + (n - 2128);
    if (n < 4438) return C_IK + S_BF + (n - 4432);
    if (n < 4950) return C_CQ + (n - 4438);
    if (n < 5462) return C_CV + (n - 4950);
    if (n < 5478) return C_IK + S_CR + (n - 5462);
    return C_CG + (n - 5478);
}
template <int MAP, int LW>
__device__ __forceinline__ void transpose_item(const float* W, int K, int N, bf16* WT, LAS float* scr, int item, int lane) {
    constexpr int PITCH = 68, LPR = 64 / LW  , RPI = 64 / LPR  , NI = 64 / RPI;
    const int nblk = (N + 63) / 64, kb = item / nblk, nb = item % nblk, k0 = 64 * kb, n0 = 64 * nb;
    const int cl = LW * (lane % LPR), rl = lane / LPR;
    const float* src = W + (size_t)(k0 + rl) * N + n0 + cl;
    const bool inb = (n0 + cl) < N;
    if constexpr (LW == 4) { f32x4 v[NI];
#pragma unroll
        for (int i = 0; i < NI; ++i) v[i] = inb ? *(const f32x4*)(src + (size_t)(RPI * i) * N) : (f32x4){0.f, 0.f, 0.f, 0.f};
#pragma unroll
        for (int i = 0; i < NI; ++i) *(LAS f32x4*)(scr + (rl + RPI * i) * PITCH + cl) = v[i];
    } else { f32x2 v[NI];
#pragma unroll
        for (int i = 0; i < NI; ++i) v[i] = inb ? *(const f32x2*)(src + (size_t)(RPI * i) * N) : (f32x2){0.f, 0.f};
#pragma unroll
        for (int i = 0; i < NI; ++i) *(LAS f32x2*)(scr + (rl + RPI * i) * PITCH + cl) = v[i];
    }
    LDS_WAIT(); asm volatile("" ::: "memory");
    const int ng = n0 + lane;
    int row = ng; if (MAP == 1) row = inmap(ng < N ? ng : 0); if (MAP == 2) row = 8 * (ng >> 2) + (ng & 3); if (MAP == 3) row = 8 * (ng >> 2) + 4 + (ng & 3);
    bf16* dst = WT + (size_t)row * K + k0;
#pragma unroll
    for (int kc = 0; kc < 8; ++kc) { const LAS float* sp = scr + (8 * kc) * PITCH + lane;
        u32x4 o; o.x = cvtpk(sp[0 * PITCH], sp[1 * PITCH]); o.y = cvtpk(sp[2 * PITCH], sp[3 * PITCH]); o.z = cvtpk(sp[4 * PITCH], sp[5 * PITCH]); o.w = cvtpk(sp[6 * PITCH], sp[7 * PITCH]);
        if (ng < N) *(u32x4*)(dst + 8 * kc) = o; }
    LDS_WAIT(); asm volatile("" ::: "memory");
}
__device__ __forceinline__ void sincos_d(double ang, float& c, float& s) {
    const double q = __builtin_rint(ang * 0.63661977236758134308);
    double r = __builtin_fma(-q, 1.5707963267948966, ang); r = __builtin_fma(-q, 6.123233995736766e-17, r);
    const double r2 = r * r;
    const double sp = r + r * r2 * (-1.0 / 6 + r2 * (1.0 / 120 + r2 * (-1.0 / 5040 + r2 * (1.0 / 362880 + r2 * (-1.0 / 39916800 + r2 * (1.0 / 6227020800.0))))));
    const double cp = 1.0 + r2 * (-0.5 + r2 * (1.0 / 24 + r2 * (-1.0 / 720 + r2 * (1.0 / 40320 + r2 * (-1.0 / 3628800 + r2 * (1.0 / 479001600.0))))));
    const int n = (int)((long long)q & 3);
    const double sv = (n == 0) ? sp : (n == 1) ? cp : (n == 2) ? -sp : -cp;
    const double cv = (n == 0) ? cp : (n == 1) ? -sp : (n == 2) ? -cp : sp;
    c = (float)cv; s = (float)sv;
}
__device__ __forceinline__ void p_prologue(Frame& F, const float* w_in, const float* w_out, const float* e_w1, const float* e_w3, const float* e_w2, const float* rgw, const float* rew, const float* g2) {
    int htid = get_tid(); const int h_lane = htid & 63, h_wave = __builtin_amdgcn_readfirstlane(htid >> 6);
    LAS float* scr = (LAS float*)(F.lds + h_wave * 17408);
    const int gw = F.bid * 8 + h_wave, NGW = F.G * 8;
    unsigned char* ws = WS();
    constexpr int I_IN = 32 * 94, I_OUT = 32 * 32, I_W1 = NEXP * 32 * 8, I_W2 = NEXP * 8 * 32, I_L = I_IN + I_OUT + 2 * I_W1 + I_W2;
    for (int it = gw; it < DEPTH * I_L; it += NGW) {
        const int l = it / I_L; int r = it % I_L;
        if (r < I_IN) { transpose_item<1, 2>(w_in + (size_t)l * DM * DIN, DM, DIN, (bf16*)(ws + WS_WIN + l * SZ_WIN), scr, r, h_lane); continue; } r -= I_IN;
        if (r < I_OUT) { transpose_item<0, 4>(w_out + (size_t)l * DM * DM, DM, DM, (bf16*)(ws + WS_WOUT + l * SZ_WOUT), scr, r, h_lane); continue; } r -= I_OUT;
        if (r < I_W1) { const int e = r / 256; transpose_item<2, 4>(e_w1 + ((size_t)l * NEXP + e) * DM * DEXP, DM, DEXP, (bf16*)(ws + WS_W13 + l * SZ_W13 + e * SZ_W13E), scr, r % 256, h_lane); continue; } r -= I_W1;
        if (r < I_W1) { const int e = r / 256; transpose_item<3, 4>(e_w3 + ((size_t)l * NEXP + e) * DM * DEXP, DM, DEXP, (bf16*)(ws + WS_W13 + l * SZ_W13 + e * SZ_W13E), scr, r % 256, h_lane); continue; } r -= I_W1;
        { const int e = r / 256; transpose_item<0, 4>(e_w2 + ((size_t)l * NEXP + e) * DEXP * DM, DEXP, DM, (bf16*)(ws + WS_W2 + l * SZ_W2 + e * SZ_W2E), scr, r % 256, h_lane); }
    }
    const int gt = F.bid * 512 + htid, NGT = F.G * 512;
    for (int i = gt; i < DEPTH * 154 * (DM / 8); i += NGT) { const int l = i / (154 * 256), rr = (i / 256) % 154, ch = i % 256;
        *(u32x4*)((bf16*)(ws + WS_WIN + l * SZ_WIN) + (size_t)(DIN + rr) * DM + ch * 8) = (u32x4){0u, 0u, 0u, 0u}; }
    for (int i = gt; i < TT * 64; i += NGT) { const int t = i >> 6, k = i & 63; double inv = 1.0; for (int j = 0; j < k; ++j) inv *= 0.86596432336006535;
        float c, s; sincos_d((double)t * inv, c, s); ((float*)(ws + WS_COS128))[i] = c; ((float*)(ws + WS_SIN128))[i] = s; }
    for (int i = gt; i < TT * 32; i += NGT) { const int t = i >> 5, k = i & 31; double inv = 1.0; for (int j = 0; j < k; ++j) inv *= 0.74989420933245583;
        float c, s; sincos_d((double)t * inv, c, s); ((float*)(ws + WS_COS64))[i] = c; ((float*)(ws + WS_SIN64))[i] = s; }
    for (int i = gt; i < NB * PADF * (DM / 8); i += NGT) { const int b = i / (PADF * 256), rr = (i / 256) % PADF, ch = i % 256; const size_t row = (size_t)b * TP + rr;
        *(u32x4*)((bf16*)(ws + WS_U) + row * DM + ch * 8) = (u32x4){0u, 0u, 0u, 0u}; *(u32x4*)((bf16*)(ws + WS_MIX) + row * DM + ch * 8) = (u32x4){0u, 0u, 0u, 0u}; }
    for (int i = gt; i < NB * PADF * (DINP / 8); i += NGT) { const int b = i / (PADF * 768), rr = (i / 768) % PADF, ch = i % 768; const size_t row = (size_t)b * TP + rr;
        *(u32x4*)((bf16*)(ws + WS_Z) + row * DINP + ch * 8) = (u32x4){0u, 0u, 0u, 0u}; }
    for (int i = gt; i < NB * PADF * 40; i += NGT) { const int b = i / (PADF * 40), rr = (i / 40) % PADF, ch = i % 40; const size_t row = (size_t)b * TP + rr;
        bf16* dst = (ch < 8) ? (bf16*)(ws + WS_IKC) + row * 64 + ch * 8 : (ch < 24 ? (bf16*)(ws + WS_KAC) + row * 128 + (ch - 8) * 8 : (bf16*)(ws + WS_VAC) + row * 128 + (ch - 24) * 8);
        *(u32x4*)dst = (u32x4){0u, 0u, 0u, 0u}; }
    for (int i = gt; i < NB * PADF * 64; i += NGT) { const int b = i / (PADF * 64), rr = (i / 64) % PADF, ch = i % 64; const size_t row = (size_t)b * TP + rr;
        *(f32x4*)((float*)(ws + WS_LA) + row * 256 + ch * 4) = zero4(); }
    for (int i = gt; i < DEPTH * 48 * DM; i += NGT) { const int l = i / (48 * DM), n = (i / DM) % 48, k = i % DM;
        float w = 0.f; if (n < 4) w = rgw[((size_t)l * DM + k) * 4 + n]; else if (n < 36) w = rew[((size_t)l * DM + k) * 32 + (n - 4)];
        w *= g2[(size_t)l * DM + k];
        const bf16 hi = f2bf(w); const bf16 lo = f2bf(w - bf2f(hi));
        bf16* wr = (bf16*)(ws + WS_WR + l * SZ_WR); wr[(size_t)n * DM + k] = hi; wr[(size_t)(48 + n) * DM + k] = lo; }
}
__device__ __forceinline__ void p_norm1(Frame& F, int l, const float* xin, const float* meta, const float* gain, size_t woff) {
    int htid = get_tid(); const int h_lane = htid & 63, h_wave = __builtin_amdgcn_readfirstlane(htid >> 6);
    const int gw = F.bid * 8 + h_wave, NGW = F.G * 8, lane = h_lane;
    float* H = (float*)(WS() + WS_H); bf16* U = (bf16*)(WS() + WS_U); const bf16* Y0 = (const bf16*)(WS() + WS_Y0); const bf16* Y1 = (const bf16*)(WS() + WS_Y1);
    for (int row = gw; row < R; row += NGW) {
        const int b = row / TP, v = row % TP;
        float* hr = H + (size_t)row * DM;
        if (v < PADF) { if (l == 0) {
#pragma unroll
                for (int j = 0; j < 8; ++j) *(f32x4*)(hr + 4 * (lane + 64 * j)) = zero4(); }
            continue; }
        const int t = v - PADF;
        f32x4 x[8]; float ss = 0.f;
#pragma unroll
        for (int j = 0; j < 8; ++j) { const int col = 4 * (lane + 64 * j);
            if (l == 0) { const float* src = (t < NMETA) ? meta + (size_t)t * DM : xin + ((size_t)b * SEQ + (t - NMETA)) * DM; x[j] = *(const f32x4*)(src + col); }
            else { x[j] = *(const f32x4*)(hr + col); const u32x2 a = *(const u32x2*)(Y0 + (size_t)row * DM + col), c = *(const u32x2*)(Y1 + (size_t)row * DM + col);
                x[j][0] += bflo(a.x) + bflo(c.x); x[j][1] += bfhi(a.x) + bfhi(c.x); x[j][2] += bflo(a.y) + bflo(c.y); x[j][3] += bfhi(a.y) + bfhi(c.y); }
            *(f32x4*)((char*)(hr + col) + woff) = x[j];
            ss += x[j][0] * x[j][0] + x[j][1] * x[j][1] + x[j][2] * x[j][2] + x[j][3] * x[j][3]; }
        ss = wave_sum(ss); const float rstd = rsqrt_(ss * (1.f / DM) + EPS);
#pragma unroll
        for (int j = 0; j < 8; ++j) { const int col = 4 * (lane + 64 * j); const f32x4 gg = *(const f32x4*)(gain + col);
            u32x2 w; w.x = cvtpk(x[j][0] * rstd * gg[0], x[j][1] * rstd * gg[1]); w.y = cvtpk(x[j][2] * rstd * gg[2], x[j][3] * rstd * gg[3]);
            *(u32x2*)((char*)(U + (size_t)row * DM + col) + woff) = w; }
    }
}
__device__ __forceinline__ void p_final(Frame& F) {
#ifdef PROBE_MASK
    float probe_delta = 0.f;
    { const volatile LAS unsigned long long* st = (const volatile LAS unsigned long long*)(F.lds + LDSCTL_OFF + 2048); unsigned long long tk = 0;
      for (int pz = 0; pz < 2 + 9 * DEPTH - 1; ++pz) { const int ty = (pz == 0) ? 0 : 1 + (pz - 1) % 9, ly = (pz == 0) ? 0 : (pz - 1) / 9;
          if (((PROBE_MASK >> ty) & 1) && ((PROBE_LAYERS >> ly) & 1)) tk += st[pz + 1] - st[pz]; }
      probe_delta = (PROBE_CONST) + (PROBE_ALPHA) * 0.01f * (float)tk; }
#endif
    int htid = get_tid(); const int h_lane = htid & 63, h_wave = __builtin_amdgcn_readfirstlane(htid >> 6);
    const int gw = F.bid * 8 + h_wave, NGW = F.G * 8, lane = h_lane;
    const float* H = (const float*)(WS() + WS_H); const bf16* Y0 = (const bf16*)(WS() + WS_Y0); const bf16* Y1 = (const bf16*)(WS() + WS_Y1);
    for (int o = gw; o < NB * SEQ; o += NGW) { const int b = o / SEQ, i = o % SEQ; const size_t row = (size_t)b * TP + PADF + NMETA + i;
#pragma unroll
        for (int j = 0; j < 8; ++j) { const int col = 4 * (lane + 64 * j); f32x4 x = *(const f32x4*)(H + row * DM + col);
            const u32x2 a = *(const u32x2*)(Y0 + row * DM + col), c = *(const u32x2*)(Y1 + row * DM + col);
            x[0] += bflo(a.x) + bflo(c.x); x[1] += bfhi(a.x) + bfhi(c.x); x[2] += bflo(a.y) + bflo(c.y); x[3] += bfhi(a.y) + bfhi(c.y);
#ifdef PROBE_MASK
            x = x + probe_delta;
#endif
            *(f32x4*)(((float*)gptr(F, P_OUT)) + (size_t)o * DM + col) = x; } }
}
__device__ __forceinline__ void unpack8(const u32x4 w, float (&x)[8]) { x[0] = bflo(w.x); x[1] = bfhi(w.x); x[2] = bflo(w.y); x[3] = bfhi(w.y); x[4] = bflo(w.z); x[5] = bfhi(w.z); x[6] = bflo(w.w); x[7] = bfhi(w.w); }
__device__ __forceinline__ u32x4 pack8f(const float (&x)[8]) { u32x4 w; w.x = cvtpk(x[0], x[1]); w.y = cvtpk(x[2], x[3]); w.z = cvtpk(x[4], x[5]); w.w = cvtpk(x[6], x[7]); return w; }
__device__ __forceinline__ void head128x(const bf16* p, bf16* dst, const float* gain, bool rope, bool raw, const float* cs, const float* sn, int lane) {
    const int c16 = lane & 15;
    const u32x4 w0 = *(const u32x4*)p;
    float x[8]; unpack8(w0, x);
    float ss = 0.f;
#pragma unroll
    for (int e = 0; e < 8; ++e) ss += x[e] * x[e];
    ss += __shfl_xor(ss, 1); ss += __shfl_xor(ss, 2); ss += __shfl_xor(ss, 4); ss += __shfl_xor(ss, 8);
    const float rstd = rsqrt_(ss * (1.f / 128.f) + EPS);
#pragma unroll
    for (int e = 0; e < 8; ++e) x[e] = x[e] * rstd * gain[8 * c16 + e];
    const int i0 = 8 * (c16 & 7);
#pragma unroll
    for (int e = 0; e < 8; ++e) { const float pr = __shfl_xor(x[e], 8); const float c = cs[i0 + e], s = sn[i0 + e];
        const float y = (c16 < 8) ? x[e] * c - pr * s : x[e] * c + pr * s; if (rope) x[e] = y; }
    *(u32x4*)dst = raw ? w0 : pack8f(x);
}
__device__ __forceinline__ void head128(bf16* p, const float* gain, bool rope, bool store, const float* cs, const float* sn, int lane, size_t woff = 0) {
    const int c16 = lane & 15;
    float x[8]; unpack8(*(const u32x4*)p, x);
    float ss = 0.f;
#pragma unroll
    for (int e = 0; e < 8; ++e) ss += x[e] * x[e];
    ss += __shfl_xor(ss, 1); ss += __shfl_xor(ss, 2); ss += __shfl_xor(ss, 4); ss += __shfl_xor(ss, 8);
    const float rstd = rsqrt_(ss * (1.f / 128.f) + EPS);
#pragma unroll
    for (int e = 0; e < 8; ++e) x[e] = x[e] * rstd * gain[8 * c16 + e];
    const int i0 = 8 * (c16 & 7);
#pragma unroll
    for (int e = 0; e < 8; ++e) { const float pr = __shfl_xor(x[e], 8); const float c = cs[i0 + e], s = sn[i0 + e];
        const float y = (c16 < 8) ? x[e] * c - pr * s : x[e] * c + pr * s; if (rope) x[e] = y; }
    if (store) *(u32x4*)((char*)p + woff) = pack8f(x);
}
struct PostP { const float *gaq, *gak, *gbq, *gbk, *fbias, *w2, *gb; };
__device__ __forceinline__ void post_row(Frame& F, const PostP& pp, int row, size_t woff) {
    int htid = get_tid(); const int h_lane = htid & 63, h_wave = __builtin_amdgcn_readfirstlane(htid >> 6);
    const int lane = h_lane, v = row % TP;
    if (v < PADF) return;
    const int t = v - PADF;
    bf16* zr = (bf16*)(WS() + WS_Z) + (size_t)row * DINP; float* zs = (float*)(WS() + WS_ZS) + (size_t)row * 256;
    const float* c128 = (const float*)(WS() + WS_COS128) + t * 64; const float* s128 = (const float*)(WS() + WS_SIN128) + t * 64;
    const float* c64 = (const float*)(WS() + WS_COS64) + t * 32; const float* s64 = (const float*)(WS() + WS_SIN64) + t * 32;
    const float* gaq = pp.gaq; const float* gak = pp.gak; const float* gbq = pp.gbq; const float* gbk = pp.gbk;
    head128(zr + 8 * lane, gaq, true, true, c128, s128, lane, woff);
    { bf16* kac = (bf16*)(WS() + WS_KAC) + (size_t)row * 128; bf16* vac = (bf16*)(WS() + WS_VAC) + (size_t)row * 128;
      bf16* dstp = (lane < 32) ? (bf16*)((char*)(zr + 512 + 8 * lane) + woff) : (lane < 48 ? kac + 8 * (lane - 32) : vac + 8 * (lane - 48));
      head128x(zr + 512 + 8 * lane, dstp, lane < 32 ? gaq : gak, true, lane >= 48, c128, s128, lane); }
#pragma unroll
    for (int j = 0; j < 2; ++j) { bf16* p = zr + C_IQ + 512 * j + 8 * lane; float x[8]; unpack8(*(const u32x4*)p, x); const int i0 = 8 * (lane & 3);
#pragma unroll
        for (int e = 0; e < 8; ++e) { const float pr = __shfl_xor(x[e], 4); const float c = c64[i0 + e], s = s64[i0 + e]; x[e] = (lane & 4) ? x[e] * c + pr * s : x[e] * c - pr * s; }
        *(u32x4*)((char*)p + woff) = pack8f(x); }
    head128(zr + C_BQ + 8 * lane, gbq, false, true, c128, s128, lane, woff);
    head128(zr + C_BQ + 512 + 8 * lane, lane < 32 ? gbq : gbk, false, true, c128, s128, lane, woff);
    head128(zr + C_BQ + 1024 + 8 * lane, gbk, false, true, c128, s128, lane, woff);
    { const float x = zs[S_IK + lane]; const float pr = __shfl_xor(x, 32); const int i = lane & 31; const float c = c64[i], s = s64[i];
      const float y = (lane < 32) ? x * c - pr * s : x * c + pr * s; const float yn = __shfl_xor(y, 1);
      if ((lane & 1) == 0) *(unsigned*)((bf16*)(WS() + WS_IKC) + (size_t)row * 64 + lane) = cvtpk(y, yn); }
    const float iwv = (lane < 16) ? zs[S_IW + lane] * 0.03125f : 0.f;
    const float lf = (lane < 6) ? logsigmoidf(zs[S_BF + lane] + pp.fbias[lane]) : 0.f;
    if (lane < 16) *(float*)((char*)(zs + S_IW + lane) + woff) = iwv;
    if (lane < 6) *(float*)((char*)(zs + S_BF + lane) + woff) = lf;
}
__device__ __forceinline__ void p_norm2(Frame& F, int l, const float* gain, const float* bg, const float* be, bool dup) {
    int htid = get_tid(); const int lane = htid & 63, wave = __builtin_amdgcn_readfirstlane(htid >> 6), g = lane >> 4, c16 = lane & 15;
    const int gw = F.bid * 8 + wave, NGW = F.G * 8;
    const float* H = (const float*)(WS() + WS_H); bf16* U = (bf16*)(WS() + WS_U);
    LAS float* lg = (LAS float*)(F.lds + wave * 4096); LAS float* rs = lg + 768;
    for (int rt = gw; rt < R / 16; rt += NGW) {
        const size_t row0 = (size_t)rt * 16; if ((int)(row0 % TP) < PADF) continue;
        const bf16* wr = (const bf16*)(WS() + WS_WR + l * SZ_WR);
        f32x4 acc[3] = {zero4(), zero4(), zero4()};
        const float* hrow = H + (row0 + c16) * DM + 8 * g;
        const bf16* wp0 = wr + (size_t)c16 * DM + 8 * g;
        float ss = 0.f;
#pragma unroll 4
        for (int ks = 0; ks < 64; ++ks) {
            const f32x4 a = *(const f32x4*)(hrow + 32 * ks), b = *(const f32x4*)(hrow + 32 * ks + 4);
            ss += (a[0] * a[0] + a[1] * a[1]) + (a[2] * a[2] + a[3] * a[3]) + (b[0] * b[0] + b[1] * b[1]) + (b[2] * b[2] + b[3] * b[3]);
            u32x4 hw; hw.x = cvtpk(a[0], a[1]); hw.y = cvtpk(a[2], a[3]); hw.z = cvtpk(b[0], b[1]); hw.w = cvtpk(b[2], b[3]);
            u32x4 lw; lw.x = cvtpk(a[0] - bflo(hw.x), a[1] - bfhi(hw.x)); lw.y = cvtpk(a[2] - bflo(hw.y), a[3] - bfhi(hw.y));
            lw.z = cvtpk(b[0] - bflo(hw.z), b[1] - bfhi(hw.z)); lw.w = cvtpk(b[2] - bflo(hw.w), b[3] - bfhi(hw.w));
            const bf16x8 Ah = *reinterpret_cast<const bf16x8*>(&hw), Al = *reinterpret_cast<const bf16x8*>(&lw);
#pragma unroll
            for (int ct = 0; ct < 3; ++ct) { const bf16* wp = wp0 + (size_t)(16 * ct) * DM + 32 * ks;
                const bf16x8 Bh = *(const bf16x8*)wp, Bl = *(const bf16x8*)(wp + (size_t)48 * DM);
                acc[ct] = __builtin_amdgcn_mfma_f32_16x16x32_bf16(Ah, Bh, acc[ct], 0, 0, 0);
                acc[ct] = __builtin_amdgcn_mfma_f32_16x16x32_bf16(Ah, Bl, acc[ct], 0, 0, 0);
                acc[ct] = __builtin_amdgcn_mfma_f32_16x16x32_bf16(Al, Bh, acc[ct], 0, 0, 0); } }
        ss += __shfl_xor(ss, 16); ss += __shfl_xor(ss, 32);
        if (g == 0) rs[c16] = rsqrt_(ss * (1.f / DM) + EPS);
#pragma unroll
        for (int ct = 0; ct < 3; ++ct)
#pragma unroll
            for (int r = 0; r < 4; ++r) lg[(4 * g + r) * 48 + 16 * ct + c16] = acc[ct][r];
        LDS_WAIT();
        if (lane < 16) { const size_t row = row0 + lane;
            const float rstd = rs[lane];
            float gl[4]; int gi = 0; float gm = -1e30f;
#pragma unroll
            for (int j = 0; j < 4; ++j) { gl[j] = lg[lane * 48 + j] * rstd + bg[j]; if (gl[j] > gm) { gm = gl[j]; gi = j; } }
            float gs = 0.f;
#pragma unroll
            for (int j = 0; j < 4; ++j) gs += fexp_(gl[j] - gm);
            const float gp = 1.f / gs;
            float el[8]; int e0 = 0, e1 = 0; float m0 = -1e30f, m1 = -1e30f;
#pragma unroll
            for (int j = 0; j < 8; ++j) el[j] = lg[lane * 48 + 4 + 8 * gi + j] * rstd + be[8 * gi + j];
#pragma unroll
            for (int j = 0; j < 8; ++j) { if (el[j] > m0) { m1 = m0; e1 = e0; m0 = el[j]; e0 = j; } else if (el[j] > m1) { m1 = el[j]; e1 = j; } }
            const float w1r = fexp_(m1 - m0); const float p0 = 1.f / (1.f + w1r), p1 = w1r / (1.f + w1r);
            unsigned* cnt = CTL() + CW_CNT + 1024 * l + (dup ? 16 : 0); unsigned* list = (unsigned*)(WS() + (dup ? WS_END : WS_LIST)); float* gate = (float*)(WS() + WS_GATE);
            const int x0 = gi * 8 + e0, x1 = gi * 8 + e1;
            const unsigned i0 = atomicAdd(cnt + 32 * x0, 1u), i1 = atomicAdd(cnt + 32 * x1, 1u);
            list[(size_t)x0 * R + i0] = (unsigned)row * 2u; list[(size_t)x1 * R + i1] = (unsigned)row * 2u + 1u;
            gate[row * 2] = gp * p0; gate[row * 2 + 1] = gp * p1; }
        LDS_WAIT();
    }
    for (int row = gw; row < R; row += NGW) { if ((row % TP) < PADF) continue;
        f32x4 x[8]; float ss = 0.f;
#pragma unroll
        for (int j = 0; j < 8; ++j) { x[j] = *(const f32x4*)(H + (size_t)row * DM + 4 * (lane + 64 * j)); ss += x[j][0] * x[j][0] + x[j][1] * x[j][1] + x[j][2] * x[j][2] + x[j][3] * x[j][3]; }
        ss = wave_sum(ss); const float rstd = rsqrt_(ss * (1.f / DM) + EPS);
#pragma unroll
        for (int j = 0; j < 8; ++j) { const int col = 4 * (lane + 64 * j); const f32x4 gg = *(const f32x4*)(gain + col);
            u32x2 w; w.x = cvtpk(x[j][0] * rstd * gg[0], x[j][1] * rstd * gg[1]); w.y = cvtpk(x[j][2] * rstd * gg[2], x[j][3] * rstd * gg[3]);
            *(u32x2*)(U + (size_t)row * DM + col) = w; } }
}
__device__ __forceinline__ void build_moetab(Frame& F, int l) {
    int htid = get_tid(); const int h_lane = htid & 63, h_wave = __builtin_amdgcn_readfirstlane(htid >> 6);
    LAS pg8::MoeTab* tab = (LAS pg8::MoeTab*)(F.lds + MOETAB_OFF);
    if (htid == 0) { int t = 0; const unsigned* cnt = CTL() + CW_CNT + 1024 * l;
        for (int e = 0; e < NEXP; ++e) { const int n = (int)__hip_atomic_load(cnt + 32 * e, __ATOMIC_RELAXED, __HIP_MEMORY_SCOPE_AGENT); tab->cnt[e] = n;
            for (int j = 0; j * 256 < n && t < 176; ++j) { tab->e[t] = e; tab->r0[t] = j * 256; ++t; } }
        tab->ntiles = t; }
    __syncthreads();
}

#define INPARG(i) args_in_dyn(args, (i))
constexpr int NPH = 2 + 9 * DEPTH;
struct Args { const float* in[21]; float* out; unsigned char* ws; int ph_lo, ph_hi; };
#define PHASE_FN static __device__ __forceinline__
#define MKFRAME Frame F; F.lds = lds; F.ldsg = (char*)lds; F.tid = 0; F.lane = 0; F.wave = 0; F.G = (int)gridDim.x; F.bid = (int)blockIdx.x
#define Z ((bf16*)(WS() + WS_Z))
#define ZS ((float*)(WS() + WS_ZS))
#define MIX ((bf16*)(WS() + WS_MIX))
#define U ((bf16*)(WS() + WS_U))
#define LA ((float*)(WS() + WS_LA))
#define KV ((float*)(WS() + WS_KV))
#define DVEC ((float*)(WS() + WS_DVEC))
#define SS ((float*)(WS() + WS_SS))
PHASE_FN void ph_prologue(LAS unsigned char* lds) { MKFRAME; p_prologue(F, INP(4), INP(13), INP(18), INP(19), INP(20), INP(14), INP(16), INP(3)); }
PHASE_FN void ph_norm1(LAS unsigned char* lds, int l, size_t woff) { MKFRAME; p_norm1(F, l, INP(0), INP(1), INP(2) + (size_t)l * DM, woff); }
PHASE_FN void ph_inproj(LAS unsigned char* lds, int l) { MKFRAME;
    pg8::DenseProb P; P.init(U, WS() + WS_WIN + l * SZ_WIN, 64 * 256, DINP, DM, F.G, F.bid);
    pg8::EpiInProj E{Z, ZS};
    pg8::gemm_phase(F.lds, P, E);
    skinny_gemm<0>(F.lds, U, (const bf16*)(WS() + WS_WIN + l * SZ_WIN), DM, DINP, F.bid, Z, ZS, nullptr);
}
PHASE_FN void ph_post(LAS unsigned char* lds, int l, size_t woff) { MKFRAME;
    PostP pp{INP(5) + l * 128, INP(6) + l * 128, INP(7) + l * 128, INP(8) + l * 128, INP(9) + l * 6, INP(10) + (size_t)l * 16 * 256, INP(11) + l * 256};
    for (int u = F.bid; u < (R / 64) * 4; u += F.G) gla::step1(F.lds, Z, ZS, LA, INP(10) + (size_t)l * 16 * 256, INP(11) + l * 256, KV, DVEC, (u >> 2) / 65, (u >> 2) % 65, u & 3);
    { const int gw = F.bid * 8 + (get_tid() >> 6);
      for (int row = gw; row < R; row += F.G * 8) post_row(F, pp, row, woff); }
}
#ifndef MIXM
#define MIXM 15
#endif
PHASE_FN void ph_mix(LAS unsigned char* lds, int l, int rep) { MKFRAME;
    volatile LAS unsigned* MISC = (volatile LAS unsigned*)(F.lds + MISC_OFF);
    if ((MIXM & 1) && F.bid < 64) gla::step2(KV, DVEC, SS, F.bid);
    if (MIXM & 2) { for (int it = F.G - 1 - F.bid; it < 192; it += F.G) fox::item(F.ldsg, Z, ZS, MIX, it); }
    if ((MIXM & 4) && F.bid < NB) fox::meta_unit(Z, ZS, MIX, F.bid);
    __syncthreads();
    for (; MIXM & 8;) {
        if (get_tid() == 0) MISC[0] = atomicAdd(CTL() + CW_QUEUE + 64 * l + 32 * rep, 1u);
        __syncthreads();
        const int q = (int)MISC[0];
        __syncthreads();
        if (q >= 65 * 32) break;
        const int c = 64 - q / 32, b = (q % 32) / 8, sub = q % 8;
        if (c == 0 && sub < 6) continue;
        dsa::unit(F.lds, Z, ZS, (const bf16*)(WS() + WS_IKC), (const bf16*)(WS() + WS_KAC), (const bf16*)(WS() + WS_VAC), MIX, b, c, sub);
    }
}
PHASE_FN void ph_gla3(LAS unsigned char* lds, int l) { MKFRAME;
    for (int u = F.bid; u < (R / 64) * 4; u += F.G) gla::step3(F.lds, Z, LA, SS, INP(12) + l * 128, MIX, (u >> 2) / 65, (u >> 2) % 65, u & 3);
}
PHASE_FN void ph_outproj(LAS unsigned char* lds, int l, size_t woff) { MKFRAME;
    pg8::DenseProb P; P.init(MIX, WS() + WS_WOUT + l * SZ_WOUT, 64 * 256, DM, DM, F.G, F.bid);
    pg8::EpiOutProj E{(float*)(WS() + WS_H + woff)};
    pg8::gemm_phase(F.lds, P, E);
    skinny_gemm<1>(F.lds, MIX, (const bf16*)(WS() + WS_WOUT + l * SZ_WOUT), DM, DM, F.bid, nullptr, nullptr, (float*)(WS() + WS_H + woff));
}
PHASE_FN void ph_norm2(LAS unsigned char* lds, int l, bool dup) { MKFRAME;
    p_norm2(F, l, INP(3) + (size_t)l * DM, INP(15) + l * 4, INP(17) + l * 32, dup);
}
PHASE_FN void ph_moeup(LAS unsigned char* lds, int l) { MKFRAME;
    build_moetab(F, l);
    pg8::MoeProb<true> P; P.K = DM; P.lda = DM; P.A = (const char*)U; P.W = (const char*)(WS() + WS_W13 + l * SZ_W13); P.list = (const unsigned*)(WS() + WS_LIST);
    P.tab = (const LAS pg8::MoeTab*)(F.lds + MOETAB_OFF); P.G = F.G; P.c = F.bid;
    pg8::EpiMoeUp E{(bf16*)(WS() + WS_HID)};
    pg8::gemm_phase(F.lds, P, E);
}
PHASE_FN void ph_moedown(LAS unsigned char* lds, int l) { MKFRAME;
    build_moetab(F, l);
    pg8::MoeProb<false> P; P.K = DEXP; P.lda = DEXP; P.A = (const char*)(WS() + WS_HID); P.W = (const char*)(WS() + WS_W2 + l * SZ_W2); P.list = (const unsigned*)(WS() + WS_LIST);
    P.tab = (const LAS pg8::MoeTab*)(F.lds + MOETAB_OFF); P.G = F.G; P.c = F.bid;
    pg8::EpiMoeDown E{(bf16*)(WS() + WS_Y0), (bf16*)(WS() + WS_Y1), (const unsigned*)(WS() + WS_LIST), (const float*)(WS() + WS_GATE), (const LAS pg8::MoeTab*)(F.lds + MOETAB_OFF)};
    pg8::gemm_phase(F.lds, P, E);
}
PHASE_FN void ph_final(LAS unsigned char* lds) { MKFRAME; p_final(F); }
#undef Z
#undef ZS
#undef MIX
#undef U
#undef LA
#undef KV
#undef DVEC
#undef SS

__device__ __forceinline__ const float* args_in_dyn(const Args& a, int i) { const float* p = a.in[0];
#pragma unroll
    for (int k = 1; k < 21; ++k) p = (i == k) ? a.in[k] : p;
    return p; }
__global__ void __launch_bounds__(512, 2) fwd_kernel(Args args) {
    extern __shared__ __attribute__((aligned(16))) unsigned char lds_raw[];
    LAS unsigned char* lds = (LAS unsigned char*)lds_raw;
    const int tid = threadIdx.x;
    if ((tid & 63) == 0) *(volatile LAS unsigned*)(uintptr_t)(WAVETAB_OFF + 4 * ((unsigned)__builtin_amdgcn_s_getreg((5 << 11) | 4) & 63u)) = (unsigned)tid >> 6;
    if (tid < 23) { const unsigned long long v = (tid < 21) ? (unsigned long long)INPARG(tid) : (tid == 21 ? (unsigned long long)args.out : (unsigned long long)args.ws);
        LAS unsigned* t = (LAS unsigned*)(lds + PTAB_OFF) + 2 * tid; t[0] = (unsigned)v; t[1] = (unsigned)(v >> 32); }
    volatile LAS unsigned* MISC = (volatile LAS unsigned*)(lds + MISC_OFF);
    for (int u = tid; u < 256; u += 512) ((LAS unsigned*)(lds + LDSCTL_OFF))[u] = 0u;
    __syncthreads();
    const int lo = args.ph_lo, hi = args.ph_hi;
    const bool multi = (hi - lo) > 1;
    unsigned* barw = (unsigned*)(args.ws + WS_CTL) + CW_BAR;
    XcdBarrier bar; bar.bar = barw; bar.x = 0; bar.st = nullptr;
    if (multi) bar = xcd_barrier_post(barw, MISC + 8);
#define IN(k) (lo <= (k) && (k) < hi)
#define SEAM(k) do { if (IN(k) && IN((k) + 1)) xcd_barrier(bar); } while (0)
#ifndef DUP_MASK
#define DUP_MASK 0
#endif
#define NREP(ty) (((DUP_MASK >> (ty)) & 1) ? 2 : 1)
#define REPBAR(rep, ty) do { if ((rep) + 1 < NREP(ty) && multi) xcd_barrier(bar); } while (0)
    constexpr size_t DUPOFF = (size_t)774000128;
    for (int rep = 0; rep < NREP(0); ++rep) { if (IN(0)) ph_prologue(lds); REPBAR(rep, 0); }
    SEAM(0);
    for (int l = 0; l < DEPTH; ++l) {
        const int pb = 1 + 9 * l;
        for (int rep = 0; rep < NREP(1); ++rep) { if (IN(pb + 0)) ph_norm1(lds, l, rep ? DUPOFF : 0); REPBAR(rep, 1); }   SEAM(pb + 0);
        for (int rep = 0; rep < NREP(2); ++rep) { if (IN(pb + 1)) ph_inproj(lds, l); REPBAR(rep, 2); }  SEAM(pb + 1);
        for (int rep = 0; rep < NREP(3); ++rep) { if (IN(pb + 2)) ph_post(lds, l, rep ? DUPOFF : 0); REPBAR(rep, 3); }    SEAM(pb + 2);
        for (int rep = 0; rep < NREP(4); ++rep) { if (IN(pb + 3)) ph_mix(lds, l, rep); REPBAR(rep, 4); }     SEAM(pb + 3);
        for (int rep = 0; rep < NREP(5); ++rep) { if (IN(pb + 4)) ph_gla3(lds, l); REPBAR(rep, 5); }    SEAM(pb + 4);
        for (int rep = 0; rep < NREP(6); ++rep) { if (IN(pb + 5)) ph_outproj(lds, l, rep ? DUPOFF : 0); REPBAR(rep, 6); } SEAM(pb + 5);
        for (int rep = 0; rep < NREP(7); ++rep) { if (IN(pb + 6)) ph_norm2(lds, l, rep != 0); REPBAR(rep, 7); }   SEAM(pb + 6);
        for (int rep = 0; rep < NREP(8); ++rep) { if (IN(pb + 7)) ph_moeup(lds, l); REPBAR(rep, 8); }   SEAM(pb + 7);
        for (int rep = 0; rep < NREP(9); ++rep) { if (IN(pb + 8)) ph_moedown(lds, l); REPBAR(rep, 9); } SEAM(pb + 8);
    }
    if (IN(NPH - 1)) ph_final(lds);
#undef IN
#undef SEAM
}

extern "C" void kernel_launch(void* const* d_in, const int* in_sizes, int n_in, void* d_out, int out_size, void* d_ws, size_t ws_size, hipStream_t stream) {
    static int grid = 0;
    if (grid == 0) {
        if (n_in != 21 || out_size != NB * SEQ * DM || ws_size < (DUP_MASK ? (size_t)2147483648u : WS_END)) { fprintf(stderr, "kernel_launch: unexpected shapes (n_in %d out %d ws %zu need %zu)\n", n_in, out_size, ws_size, (size_t)WS_END); grid = -1; return; }
        int dev = 0, cus = 0, per_cu = 0;
        if (hipGetDevice(&dev) != hipSuccess || hipDeviceGetAttribute(&cus, hipDeviceAttributeMultiprocessorCount, dev) != hipSuccess) { grid = -1; return; }
        if (hipFuncSetAttribute((const void*)fwd_kernel, hipFuncAttributeMaxDynamicSharedMemorySize, LDS_BYTES) != hipSuccess) { fprintf(stderr, "kernel_launch: hipFuncSetAttribute failed\n"); grid = -1; return; }
        if (hipOccupancyMaxActiveBlocksPerMultiprocessor(&per_cu, (const void*)fwd_kernel, 512, LDS_BYTES) != hipSuccess || per_cu < 1) fprintf(stderr, "kernel_launch: occupancy query says %d\n", per_cu);
        (void)hipGetLastError();
        grid = cus;
    }
    if (grid < 0) return;
    (void)hipMemsetAsync((char*)d_ws + WS_CTL, 0, CTL_ZERO_BYTES, stream);
    Args a{};
    for (int i = 0; i < 21; ++i) a.in[i] = (const float*)d_in[i];
    a.out = (float*)d_out; a.ws = (unsigned char*)d_ws;
#if MK_N_LAUNCHES == 1
    a.ph_lo = 0; a.ph_hi = NPH;
    hipLaunchKernelGGL(fwd_kernel, dim3(grid), dim3(512), LDS_BYTES, stream, a);
#else
    for (int p = 0; p < NPH; ++p) { a.ph_lo = p; a.ph_hi = p + 1; hipLaunchKernelGGL(fwd_kernel, dim3(grid), dim3(512), LDS_BYTES, stream, a); }
#endif
}
```

```cpp
#include <hip/hip_runtime.h>
#include <cstdio>
#include <cstdint>

#ifndef MK_N_LAUNCHES
#define MK_N_LAUNCHES 1
#endif

#define GAS __attribute__((address_space(1)))
#define LAS __attribute__((address_space(3)))
typedef unsigned short bf16;
typedef unsigned u32x4 __attribute__((ext_vector_type(4)));
typedef unsigned u32x2 __attribute__((ext_vector_type(2)));
typedef float f32x4 __attribute__((ext_vector_type(4)));
typedef float f32x2 __attribute__((ext_vector_type(2)));
typedef float f32x16 __attribute__((ext_vector_type(16)));
typedef short bf16x8 __attribute__((ext_vector_type(8)));
typedef short s16x4 __attribute__((ext_vector_type(4)));
#define LDS_WAIT() asm volatile("s_waitcnt lgkmcnt(0)" ::: "memory")
#define VM_WAIT() asm volatile("s_waitcnt vmcnt(0)" ::: "memory")

constexpr int NB = 4, SEQ = 4096, NMETA = 16, TT = SEQ + NMETA;
constexpr int PADF = 48, TP = 4160;
constexpr int R = NB * TP;
constexpr int DM = 2048, DEPTH = 4;
constexpr int DIN = 5990, DINP = 6144;
constexpr int NEXP = 32, DEXP = 512;
constexpr float EPS = 1e-6f;
constexpr int C_AQ = 0, C_AK = 768, C_AV = 896, C_IQ = 1024, C_BQ = 2048, C_BK = 2816, C_BV = 3584, C_CQ = 4352, C_CK = 4608, C_CV = 4864, C_CG = 5376, C_IK = 5888;
constexpr int S_IK = 0, S_IW = 64, S_BF = 80, S_CR = 86;

constexpr size_t al256(size_t x) { return (x + 255) & ~(size_t)255; }
constexpr size_t WS_CTL = 0, CTL_ZERO_BYTES = 1u << 20;
constexpr size_t WS_COS128 = WS_CTL + CTL_ZERO_BYTES;
constexpr size_t WS_SIN128 = WS_COS128 + al256((size_t)TT * 64 * 4);
constexpr size_t WS_COS64 = WS_SIN128 + al256((size_t)TT * 64 * 4);
constexpr size_t WS_SIN64 = WS_COS64 + al256((size_t)TT * 32 * 4);
constexpr size_t WS_WIN = WS_SIN64 + al256((size_t)TT * 32 * 4);
constexpr size_t SZ_WIN = (size_t)DINP * DM * 2;
constexpr size_t WS_WOUT = WS_WIN + DEPTH * SZ_WIN;
constexpr size_t SZ_WOUT = (size_t)DM * DM * 2;
constexpr size_t WS_W13 = WS_WOUT + DEPTH * SZ_WOUT;
constexpr size_t SZ_W13E = (size_t)1024 * DM * 2, SZ_W13 = NEXP * SZ_W13E;
constexpr size_t WS_W2 = WS_W13 + DEPTH * SZ_W13;
constexpr size_t SZ_W2E = (size_t)DM * DEXP * 2, SZ_W2 = NEXP * SZ_W2E;
constexpr size_t WS_WR = WS_W2 + DEPTH * SZ_W2;
constexpr size_t SZ_WR = (size_t)2 * 48 * DM * 2;
constexpr size_t WS_H = WS_WR + DEPTH * SZ_WR;
constexpr size_t WS_U = WS_H + (size_t)R * DM * 4;
constexpr size_t WS_Z = WS_U + (size_t)R * DM * 2;
constexpr size_t WS_ZS = WS_Z + (size_t)R * DINP * 2;
constexpr size_t WS_LA = WS_ZS + (size_t)R * 256 * 4;
constexpr size_t WS_MIX = WS_LA + (size_t)R * 256 * 4;
constexpr int HID_TILES = 168;
constexpr size_t WS_HID = WS_MIX + (size_t)R * DM * 2;
constexpr size_t WS_Y0 = WS_HID + (size_t)HID_TILES * 256 * DEXP * 2;
constexpr size_t WS_Y1 = WS_Y0 + (size_t)R * DM * 2;
constexpr size_t WS_KV = WS_Y1 + (size_t)R * DM * 2;
constexpr size_t WS_DVEC = WS_KV + (size_t)16 * 65 * 64 * 128 * 4;
constexpr size_t WS_SS = WS_DVEC + al256((size_t)16 * 65 * 64 * 4);
constexpr size_t WS_LIST = WS_SS + (size_t)16 * 66 * 64 * 128 * 4;
constexpr size_t WS_GATE = WS_LIST + (size_t)NEXP * R * 4;
constexpr size_t WS_IKC = WS_GATE + (size_t)R * 2 * 4;
constexpr size_t WS_KAC = WS_IKC + (size_t)R * 64 * 2;
constexpr size_t WS_VAC = WS_KAC + (size_t)R * 128 * 2;
constexpr size_t WS_END = WS_VAC + (size_t)R * 128 * 2;

constexpr int CW_BAR = 4096;
constexpr int CW_CNT = 16384;
constexpr int CW_QUEUE = 20480;

constexpr int RING_BYTES = 131072;
constexpr int MOETAB_OFF = 131072;
constexpr int LDSCTL_OFF = 143360, MISC_OFF = LDSCTL_OFF + 320;
constexpr int LDS_BYTES = 147456;

constexpr int WAVETAB_OFF = LDSCTL_OFF + 1536;
__device__ __forceinline__ int get_tid() {
    const unsigned slot = (unsigned)__builtin_amdgcn_s_getreg((5 << 11) | 4) & 63u;
    const unsigned w = *(volatile LAS unsigned*)(uintptr_t)(WAVETAB_OFF + 4 * slot);
    unsigned lane; asm volatile("v_mbcnt_lo_u32_b32 %0, -1, 0\n\tv_mbcnt_hi_u32_b32 %0, -1, %0" : "=v"(lane));
    return (int)((unsigned)__builtin_amdgcn_readfirstlane(w) * 64u + lane);
}
typedef __bf16 bf16x2_t __attribute__((ext_vector_type(2)));
__device__ __forceinline__ unsigned cvtpk(float lo, float hi) { const bf16x2_t v = __builtin_convertvector((f32x2){lo, hi}, bf16x2_t); return __builtin_bit_cast(unsigned, v); }
__device__ __forceinline__ float bf2f(unsigned short b) { return __uint_as_float(((unsigned)b) << 16); }
__device__ __forceinline__ float bflo(unsigned w) { return __uint_as_float(w << 16); }
__device__ __forceinline__ float bfhi(unsigned w) { return __uint_as_float(w & 0xffff0000u); }
__device__ __forceinline__ bf16 f2bf(float f) { return (bf16)(cvtpk(f, 0.f) & 0xffffu); }
__device__ __forceinline__ float wave_sum(float v) {
#pragma unroll
    for (int o = 1; o < 64; o <<= 1) v += __shfl_xor(v, o);
    return v;
}
__device__ __forceinline__ f32x4 zero4() { float z = 0.f; asm volatile("" : "+v"(z)); return (f32x4){z, z, z, z}; }
__device__ __forceinline__ float logsigmoidf(float x) { const float e = __builtin_amdgcn_exp2f(-fabsf(x) * 1.4426950408889634f); return fminf(x, 0.f) - __builtin_amdgcn_logf(1.0f + e) * 0.6931471805599453f; }
__device__ __forceinline__ float fexp_(float x) { return __builtin_amdgcn_exp2f(x * 1.4426950408889634f); }
__device__ __forceinline__ float rsqrt_(float x) { return __builtin_amdgcn_rsqf(x); }
__device__ __forceinline__ float siluf(float x) { return x * __builtin_amdgcn_rcpf(1.f + __builtin_amdgcn_exp2f(-x * 1.4426950408889634f)); }

#define XB_TMO      128
#define XB_XCNT(j)  (256  + 64 * (j))
#define XB_XSUB(j)  (1280 + 64 * (j))
#define XB_XGEN(j)  (2304 + 64 * (j))
#define XB_TOP      3328
#define XB_TOPGEN   3392
#define XCD_BAR_WORDS 3456
#define XB_SPIN_CAP (1u << 18)
__device__ __forceinline__ unsigned xb_ld(unsigned* p)              { return __hip_atomic_load(p, __ATOMIC_RELAXED, __HIP_MEMORY_SCOPE_AGENT); }
__device__ __forceinline__ unsigned xb_add(unsigned* p, unsigned v) { return __hip_atomic_fetch_add(p, v, __ATOMIC_RELAXED, __HIP_MEMORY_SCOPE_AGENT); }
__device__ __forceinline__ unsigned xb_xcc_id() { return (unsigned)__builtin_amdgcn_s_getreg((3 << 11) | 20) & 0xFu; }
#define XB_SPIN(cond, bar) do { unsigned _sp = 0; while (cond) { __builtin_amdgcn_s_sleep(1); \
    if ((++_sp & 255u) == 0u) { if (xb_ld(&(bar)[XB_TMO])) break; if (_sp > XB_SPIN_CAP) { atomicAdd(&(bar)[XB_TMO], 1u); break; } } } } while (0)
struct XcdBarrier { unsigned* bar; unsigned x; volatile LAS unsigned* st; };
__device__ __forceinline__ XcdBarrier xcd_barrier_post(unsigned* bar, volatile LAS unsigned* st) {
    XcdBarrier b; b.bar = bar; b.x = xb_xcc_id(); b.st = st;
    if (get_tid() == 0) (void)xb_add(&bar[XB_XCNT(b.x)], 1u);
    return b;
}
__device__ __forceinline__ void xcd_barrier_complete(unsigned* bar, unsigned x, unsigned& nloc, unsigned& nx) {
    const unsigned G = gridDim.x * gridDim.y * gridDim.z;
    unsigned sum, cnt, mine, sp = 0u;
    for (;;) {
        sum = 0u; cnt = 0u; mine = 0u;
#pragma unroll
        for (unsigned j = 0; j < 16; ++j) { const unsigned c = xb_ld(&bar[XB_XCNT(j)]); sum += c; cnt += (c > 0u) ? 1u : 0u; mine = (j == x) ? c : mine; }
        if (sum == G) break;
        __builtin_amdgcn_s_sleep(1);
        if ((++sp & 255u) == 0u) { if (xb_ld(&bar[XB_TMO])) break; if (sp > XB_SPIN_CAP) { atomicAdd(&bar[XB_TMO], 1u); break; } }
    }
    nloc = mine > 0u ? mine : 1u; nx = cnt > 0u ? cnt : 1u;
}
__device__ __forceinline__ void xcd_barrier(const XcdBarrier& b) {
    asm volatile("s_waitcnt vmcnt(0)" ::: "memory");
    __syncthreads();
    if (get_tid() == 0) {
        unsigned* bar = b.bar; unsigned bx = b.x;
        asm volatile("" : "+s"(bar), "+s"(bx));
        __builtin_amdgcn_s_waitcnt(0);
        unsigned nloc = b.st[0], nx = b.st[1];
        if (nloc == 0u) { xcd_barrier_complete(bar, bx, nloc, nx); b.st[0] = nloc; b.st[1] = nx; }
        const unsigned old = xb_add(&bar[XB_XSUB(bx)], 1u);
        const unsigned gen = old / nloc;
        if (old + 1u == (gen + 1u) * nloc) {
            __builtin_amdgcn_fence(__ATOMIC_RELEASE, "agent");
            asm volatile("s_waitcnt vmcnt(0)" ::: "memory");
            const unsigned og = xb_add(&bar[XB_TOP], 1u);
            const unsigned tg = og / nx;
            if (og + 1u == (tg + 1u) * nx) xb_add(&bar[XB_TOPGEN], 1u);
            else XB_SPIN(xb_ld(&bar[XB_TOPGEN]) == tg, bar);
            __builtin_amdgcn_fence(__ATOMIC_ACQUIRE, "agent");
            xb_add(&bar[XB_XGEN(bx)], 1u);
            asm volatile("s_waitcnt vmcnt(0)" ::: "memory");
        } else {
            XB_SPIN(xb_ld(&bar[XB_XGEN(bx)]) == gen, bar);
            __builtin_amdgcn_fence(__ATOMIC_ACQUIRE, "agent");
            asm volatile("s_waitcnt vmcnt(0)" ::: "memory");
        }
    }
    __syncthreads();
}

namespace pg8 {
constexpr int BM = 256, BK = 64, HALF = 128, HTB = HALF * BK * 2, STAGE_BYTES = 8 * HTB;
__host__ __device__ __forceinline__ int lds_byte(int r, int c) { const int st = (r >> 4) * 2 + (c >> 5), rr = r & 15, cc = c & 31, ob = rr * 64 + cc * 2; return st * 1024 + (ob ^ (((ob >> 9) & 1) << 5)); }
__host__ __device__ __forceinline__ void stage_rc(int b, int& Rr, int& C) { const int st = b / 1024, sb = b % 1024, swz = sb ^ (((sb >> 9) & 1) << 5); Rr = (st >> 1) * 16 + swz / 64; C = (st & 1) * 32 + (swz % 64) / 2; }
__host__ __device__ __forceinline__ int perm32(int rho) { const int n = rho >> 4, i = rho & 15; return 8 * (i >> 2) + 4 * n + (i & 3); }
struct Unit { int pm, pn, e, r0; };

template <class Epi, class Prob>
__device__ __forceinline__ void gemm_phase(LAS unsigned char* lds, const Prob& P, const Epi& E) {
    int tid = get_tid();
    const int wid = __builtin_amdgcn_readfirstlane(tid >> 6), lane = tid & 63, wr = wid >> 2, wc = wid & 3, fr = lane & 15, fq = lane >> 4;
    const int K = P.K, nt = K / BK;
    unsigned voffB;
    { int Rr, C; stage_rc(tid * 16, Rr, C); const int Rb = Epi::PERM ? ((Rr & ~31) + perm32(Rr & 31)) : Rr; voffB = (unsigned)(Rb * K + C) * 2u; }
    const size_t hstep = (size_t)HALF * K * 2, qstepB = (size_t)64 * K * 2;
    const unsigned ldsw = (unsigned)wid * 1024u;
    const int aoff = lds_byte(wr * 64 + fr, fq * 8), boff = lds_byte(wc * 32 + fr, fq * 8);
#define PG8_SA(b, h) (((b) * 2 + (h)) * HTB)
#define PG8_SB(b, h) ((4 + (b) * 2 + (h)) * HTB)
#define PG8_STAGE1(bufoff, gbase, voff, qstep) do { _Pragma("unroll") for (int _i = 0; _i < 2; ++_i) \
        __builtin_amdgcn_global_load_lds((const unsigned*)((const char*)(gbase) + (size_t)_i * (qstep) + (voff)), (LAS unsigned*)(lds + (bufoff) + ldsw + _i * 8192), 16, 0, 0); } while (0)
#define PG8_STAGE2(bufoff, gbase, voff) do { _Pragma("unroll") for (int _i = 0; _i < 2; ++_i) \
        __builtin_amdgcn_global_load_lds((const unsigned*)((const char*)(gbase) + (voff)[_i]), (LAS unsigned*)(lds + (bufoff) + ldsw + _i * 8192), 16, 0, 0); } while (0)
#define PG8_STB(bufoff, gbase) PG8_STAGE1(bufoff, gbase, voffB, qstepB)
#define PG8_STA(bufoff, gbase, h) do { if constexpr (GA) PG8_STAGE2(bufoff, gbase, ao[h]); else PG8_STAGE1(bufoff, (gbase) + (size_t)(h) * hstepA, ao[0][0], qstepA); } while (0)
#define PG8_LDA(dst, b, h) do { _Pragma("unroll") for (int m = 0; m < 4; ++m) _Pragma("unroll") for (int k = 0; k < 2; ++k) dst[m][k] = *(const LAS bf16x8*)(lds + PG8_SA(b, h) + aoff + m * 2048 + k * 1024); } while (0)
#define PG8_LDB(dst, b, h) do { _Pragma("unroll") for (int n = 0; n < 2; ++n) _Pragma("unroll") for (int k = 0; k < 2; ++k) dst[n][k] = *(const LAS bf16x8*)(lds + PG8_SB(b, h) + boff + n * 2048 + k * 1024); } while (0)
#define PG8_MMA(ai, bj, At, Bt) do { __builtin_amdgcn_s_setprio(1); _Pragma("unroll") for (int m = 0; m < 4; ++m) _Pragma("unroll") for (int n = 0; n < 2; ++n) _Pragma("unroll") for (int k = 0; k < 2; ++k) \
        acc[ai][bj][m][n] = __builtin_amdgcn_mfma_f32_16x16x32_bf16(Bt[n][k], At[m][k], acc[ai][bj][m][n], 0, 0, 0); __builtin_amdgcn_s_setprio(0); } while (0)
#define PG8_WAIT_V(n) asm volatile("s_waitcnt vmcnt(" #n ")" ::: "memory")
#define PG8_WAIT_L(n) asm volatile("s_waitcnt lgkmcnt(" #n ")" ::: "memory")
#define PG8_BAR __builtin_amdgcn_s_barrier()
#define PG8_SCHED __builtin_amdgcn_sched_barrier(0)
    Unit cur, nxt; int ui = 0;
    if (!P.next(0, cur)) return;
    constexpr bool GA = Prob::GATHER;
    unsigned ao[2][2]; const size_t hstepA = (size_t)HALF * P.lda * 2, qstepA = (size_t)64 * P.lda * 2;
    const char* cA = P.abase();
    if constexpr (GA) P.aoffs(cur, tid, ao);
    else { ao[0][0] = P.aoffs0(tid); cA += P.aunit(cur); }
    const char* cB = P.bptr(cur);
    const size_t kstep = (size_t)(BK * 2);
    PG8_STB(PG8_SB(0, 0), cB); PG8_STB(PG8_SB(0, 1), cB + hstep); PG8_STA(PG8_SA(0, 0), cA, 0); PG8_STA(PG8_SA(0, 1), cA, 1);
    if (wr == 1) PG8_BAR;
    PG8_WAIT_V(2); PG8_BAR;
    PG8_STB(PG8_SB(1, 0), cB + kstep); PG8_STA(PG8_SA(1, 0), cA + kstep, 0); PG8_STB(PG8_SB(1, 1), cB + hstep + kstep);
    PG8_WAIT_V(6); PG8_BAR;
    f32x4 acc[2][2][4][2];
#pragma unroll
    for (int a = 0; a < 2; ++a)
#pragma unroll
        for (int b = 0; b < 2; ++b)
#pragma unroll
            for (int m = 0; m < 4; ++m)
#pragma unroll
                for (int n = 0; n < 2; ++n) acc[a][b][m][n] = zero4();
    bf16x8 At[4][2], B0[2][2], B1[2][2];
    for (;;) {
        const bool has_next = P.next(ui + 1, nxt);
        const char* nB = has_next ? P.bptr(nxt) : cB;
        const char* nA = (has_next && !GA) ? P.abase() + P.aunit(nxt) : cA;
        for (int t = 0; t < nt; t += 2) {
            const bool last = (t == nt - 2);
            const char* a1 = cA + (size_t)(t + 1) * kstep;
            const char* a2 = last ? nA : cA + (size_t)(t + 2) * kstep; const char* b2 = last ? nB : cB + (size_t)(t + 2) * kstep;
            const char* a3 = a2 + kstep; const char* b3 = b2 + kstep;
            PG8_LDB(B0, 0, 0); PG8_LDB(B1, 0, 1); PG8_SCHED; PG8_LDA(At, 0, 0); PG8_STA(PG8_SA(1, 1), a1, 1);
            if constexpr (GA) { if (last && has_next) P.aoffs(nxt, tid, ao); }
            PG8_WAIT_V(8); PG8_WAIT_L(0); PG8_BAR; PG8_MMA(0, 0, At, B0); PG8_MMA(0, 1, At, B1); PG8_BAR; PG8_SCHED;
            PG8_LDA(At, 0, 1); PG8_STB(PG8_SB(0, 0), b2); PG8_STB(PG8_SB(0, 1), b2 + hstep); PG8_STA(PG8_SA(0, 0), a2, 0);
            PG8_WAIT_V(8); PG8_WAIT_L(0); PG8_BAR; PG8_MMA(1, 0, At, B0); PG8_MMA(1, 1, At, B1); PG8_BAR; PG8_SCHED;
            PG8_LDB(B0, 1, 0); PG8_LDB(B1, 1, 1); PG8_SCHED; PG8_LDA(At, 1, 0); PG8_STA(PG8_SA(0, 1), a2, 1);
            PG8_WAIT_V(8); PG8_WAIT_L(0); PG8_BAR; PG8_MMA(0, 0, At, B0); PG8_MMA(0, 1, At, B1); PG8_BAR; PG8_SCHED;
            PG8_LDA(At, 1, 1); PG8_STB(PG8_SB(1, 0), b3); PG8_STB(PG8_SB(1, 1), b3 + hstep); PG8_STA(PG8_SA(1, 0), a3, 0);
            PG8_WAIT_V(8); PG8_WAIT_L(0); PG8_BAR; PG8_MMA(1, 0, At, B0); PG8_MMA(1, 1, At, B1); PG8_BAR; PG8_SCHED;
        }
        if (wr == 0) PG8_BAR;
        { const int tz = get_tid(); const int wz = tz >> 6, lz = tz & 63; E(acc, cur, wz >> 2, wz & 3, lz & 15, lz >> 4); }
        if (!has_next) break;
#pragma unroll
        for (int a = 0; a < 2; ++a)
#pragma unroll
            for (int b = 0; b < 2; ++b)
#pragma unroll
                for (int m = 0; m < 4; ++m)
#pragma unroll
                    for (int n = 0; n < 2; ++n) acc[a][b][m][n] = zero4();
        cur = nxt; cB = nB; cA = nA; ++ui;
        if (wr == 1) PG8_BAR;
    }
    PG8_WAIT_V(0);
    PG8_BAR;
#undef PG8_SA
#undef PG8_STAGE1
#undef PG8_STAGE2
#undef PG8_STB
#undef PG8_STA
#undef PG8_SB
#undef PG8_LDA
#undef PG8_LDB
#undef PG8_MMA
#undef PG8_WAIT_V
#undef PG8_WAIT_L
#undef PG8_BAR
#undef PG8_SCHED
}

__host__ __device__ __forceinline__ int mrow(int pm) { return (pm >> 4) * TP + 64 + (pm & 15) * 256; }
struct DenseProb {
    int K; const char* A; const char* Bt; int nM, nN, nwg, G, c;
    __device__ __forceinline__ void init(const void* A_, const void* Bt_, int M, int N, int K_, int G_, int c_) { A = (const char*)A_; Bt = (const char*)Bt_; K = K_; lda = K_; nM = M / BM; nN = N / BM; nwg = nM * nN; G = G_; c = c_; }
    __device__ __forceinline__ bool next(int i, Unit& u) const {
        const int L = i * G + c; if (L >= nwg) return false;
        int wgid = L; { const int q = nwg / 8, r = nwg % 8, xcd = wgid % 8, off = wgid / 8; wgid = (xcd < r ? xcd * (q + 1) : r * (q + 1) + (xcd - r) * q) + off; }
        const int nig = 8 * nN, gid = wgid / nig, fm = gid * 8, gsz = (nM - fm) < 8 ? (nM - fm) : 8;
        u.pm = fm + ((wgid % nig) % gsz); u.pn = (wgid % nig) / gsz; u.e = 0; u.r0 = 0; return true;
    }
    static constexpr bool GATHER = false; int lda;
    __device__ __forceinline__ const char* abase() const { return A; }
    __device__ __forceinline__ size_t aunit(const Unit& u) const { return (size_t)mrow(u.pm) * K * 2; }
    __device__ __forceinline__ unsigned aoffs0(int tid) const { int Rr, C; stage_rc(tid * 16, Rr, C); return (unsigned)(Rr * K + C) * 2u; }
    __device__ __forceinline__ void aoffs(const Unit&, int, unsigned (&)[2][2]) const {}
    __device__ __forceinline__ const char* bptr(const Unit& u) const { return Bt + (size_t)u.pn * BM * K * 2; }
};
struct MoeTab { int e[176]; int r0[176]; int cnt[32]; int ntiles; };
template <bool UP> struct MoeProb {
    int K; const char* A; const char* W; const unsigned* list; const LAS MoeTab* tab; int G, c;
    __device__ __forceinline__ bool next(int i, Unit& u) const {
        constexpr int NPN = UP ? 4 : 8;
        const int L = i * G + c; if (L >= __builtin_amdgcn_readfirstlane(tab->ntiles) * NPN) return false;
        const int tile = L / NPN; u.pm = tile; u.pn = L % NPN; u.e = __builtin_amdgcn_readfirstlane(tab->e[tile]); u.r0 = __builtin_amdgcn_readfirstlane(tab->r0[tile]); return true;
    }
    static constexpr bool GATHER = UP; int lda;
    __device__ __forceinline__ const char* abase() const { return A; }
    __device__ __forceinline__ size_t aunit(const Unit& u) const { return (size_t)u.pm * BM * DEXP * 2; }
    __device__ __forceinline__ unsigned aoffs0(int tid) const { int Rr, C; stage_rc(tid * 16, Rr, C); return (unsigned)(Rr * DEXP + C) * 2u; }
    __device__ __forceinline__ void aoffs(const Unit& u, int tid_, unsigned (&o)[2][2]) const {
        int tid = get_tid(); (void)tid_;
        const int n = __builtin_amdgcn_readfirstlane(tab->cnt[u.e]);
#pragma unroll
        for (int i = 0; i < 2; ++i) { int Rr, C; stage_rc(tid * 16 + i * 8192, Rr, C);
#pragma unroll
            for (int h = 0; h < 2; ++h) { const int li = u.r0 + h * HALF + Rr;
                const unsigned row = (li < n) ? (list[(size_t)u.e * R + li] >> 1) : (unsigned)PADF;
                o[h][i] = (row * (unsigned)DM + (unsigned)C) * 2u; } }
    }
    __device__ __forceinline__ const char* bptr(const Unit& u) const { return W + (size_t)u.e * (UP ? SZ_W13E : SZ_W2E) + (size_t)u.pn * BM * K * 2; }
};

struct EpiInProj {
    static constexpr bool PERM = true;
    bf16* Z; float* ZS;
    __device__ __forceinline__ void operator()(const f32x4 (&acc)[2][2][4][2], const Unit& u, int wr, int wc, int fr, int fq) const {
        const int row0 = mrow(u.pm) + wr * 64 + fr;
        if (u.pn < 23) {
            const int col0 = u.pn * BM + wc * 32 + 8 * fq;
#pragma unroll
            for (int ai = 0; ai < 2; ++ai)
#pragma unroll
                for (int m = 0; m < 4; ++m) { bf16* rowp = Z + (size_t)(row0 + ai * HALF + m * 16) * DINP + col0;
#pragma unroll
                    for (int bj = 0; bj < 2; ++bj) { const f32x4 v0 = acc[ai][bj][m][0], v1 = acc[ai][bj][m][1];
                        u32x4 w; w.x = cvtpk(v0[0], v0[1]); w.y = cvtpk(v0[2], v0[3]); w.z = cvtpk(v1[0], v1[1]); w.w = cvtpk(v1[2], v1[3]);
                        *(u32x4*)(rowp + bj * HALF) = w; } }
        } else {
            const int col0 = wc * 32 + 8 * fq;
#pragma unroll
            for (int ai = 0; ai < 2; ++ai)
#pragma unroll
                for (int m = 0; m < 4; ++m) { float* rowp = ZS + (size_t)(row0 + ai * HALF + m * 16) * 256 + col0;
#pragma unroll
                    for (int bj = 0; bj < 2; ++bj) { *(f32x4*)(rowp + bj * HALF) = acc[ai][bj][m][0]; *(f32x4*)(rowp + bj * HALF + 4) = acc[ai][bj][m][1]; } }
        }
    }
};
struct EpiOutProj {
    static constexpr bool PERM = false;
    float* H;
    __device__ __forceinline__ void operator()(const f32x4 (&acc)[2][2][4][2], const Unit& u, int wr, int wc, int fr, int fq) const {
        const int row0 = mrow(u.pm) + wr * 64 + fr, col0 = u.pn * BM + wc * 32 + 4 * fq;
#pragma unroll
        for (int ai = 0; ai < 2; ++ai) { float* base = H + (size_t)(row0 + ai * HALF) * DM + col0;
            f32x4 hv[4][2][2];
#pragma unroll
            for (int m = 0; m < 4; ++m)
#pragma unroll
                for (int bj = 0; bj < 2; ++bj)
#pragma unroll
                    for (int n = 0; n < 2; ++n) hv[m][bj][n] = *(const f32x4*)(base + (size_t)(m * 16) * DM + bj * HALF + n * 16);
#pragma unroll
            for (int m = 0; m < 4; ++m)
#pragma unroll
                for (int bj = 0; bj < 2; ++bj)
#pragma unroll
                    for (int n = 0; n < 2; ++n) *(f32x4*)(base + (size_t)(m * 16) * DM + bj * HALF + n * 16) = hv[m][bj][n] + acc[ai][bj][m][n];
            asm volatile("" ::: "memory"); }
    }
};
struct EpiMoeUp {
    static constexpr bool PERM = true;
    bf16* HID;
    __device__ __forceinline__ void operator()(const f32x4 (&acc)[2][2][4][2], const Unit& u, int wr, int wc, int fr, int fq) const {
        const int row0 = u.pm * BM + wr * 64 + fr, col0 = (u.pn * BM + wc * 32 + 8 * fq) >> 1;
#pragma unroll
        for (int ai = 0; ai < 2; ++ai)
#pragma unroll
            for (int m = 0; m < 4; ++m) { bf16* rowp = HID + (size_t)(row0 + ai * HALF + m * 16) * DEXP + col0;
#pragma unroll
                for (int bj = 0; bj < 2; ++bj) { const f32x4 a = acc[ai][bj][m][0], b = acc[ai][bj][m][1];
                    u32x2 w; w.x = cvtpk(siluf(a[0]) * b[0], siluf(a[1]) * b[1]); w.y = cvtpk(siluf(a[2]) * b[2], siluf(a[3]) * b[3]);
                    *(u32x2*)(rowp + bj * (HALF / 2)) = w; }
                asm volatile("" ::: "memory"); }
    }
};
struct EpiMoeDown {
    static constexpr bool PERM = true;
    bf16* Y0; bf16* Y1; const unsigned* list; const float* gate; const LAS MoeTab* tab;
    __device__ __forceinline__ void operator()(const f32x4 (&acc)[2][2][4][2], const Unit& u, int wr, int wc, int fr, int fq) const {
        const int n = __builtin_amdgcn_readfirstlane(tab->cnt[u.e]); const int col0 = u.pn * BM + wc * 32 + 8 * fq;
#pragma unroll
        for (int ai = 0; ai < 2; ++ai)
#pragma unroll
            for (int m = 0; m < 4; ++m) { const int li = u.r0 + ai * HALF + wr * 64 + m * 16 + fr;
                if (li < n) { const unsigned ent = list[(size_t)u.e * R + li]; const float g = gate[ent];
                    bf16* rowp = Y0 + (size_t)(ent & 1u) * ((size_t)R * DM) + (size_t)(ent >> 1) * DM + col0;
#pragma unroll
                    for (int bj = 0; bj < 2; ++bj) { const f32x4 v0 = acc[ai][bj][m][0] * g, v1 = acc[ai][bj][m][1] * g;
                        u32x4 w; w.x = cvtpk(v0[0], v0[1]); w.y = cvtpk(v0[2], v0[3]); w.z = cvtpk(v1[0], v1[1]); w.w = cvtpk(v1[2], v1[3]);
                        *(u32x4*)(rowp + bj * HALF) = w; } } }
    }
};
}

template <int MODE>
__device__ __forceinline__ void skinny_gemm(LAS unsigned char* lds, const bf16* A, const bf16* Bt, int K, int N, int bid, bf16* Zo, float* ZSo, float* Ho) {
    const int tid = get_tid(), lane = tid & 63, wave = __builtin_amdgcn_readfirstlane(tid >> 6), g = lane >> 4, c16 = lane & 15;
    if (bid >= N / 32) return;
    const int ksw = K / 32 / 8;
    f32x4 acc[4][2];
#pragma unroll
    for (int rt = 0; rt < 4; ++rt) { acc[rt][0] = zero4(); acc[rt][1] = zero4(); }
    const bf16* ap = A + (size_t)(PADF + c16) * K + 8 * g; const bf16* bp = Bt + (size_t)(32 * bid + c16) * K + 8 * g;
#pragma unroll 2
    for (int kk = 0; kk < ksw; ++kk) { const int ks = wave * ksw + kk;
        bf16x8 a[4], b[2];
#pragma unroll
        for (int rt = 0; rt < 4; ++rt) a[rt] = *(const bf16x8*)(ap + (size_t)rt * TP * K + 32 * ks);
#pragma unroll
        for (int ct = 0; ct < 2; ++ct) b[ct] = *(const bf16x8*)(bp + (size_t)(16 * ct) * K + 32 * ks);
#pragma unroll
        for (int rt = 0; rt < 4; ++rt)
#pragma unroll
            for (int ct = 0; ct < 2; ++ct) acc[rt][ct] = __builtin_amdgcn_mfma_f32_16x16x32_bf16(a[rt], b[ct], acc[rt][ct], 0, 0, 0); }
    LAS float* red = (LAS float*)lds;
#pragma unroll
    for (int rt = 0; rt < 4; ++rt)
#pragma unroll
        for (int ct = 0; ct < 2; ++ct)
#pragma unroll
            for (int r = 0; r < 4; ++r) red[wave * 2048 + (16 * rt + 4 * g + r) * 32 + 16 * ct + c16] = acc[rt][ct][r];
    __syncthreads();
    { const int rr = tid >> 3, c4 = 4 * (tid & 7); f32x4 sum = *(LAS f32x4*)(red + rr * 32 + c4);
#pragma unroll
      for (int w = 1; w < 8; ++w) sum = sum + *(LAS f32x4*)(red + w * 2048 + rr * 32 + c4);
      const size_t row = (size_t)(rr >> 4) * TP + PADF + (rr & 15); const int col = 32 * bid + c4;
      if (MODE == 0) { if (col < C_IK) { u32x2 w2; w2.x = cvtpk(sum[0], sum[1]); w2.y = cvtpk(sum[2], sum[3]); *(u32x2*)(Zo + row * DINP + col) = w2; }
                       else *(f32x4*)(ZSo + row * 256 + (col - C_IK)) = sum; }
      else { float* hp = Ho + row * DM + col; *(f32x4*)hp = *(const f32x4*)hp + sum; } }
    __syncthreads();
}

namespace fox {
constexpr int D = 128, NW = 8, QBLK = 32, KVBLK = 64, QB = NW * QBLK;
constexpr int SHM_V = KVBLK * D * 2, SHM_K = KVBLK * D * 2;
constexpr int LDS_BODY = 2 * SHM_V + 2 * SHM_K + NW * 64 * 4;
constexpr int BIAS_OFF = LDS_BODY;
constexpr int SCAN_OFF = BIAS_OFF + TP * 4;
constexpr int LDQ = DINP, LDO = DM;
constexpr float SCALE = 0.08838834764831845f, THR = 8.f;
constexpr int WBIG = 1 << 28;
#define KSWZ(row, colB) ((row) * 256 + ((colB) ^ (((row) & 7) << 4)))
#define SBAR() __builtin_amdgcn_sched_barrier(0)
__device__ __forceinline__ int v_st(int k, int c) { const int kk = (k & ~0xC) | ((k & 4) << 1) | ((k & 8) >> 1); return ((kk >> 3) * 4 + (c >> 5)) * 512 + ((kk & 7) * 32 + (c & 31)) * 2; }
__device__ __forceinline__ int v_rd_base(int lane) { return ((lane & 3) << 3) | (((lane >> 2) & 3) << 6) | (((lane >> 4) & 1) << 5) | (((lane >> 5) & 1) << 8); }
constexpr int v_rd_off(int d0, int ks, int half) { return d0 * 512 + ks * 4096 + half * 2048; }
__device__ __forceinline__ int crow(int r, int hi) { return (r & 3) + 8 * (r >> 2) + 4 * hi; }
__device__ __forceinline__ bf16x8 load8(const bf16* p) { return *reinterpret_cast<const bf16x8*>(p); }
__device__ __forceinline__ void mask_tile(f32x16& p0, f32x16& p1, int dq, unsigned W) {
    const float NEG = -__builtin_inff();
#pragma unroll
    for (int r = 0; r < 16; ++r) {
        const int c = (r & 3) + 8 * (r >> 2);
        if ((unsigned)(dq - c) >= W) p0[r] = NEG;
        if ((unsigned)(dq - c - 32) >= W) p1[r] = NEG;
    }
}
__device__ __forceinline__ void partialSM(f32x16& p0, f32x16& p1, float& m_reg, float& mn, float& alpha) {
    float pmax = p0[0]; for (int r = 1; r < 16; ++r) pmax = fmaxf(pmax, p0[r]); for (int r = 0; r < 16; ++r) pmax = fmaxf(pmax, p1[r]);
    { auto rr = __builtin_amdgcn_permlane32_swap(__float_as_uint(pmax), __float_as_uint(pmax), false, false);
      pmax = fmaxf(__uint_as_float(rr[0]), __uint_as_float(rr[1])); }
    constexpr float C2 = 1.4426950408889634f * SCALE;
    if (__builtin_expect(__all((pmax - m_reg) * SCALE <= THR), 1)) { mn = m_reg; alpha = 1.f; }
    else { mn = fmaxf(m_reg, pmax); alpha = __builtin_amdgcn_exp2f((m_reg - mn) * C2); m_reg = mn; }
    const float mnL = -mn * C2;
    for (int r = 0; r < 16; ++r) p0[r] = fmaf(p0[r], C2, mnL); for (int r = 0; r < 16; ++r) p1[r] = fmaf(p1[r], C2, mnL);
    for (int r = 0; r < 16; ++r) p0[r] = __builtin_amdgcn_exp2f(p0[r]);
}
__device__ __forceinline__ void finishSM(f32x16& p0, f32x16& p1, float alpha, float& l_reg, bf16x8& pa0, bf16x8& pa1, bf16x8& pa2, bf16x8& pa3) {
    for (int r = 0; r < 16; ++r) p1[r] = __builtin_amdgcn_exp2f(p1[r]);
    float ps = 0; for (int r = 0; r < 16; ++r) ps += p0[r]; for (int r = 0; r < 16; ++r) ps += p1[r];
    { auto rr = __builtin_amdgcn_permlane32_swap(__float_as_uint(ps), __float_as_uint(ps), false, false);
      ps = __uint_as_float(rr[0]) + __uint_as_float(rr[1]); }
    l_reg = l_reg * alpha + ps;
#define PK4(P, B_, OUT) do { unsigned a0 = cvtpk(P[B_+0], P[B_+1]), a1 = cvtpk(P[B_+2], P[B_+3]);                          \
        unsigned b0 = cvtpk(P[B_+4], P[B_+5]), b1 = cvtpk(P[B_+6], P[B_+7]);                                             \
        auto r0 = __builtin_amdgcn_permlane32_swap(a0, b0, false, false); auto r1 = __builtin_amdgcn_permlane32_swap(a1, b1, false, false); \
        u32x4 w = {r0[0], r1[0], r0[1], r1[1]}; OUT = *reinterpret_cast<bf16x8*>(&w); } while (0)
    PK4(p0, 0, pa0); PK4(p0, 8, pa1); PK4(p1, 0, pa2); PK4(p1, 8, pa3);
#undef PK4
}
template <int KB>
__device__ __forceinline__ void qkt(f32x16& p0, f32x16& p1, const char* K_lds, const float* biask  , int r32, int hi, const bf16x8* qr) {
#pragma unroll
    for (int a = 0; a < 4; ++a) { const f32x4 b0 = *(const f32x4*)(biask + 8 * a), b1 = *(const f32x4*)(biask + 32 + 8 * a);
#pragma unroll
        for (int j = 0; j < 4; ++j) { p0[4 * a + j] = b0[j]; p1[4 * a + j] = b1[j]; } }
    const char* kb[4];
#pragma unroll
    for (int dd = 0; dd < 4; ++dd) kb[dd] = K_lds + KB * SHM_K + KSWZ(r32, (dd * 16 + hi * 8) * 2);
#pragma unroll
    for (int d0 = 0; d0 < 8; ++d0) { const char* a = kb[d0 & 3] + (d0 >> 2) * 128;
        bf16x8 b0 = *reinterpret_cast<const bf16x8*>(a);
        bf16x8 b1 = *reinterpret_cast<const bf16x8*>(a + 32 * 256);
        p0 = __builtin_amdgcn_mfma_f32_32x32x16_bf16(b0, qr[d0], p0, 0, 0, 0);
        p1 = __builtin_amdgcn_mfma_f32_32x32x16_bf16(b1, qr[d0], p1, 0, 0, 0); }
}
template <int VB>
__device__ __forceinline__ void pv_tile(f32x16* o, int vb0, bf16x8 pa0, bf16x8 pa1, bf16x8 pa2, bf16x8 pa3) {
#define TRRD(dst, off) asm volatile("ds_read_b64_tr_b16 %0, %1 offset:%2" : "=&v"(dst) : "v"(vb0), "i"(off) : "memory")
#define PV_D0(d0) do { s16x4 l0, l1, l2, l3, h0, h1, h2, h3; constexpr int b_ = VB * SHM_V + v_rd_off(d0, 0, 0); \
        TRRD(l0, b_); TRRD(h0, b_ + 2048); TRRD(l1, b_ + 4096); TRRD(h1, b_ + 6144); TRRD(l2, b_ + 8192); TRRD(h2, b_ + 10240); TRRD(l3, b_ + 12288); TRRD(h3, b_ + 14336); \
        asm volatile("s_waitcnt lgkmcnt(0)" ::: "memory"); SBAR();   \
        o[d0] = __builtin_amdgcn_mfma_f32_32x32x16_bf16(pa0, (bf16x8){l0[0], l0[1], l0[2], l0[3], h0[0], h0[1], h0[2], h0[3]}, o[d0], 0, 0, 0);   \
        o[d0] = __builtin_amdgcn_mfma_f32_32x32x16_bf16(pa1, (bf16x8){l1[0], l1[1], l1[2], l1[3], h1[0], h1[1], h1[2], h1[3]}, o[d0], 0, 0, 0);   \
        o[d0] = __builtin_amdgcn_mfma_f32_32x32x16_bf16(pa2, (bf16x8){l2[0], l2[1], l2[2], l2[3], h2[0], h2[1], h2[2], h2[3]}, o[d0], 0, 0, 0);   \
        o[d0] = __builtin_amdgcn_mfma_f32_32x32x16_bf16(pa3, (bf16x8){l3[0], l3[1], l3[2], l3[3], h3[0], h3[1], h3[2], h3[3]}, o[d0], 0, 0, 0); } while (0)
    PV_D0(0); PV_D0(1); PV_D0(2); PV_D0(3);
#undef PV_D0
#undef TRRD
}
struct BlockRef { const bf16* Q; const bf16* K; const bf16* V; bf16* O; int P0; int jlo; };
struct Seam { bf16x8 qr[8]; bf16x8 st_v0, st_v1, st_k0, st_k1; };
#define ROW(p, k0, rr) ((p) + (unsigned)(((k0) + (rr)) * LDQ + sc))
#define VMW() asm volatile("s_waitcnt vmcnt(0)" ::: "memory")
#define VMWN(n) asm volatile("s_waitcnt vmcnt(%0)" :: "i"(n) : "memory")
#define SLOAD_H(Kp, Vp, k0) do { S.st_v0 = load8(ROW(Vp, k0, sr)); S.st_v1 = load8(ROW(Vp, k0, 32 + sr));              \
                         S.st_k0 = load8(ROW(Kp, k0, sr)); S.st_k1 = load8(ROW(Kp, k0, 32 + sr)); } while (0)
#define SWRITE_HK(bf) do { *(bf16x8*)(K_lds + (bf) * SHM_K + kws) = S.st_k0; *(bf16x8*)(K_lds + (bf) * SHM_K + kws + 32 * 256) = S.st_k1; } while (0)
#define SWRITE_HV(bf) do { *(bf16x8*)(V_lds + (bf) * SHM_V + vst0) = S.st_v0; *(bf16x8*)(V_lds + (bf) * SHM_V + vst1) = S.st_v1; } while (0)
#define SWRITE_H(bf) do { SWRITE_HV(bf); SWRITE_HK(bf); } while (0)
__device__ __forceinline__ void prime(const BlockRef& cur, char* lds, Seam& S) {
    int tid = get_tid();
    const int wid = __builtin_amdgcn_readfirstlane(tid >> 6), lane = tid & 63, r32 = lane & 31, hi = lane >> 5;
    const int sr = tid >> 4, sc = (tid & 15) * 8, kws = KSWZ(sr, sc * 2); char* K_lds = lds + 2 * SHM_V;
    const int kb0 = cur.jlo * KVBLK;
    for (int d0 = 0; d0 < 8; ++d0) S.qr[d0] = load8(cur.Q + (unsigned)((wid * QBLK + r32) * LDQ + d0 * 16 + hi * 8));
    SLOAD_H(cur.K, cur.V, kb0); VMW(); SWRITE_HK(0);
    __syncthreads();
}
__device__ __forceinline__ void block(const BlockRef& cur, const BlockRef& nxt, int skv, char* lds, Seam& S) {
    constexpr int W = WBIG;
    int tid = get_tid();
    const int wid = __builtin_amdgcn_readfirstlane(tid >> 6), lane = tid & 63, r32 = lane & 31, hi = lane >> 5;
    const int j_lo = cur.jlo;
    int j_hi = (cur.P0 + QB - 1) / KVBLK + 1; if (j_hi > skv / KVBLK) j_hi = skv / KVBLK;
    const int NT = j_hi - j_lo;
    const int kbn = nxt.jlo * KVBLK;
    const int qlo = cur.P0 + wid * QBLK, qm = qlo + r32 - 4 * hi;
    char* V_lds = lds; char* K_lds = lds + 2 * SHM_V;
    float* ws = (float*)(lds + 2 * SHM_V + 2 * SHM_K) + wid * 64; float* li_l = ws, * al_l = ws + 32;
    const float* biasb = (const float*)(lds + BIAS_OFF) + 4 * hi;
    float m_reg = -1e30f, l_reg = 0; f32x16 o[4] = {};
    const int sr = tid >> 4, sc = (tid & 15) * 8, vst0 = v_st(sr, sc), vst1 = v_st(32 + sr, sc), kws = KSWZ(sr, sc * 2);
    const int vb0 = (int)(uintptr_t)V_lds + v_rd_base(lane);
    const bf16* Kh = cur.K; const bf16* Vh = cur.V;
#define RESC(a) do { if (__any((a) < 1.f)) { if (hi == 0) al_l[r32] = (a); asm volatile("s_waitcnt lgkmcnt(0)" ::: "memory");              \
                     for (int d_ = 0; d_ < 4; ++d_) for (int r = 0; r < 16; ++r) o[d_][r] *= al_l[crow(r, hi)]; } } while (0)
#define KBASE(t) ((j_lo + (t)) * KVBLK)
#define MASKT(P0_, P1_, t) do { const int kb_ = KBASE(t); if (kb_ + KVBLK - 1 > qlo) mask_tile(P0_, P1_, qm - kb_, (unsigned)W); } while (0)
    constexpr int NQL = 8;
#define SEAM_K0() do { VMWN(NQL); SWRITE_HK(0); SBAR(); } while (0)
    f32x16 pA0, pA1, pB0, pB1; float mnA, mnB, alA, alB; bf16x8 pa0, pa1, pa2, pa3;
    SWRITE_HV(0); SBAR();
    if (NT > 1) { SLOAD_H(Kh, Vh, KBASE(1)); }
    SBAR(); qkt<0>(pA0, pA1, K_lds, biasb + KBASE(0), r32, hi, S.qr);
    MASKT(pA0, pA1, 0); partialSM(pA0, pA1, m_reg, mnA, alA);
    if (NT > 1) { VMW(); SWRITE_H(1); }
    __syncthreads();
#define HALF_STEP(PX0, PX1, mnX, alX, PY0, PY1, alY, t, KB, VB, SB) do {                                                      \
        SBAR(); qkt<KB>(PX0, PX1, K_lds, biasb + KBASE(t), r32, hi, S.qr);                                             \
        finishSM(PY0, PY1, alY, l_reg, pa0, pa1, pa2, pa3); SBAR();                                                           \
        if ((t) + 1 < NT) { SLOAD_H(Kh, Vh, KBASE((t) + 1)); SBAR(); }                                               \
        pv_tile<VB>(o, vb0, pa0, pa1, pa2, pa3); MASKT(PX0, PX1, (t)); partialSM(PX0, PX1, m_reg, mnX, alX);                                        \
        __syncthreads();                                                                                                      \
        if ((t) + 1 < NT) { VMW(); SWRITE_H(SB); }                                                                          \
        RESC(alX); __syncthreads(); } while (0)
    for (int t = 1; t + 1 < NT; t += 2) {
        HALF_STEP(pB0, pB1, mnB, alB, pA0, pA1, alA, t, 1, 0, 0);
        HALF_STEP(pA0, pA1, mnA, alA, pB0, pB1, alB, t + 1, 0, 1, 1);
    }
    const bool even = (NT & 1) == 0;
    if (even) { SBAR(); qkt<1>(pB0, pB1, K_lds, biasb + KBASE(NT - 1), r32, hi, S.qr); SBAR(); }
    SLOAD_H(nxt.K, nxt.V, kbn); SBAR();
#pragma unroll
    for (int d0 = 0; d0 < 8; ++d0) S.qr[d0] = load8(nxt.Q + (unsigned)((wid * QBLK + r32) * LDQ + d0 * 16 + hi * 8));
    SBAR();
    finishSM(pA0, pA1, alA, l_reg, pa0, pa1, pa2, pa3); SBAR();
    pv_tile<0>(o, vb0, pa0, pa1, pa2, pa3);
    if (even) { MASKT(pB0, pB1, NT - 1); partialSM(pB0, pB1, m_reg, mnB, alB); __syncthreads(); RESC(alB);
        finishSM(pB0, pB1, alB, l_reg, pa0, pa1, pa2, pa3); SBAR(); pv_tile<1>(o, vb0, pa0, pa1, pa2, pa3); }
    SBAR(); SEAM_K0();
    if (hi == 0) li_l[r32] = l_reg; asm volatile("s_waitcnt lgkmcnt(0)" ::: "memory");
    float rli[16];
#pragma unroll
    for (int r = 0; r < 16; ++r) rli[r] = __builtin_amdgcn_rcpf(li_l[crow(r, hi)]);
    bf16* Ow = cur.O + (unsigned)(wid * QBLK * LDO);
#pragma unroll
    for (int r = 0; r < 16; ++r) { const int orow = crow(r, hi);
#pragma unroll
        for (int d0 = 0; d0 < 4; ++d0) { const float v = o[d0][r] * rli[r];
            const float vn = __shfl_xor(v, 1);
            if ((r32 & 1) == 0) *(unsigned*)(Ow + (unsigned)(orow * LDO + d0 * 32 + r32)) = cvtpk(v, vn); } }
    __syncthreads();
#undef RESC
#undef KBASE
#undef MASKT
#undef SEAM_K0
#undef HALF_STEP
}
#undef ROW
#undef VMW
#undef VMWN
#undef SLOAD_H
#undef SWRITE_HK
#undef SWRITE_HV
#undef SWRITE_H

__device__ __forceinline__ void build_bias(char* lds, const float* zs_b  , int h) {
    int tid = get_tid();
    const int lane = tid & 63, wid = tid >> 6;
    float* bias = (float*)(lds + BIAS_OFF); float* wsum = (float*)(lds + SCAN_OFF);
    float loc[9]; float s = 0.f;
#pragma unroll
    for (int k = 0; k < 9; ++k) { const int t = tid * 9 + k; const float x = (t < TT) ? zs_b[(size_t)(PADF + t) * 256 + S_BF + h] : 0.f; s += x; loc[k] = s; }
    float incl = s;
#pragma unroll
    for (int o = 1; o < 64; o <<= 1) { const float y = __shfl_up(incl, o); if (lane >= o) incl += y; }
    if (lane == 63) wsum[wid] = incl;
    __syncthreads();
    float woff = 0.f;
    for (int w = 0; w < wid; ++w) woff += wsum[w];
    const float excl = woff + incl - s;
    constexpr float INVS = 1.0f / SCALE;
#pragma unroll
    for (int k = 0; k < 9; ++k) { const int t = tid * 9 + k; if (t < TT) bias[PADF + t] = -(excl + loc[k]) * INVS; }
    if (tid < PADF) bias[tid] = -__builtin_inff();
    __syncthreads();
}
__device__ __forceinline__ int prune_jlo(const char* lds, int q0v) {
    const float* bias = (const float*)(lds + BIAS_OFF);
    constexpr float PRUNE = 64.f;
    const float thr = bias[q0v] - PRUNE * (1.0f / SCALE);
    int j = 0; const int jmax = q0v / KVBLK;
    while (j < jmax && bias[KVBLK * j + KVBLK - 1] < thr) ++j;
    return j;
}
__device__ __forceinline__ void item(char* lds, const bf16* Z, const float* ZS, bf16* MIX, int it) {
    const int bh = it >> 3, x = it & 7, b = bh / 6, h = bh % 6;
    build_bias(lds, ZS + (size_t)b * TP * 256, h);
    const bf16* zb = Z + (size_t)b * TP * DINP;
    BlockRef b0, b1;
    b0.K = b1.K = zb + C_BK + h * 128; b0.V = b1.V = zb + C_BV + h * 128;
    const int q0 = 64 + 256 * x, q1 = 64 + 256 * (15 - x);
    b0.Q = zb + (size_t)q0 * DINP + C_BQ + h * 128; b1.Q = zb + (size_t)q1 * DINP + C_BQ + h * 128;
    b0.O = MIX + (size_t)(b * TP + q0) * DM + 768 + h * 128; b1.O = MIX + (size_t)(b * TP + q1) * DM + 768 + h * 128;
    b0.P0 = q0; b1.P0 = q1;
    b0.jlo = prune_jlo(lds, q0); b1.jlo = prune_jlo(lds, q1);
    Seam S;
    prime(b0, lds, S);
    block(b0, b1, TP, lds, S);
    block(b1, b1, TP, lds, S);
}
__device__ __forceinline__ void meta_unit(const bf16* Z, const float* ZS, bf16* MIX, int b) {
    int tid = get_tid();
    const int lane = tid & 63, wid = tid >> 6;
    for (int task = wid; task < 96; task += 8) {
        const int h = task >> 4, m = task & 15;
        const size_t rq = (size_t)b * TP + PADF + m;
        const unsigned qw = *(const unsigned*)(Z + rq * DINP + C_BQ + h * 128 + 2 * lane);
        const float q0 = bflo(qw), q1 = bfhi(qw);
        float lg[16]; float F = 0.f, Fk[16];
#pragma unroll
        for (int k = 0; k < 16; ++k) { F += ZS[((size_t)b * TP + PADF + k) * 256 + S_BF + h]; Fk[k] = F; }
        float Fm = 0.f;
#pragma unroll
        for (int k = 0; k < 16; ++k) if (k == m) Fm = Fk[k];
        float mx = -1e30f;
#pragma unroll
        for (int k = 0; k < 16; ++k) { const size_t rk = (size_t)b * TP + PADF + k;
            const unsigned kw = *(const unsigned*)(Z + rk * DINP + C_BK + h * 128 + 2 * lane);
            const float d = wave_sum(q0 * bflo(kw) + q1 * bfhi(kw));
            lg[k] = (k <= m) ? d * SCALE + Fm - Fk[k] : -__builtin_inff(); mx = fmaxf(mx, lg[k]); }
        float sum = 0.f, o0 = 0.f, o1 = 0.f;
#pragma unroll
        for (int k = 0; k < 16; ++k) { const float p = fexp_(lg[k] - mx); sum += p;
            const size_t rk = (size_t)b * TP + PADF + k;
            const unsigned vw = *(const unsigned*)(Z + rk * DINP + C_BV + h * 128 + 2 * lane);
            o0 += p * bflo(vw); o1 += p * bfhi(vw); }
        const float inv = 1.f / sum;
        *(unsigned*)(MIX + rq * DM + 768 + h * 128 + 2 * lane) = cvtpk(o0 * inv, o1 * inv);
    }
}
}

namespace dsa {
constexpr int NQ = 8, SCW = TP;
constexpr int SC_BYTES = NQ * SCW * 4;
constexpr int IDX_OFF = SC_BYTES;
constexpr int LDS_NEED = SC_BYTES + NQ * 256 * 2;
constexpr int KTOP = 256;
typedef short s16x2v __attribute__((ext_vector_type(2)));
__device__ __forceinline__ unsigned relu_pk(unsigned w) { s16x2v v = *reinterpret_cast<s16x2v*>(&w); v = __builtin_elementwise_max(v, (s16x2v){0, 0}); return *reinterpret_cast<unsigned*>(&v); }
__device__ __forceinline__ unsigned sortable(float f) { const unsigned u = __float_as_uint(f); return (u >> 31) ? ~u : (u | 0x80000000u); }
__device__ __forceinline__ unsigned mbcnt(unsigned long long m) { return __builtin_amdgcn_mbcnt_hi((unsigned)(m >> 32), __builtin_amdgcn_mbcnt_lo((unsigned)m, 0u)); }
__device__ __forceinline__ unsigned off_b(unsigned row, unsigned ch) { return 256u * row + 16u * (ch ^ (((row & 3) << 2) | ((row >> 2) & 3))); }

template <int NG>
__device__ __forceinline__ void select_topk(const LAS float* myc, LAS unsigned short* idx, int lane) {
    unsigned key[NG];
#pragma unroll
    for (int j = 0; j < NG; ++j) key[j] = sortable(myc[64 * j + lane]);
    unsigned tau = 0u;
    for (int bit = 31; bit >= 0; --bit) {
        const unsigned cand = tau | (1u << bit); int cnt = 0;
#pragma unroll
        for (int j0 = 0; j0 < NG; j0 += 8) { unsigned long long mk[8];
#pragma unroll
            for (int q = 0; q < 8; ++q) mk[q] = (j0 + q < NG) ? __ballot(key[j0 + q] >= cand) : 0ull;
            asm volatile("" : "+s"(mk[0]), "+s"(mk[1]), "+s"(mk[2]), "+s"(mk[3]), "+s"(mk[4]), "+s"(mk[5]), "+s"(mk[6]), "+s"(mk[7]));
#pragma unroll
            for (int q = 0; q < 8; ++q) cnt += __popcll(mk[q]); }
        if (cnt >= KTOP) tau = cand;
        if (cnt == KTOP) break;
    }
    int cgt = 0;
#pragma unroll
    for (int j = 0; j < NG; ++j) cgt += __popcll(__ballot(key[j] > tau));
    int eq_rem = KTOP - cgt, run = 0;
#pragma unroll
    for (int j = 0; j < NG; ++j) {
        const bool gt = key[j] > tau, eq = key[j] == tau;
        const unsigned long long m_eq = __ballot(eq);
        const bool take = gt || (eq && (int)mbcnt(m_eq) < eq_rem);
        const unsigned long long m = __ballot(take);
        if (take) idx[run + (int)mbcnt(m)] = (unsigned short)(64 * j + lane);
        run += __popcll(m); const int ne = __popcll(m_eq); eq_rem -= (ne < eq_rem) ? ne : eq_rem;
    }
}
__device__ __forceinline__ void unit(LAS unsigned char* lds, const bf16* Z, const float* ZS, const bf16* IKC, const bf16* KAC, const bf16* VAC, bf16* MIX, int b, int c, int sub) {
    int tid = get_tid();
    const int lane = tid & 63, wave = __builtin_amdgcn_readfirstlane(tid >> 6), g = lane >> 4, c16 = lane & 15;
    const int v0 = 64 * c + 8 * sub;
    const size_t rb = (size_t)b * TP;
    LAS float* sc = (LAS float*)lds;
    {
        bf16x8 A[NQ][2];
#pragma unroll
        for (int qi = 0; qi < NQ; ++qi) { const bf16* zq = Z + (rb + v0 + qi) * DINP + C_IQ + c16 * 64 + 8 * g;
            A[qi][0] = *(const bf16x8*)zq; A[qi][1] = *(const bf16x8*)(zq + 32); }
        u32x4 Aw[4];
        { const f32x4 w4 = *(const f32x4*)(ZS + (rb + v0 + (c16 & 7)) * 256 + S_IW + 4 * g);
          const unsigned w01 = cvtpk(w4[0], w4[1]), w23 = cvtpk(w4[2], w4[3]);
#pragma unroll
          for (int s2 = 0; s2 < 4; ++s2) { const bool ev = (c16 == 2 * s2), od = (c16 == 2 * s2 + 1);
              Aw[s2] = (u32x4){ev ? w01 : 0u, ev ? w23 : 0u, od ? w01 : 0u, od ? w23 : 0u}; } }
        const int ntile = 4 * (c + 1);
        const bf16* ikb = IKC + rb * 64 + c16 * 64 + 8 * g;
        const f32x4 Z4 = {0.f, 0.f, 0.f, 0.f};
#define DSA_BLD(dst0, dst1, tt) do { const int t_ = (tt) < ntile ? (tt) : ntile - 1; dst0 = *(const bf16x8*)(ikb + (size_t)t_ * 1024); dst1 = *(const bf16x8*)(ikb + (size_t)t_ * 1024 + 32); } while (0)
#define DSA_TILE(B0_, B1_, tt) do { f32x4 d[NQ]; \
            _Pragma("unroll") for (int qi = 0; qi < NQ; ++qi) { d[qi] = __builtin_amdgcn_mfma_f32_16x16x32_bf16(A[qi][0], B0_, Z4, 0, 0, 0); \
                d[qi] = __builtin_amdgcn_mfma_f32_16x16x32_bf16(A[qi][1], B1_, d[qi], 0, 0, 0); } \
            f32x4 D2 = Z4; \
            _Pragma("unroll") for (int s2 = 0; s2 < 4; ++s2) { const f32x4 x = d[2 * s2], y = d[2 * s2 + 1]; \
                u32x4 rw; rw.x = relu_pk(cvtpk(x[0], x[1])); rw.y = relu_pk(cvtpk(x[2], x[3])); rw.z = relu_pk(cvtpk(y[0], y[1])); rw.w = relu_pk(cvtpk(y[2], y[3])); \
                D2 = __builtin_amdgcn_mfma_f32_16x16x32_bf16(*reinterpret_cast<const bf16x8*>(&Aw[s2]), *reinterpret_cast<const bf16x8*>(&rw), D2, 0, 0, 0); } \
            const int key = 16 * (tt) + c16; \
            if (g < 2) { _Pragma("unroll") for (int r = 0; r < 4; ++r) sc[(4 * g + r) * SCW + key] = (key >= PADF) ? D2[r] : -__builtin_inff(); } } while (0)
        bf16x8 Ba0, Ba1, Bb0, Bb1, Bc0, Bc1;
        int t = wave;
        DSA_BLD(Ba0, Ba1, t); DSA_BLD(Bb0, Bb1, t + 8);
        for (; t < ntile; t += 24) {
            DSA_BLD(Bc0, Bc1, t + 16); DSA_TILE(Ba0, Ba1, t);
            if (t + 8 >= ntile) break;
            DSA_BLD(Ba0, Ba1, t + 24); DSA_TILE(Bb0, Bb1, t + 8);
            if (t + 16 >= ntile) break;
            DSA_BLD(Bb0, Bb1, t + 32); DSA_TILE(Bc0, Bc1, t + 16);
        }
#undef DSA_BLD
#undef DSA_TILE
    }
    { const int n_ = 64 * (c + 1), ng_ = (c + 1 <= 16) ? 16 : (c + 1 <= 32 ? 32 : (c + 1 <= 48 ? 48 : 65));
      for (int i = n_ + tid; i < 64 * ng_; i += 512) {
#pragma unroll
          for (int qi = 0; qi < NQ; ++qi) sc[qi * SCW + i] = -__builtin_inff(); } }
    __syncthreads();
    const int n = 64 * (c + 1), nreal = n - PADF, ngrp = c + 1;
    LAS unsigned short* idx = (LAS unsigned short*)(lds + IDX_OFF) + wave * 256;
    LAS float* myc = sc + wave * SCW;
    int nsel;
    if (nreal <= KTOP) { nsel = nreal; for (int s = lane; s < nsel; s += 64) idx[s] = (unsigned short)(PADF + s); }
    else { nsel = KTOP;
        if (ngrp <= 16) select_topk<16>(myc, idx, lane); else if (ngrp <= 32) select_topk<32>(myc, idx, lane);
        else if (ngrp <= 48) select_topk<48>(myc, idx, lane); else select_topk<65>(myc, idx, lane); }
    LDS_WAIT();
    {
        const size_t qrow = rb + v0 + wave;
        bf16x8 Bq[4];
#pragma unroll
        for (int kd = 0; kd < 4; ++kd) { Bq[kd] = (bf16x8){0, 0, 0, 0, 0, 0, 0, 0}; if (c16 < 6) Bq[kd] = *(const bf16x8*)(Z + qrow * DINP + C_AQ + c16 * 128 + 32 * kd + 8 * g); }
        f32x4 Dl[8][2];
        const int srow = 8 * (c16 >> 2) + (c16 & 3);
        const bf16* kab = KAC + rb * 128 + 8 * g;
        bf16x8 Ka[3][8];
        const f32x4 Z4 = {0.f, 0.f, 0.f, 0.f};
#define DSA_KLOAD(buf, ks_) do { int s0_ = 32 * (ks_) + srow, s1_ = s0_ + 4; s0_ = s0_ < nsel ? s0_ : nsel - 1; s1_ = s1_ < nsel ? s1_ : nsel - 1; \
            const bf16* k0_ = kab + (size_t)idx[s0_] * 128; const bf16* k1_ = kab + (size_t)idx[s1_] * 128; \
            _Pragma("unroll") for (int kd = 0; kd < 4; ++kd) { Ka[buf][kd] = *(const bf16x8*)(k0_ + 32 * kd); Ka[buf][4 + kd] = *(const bf16x8*)(k1_ + 32 * kd); } } while (0)
        DSA_KLOAD(0, 0); DSA_KLOAD(1, 1);
#pragma unroll
        for (int ks = 0; ks < 8; ++ks) {
            if (ks + 2 < 8) DSA_KLOAD((ks + 2) % 3, ks + 2);
            f32x4 d0 = Z4, d1 = Z4;
#pragma unroll
            for (int kd = 0; kd < 4; ++kd) { d0 = __builtin_amdgcn_mfma_f32_16x16x32_bf16(Ka[ks % 3][kd], Bq[kd], d0, 0, 0, 0); d1 = __builtin_amdgcn_mfma_f32_16x16x32_bf16(Ka[ks % 3][4 + kd], Bq[kd], d1, 0, 0, 0); }
            Dl[ks][0] = d0; Dl[ks][1] = d1;
        }
#undef DSA_KLOAD
        constexpr float C2 = 0.08838834764831845f * 1.4426950408889634f;
        float mx = -1e30f;
#pragma unroll
        for (int ks = 0; ks < 8; ++ks)
#pragma unroll
            for (int tt = 0; tt < 2; ++tt)
#pragma unroll
                for (int r = 0; r < 4; ++r) { const int slot = 32 * ks + 8 * g + 4 * tt + r; float x = Dl[ks][tt][r] * C2; x = (slot < nsel) ? x : -__builtin_inff(); Dl[ks][tt][r] = x; mx = fmaxf(mx, x); }
        mx = fmaxf(mx, __shfl_xor(mx, 16)); mx = fmaxf(mx, __shfl_xor(mx, 32));
        float sum = 0.f;
#pragma unroll
        for (int ks = 0; ks < 8; ++ks)
#pragma unroll
            for (int tt = 0; tt < 2; ++tt)
#pragma unroll
                for (int r = 0; r < 4; ++r) { const float p = __builtin_amdgcn_exp2f(Dl[ks][tt][r] - mx); Dl[ks][tt][r] = p; sum += p; }
        sum += __shfl_xor(sum, 16); sum += __shfl_xor(sum, 32);
        LAS unsigned char* stg = (LAS unsigned char*)myc;
        const unsigned stg_addr = (unsigned)(uintptr_t)stg;
        f32x4 O[8];
#pragma unroll
        for (int dt = 0; dt < 8; ++dt) O[dt] = Z4;
        const unsigned q4 = (unsigned)c16 >> 2, p4 = (unsigned)c16 & 3;
        const unsigned rd_base = stg_addr + (8u * g + q4) * 256u + 8u * p4;
        const bf16* vab = VAC + rb * 128 + (lane & 15) * 8;
        u32x4 Vr[2][8];
#define DSA_VLOAD(buf, ks_) do { _Pragma("unroll") for (int i = 0; i < 8; ++i) { int s_ = 32 * (ks_) + (lane >> 4) + 4 * i; s_ = s_ < nsel ? s_ : nsel - 1; Vr[buf][i] = *(const u32x4*)(vab + (size_t)idx[s_] * 128); } } while (0)
        DSA_VLOAD(0, 0); DSA_VLOAD(1, 1);
#pragma unroll
        for (int ks = 0; ks < 8; ++ks) {
            LAS unsigned char* sb = stg + (ks & 1) * 8192;
#pragma unroll
            for (int i = 0; i < 8; ++i) *(LAS u32x4*)(sb + ((lane >> 4) + 4 * i) * 256 + (lane & 15) * 16) = Vr[ks & 1][i];
            if (ks + 2 < 8) DSA_VLOAD(ks & 1, ks + 2);
            u32x4 pw; pw.x = cvtpk(Dl[ks][0][0], Dl[ks][0][1]); pw.y = cvtpk(Dl[ks][0][2], Dl[ks][0][3]); pw.z = cvtpk(Dl[ks][1][0], Dl[ks][1][1]); pw.w = cvtpk(Dl[ks][1][2], Dl[ks][1][3]);
            const bf16x8 Bp = *reinterpret_cast<const bf16x8*>(&pw);
            const unsigned ra = rd_base + (ks & 1) * 8192u;
            s16x4 l0, l1, l2, l3, l4, l5, l6, l7, h0, h1, h2, h3, h4, h5, h6, h7;
            asm volatile("s_waitcnt lgkmcnt(0)\n\t"
                "ds_read_b64_tr_b16 %0, %16\n\tds_read_b64_tr_b16 %8, %16 offset:1024\n\t"
                "ds_read_b64_tr_b16 %1, %16 offset:32\n\tds_read_b64_tr_b16 %9, %16 offset:1056\n\t"
                "ds_read_b64_tr_b16 %2, %16 offset:64\n\tds_read_b64_tr_b16 %10, %16 offset:1088\n\t"
                "ds_read_b64_tr_b16 %3, %16 offset:96\n\tds_read_b64_tr_b16 %11, %16 offset:1120\n\t"
                "ds_read_b64_tr_b16 %4, %16 offset:128\n\tds_read_b64_tr_b16 %12, %16 offset:1152\n\t"
                "ds_read_b64_tr_b16 %5, %16 offset:160\n\tds_read_b64_tr_b16 %13, %16 offset:1184\n\t"
                "ds_read_b64_tr_b16 %6, %16 offset:192\n\tds_read_b64_tr_b16 %14, %16 offset:1216\n\t"
                "ds_read_b64_tr_b16 %7, %16 offset:224\n\tds_read_b64_tr_b16 %15, %16 offset:1248\n\t"
                "s_waitcnt lgkmcnt(0)"
                : "=&v"(l0), "=&v"(l1), "=&v"(l2), "=&v"(l3), "=&v"(l4), "=&v"(l5), "=&v"(l6), "=&v"(l7), "=&v"(h0), "=&v"(h1), "=&v"(h2), "=&v"(h3), "=&v"(h4), "=&v"(h5), "=&v"(h6), "=&v"(h7)
                : "v"(ra) : "memory");
#define DSA_PV(dt, lo, hi2) O[dt] = __builtin_amdgcn_mfma_f32_16x16x32_bf16((bf16x8){lo[0], lo[1], lo[2], lo[3], hi2[0], hi2[1], hi2[2], hi2[3]}, Bp, O[dt], 0, 0, 0)
            DSA_PV(0, l0, h0); DSA_PV(1, l1, h1); DSA_PV(2, l2, h2); DSA_PV(3, l3, h3); DSA_PV(4, l4, h4); DSA_PV(5, l5, h5); DSA_PV(6, l6, h6); DSA_PV(7, l7, h7);
#undef DSA_PV
        }
#undef DSA_VLOAD
        if (c16 < 6) { const float inv = 1.f / sum; bf16* op = MIX + qrow * DM + c16 * 128 + 4 * g;
#pragma unroll
            for (int dt = 0; dt < 8; ++dt) { u32x2 w; w.x = cvtpk(O[dt][0] * inv, O[dt][1] * inv); w.y = cvtpk(O[dt][2] * inv, O[dt][3] * inv); *(u32x2*)(op + 16 * dt) = w; } }
    }
    __syncthreads();
}
}

namespace gla {
constexpr int LDT = 72;
constexpr int L_BL = 0;
constexpr int L_SEG = L_BL + 16384;
constexpr int L_QH = L_SEG + 2048;
constexpr int L_KH = L_QH + 64 * LDT * 2;
constexpr int L_SC = L_KH + 64 * LDT * 2;
constexpr int L_VT = L_SC + 64 * LDT * 2;
constexpr int L_ST = L_VT + 128 * LDT * 2;
constexpr int L_O = L_ST + 128 * LDT * 2;
constexpr int LDS_NEED = L_O + 64 * 132 * 4;
__device__ __forceinline__ bf16x8 ldfrag(const LAS bf16* base, int row, int k0) { return *(const LAS bf16x8*)(base + row * LDT + k0); }

__device__ __forceinline__ void cum_decay(LAS unsigned char* lds, const float* LA, size_t row0, int hd, bool chunk0) {
    int tid = get_tid();
    const int d = tid & 63, seg = tid >> 6;
    LAS float* bl = (LAS float*)(lds + L_BL); LAS float* sg = (LAS float*)(lds + L_SEG);
    float v[8]; float s = 0.f;
#pragma unroll
    for (int k = 0; k < 8; ++k) { const int i = 8 * seg + k; float x = LA[(row0 + i) * 256 + hd * 64 + d]; if (chunk0 && i < PADF) x = 0.f; s += x; v[k] = s; }
    sg[seg * 64 + d] = s;
    __syncthreads();
    float off = 0.f;
    for (int w = 0; w < seg; ++w) off += sg[w * 64 + d];
#pragma unroll
    for (int k = 0; k < 8; ++k) bl[(8 * seg + k) * 64 + d] = v[k] + off;
    __syncthreads();
}
__device__ __forceinline__ void load_vT(LAS unsigned char* lds, const bf16* Z, size_t row0, int hd) {
    int tid = get_tid(); LAS bf16* vT = (LAS bf16*)(lds + L_VT);
#pragma unroll
    for (int it = 0; it < 2; ++it) { const int pc = tid + 512 * it, i = pc >> 4, e0 = (pc & 15) * 8;
        const u32x4 w = *(const u32x4*)(Z + (row0 + i) * DINP + C_CV + hd * 128 + e0);
        const unsigned ww[4] = {w.x, w.y, w.z, w.w};
#pragma unroll
        for (int k = 0; k < 4; ++k) { vT[(e0 + 2 * k) * LDT + i] = (bf16)(ww[k] & 0xffffu); vT[(e0 + 2 * k + 1) * LDT + i] = (bf16)(ww[k] >> 16); } }
}
__device__ __forceinline__ void step1(LAS unsigned char* lds, const bf16* Z, const float* ZS, float* LA, const float* w2, const float* gb, float* KV, float* DVEC, int b, int c, int hd) {
    int tid = get_tid();
    const int lane = tid & 63, wave = tid >> 6, g = lane >> 4, c16 = lane & 15;
    const size_t row0 = (size_t)b * TP + 64 * c;
    LAS float* bl = (LAS float*)(lds + L_BL); LAS float* sg = (LAS float*)(lds + L_SEG); LAS bf16* kdT = (LAS bf16*)(lds + L_QH); LAS bf16* vT = (LAS bf16*)(lds + L_VT);
    LAS float* crs = (LAS float*)(lds + L_O);
    if (tid < 256) { const int i = tid >> 2; *(LAS f32x4*)(crs + i * 16 + 4 * (tid & 3)) = *(const f32x4*)(ZS + (row0 + i) * 256 + S_CR + 4 * (tid & 3)); }
    __syncthreads();
    { const int d = tid & 63, seg = tid >> 6, n = hd * 64 + d;
      float wc[16];
#pragma unroll
      for (int r = 0; r < 16; ++r) wc[r] = w2[r * 256 + n];
      const float gbn = gb[n];
      float v[8]; float s = 0.f;
#pragma unroll
      for (int k = 0; k < 8; ++k) { const int i = 8 * seg + k; float a = gbn;
#pragma unroll
          for (int r = 0; r < 16; ++r) a += crs[i * 16 + r] * wc[r];
          float x = logsigmoidf(a) * (1.f / 16.f); if (c == 0 && i < PADF) x = 0.f;
          LA[(row0 + i) * 256 + n] = x; s += x; v[k] = s; }
      sg[seg * 64 + d] = s;
      __syncthreads();
      float off = 0.f;
      for (int w = 0; w < seg; ++w) off += sg[w * 64 + d];
#pragma unroll
      for (int k = 0; k < 8; ++k) bl[(8 * seg + k) * 64 + d] = v[k] + off; }
    __syncthreads();
    { const int i = tid >> 3, d0 = (tid & 7) * 8;
      const u32x4 w = *(const u32x4*)(Z + (row0 + i) * DINP + C_CK + hd * 64 + d0); const unsigned ww[4] = {w.x, w.y, w.z, w.w};
#pragma unroll
      for (int k = 0; k < 8; ++k) { const int d = d0 + k; const float kk = (k & 1) ? bfhi(ww[k >> 1]) : bflo(ww[k >> 1]);
          kdT[d * LDT + i] = f2bf(kk * fexp_(bl[63 * 64 + d] - bl[i * 64 + d])); } }
    load_vT(lds, Z, row0, hd);
    __syncthreads();
    const int bh = b * 4 + hd;
    float* kvp = KV + ((size_t)bh * 65 + c) * 8192;
#pragma unroll
    for (int dt = 0; dt < 4; ++dt) { f32x4 acc = zero4();
#pragma unroll
        for (int ks = 0; ks < 2; ++ks) acc = __builtin_amdgcn_mfma_f32_16x16x32_bf16(ldfrag(kdT, 16 * dt + c16, 32 * ks + 8 * g), ldfrag(vT, 16 * wave + c16, 32 * ks + 8 * g), acc, 0, 0, 0);
#pragma unroll
        for (int r = 0; r < 4; ++r) kvp[(16 * dt + 4 * g + r) * 128 + 16 * wave + c16] = acc[r]; }
    if (tid < 64) DVEC[((size_t)bh * 65 + c) * 64 + tid] = fexp_(bl[63 * 64 + tid]);
    __syncthreads();
}
__device__ __forceinline__ void step2(const float* KV, const float* DVEC, float* SS, int u) {
    int tid = get_tid();
    const int bh = u >> 2, idx = (u & 3) * 2048 + tid * 4, d = idx >> 7;
    f32x4 S = zero4();
    *(f32x4*)(SS + ((size_t)bh * 66) * 8192 + idx) = S;
#pragma unroll 4
    for (int c = 0; c < 64; ++c) {
        const f32x4 kv = *(const f32x4*)(KV + ((size_t)bh * 65 + c) * 8192 + idx); const float dv = DVEC[((size_t)bh * 65 + c) * 64 + d];
        S = S * dv + kv;
        *(f32x4*)(SS + ((size_t)bh * 66 + c + 1) * 8192 + idx) = S;
    }
}
__device__ __forceinline__ void step3(LAS unsigned char* lds, const bf16* Z, const float* LA, const float* SS, const float* gon, bf16* MIX, int b, int c, int hd) {
    int tid = get_tid();
    const int lane = tid & 63, wave = tid >> 6, g = lane >> 4, c16 = lane & 15;
    const size_t row0 = (size_t)b * TP + 64 * c;
    LAS float* bl = (LAS float*)(lds + L_BL); LAS bf16* qh = (LAS bf16*)(lds + L_QH); LAS bf16* kh = (LAS bf16*)(lds + L_KH); LAS bf16* scb = (LAS bf16*)(lds + L_SC);
    LAS bf16* vT = (LAS bf16*)(lds + L_VT); LAS bf16* sT = (LAS bf16*)(lds + L_ST); LAS float* ol = (LAS float*)(lds + L_O);
    {
        const int bh = b * 4 + hd;
        cum_decay(lds, LA, row0, hd, c == 0);
        { const int i = tid >> 3, d0 = (tid & 7) * 8;
          const u32x4 wq = *(const u32x4*)(Z + (row0 + i) * DINP + C_CQ + hd * 64 + d0), wk = *(const u32x4*)(Z + (row0 + i) * DINP + C_CK + hd * 64 + d0);
          const unsigned q4[4] = {wq.x, wq.y, wq.z, wq.w}, k4[4] = {wk.x, wk.y, wk.z, wk.w};
          unsigned oq[4], ok[4];
#pragma unroll
          for (int k = 0; k < 4; ++k) { const float b0 = bl[i * 64 + d0 + 2 * k], b1 = bl[i * 64 + d0 + 2 * k + 1];
              oq[k] = cvtpk(bflo(q4[k]) * 0.125f * fexp_(b0), bfhi(q4[k]) * 0.125f * fexp_(b1));
              ok[k] = cvtpk(bflo(k4[k]) * fexp_(-b0), bfhi(k4[k]) * fexp_(-b1)); }
          *(LAS u32x4*)(qh + i * LDT + d0) = (u32x4){oq[0], oq[1], oq[2], oq[3]};
          *(LAS u32x4*)(kh + i * LDT + d0) = (u32x4){ok[0], ok[1], ok[2], ok[3]}; }
        load_vT(lds, Z, row0, hd);
        { const float* sp = SS + ((size_t)bh * 66 + c) * 8192;
#pragma unroll
          for (int it = 0; it < 4; ++it) { const int pc = tid + 512 * it, d = pc >> 5, e0 = (pc & 31) * 4; const f32x4 s4 = *(const f32x4*)(sp + d * 128 + e0);
#pragma unroll
              for (int k = 0; k < 4; ++k) sT[(e0 + k) * LDT + d] = f2bf(s4[k]); } }
        __syncthreads();
        { const int it = wave & 3;
#pragma unroll
          for (int jj = 0; jj < 2; ++jj) { const int jt = 2 * (wave >> 2) + jj; f32x4 acc = zero4();
              if (jt <= it) {
#pragma unroll
                  for (int ks = 0; ks < 2; ++ks) acc = __builtin_amdgcn_mfma_f32_16x16x32_bf16(ldfrag(qh, 16 * it + c16, 32 * ks + 8 * g), ldfrag(kh, 16 * jt + c16, 32 * ks + 8 * g), acc, 0, 0, 0); }
#pragma unroll
              for (int r = 0; r < 4; ++r) { const int i = 16 * it + 4 * g + r, j = 16 * jt + c16; scb[i * LDT + j] = f2bf((j <= i) ? acc[r] : 0.f); } } }
        __syncthreads();
#pragma unroll
        for (int it = 0; it < 4; ++it) { f32x4 acc = zero4();
#pragma unroll
            for (int ks = 0; ks < 2; ++ks) acc = __builtin_amdgcn_mfma_f32_16x16x32_bf16(ldfrag(scb, 16 * it + c16, 32 * ks + 8 * g), ldfrag(vT, 16 * wave + c16, 32 * ks + 8 * g), acc, 0, 0, 0);
#pragma unroll
            for (int ks = 0; ks < 2; ++ks) acc = __builtin_amdgcn_mfma_f32_16x16x32_bf16(ldfrag(qh, 16 * it + c16, 32 * ks + 8 * g), ldfrag(sT, 16 * wave + c16, 32 * ks + 8 * g), acc, 0, 0, 0);
#pragma unroll
            for (int r = 0; r < 4; ++r) ol[(16 * it + 4 * g + r) * 132 + 16 * wave + c16] = acc[r]; }
        __syncthreads();
#pragma unroll
        for (int k = 0; k < 8; ++k) { const int i = 8 * wave + k; const float x0 = ol[i * 132 + 2 * lane], x1 = ol[i * 132 + 2 * lane + 1];
            const float ss = wave_sum(x0 * x0 + x1 * x1); const float rstd = rsqrt_(ss * (1.f / 128.f) + EPS);
            if (!(c == 0 && i < PADF)) { const unsigned gw = *(const unsigned*)(Z + (row0 + i) * DINP + C_CG + hd * 128 + 2 * lane);
                const float y0 = x0 * rstd * gon[2 * lane] * siluf(bflo(gw)), y1 = x1 * rstd * gon[2 * lane + 1] * siluf(bfhi(gw));
                *(unsigned*)(MIX + (row0 + i) * DM + 1536 + hd * 128 + 2 * lane) = cvtpk(y0, y1); } }
        __syncthreads();
    }
}
}

struct Frame {
    LAS unsigned char* lds; char* ldsg;
    int tid, lane, wave, G, bid;
};
constexpr int PTAB_OFF = LDSCTL_OFF + 1024, P_OUT = 21, P_WS = 22;
__device__ __forceinline__ unsigned char* gptr(const Frame& F, int k) {
    const LAS unsigned* t = (const LAS unsigned*)(F.lds + PTAB_OFF) + 2 * k;
    const unsigned lo = __builtin_amdgcn_readfirstlane(t[0]), hi = __builtin_amdgcn_readfirstlane(t[1]);
    return (unsigned char*)(GAS unsigned char*)(((unsigned long long)hi << 32) | lo);
}
#define WS() gptr(F, P_WS)
#define INP(k) ((const float*)gptr(F, (k)))
#define CTL() ((unsigned*)(gptr(F, P_WS) + WS_CTL))
__device__ __forceinline__ int inmap(int n) {
    if (n < 2048) return n;
    if (n < 2112) return C_IK + (n - 2048);
    if (n < 2128) return C_IK + S_IW + (n - 2112);
    if (n < 4432) return C_BQ + (n - 2128);
    if (n < 4438) return C_IK + S_BF + (n - 4432);
    if (n < 4950) return C_CQ + (n - 4438);
    if (n < 5462) return C_CV + (n - 4950);
    if (n < 5478) return C_IK + S_CR + (n - 5462);
    return C_CG + (n - 5478);
}
template <int MAP, int LW>
__device__ __forceinline__ void transpose_item(const float* W, int K, int N, bf16* WT, LAS float* scr, int item, int lane) {
    constexpr int PITCH = 68, LPR = 64 / LW  , RPI = 64 / LPR  , NI = 64 / RPI;
    const int nblk = (N + 63) / 64, kb = item / nblk, nb = item % nblk, k0 = 64 * kb, n0 = 64 * nb;
    const int cl = LW * (lane % LPR), rl = lane / LPR;
    const float* src = W + (size_t)(k0 + rl) * N + n0 + cl;
    const bool inb = (n0 + cl) < N;
    if constexpr (LW == 4) { f32x4 v[NI];
#pragma unroll
        for (int i = 0; i < NI; ++i) v[i] = inb ? *(const f32x4*)(src + (size_t)(RPI * i) * N) : (f32x4){0.f, 0.f, 0.f, 0.f};
#pragma unroll
        for (int i = 0; i < NI; ++i) *(LAS f32x4*)(scr + (rl + RPI * i) * PITCH + cl) = v[i];
    } else { f32x2 v[NI];
#pragma unroll
        for (int i = 0; i < NI; ++i) v[i] = inb ? *(const f32x2*)(src + (size_t)(RPI * i) * N) : (f32x2){0.f, 0.f};
#pragma unroll
        for (int i = 0; i < NI; ++i) *(LAS f32x2*)(scr + (rl + RPI * i) * PITCH + cl) = v[i];
    }
    LDS_WAIT(); asm volatile("" ::: "memory");
    const int ng = n0 + lane;
    int row = ng; if (MAP == 1) row = inmap(ng < N ? ng : 0); if (MAP == 2) row = 8 * (ng >> 2) + (ng & 3); if (MAP == 3) row = 8 * (ng >> 2) + 4 + (ng & 3);
    bf16* dst = WT + (size_t)row * K + k0;
#pragma unroll
    for (int kc = 0; kc < 8; ++kc) { const LAS float* sp = scr + (8 * kc) * PITCH + lane;
        u32x4 o; o.x = cvtpk(sp[0 * PITCH], sp[1 * PITCH]); o.y = cvtpk(sp[2 * PITCH], sp[3 * PITCH]); o.z = cvtpk(sp[4 * PITCH], sp[5 * PITCH]); o.w = cvtpk(sp[6 * PITCH], sp[7 * PITCH]);
        if (ng < N) *(u32x4*)(dst + 8 * kc) = o; }
    LDS_WAIT(); asm volatile("" ::: "memory");
}
__device__ __forceinline__ void sincos_d(double ang, float& c, float& s) {
    const double q = __builtin_rint(ang * 0.63661977236758134308);
    double r = __builtin_fma(-q, 1.5707963267948966, ang); r = __builtin_fma(-q, 6.123233995736766e-17, r);
    const double r2 = r * r;
    const double sp = r + r * r2 * (-1.0 / 6 + r2 * (1.0 / 120 + r2 * (-1.0 / 5040 + r2 * (1.0 / 362880 + r2 * (-1.0 / 39916800 + r2 * (1.0 / 6227020800.0))))));
    const double cp = 1.0 + r2 * (-0.5 + r2 * (1.0 / 24 + r2 * (-1.0 / 720 + r2 * (1.0 / 40320 + r2 * (-1.0 / 3628800 + r2 * (1.0 / 479001600.0))))));
    const int n = (int)((long long)q & 3);
    const double sv = (n == 0) ? sp : (n == 1) ? cp : (n == 2) ? -sp : -cp;
    const double cv = (n == 0) ? cp : (n == 1) ? -sp : (n == 2) ? -cp : sp;
    c = (float)cv; s = (float)sv;
}
__device__ __forceinline__ void p_prologue(Frame& F, const float* w_in, const float* w_out, const float* e_w1, const float* e_w3, const float* e_w2, const float* rgw, const float* rew, const float* g2) {
    int htid = get_tid(); const int h_lane = htid & 63, h_wave = __builtin_amdgcn_readfirstlane(htid >> 6);
    LAS float* scr = (LAS float*)(F.lds + h_wave * 17408);
    const int gw = F.bid * 8 + h_wave, NGW = F.G * 8;
    unsigned char* ws = WS();
    constexpr int I_IN = 32 * 94, I_OUT = 32 * 32, I_W1 = NEXP * 32 * 8, I_W2 = NEXP * 8 * 32, I_L = I_IN + I_OUT + 2 * I_W1 + I_W2;
    for (int it = gw; it < DEPTH * I_L; it += NGW) {
        const int l = it / I_L; int r = it % I_L;
        if (r < I_IN) { transpose_item<1, 2>(w_in + (size_t)l * DM * DIN, DM, DIN, (bf16*)(ws + WS_WIN + l * SZ_WIN), scr, r, h_lane); continue; } r -= I_IN;
        if (r < I_OUT) { transpose_item<0, 4>(w_out + (size_t)l * DM * DM, DM, DM, (bf16*)(ws + WS_WOUT + l * SZ_WOUT), scr, r, h_lane); continue; } r -= I_OUT;
        if (r < I_W1) { const int e = r / 256; transpose_item<2, 4>(e_w1 + ((size_t)l * NEXP + e) * DM * DEXP, DM, DEXP, (bf16*)(ws + WS_W13 + l * SZ_W13 + e * SZ_W13E), scr, r % 256, h_lane); continue; } r -= I_W1;
        if (r < I_W1) { const int e = r / 256; transpose_item<3, 4>(e_w3 + ((size_t)l * NEXP + e) * DM * DEXP, DM, DEXP, (bf16*)(ws + WS_W13 + l * SZ_W13 + e * SZ_W13E), scr, r % 256, h_lane); continue; } r -= I_W1;
        { const int e = r / 256; transpose_item<0, 4>(e_w2 + ((size_t)l * NEXP + e) * DEXP * DM, DEXP, DM, (bf16*)(ws + WS_W2 + l * SZ_W2 + e * SZ_W2E), scr, r % 256, h_lane); }
    }
    const int gt = F.bid * 512 + htid, NGT = F.G * 512;
    for (int i = gt; i < DEPTH * 154 * (DM / 8); i += NGT) { const int l = i / (154 * 256), rr = (i / 256) % 154, ch = i % 256;
        *(u32x4*)((bf16*)(ws + WS_WIN + l * SZ_WIN) + (size_t)(DIN + rr) * DM + ch * 8) = (u32x4){0u, 0u, 0u, 0u}; }
    for (int i = gt; i < TT * 64; i += NGT) { const int t = i >> 6, k = i & 63; double inv = 1.0; for (int j = 0; j < k; ++j) inv *= 0.86596432336006535;
        float c, s; sincos_d((double)t * inv, c, s); ((float*)(ws + WS_COS128))[i] = c; ((float*)(ws + WS_SIN128))[i] = s; }
    for (int i = gt; i < TT * 32; i += NGT) { const int t = i >> 5, k = i & 31; double inv = 1.0; for (int j = 0; j < k; ++j) inv *= 0.74989420933245583;
        float c, s; sincos_d((double)t * inv, c, s); ((float*)(ws + WS_COS64))[i] = c; ((float*)(ws + WS_SIN64))[i] = s; }
    for (int i = gt; i < NB * PADF * (DM / 8); i += NGT) { const int b = i / (PADF * 256), rr = (i / 256) % PADF, ch = i % 256; const size_t row = (size_t)b * TP + rr;
        *(u32x4*)((bf16*)(ws + WS_U) + row * DM + ch * 8) = (u32x4){0u, 0u, 0u, 0u}; *(u32x4*)((bf16*)(ws + WS_MIX) + row * DM + ch * 8) = (u32x4){0u, 0u, 0u, 0u}; }
    for (int i = gt; i < NB * PADF * (DINP / 8); i += NGT) { const int b = i / (PADF * 768), rr = (i / 768) % PADF, ch = i % 768; const size_t row = (size_t)b * TP + rr;
        *(u32x4*)((bf16*)(ws + WS_Z) + row * DINP + ch * 8) = (u32x4){0u, 0u, 0u, 0u}; }
    for (int i = gt; i < NB * PADF * 40; i += NGT) { const int b = i / (PADF * 40), rr = (i / 40) % PADF, ch = i % 40; const size_t row = (size_t)b * TP + rr;
        bf16* dst = (ch < 8) ? (bf16*)(ws + WS_IKC) + row * 64 + ch * 8 : (ch < 24 ? (bf16*)(ws + WS_KAC) + row * 128 + (ch - 8) * 8 : (bf16*)(ws + WS_VAC) + row * 128 + (ch - 24) * 8);
        *(u32x4*)dst = (u32x4){0u, 0u, 0u, 0u}; }
    for (int i = gt; i < NB * PADF * 64; i += NGT) { const int b = i / (PADF * 64), rr = (i / 64) % PADF, ch = i % 64; const size_t row = (size_t)b * TP + rr;
        *(f32x4*)((float*)(ws + WS_LA) + row * 256 + ch * 4) = zero4(); }
    for (int i = gt; i < DEPTH * 48 * DM; i += NGT) { const int l = i / (48 * DM), n = (i / DM) % 48, k = i % DM;
        float w = 0.f; if (n < 4) w = rgw[((size_t)l * DM + k) * 4 + n]; else if (n < 36) w = rew[((size_t)l * DM + k) * 32 + (n - 4)];
        w *= g2[(size_t)l * DM + k];
        const bf16 hi = f2bf(w); const bf16 lo = f2bf(w - bf2f(hi));
        bf16* wr = (bf16*)(ws + WS_WR + l * SZ_WR); wr[(size_t)n * DM + k] = hi; wr[(size_t)(48 + n) * DM + k] = lo; }
}
__device__ __forceinline__ void p_norm1(Frame& F, int l, const float* xin, const float* meta, const float* gain, size_t woff) {
    int htid = get_tid(); const int h_lane = htid & 63, h_wave = __builtin_amdgcn_readfirstlane(htid >> 6);
    const int gw = F.bid * 8 + h_wave, NGW = F.G * 8, lane = h_lane;
    float* H = (float*)(WS() + WS_H); bf16* U = (bf16*)(WS() + WS_U); const bf16* Y0 = (const bf16*)(WS() + WS_Y0); const bf16* Y1 = (const bf16*)(WS() + WS_Y1);
    for (int row = gw; row < R; row += NGW) {
        const int b = row / TP, v = row % TP;
        float* hr = H + (size_t)row * DM;
        if (v < PADF) { if (l == 0) {
#pragma unroll
                for (int j = 0; j < 8; ++j) *(f32x4*)(hr + 4 * (lane + 64 * j)) = zero4(); }
            continue; }
        const int t = v - PADF;
        f32x4 x[8]; float ss = 0.f;
#pragma unroll
        for (int j = 0; j < 8; ++j) { const int col = 4 * (lane + 64 * j);
            if (l == 0) { const float* src = (t < NMETA) ? meta + (size_t)t * DM : xin + ((size_t)b * SEQ + (t - NMETA)) * DM; x[j] = *(const f32x4*)(src + col); }
            else { x[j] = *(const f32x4*)(hr + col); const u32x2 a = *(const u32x2*)(Y0 + (size_t)row * DM + col), c = *(const u32x2*)(Y1 + (size_t)row * DM + col);
                x[j][0] += bflo(a.x) + bflo(c.x); x[j][1] += bfhi(a.x) + bfhi(c.x); x[j][2] += bflo(a.y) + bflo(c.y); x[j][3] += bfhi(a.y) + bfhi(c.y); }
            *(f32x4*)((char*)(hr + col) + woff) = x[j];
            ss += x[j][0] * x[j][0] + x[j][1] * x[j][1] + x[j][2] * x[j][2] + x[j][3] * x[j][3]; }
        ss = wave_sum(ss); const float rstd = rsqrt_(ss * (1.f / DM) + EPS);
#pragma unroll
        for (int j = 0; j < 8; ++j) { const int col = 4 * (lane + 64 * j); const f32x4 gg = *(const f32x4*)(gain + col);
            u32x2 w; w.x = cvtpk(x[j][0] * rstd * gg[0], x[j][1] * rstd * gg[1]); w.y = cvtpk(x[j][2] * rstd * gg[2], x[j][3] * rstd * gg[3]);
            *(u32x2*)((char*)(U + (size_t)row * DM + col) + woff) = w; }
    }
}
__device__ __forceinline__ void p_final(Frame& F) {
#ifdef PROBE_MASK
    float probe_delta = 0.f;
    { const volatile LAS unsigned long long* st = (const volatile LAS unsigned long long*)(F.lds + LDSCTL_OFF + 2048); unsigned long long tk = 0;
      for (int pz = 0; pz < 2 + 9 * DEPTH - 1; ++pz) { const int ty = (pz == 0) ? 0 : 1 + (pz - 1) % 9, ly = (pz == 0) ? 0 : (pz - 1) / 9;
          if (((PROBE_MASK >> ty) & 1) && ((PROBE_LAYERS >> ly) & 1)) tk += st[pz + 1] - st[pz]; }
      probe_delta = (PROBE_CONST) + (PROBE_ALPHA) * 0.01f * (float)tk; }
#endif
    int htid = get_tid(); const int h_lane = htid & 63, h_wave = __builtin_amdgcn_readfirstlane(htid >> 6);
    const int gw = F.bid * 8 + h_wave, NGW = F.G * 8, lane = h_lane;
    const float* H = (const float*)(WS() + WS_H); const bf16* Y0 = (const bf16*)(WS() + WS_Y0); const bf16* Y1 = (const bf16*)(WS() + WS_Y1);
    for (int o = gw; o < NB * SEQ; o += NGW) { const int b = o / SEQ, i = o % SEQ; const size_t row = (size_t)b * TP + PADF + NMETA + i;
#pragma unroll
        for (int j = 0; j < 8; ++j) { const int col = 4 * (lane + 64 * j); f32x4 x = *(const f32x4*)(H + row * DM + col);
            const u32x2 a = *(const u32x2*)(Y0 + row * DM + col), c = *(const u32x2*)(Y1 + row * DM + col);
            x[0] += bflo(a.x) + bflo(c.x); x[1] += bfhi(a.x) + bfhi(c.x); x[2] += bflo(a.y) + bflo(c.y); x[3] += bfhi(a.y) + bfhi(c.y);
#ifdef PROBE_MASK
            x = x + probe_delta;
#endif
            *(f32x4*)(((float*)gptr(F, P_OUT)) + (size_t)o * DM + col) = x; } }
}
__device__ __forceinline__ void unpack8(const u32x4 w, float (&x)[8]) { x[0] = bflo(w.x); x[1] = bfhi(w.x); x[2] = bflo(w.y); x[3] = bfhi(w.y); x[4] = bflo(w.z); x[5] = bfhi(w.z); x[6] = bflo(w.w); x[7] = bfhi(w.w); }
__device__ __forceinline__ u32x4 pack8f(const float (&x)[8]) { u32x4 w; w.x = cvtpk(x[0], x[1]); w.y = cvtpk(x[2], x[3]); w.z = cvtpk(x[4], x[5]); w.w = cvtpk(x[6], x[7]); return w; }
__device__ __forceinline__ void head128x(const bf16* p, bf16* dst, const float* gain, bool rope, bool raw, const float* cs, const float* sn, int lane) {
    const int c16 = lane & 15;
    const u32x4 w0 = *(const u32x4*)p;
    float x[8]; unpack8(w0, x);
    float ss = 0.f;
#pragma unroll
    for (int e = 0; e < 8; ++e) ss += x[e] * x[e];
    ss += __shfl_xor(ss, 1); ss += __shfl_xor(ss, 2); ss += __shfl_xor(ss, 4); ss += __shfl_xor(ss, 8);
    const float rstd = rsqrt_(ss * (1.f / 128.f) + EPS);
#pragma unroll
    for (int e = 0; e < 8; ++e) x[e] = x[e] * rstd * gain[8 * c16 + e];
    const int i0 = 8 * (c16 & 7);
#pragma unroll
    for (int e = 0; e < 8; ++e) { const float pr = __shfl_xor(x[e], 8); const float c = cs[i0 + e], s = sn[i0 + e];
        const float y = (c16 < 8) ? x[e] * c - pr * s : x[e] * c + pr * s; if (rope) x[e] = y; }
    *(u32x4*)dst = raw ? w0 : pack8f(x);
}
__device__ __forceinline__ void head128(bf16* p, const float* gain, bool rope, bool store, const float* cs, const float* sn, int lane, size_t woff = 0) {
    const int c16 = lane & 15;
    float x[8]; unpack8(*(const u32x4*)p, x);
    float ss = 0.f;
#pragma unroll
    for (int e = 0; e < 8; ++e) ss += x[e] * x[e];
    ss += __shfl_xor(ss, 1); ss += __shfl_xor(ss, 2); ss += __shfl_xor(ss, 4); ss += __shfl_xor(ss, 8);
    const float rstd = rsqrt_(ss * (1.f / 128.f) + EPS);
#pragma unroll
    for (int e = 0; e < 8; ++e) x[e] = x[e] * rstd * gain[8 * c16 + e];
    const int i0 = 8 * (c16 & 7);
#pragma unroll
    for (int e = 0; e < 8; ++e) { const float pr = __shfl_xor(x[e], 8); const float c = cs[i0 + e], s = sn[i0 + e];
        const float y = (c16 < 8) ? x[e] * c - pr * s : x[e] * c + pr * s; if (rope) x[e] = y; }
    if (store) *(u32x4*)((char*)p + woff) = pack8f(x);
}
struct PostP { const float *gaq, *gak, *gbq, *gbk, *fbias, *w2, *gb; };
__device__ __forceinline__ void post_row(Frame& F, const PostP& pp, int row, size_t woff) {
    int htid = get_tid(); const int h_lane = htid & 63, h_wave = __builtin_amdgcn_readfirstlane(htid >> 6);
    const int lane = h_lane, v = row % TP;
    if (v < PADF) return;
    const int t = v - PADF;
    bf16* zr = (bf16*)(WS() + WS_Z) + (size_t)row * DINP; float* zs = (float*)(WS() + WS_ZS) + (size_t)row * 256;
    const float* c128 = (const float*)(WS() + WS_COS128) + t * 64; const float* s128 = (const float*)(WS() + WS_SIN128) + t * 64;
    const float* c64 = (const float*)(WS() + WS_COS64) + t * 32; const float* s64 = (const float*)(WS() + WS_SIN64) + t * 32;
    const float* gaq = pp.gaq; const float* gak = pp.gak; const float* gbq = pp.gbq; const float* gbk = pp.gbk;
    head128(zr + 8 * lane, gaq, true, true, c128, s128, lane, woff);
    { bf16* kac = (bf16*)(WS() + WS_KAC) + (size_t)row * 128; bf16* vac = (bf16*)(WS() + WS_VAC) + (size_t)row * 128;
      bf16* dstp = (lane < 32) ? (bf16*)((char*)(zr + 512 + 8 * lane) + woff) : (lane < 48 ? kac + 8 * (lane - 32) : vac + 8 * (lane - 48));
      head128x(zr + 512 + 8 * lane, dstp, lane < 32 ? gaq : gak, true, lane >= 48, c128, s128, lane); }
#pragma unroll
    for (int j = 0; j < 2; ++j) { bf16* p = zr + C_IQ + 512 * j + 8 * lane; float x[8]; unpack8(*(const u32x4*)p, x); const int i0 = 8 * (lane & 3);
#pragma unroll
        for (int e = 0; e < 8; ++e) { const float pr = __shfl_xor(x[e], 4); const float c = c64[i0 + e], s = s64[i0 + e]; x[e] = (lane & 4) ? x[e] * c + pr * s : x[e] * c - pr * s; }
        *(u32x4*)((char*)p + woff) = pack8f(x); }
    head128(zr + C_BQ + 8 * lane, gbq, false, true, c128, s128, lane, woff);
    head128(zr + C_BQ + 512 + 8 * lane, lane < 32 ? gbq : gbk, false, true, c128, s128, lane, woff);
    head128(zr + C_BQ + 1024 + 8 * lane, gbk, false, true, c128, s128, lane, woff);
    { const float x = zs[S_IK + lane]; const float pr = __shfl_xor(x, 32); const int i = lane & 31; const float c = c64[i], s = s64[i];
      const float y = (lane < 32) ? x * c - pr * s : x * c + pr * s; const float yn = __shfl_xor(y, 1);
      if ((lane & 1) == 0) *(unsigned*)((bf16*)(WS() + WS_IKC) + (size_t)row * 64 + lane) = cvtpk(y, yn); }
    const float iwv = (lane < 16) ? zs[S_IW + lane] * 0.03125f : 0.f;
    const float lf = (lane < 6) ? logsigmoidf(zs[S_BF + lane] + pp.fbias[lane]) : 0.f;
    if (lane < 16) *(float*)((char*)(zs + S_IW + lane) + woff) = iwv;
    if (lane < 6) *(float*)((char*)(zs + S_BF + lane) + woff) = lf;
}
__device__ __forceinline__ void p_norm2(Frame& F, int l, const float* gain, const float* bg, const float* be, bool dup) {
    int htid = get_tid(); const int lane = htid & 63, wave = __builtin_amdgcn_readfirstlane(htid >> 6), g = lane >> 4, c16 = lane & 15;
    const int gw = F.bid * 8 + wave, NGW = F.G * 8;
    const float* H = (const float*)(WS() + WS_H); bf16* U = (bf16*)(WS() + WS_U);
    LAS float* lg = (LAS float*)(F.lds + wave * 4096); LAS float* rs = lg + 768;
    for (int rt = gw; rt < R / 16; rt += NGW) {
        const size_t row0 = (size_t)rt * 16; if ((int)(row0 % TP) < PADF) continue;
        const bf16* wr = (const bf16*)(WS() + WS_WR + l * SZ_WR);
        f32x4 acc[3] = {zero4(), zero4(), zero4()};
        const float* hrow = H + (row0 + c16) * DM + 8 * g;
        const bf16* wp0 = wr + (size_t)c16 * DM + 8 * g;
        float ss = 0.f;
#pragma unroll 4
        for (int ks = 0; ks < 64; ++ks) {
            const f32x4 a = *(const f32x4*)(hrow + 32 * ks), b = *(const f32x4*)(hrow + 32 * ks + 4);
            ss += (a[0] * a[0] + a[1] * a[1]) + (a[2] * a[2] + a[3] * a[3]) + (b[0] * b[0] + b[1] * b[1]) + (b[2] * b[2] + b[3] * b[3]);
            u32x4 hw; hw.x = cvtpk(a[0], a[1]); hw.y = cvtpk(a[2], a[3]); hw.z = cvtpk(b[0], b[1]); hw.w = cvtpk(b[2], b[3]);
            u32x4 lw; lw.x = cvtpk(a[0] - bflo(hw.x), a[1] - bfhi(hw.x)); lw.y = cvtpk(a[2] - bflo(hw.y), a[3] - bfhi(hw.y));
            lw.z = cvtpk(b[0] - bflo(hw.z), b[1] - bfhi(hw.z)); lw.w = cvtpk(b[2] - bflo(hw.w), b[3] - bfhi(hw.w));
            const bf16x8 Ah = *reinterpret_cast<const bf16x8*>(&hw), Al = *reinterpret_cast<const bf16x8*>(&lw);
#pragma unroll
            for (int ct = 0; ct < 3; ++ct) { const bf16* wp = wp0 + (size_t)(16 * ct) * DM + 32 * ks;
                const bf16x8 Bh = *(const bf16x8*)wp, Bl = *(const bf16x8*)(wp + (size_t)48 * DM);
                acc[ct] = __builtin_amdgcn_mfma_f32_16x16x32_bf16(Ah, Bh, acc[ct], 0, 0, 0);
                acc[ct] = __builtin_amdgcn_mfma_f32_16x16x32_bf16(Ah, Bl, acc[ct], 0, 0, 0);
                acc[ct] = __builtin_amdgcn_mfma_f32_16x16x32_bf16(Al, Bh, acc[ct], 0, 0, 0); } }
        ss += __shfl_xor(ss, 16); ss += __shfl_xor(ss, 32);
        if (g == 0) rs[c16] = rsqrt_(ss * (1.f / DM) + EPS);
#pragma unroll
        for (int ct = 0; ct < 3; ++ct)
#pragma unroll
            for (int r = 0; r < 4; ++r) lg[(4 * g + r) * 48 + 16 * ct + c16] = acc[ct][r];
        LDS_WAIT();
        if (lane < 16) { const size_t row = row0 + lane;
            const float rstd = rs[lane];
            float gl[4]; int gi = 0; float gm = -1e30f;
#pragma unroll
            for (int j = 0; j < 4; ++j) { gl[j] = lg[lane * 48 + j] * rstd + bg[j]; if (gl[j] > gm) { gm = gl[j]; gi = j; } }
            float gs = 0.f;
#pragma unroll
            for (int j = 0; j < 4; ++j) gs += fexp_(gl[j] - gm);
            const float gp = 1.f / gs;
            float el[8]; int e0 = 0, e1 = 0; float m0 = -1e30f, m1 = -1e30f;
#pragma unroll
            for (int j = 0; j < 8; ++j) el[j] = lg[lane * 48 + 4 + 8 * gi + j] * rstd + be[8 * gi + j];
#pragma unroll
            for (int j = 0; j < 8; ++j) { if (el[j] > m0) { m1 = m0; e1 = e0; m0 = el[j]; e0 = j; } else if (el[j] > m1) { m1 = el[j]; e1 = j; } }
            const float w1r = fexp_(m1 - m0); const float p0 = 1.f / (1.f + w1r), p1 = w1r / (1.f + w1r);
            unsigned* cnt = CTL() + CW_CNT + 1024 * l + (dup ? 16 : 0); unsigned* list = (unsigned*)(WS() + (dup ? WS_END : WS_LIST)); float* gate = (float*)(WS() + WS_GATE);
            const int x0 = gi * 8 + e0, x1 = gi * 8 + e1;
            const unsigned i0 = atomicAdd(cnt + 32 * x0, 1u), i1 = atomicAdd(cnt + 32 * x1, 1u);
            list[(size_t)x0 * R + i0] = (unsigned)row * 2u; list[(size_t)x1 * R + i1] = (unsigned)row * 2u + 1u;
            gate[row * 2] = gp * p0; gate[row * 2 + 1] = gp * p1; }
        LDS_WAIT();
    }
    for (int row = gw; row < R; row += NGW) { if ((row % TP) < PADF) continue;
        f32x4 x[8]; float ss = 0.f;
#pragma unroll
        for (int j = 0; j < 8; ++j) { x[j] = *(const f32x4*)(H + (size_t)row * DM + 4 * (lane + 64 * j)); ss += x[j][0] * x[j][0] + x[j][1] * x[j][1] + x[j][2] * x[j][2] + x[j][3] * x[j][3]; }
        ss = wave_sum(ss); const float rstd = rsqrt_(ss * (1.f / DM) + EPS);
#pragma unroll
        for (int j = 0; j < 8; ++j) { const int col = 4 * (lane + 64 * j); const f32x4 gg = *(const f32x4*)(gain + col);
            u32x2 w; w.x = cvtpk(x[j][0] * rstd * gg[0], x[j][1] * rstd * gg[1]); w.y = cvtpk(x[j][2] * rstd * gg[2], x[j][3] * rstd * gg[3]);
            *(u32x2*)(U + (size_t)row * DM + col) = w; } }
}
__device__ __forceinline__ void build_moetab(Frame& F, int l) {
    int htid = get_tid(); const int h_lane = htid & 63, h_wave = __builtin_amdgcn_readfirstlane(htid >> 6);
    LAS pg8::MoeTab* tab = (LAS pg8::MoeTab*)(F.lds + MOETAB_OFF);
    if (htid == 0) { int t = 0; const unsigned* cnt = CTL() + CW_CNT + 1024 * l;
        for (int e = 0; e < NEXP; ++e) { const int n = (int)__hip_atomic_load(cnt + 32 * e, __ATOMIC_RELAXED, __HIP_MEMORY_SCOPE_AGENT); tab->cnt[e] = n;
            for (int j = 0; j * 256 < n && t < 176; ++j) { tab->e[t] = e; tab->r0[t] = j * 256; ++t; } }
        tab->ntiles = t; }
    __syncthreads();
}

#define INPARG(i) args_in_dyn(args, (i))
constexpr int NPH = 2 + 9 * DEPTH;
struct Args { const float* in[21]; float* out; unsigned char* ws; int ph_lo, ph_hi; };
#define PHASE_FN static __device__ __forceinline__
#define MKFRAME Frame F; F.lds = lds; F.ldsg = (char*)lds; F.tid = 0; F.lane = 0; F.wave = 0; F.G = (int)gridDim.x; F.bid = (int)blockIdx.x
#define Z ((bf16*)(WS() + WS_Z))
#define ZS ((float*)(WS() + WS_ZS))
#define MIX ((bf16*)(WS() + WS_MIX))
#define U ((bf16*)(WS() + WS_U))
#define LA ((float*)(WS() + WS_LA))
#define KV ((float*)(WS() + WS_KV))
#define DVEC ((float*)(WS() + WS_DVEC))
#define SS ((float*)(WS() + WS_SS))
PHASE_FN void ph_prologue(LAS unsigned char* lds) { MKFRAME; p_prologue(F, INP(4), INP(13), INP(18), INP(19), INP(20), INP(14), INP(16), INP(3)); }
PHASE_FN void ph_norm1(LAS unsigned char* lds, int l, size_t woff) { MKFRAME; p_norm1(F, l, INP(0), INP(1), INP(2) + (size_t)l * DM, woff); }
PHASE_FN void ph_inproj(LAS unsigned char* lds, int l) { MKFRAME;
    pg8::DenseProb P; P.init(U, WS() + WS_WIN + l * SZ_WIN, 64 * 256, DINP, DM, F.G, F.bid);
    pg8::EpiInProj E{Z, ZS};
    pg8::gemm_phase(F.lds, P, E);
    skinny_gemm<0>(F.lds, U, (const bf16*)(WS() + WS_WIN + l * SZ_WIN), DM, DINP, F.bid, Z, ZS, nullptr);
}
PHASE_FN void ph_post(LAS unsigned char* lds, int l, size_t woff) { MKFRAME;
    PostP pp{INP(5) + l * 128, INP(6) + l * 128, INP(7) + l * 128, INP(8) + l * 128, INP(9) + l * 6, INP(10) + (size_t)l * 16 * 256, INP(11) + l * 256};
    for (int u = F.bid; u < (R / 64) * 4; u += F.G) gla::step1(F.lds, Z, ZS, LA, INP(10) + (size_t)l * 16 * 256, INP(11) + l * 256, KV, DVEC, (u >> 2) / 65, (u >> 2) % 65, u & 3);
    { const int gw = F.bid * 8 + (get_tid() >> 6);
      for (int row = gw; row < R; row += F.G * 8) post_row(F, pp, row, woff); }
}
#ifndef MIXM
#define MIXM 15
#endif
PHASE_FN void ph_mix(LAS unsigned char* lds, int l, int rep) { MKFRAME;
    volatile LAS unsigned* MISC = (volatile LAS unsigned*)(F.lds + MISC_OFF);
    if ((MIXM & 1) && F.bid < 64) gla::step2(KV, DVEC, SS, F.bid);
    if (MIXM & 2) { for (int it = F.G - 1 - F.bid; it < 192; it += F.G) fox::item(F.ldsg, Z, ZS, MIX, it); }
    if ((MIXM & 4) && F.bid < NB) fox::meta_unit(Z, ZS, MIX, F.bid);
    __syncthreads();
    unsigned nq = 0u; const bool t0 = (get_tid() == 0);
    unsigned* qhead = CTL() + CW_QUEUE + 64 * l + 32 * rep;
    if (t0) nq = atomicAdd(qhead, 1u);
    for (; MIXM & 8;) {
        if (t0) MISC[0] = nq;
        __syncthreads();
        const int q = (int)MISC[0];
        __syncthreads();
        if (q >= 65 * 32) break;
        if (t0) nq = atomicAdd(qhead, 1u);
        const int c = 64 - q / 32, b = (q % 32) / 8, sub = q % 8;
        if (c == 0 && sub < 6) continue;
        dsa::unit(F.lds, Z, ZS, (const bf16*)(WS() + WS_IKC), (const bf16*)(WS() + WS_KAC), (const bf16*)(WS() + WS_VAC), MIX, b, c, sub);
    }
}
PHASE_FN void ph_gla3(LAS unsigned char* lds, int l) { MKFRAME;
    for (int u = F.bid; u < (R / 64) * 4; u += F.G) gla::step3(F.lds, Z, LA, SS, INP(12) + l * 128, MIX, (u >> 2) / 65, (u >> 2) % 65, u & 3);
}
PHASE_FN void ph_outproj(LAS unsigned char* lds, int l, size_t woff) { MKFRAME;
    pg8::DenseProb P; P.init(MIX, WS() + WS_WOUT + l * SZ_WOUT, 64 * 256, DM, DM, F.G, F.bid);
    pg8::EpiOutProj E{(float*)(WS() + WS_H + woff)};
    pg8::gemm_phase(F.lds, P, E);
    skinny_gemm<1>(F.lds, MIX, (const bf16*)(WS() + WS_WOUT + l * SZ_WOUT), DM, DM, F.bid, nullptr, nullptr, (float*)(WS() + WS_H + woff));
}
PHASE_FN void ph_norm2(LAS unsigned char* lds, int l, bool dup) { MKFRAME;
    p_norm2(F, l, INP(3) + (size_t)l * DM, INP(15) + l * 4, INP(17) + l * 32, dup);
}
PHASE_FN void ph_moeup(LAS unsigned char* lds, int l) { MKFRAME;
    build_moetab(F, l);
    pg8::MoeProb<true> P; P.K = DM; P.lda = DM; P.A = (const char*)U; P.W = (const char*)(WS() + WS_W13 + l * SZ_W13); P.list = (const unsigned*)(WS() + WS_LIST);
    P.tab = (const LAS pg8::MoeTab*)(F.lds + MOETAB_OFF); P.G = F.G; P.c = F.bid;
    pg8::EpiMoeUp E{(bf16*)(WS() + WS_HID)};
    pg8::gemm_phase(F.lds, P, E);
}
PHASE_FN void ph_moedown(LAS unsigned char* lds, int l) { MKFRAME;
    build_moetab(F, l);
    pg8::MoeProb<false> P; P.K = DEXP; P.lda = DEXP; P.A = (const char*)(WS() + WS_HID); P.W = (const char*)(WS() + WS_W2 + l * SZ_W2); P.list = (const unsigned*)(WS() + WS_LIST);
    P.tab = (const LAS pg8::MoeTab*)(F.lds + MOETAB_OFF); P.G = F.G; P.c = F.bid;
    pg8::EpiMoeDown E{(bf16*)(WS() + WS_Y0), (bf16*)(WS() + WS_Y1), (const unsigned*)(WS() + WS_LIST), (const float*)(WS() + WS_GATE), (const LAS pg8::MoeTab*)(F.lds + MOETAB_OFF)};
    pg8::gemm_phase(F.lds, P, E);
}
PHASE_FN void ph_final(LAS unsigned char* lds) { MKFRAME; p_final(F); }
#undef Z
#undef ZS
#undef MIX
#undef U
#undef LA
#undef KV
#undef DVEC
#undef SS

__device__ __forceinline__ const float* args_in_dyn(const Args& a, int i) { const float* p = a.in[0];
#pragma unroll
    for (int k = 1; k < 21; ++k) p = (i == k) ? a.in[k] : p;
    return p; }
__global__ void __launch_bounds__(512, 2) fwd_kernel(Args args) {
    extern __shared__ __attribute__((aligned(16))) unsigned char lds_raw[];
    LAS unsigned char* lds = (LAS unsigned char*)lds_raw;
    const int tid = threadIdx.x;
    if ((tid & 63) == 0) *(volatile LAS unsigned*)(uintptr_t)(WAVETAB_OFF + 4 * ((unsigned)__builtin_amdgcn_s_getreg((5 << 11) | 4) & 63u)) = (unsigned)tid >> 6;
    if (tid < 23) { const unsigned long long v = (tid < 21) ? (unsigned long long)INPARG(tid) : (tid == 21 ? (unsigned long long)args.out : (unsigned long long)args.ws);
        LAS unsigned* t = (LAS unsigned*)(lds + PTAB_OFF) + 2 * tid; t[0] = (unsigned)v; t[1] = (unsigned)(v >> 32); }
    volatile LAS unsigned* MISC = (volatile LAS unsigned*)(lds + MISC_OFF);
    for (int u = tid; u < 256; u += 512) ((LAS unsigned*)(lds + LDSCTL_OFF))[u] = 0u;
    __syncthreads();
    const int lo = args.ph_lo, hi = args.ph_hi;
    const bool multi = (hi - lo) > 1;
    unsigned* barw = (unsigned*)(args.ws + WS_CTL) + CW_BAR;
    XcdBarrier bar; bar.bar = barw; bar.x = 0; bar.st = nullptr;
    if (multi) bar = xcd_barrier_post(barw, MISC + 8);
#define IN(k) (lo <= (k) && (k) < hi)
#define SEAM(k) do { if (IN(k) && IN((k) + 1)) xcd_barrier(bar); } while (0)
#ifndef DUP_MASK
#define DUP_MASK 0
#endif
#define NREP(ty) (((DUP_MASK >> (ty)) & 1) ? 2 : 1)
#define REPBAR(rep, ty) do { if ((rep) + 1 < NREP(ty) && multi) xcd_barrier(bar); } while (0)
    constexpr size_t DUPOFF = (size_t)774000128;
    for (int rep = 0; rep < NREP(0); ++rep) { if (IN(0)) ph_prologue(lds); REPBAR(rep, 0); }
    SEAM(0);
    for (int l = 0; l < DEPTH; ++l) {
        const int pb = 1 + 9 * l;
        for (int rep = 0; rep < NREP(1); ++rep) { if (IN(pb + 0)) ph_norm1(lds, l, rep ? DUPOFF : 0); REPBAR(rep, 1); }   SEAM(pb + 0);
        for (int rep = 0; rep < NREP(2); ++rep) { if (IN(pb + 1)) ph_inproj(lds, l); REPBAR(rep, 2); }  SEAM(pb + 1);
        for (int rep = 0; rep < NREP(3); ++rep) { if (IN(pb + 2)) ph_post(lds, l, rep ? DUPOFF : 0); REPBAR(rep, 3); }    SEAM(pb + 2);
        for (int rep = 0; rep < NREP(4); ++rep) { if (IN(pb + 3)) ph_mix(lds, l, rep); REPBAR(rep, 4); }     SEAM(pb + 3);
        for (int rep = 0; rep < NREP(5); ++rep) { if (IN(pb + 4)) ph_gla3(lds, l); REPBAR(rep, 5); }    SEAM(pb + 4);
        for (int rep = 0; rep < NREP(6); ++rep) { if (IN(pb + 5)) ph_outproj(lds, l, rep ? DUPOFF : 0); REPBAR(rep, 6); } SEAM(pb + 5);
        for (int rep = 0; rep < NREP(7); ++rep) { if (IN(pb + 6)) ph_norm2(lds, l, rep != 0); REPBAR(rep, 7); }   SEAM(pb + 6);
        for (int rep = 0; rep < NREP(8); ++rep) { if (IN(pb + 7)) ph_moeup(lds, l); REPBAR(rep, 8); }   SEAM(pb + 7);
        for (int rep = 0; rep < NREP(9); ++rep) { if (IN(pb + 8)) ph_moedown(lds, l); REPBAR(rep, 9); } SEAM(pb + 8);
    }
    if (IN(NPH - 1)) ph_final(lds);
#undef IN
#undef SEAM
}

extern "C" void kernel_launch(void* const* d_in, const int* in_sizes, int n_in, void* d_out, int out_size, void* d_ws, size_t ws_size, hipStream_t stream) {
    static int grid = 0;
    if (grid == 0) {
        if (n_in != 21 || out_size != NB * SEQ * DM || ws_size < (DUP_MASK ? (size_t)2147483648u : WS_END)) { fprintf(stderr, "kernel_launch: unexpected shapes (n_in %d out %d ws %zu need %zu)\n", n_in, out_size, ws_size, (size_t)WS_END); grid = -1; return; }
        int dev = 0, cus = 0, per_cu = 0;
        if (hipGetDevice(&dev) != hipSuccess || hipDeviceGetAttribute(&cus, hipDeviceAttributeMultiprocessorCount, dev) != hipSuccess) { grid = -1; return; }
        if (hipFuncSetAttribute((const void*)fwd_kernel, hipFuncAttributeMaxDynamicSharedMemorySize, LDS_BYTES) != hipSuccess) { fprintf(stderr, "kernel_launch: hipFuncSetAttribute failed\n"); grid = -1; return; }
        if (hipOccupancyMaxActiveBlocksPerMultiprocessor(&per_cu, (const void*)fwd_kernel, 512, LDS_BYTES) != hipSuccess || per_cu < 1) fprintf(stderr, "kernel_launch: occupancy query says %d\n", per_cu);
        (void)hipGetLastError();
        grid = cus;
    }
    if (grid < 0) return;
    (void)hipMemsetAsync((char*)d_ws + WS_CTL, 0, CTL_ZERO_BYTES, stream);
    Args a{};
    for (int i = 0; i < 21; ++i) a.in[i] = (const float*)d_in[i];
    a.out = (float*)d_out; a.ws = (unsigned char*)d_ws;
#if MK_N_LAUNCHES == 1
    a.ph_lo = 0; a.ph_hi = NPH;
    hipLaunchKernelGGL(fwd_kernel, dim3(grid), dim3(512), LDS_BYTES, stream, a);
#else
    for (int p = 0; p < NPH; ++p) { a.ph_lo = p; a.ph_hi = p + 1; hipLaunchKernelGGL(fwd_kernel, dim3(grid), dim3(512), LDS_BYTES, stream, a); }
#endif
}
```

```cpp
#include <hip/hip_runtime.h>
#include <cstdio>
#include <cstdint>

#ifndef MK_N_LAUNCHES
#define MK_N_LAUNCHES 1
#endif

#define GAS __attribute__((address_space(1)))
#define LAS __attribute__((address_space(3)))
typedef unsigned short bf16;
typedef unsigned u32x4 __attribute__((ext_vector_type(4)));
typedef unsigned u32x2 __attribute__((ext_vector_type(2)));
typedef float f32x4 __attribute__((ext_vector_type(4)));
typedef float f32x2 __attribute__((ext_vector_type(2)));
typedef float f32x16 __attribute__((ext_vector_type(16)));
typedef short bf16x8 __attribute__((ext_vector_type(8)));
typedef short s16x4 __attribute__((ext_vector_type(4)));
#define LDS_WAIT() asm volatile("s_waitcnt lgkmcnt(0)" ::: "memory")
#define VM_WAIT() asm volatile("s_waitcnt vmcnt(0)" ::: "memory")

constexpr int NB = 4, SEQ = 4096, NMETA = 16, TT = SEQ + NMETA;
constexpr int PADF = 48, TP = 4160;
constexpr int R = NB * TP;
constexpr int DM = 2048, DEPTH = 4;
constexpr int DIN = 5990, DINP = 6144;
constexpr int NEXP = 32, DEXP = 512;
constexpr float EPS = 1e-6f;
constexpr int C_AQ = 0, C_AK = 768, C_AV = 896, C_IQ = 1024, C_BQ = 2048, C_BK = 2816, C_BV = 3584, C_CQ = 4352, C_CK = 4608, C_CV = 4864, C_CG = 5376, C_IK = 5888;
constexpr int S_IK = 0, S_IW = 64, S_BF = 80, S_CR = 86;

constexpr size_t al256(size_t x) { return (x + 255) & ~(size_t)255; }
constexpr size_t WS_CTL = 0, CTL_ZERO_BYTES = 1u << 20;
constexpr size_t WS_COS128 = WS_CTL + CTL_ZERO_BYTES;
constexpr size_t WS_SIN128 = WS_COS128 + al256((size_t)TT * 64 * 4);
constexpr size_t WS_COS64 = WS_SIN128 + al256((size_t)TT * 64 * 4);
constexpr size_t WS_SIN64 = WS_COS64 + al256((size_t)TT * 32 * 4);
constexpr size_t WS_WIN = WS_SIN64 + al256((size_t)TT * 32 * 4);
constexpr size_t SZ_WIN = (size_t)DINP * DM * 2;
constexpr size_t WS_WOUT = WS_WIN + DEPTH * SZ_WIN;
constexpr size_t SZ_WOUT = (size_t)DM * DM * 2;
constexpr size_t WS_W13 = WS_WOUT + DEPTH * SZ_WOUT;
constexpr size_t SZ_W13E = (size_t)1024 * DM * 2, SZ_W13 = NEXP * SZ_W13E;
constexpr size_t WS_W2 = WS_W13 + DEPTH * SZ_W13;
constexpr size_t SZ_W2E = (size_t)DM * DEXP * 2, SZ_W2 = NEXP * SZ_W2E;
constexpr size_t WS_WR = WS_W2 + DEPTH * SZ_W2;
constexpr size_t SZ_WR = (size_t)2 * 48 * DM * 2;
constexpr size_t WS_H = WS_WR + DEPTH * SZ_WR;
constexpr size_t WS_U = WS_H + (size_t)R * DM * 4;
constexpr size_t WS_Z = WS_U + (size_t)R * DM * 2;
constexpr size_t WS_ZS = WS_Z + (size_t)R * DINP * 2;
constexpr size_t WS_LA = WS_ZS + (size_t)R * 256 * 4;
constexpr size_t WS_MIX = WS_LA + (size_t)R * 256 * 4;
constexpr int HID_TILES = 168;
constexpr size_t WS_HID = WS_MIX + (size_t)R * DM * 2;
constexpr size_t WS_Y0 = WS_HID + (size_t)HID_TILES * 256 * DEXP * 2;
constexpr size_t WS_Y1 = WS_Y0 + (size_t)R * DM * 2;
constexpr size_t WS_KV = WS_Y1 + (size_t)R * DM * 2;
constexpr size_t WS_DVEC = WS_KV + (size_t)16 * 65 * 64 * 128 * 4;
constexpr size_t WS_SS = WS_DVEC + al256((size_t)16 * 65 * 64 * 4);
constexpr size_t WS_LIST = WS_SS + (size_t)16 * 66 * 64 * 128 * 4;
constexpr size_t WS_GATE = WS_LIST + (size_t)NEXP * R * 4;
constexpr size_t WS_IKC = WS_GATE + (size_t)R * 2 * 4;
constexpr size_t WS_KAC = WS_IKC + (size_t)R * 64 * 2;
constexpr size_t WS_VAC = WS_KAC + (size_t)R * 128 * 2;
constexpr size_t WS_END = WS_VAC + (size_t)R * 128 * 2;

constexpr int CW_BAR = 4096;
constexpr int CW_CNT = 16384;
constexpr int CW_QUEUE = 20480;

constexpr int RING_BYTES = 131072;
constexpr int MOETAB_OFF = 131072;
constexpr int LDSCTL_OFF = 143360, MISC_OFF = LDSCTL_OFF + 320;
constexpr int LDS_BYTES = 147456;

constexpr int WAVETAB_OFF = LDSCTL_OFF + 1536;
__device__ __forceinline__ int get_tid() {
    const unsigned slot = (unsigned)__builtin_amdgcn_s_getreg((5 << 11) | 4) & 63u;
    const unsigned w = *(volatile LAS unsigned*)(uintptr_t)(WAVETAB_OFF + 4 * slot);
    unsigned lane; asm volatile("v_mbcnt_lo_u32_b32 %0, -1, 0\n\tv_mbcnt_hi_u32_b32 %0, -1, %0" : "=v"(lane));
    return (int)((unsigned)__builtin_amdgcn_readfirstlane(w) * 64u + lane);
}
typedef __bf16 bf16x2_t __attribute__((ext_vector_type(2)));
__device__ __forceinline__ unsigned cvtpk(float lo, float hi) { const bf16x2_t v = __builtin_convertvector((f32x2){lo, hi}, bf16x2_t); return __builtin_bit_cast(unsigned, v); }
__device__ __forceinline__ float bf2f(unsigned short b) { return __uint_as_float(((unsigned)b) << 16); }
__device__ __forceinline__ float bflo(unsigned w) { return __uint_as_float(w << 16); }
__device__ __forceinline__ float bfhi(unsigned w) { return __uint_as_float(w & 0xffff0000u); }
__device__ __forceinline__ bf16 f2bf(float f) { return (bf16)(cvtpk(f, 0.f) & 0xffffu); }
__device__ __forceinline__ float wave_sum(float v) {
#pragma unroll
    for (int o = 1; o < 64; o <<= 1) v += __shfl_xor(v, o);
    return v;
}
__device__ __forceinline__ f32x4 zero4() { float z = 0.f; asm volatile("" : "+v"(z)); return (f32x4){z, z, z, z}; }
__device__ __forceinline__ float logsigmoidf(float x) { const float e = __builtin_amdgcn_exp2f(-fabsf(x) * 1.4426950408889634f); return fminf(x, 0.f) - __builtin_amdgcn_logf(1.0f + e) * 0.6931471805599453f; }
__device__ __forceinline__ float fexp_(float x) { return __builtin_amdgcn_exp2f(x * 1.4426950408889634f); }
__device__ __forceinline__ float rsqrt_(float x) { return __builtin_amdgcn_rsqf(x); }
__device__ __forceinline__ float siluf(float x) { return x * __builtin_amdgcn_rcpf(1.f + __builtin_amdgcn_exp2f(-x * 1.4426950408889634f)); }

#define XB_TMO      128
#define XB_XCNT(j)  (256  + 64 * (j))
#define XB_XSUB(j)  (1280 + 64 * (j))
#define XB_XGEN(j)  (2304 + 64 * (j))
#define XB_TOP      3328
#define XB_TOPGEN   3392
#define XCD_BAR_WORDS 3456
#define XB_SPIN_CAP (1u << 18)
__device__ __forceinline__ unsigned xb_ld(unsigned* p)              { return __hip_atomic_load(p, __ATOMIC_RELAXED, __HIP_MEMORY_SCOPE_AGENT); }
__device__ __forceinline__ unsigned xb_add(unsigned* p, unsigned v) { return __hip_atomic_fetch_add(p, v, __ATOMIC_RELAXED, __HIP_MEMORY_SCOPE_AGENT); }
__device__ __forceinline__ unsigned xb_xcc_id() { return (unsigned)__builtin_amdgcn_s_getreg((3 << 11) | 20) & 0xFu; }
#define XB_SPIN(cond, bar) do { unsigned _sp = 0; while (cond) { __builtin_amdgcn_s_sleep(1); \
    if ((++_sp & 255u) == 0u) { if (xb_ld(&(bar)[XB_TMO])) break; if (_sp > XB_SPIN_CAP) { atomicAdd(&(bar)[XB_TMO], 1u); break; } } } } while (0)
struct XcdBarrier { unsigned* bar; unsigned x; volatile LAS unsigned* st; };
__device__ __forceinline__ XcdBarrier xcd_barrier_post(unsigned* bar, volatile LAS unsigned* st) {
    XcdBarrier b; b.bar = bar; b.x = xb_xcc_id(); b.st = st;
    if (get_tid() == 0) (void)xb_add(&bar[XB_XCNT(b.x)], 1u);
    return b;
}
__device__ __forceinline__ void xcd_barrier_complete(unsigned* bar, unsigned x, unsigned& nloc, unsigned& nx) {
    const unsigned G = gridDim.x * gridDim.y * gridDim.z;
    unsigned sum, cnt, mine, sp = 0u;
    for (;;) {
        sum = 0u; cnt = 0u; mine = 0u;
#pragma unroll
        for (unsigned j = 0; j < 16; ++j) { const unsigned c = xb_ld(&bar[XB_XCNT(j)]); sum += c; cnt += (c > 0u) ? 1u : 0u; mine = (j == x) ? c : mine; }
        if (sum == G) break;
        __builtin_amdgcn_s_sleep(1);
        if ((++sp & 255u) == 0u) { if (xb_ld(&bar[XB_TMO])) break; if (sp > XB_SPIN_CAP) { atomicAdd(&bar[XB_TMO], 1u); break; } }
    }
    nloc = mine > 0u ? mine : 1u; nx = cnt > 0u ? cnt : 1u;
}
__device__ __forceinline__ void xcd_barrier(const XcdBarrier& b) {
    asm volatile("s_waitcnt vmcnt(0)" ::: "memory");
    __syncthreads();
    if (get_tid() == 0) {
        unsigned* bar = b.bar; unsigned bx = b.x;
        asm volatile("" : "+s"(bar), "+s"(bx));
        __builtin_amdgcn_s_waitcnt(0);
        unsigned nloc = b.st[0], nx = b.st[1];
        if (nloc == 0u) { xcd_barrier_complete(bar, bx, nloc, nx); b.st[0] = nloc; b.st[1] = nx; }
        const unsigned old = xb_add(&bar[XB_XSUB(bx)], 1u);
        const unsigned gen = old / nloc;
        if (old + 1u == (gen + 1u) * nloc) {
            __builtin_amdgcn_fence(__ATOMIC_RELEASE, "agent");
            asm volatile("s_waitcnt vmcnt(0)" ::: "memory");
            const unsigned og = xb_add(&bar[XB_TOP], 1u);
            const unsigned tg = og / nx;
            if (og + 1u == (tg + 1u) * nx) xb_add(&bar[XB_TOPGEN], 1u);
            else XB_SPIN(xb_ld(&bar[XB_TOPGEN]) == tg, bar);
            __builtin_amdgcn_fence(__ATOMIC_ACQUIRE, "agent");
            xb_add(&bar[XB_XGEN(bx)], 1u);
            asm volatile("s_waitcnt vmcnt(0)" ::: "memory");
        } else {
            XB_SPIN(xb_ld(&bar[XB_XGEN(bx)]) == gen, bar);
            __builtin_amdgcn_fence(__ATOMIC_ACQUIRE, "agent");
            asm volatile("s_waitcnt vmcnt(0)" ::: "memory");
        }
    }
    __syncthreads();
}

namespace pg8 {
constexpr int BM = 256, BK = 64, HALF = 128, HTB = HALF * BK * 2, STAGE_BYTES = 8 * HTB;
__host__ __device__ __forceinline__ int lds_byte(int r, int c) { const int st = (r >> 4) * 2 + (c >> 5), rr = r & 15, cc = c & 31, ob = rr * 64 + cc * 2; return st * 1024 + (ob ^ (((ob >> 9) & 1) << 5)); }
__host__ __device__ __forceinline__ void stage_rc(int b, int& Rr, int& C) { const int st = b / 1024, sb = b % 1024, swz = sb ^ (((sb >> 9) & 1) << 5); Rr = (st >> 1) * 16 + swz / 64; C = (st & 1) * 32 + (swz % 64) / 2; }
__host__ __device__ __forceinline__ int perm32(int rho) { const int n = rho >> 4, i = rho & 15; return 8 * (i >> 2) + 4 * n + (i & 3); }
struct Unit { int pm, pn, e, r0; };

template <class Epi, class Prob>
__device__ __forceinline__ void gemm_phase(LAS unsigned char* lds, const Prob& P, const Epi& E) {
    int tid = get_tid();
    const int wid = __builtin_amdgcn_readfirstlane(tid >> 6), lane = tid & 63, wr = wid >> 2, wc = wid & 3, fr = lane & 15, fq = lane >> 4;
    const int K = P.K, nt = K / BK;
    unsigned voffB;
    { int Rr, C; stage_rc(tid * 16, Rr, C); const int Rb = Epi::PERM ? ((Rr & ~31) + perm32(Rr & 31)) : Rr; voffB = (unsigned)(Rb * K + C) * 2u; }
    const size_t hstep = (size_t)HALF * K * 2, qstepB = (size_t)64 * K * 2;
    const unsigned ldsw = (unsigned)wid * 1024u;
    const int aoff = lds_byte(wr * 64 + fr, fq * 8), boff = lds_byte(wc * 32 + fr, fq * 8);
#define PG8_SA(b, h) (((b) * 2 + (h)) * HTB)
#define PG8_SB(b, h) ((4 + (b) * 2 + (h)) * HTB)
#define PG8_STAGE1(bufoff, gbase, voff, qstep) do { _Pragma("unroll") for (int _i = 0; _i < 2; ++_i) \
        __builtin_amdgcn_global_load_lds((const unsigned*)((const char*)(gbase) + (size_t)_i * (qstep) + (voff)), (LAS unsigned*)(lds + (bufoff) + ldsw + _i * 8192), 16, 0, 0); } while (0)
#define PG8_STAGE2(bufoff, gbase, voff) do { _Pragma("unroll") for (int _i = 0; _i < 2; ++_i) \
        __builtin_amdgcn_global_load_lds((const unsigned*)((const char*)(gbase) + (voff)[_i]), (LAS unsigned*)(lds + (bufoff) + ldsw + _i * 8192), 16, 0, 0); } while (0)
#define PG8_STB(bufoff, gbase) PG8_STAGE1(bufoff, gbase, voffB, qstepB)
#define PG8_STA(bufoff, gbase, h) do { if constexpr (GA) PG8_STAGE2(bufoff, gbase, ao[h]); else PG8_STAGE1(bufoff, (gbase) + (size_t)(h) * hstepA, ao[0][0], qstepA); } while (0)
#define PG8_LDA(dst, b, h) do { _Pragma("unroll") for (int m = 0; m < 4; ++m) _Pragma("unroll") for (int k = 0; k < 2; ++k) dst[m][k] = *(const LAS bf16x8*)(lds + PG8_SA(b, h) + aoff + m * 2048 + k * 1024); } while (0)
#define PG8_LDB(dst, b, h) do { _Pragma("unroll") for (int n = 0; n < 2; ++n) _Pragma("unroll") for (int k = 0; k < 2; ++k) dst[n][k] = *(const LAS bf16x8*)(lds + PG8_SB(b, h) + boff + n * 2048 + k * 1024); } while (0)
#define PG8_MMA(ai, bj, At, Bt) do { __builtin_amdgcn_s_setprio(1); _Pragma("unroll") for (int m = 0; m < 4; ++m) _Pragma("unroll") for (int n = 0; n < 2; ++n) _Pragma("unroll") for (int k = 0; k < 2; ++k) \
        acc[ai][bj][m][n] = __builtin_amdgcn_mfma_f32_16x16x32_bf16(Bt[n][k], At[m][k], acc[ai][bj][m][n], 0, 0, 0); __builtin_amdgcn_s_setprio(0); } while (0)
#define PG8_WAIT_V(n) asm volatile("s_waitcnt vmcnt(" #n ")" ::: "memory")
#define PG8_WAIT_L(n) asm volatile("s_waitcnt lgkmcnt(" #n ")" ::: "memory")
#define PG8_BAR __builtin_amdgcn_s_barrier()
#define PG8_SCHED __builtin_amdgcn_sched_barrier(0)
    Unit cur, nxt; int ui = 0;
    if (!P.next(0, cur)) return;
    constexpr bool GA = Prob::GATHER;
    unsigned ao[2][2]; const size_t hstepA = (size_t)HALF * P.lda * 2, qstepA = (size_t)64 * P.lda * 2;
    const char* cA = P.abase();
    if constexpr (GA) P.aoffs(cur, tid, ao);
    else { ao[0][0] = P.aoffs0(tid); cA += P.aunit(cur); }
    const char* cB = P.bptr(cur);
    const size_t kstep = (size_t)(BK * 2);
    PG8_STB(PG8_SB(0, 0), cB); PG8_STB(PG8_SB(0, 1), cB + hstep); PG8_STA(PG8_SA(0, 0), cA, 0); PG8_STA(PG8_SA(0, 1), cA, 1);
    if (wr == 1) PG8_BAR;
    PG8_WAIT_V(2); PG8_BAR;
    PG8_STB(PG8_SB(1, 0), cB + kstep); PG8_STA(PG8_SA(1, 0), cA + kstep, 0); PG8_STB(PG8_SB(1, 1), cB + hstep + kstep);
    PG8_WAIT_V(6); PG8_BAR;
    f32x4 acc[2][2][4][2];
#pragma unroll
    for (int a = 0; a < 2; ++a)
#pragma unroll
        for (int b = 0; b < 2; ++b)
#pragma unroll
            for (int m = 0; m < 4; ++m)
#pragma unroll
                for (int n = 0; n < 2; ++n) acc[a][b][m][n] = zero4();
    bf16x8 At[4][2], B0[2][2], B1[2][2];
    for (;;) {
        const bool has_next = P.next(ui + 1, nxt);
        const char* nB = has_next ? P.bptr(nxt) : cB;
        const char* nA = (has_next && !GA) ? P.abase() + P.aunit(nxt) : cA;
        for (int t = 0; t < nt; t += 2) {
            const bool last = (t == nt - 2);
            const char* a1 = cA + (size_t)(t + 1) * kstep;
            const char* a2 = last ? nA : cA + (size_t)(t + 2) * kstep; const char* b2 = last ? nB : cB + (size_t)(t + 2) * kstep;
            const char* a3 = a2 + kstep; const char* b3 = b2 + kstep;
            PG8_LDB(B0, 0, 0); PG8_LDB(B1, 0, 1); PG8_SCHED; PG8_LDA(At, 0, 0); PG8_STA(PG8_SA(1, 1), a1, 1);
            if constexpr (GA) { if (last && has_next) P.aoffs(nxt, tid, ao); }
            PG8_WAIT_V(8); PG8_WAIT_L(0); PG8_BAR; PG8_MMA(0, 0, At, B0); PG8_MMA(0, 1, At, B1); PG8_BAR; PG8_SCHED;
            PG8_LDA(At, 0, 1); PG8_STB(PG8_SB(0, 0), b2); PG8_STB(PG8_SB(0, 1), b2 + hstep); PG8_STA(PG8_SA(0, 0), a2, 0);
            PG8_WAIT_V(8); PG8_WAIT_L(0); PG8_BAR; PG8_MMA(1, 0, At, B0); PG8_MMA(1, 1, At, B1); PG8_BAR; PG8_SCHED;
            PG8_LDB(B0, 1, 0); PG8_LDB(B1, 1, 1); PG8_SCHED; PG8_LDA(At, 1, 0); PG8_STA(PG8_SA(0, 1), a2, 1);
            PG8_WAIT_V(8); PG8_WAIT_L(0); PG8_BAR; PG8_MMA(0, 0, At, B0); PG8_MMA(0, 1, At, B1); PG8_BAR; PG8_SCHED;
            PG8_LDA(At, 1, 1); PG8_STB(PG8_SB(1, 0), b3); PG8_STB(PG8_SB(1, 1), b3 + hstep); PG8_STA(PG8_SA(1, 0), a3, 0);
            PG8_WAIT_V(8); PG8_WAIT_L(0); PG8_BAR; PG8_MMA(1, 0, At, B0); PG8_MMA(1, 1, At, B1); PG8_BAR; PG8_SCHED;
        }
        if (wr == 0) PG8_BAR;
        { const int tz = get_tid(); const int wz = tz >> 6, lz = tz & 63; E(acc, cur, wz >> 2, wz & 3, lz & 15, lz >> 4); }
        if (!has_next) break;
#pragma unroll
        for (int a = 0; a < 2; ++a)
#pragma unroll
            for (int b = 0; b < 2; ++b)
#pragma unroll
                for (int m = 0; m < 4; ++m)
#pragma unroll
                    for (int n = 0; n < 2; ++n) acc[a][b][m][n] = zero4();
        cur = nxt; cB = nB; cA = nA; ++ui;
        if (wr == 1) PG8_BAR;
    }
    PG8_WAIT_V(0);
    PG8_BAR;
#undef PG8_SA
#undef PG8_STAGE1
#undef PG8_STAGE2
#undef PG8_STB
#undef PG8_STA
#undef PG8_SB
#undef PG8_LDA
#undef PG8_LDB
#undef PG8_MMA
#undef PG8_WAIT_V
#undef PG8_WAIT_L
#undef PG8_BAR
#undef PG8_SCHED
}

__host__ __device__ __forceinline__ int mrow(int pm) { return (pm >> 4) * TP + 64 + (pm & 15) * 256; }
struct DenseProb {
    int K; const char* A; const char* Bt; int nM, nN, nwg, G, c;
    __device__ __forceinline__ void init(const void* A_, const void* Bt_, int M, int N, int K_, int G_, int c_) { A = (const char*)A_; Bt = (const char*)Bt_; K = K_; lda = K_; nM = M / BM; nN = N / BM; nwg = nM * nN; G = G_; c = c_; }
    __device__ __forceinline__ bool next(int i, Unit& u) const {
        const int L = i * G + c; if (L >= nwg) return false;
        int wgid = L; { const int q = nwg / 8, r = nwg % 8, xcd = wgid % 8, off = wgid / 8; wgid = (xcd < r ? xcd * (q + 1) : r * (q + 1) + (xcd - r) * q) + off; }
        const int nig = 8 * nN, gid = wgid / nig, fm = gid * 8, gsz = (nM - fm) < 8 ? (nM - fm) : 8;
        u.pm = fm + ((wgid % nig) % gsz); u.pn = (wgid % nig) / gsz; u.e = 0; u.r0 = 0; return true;
    }
    static constexpr bool GATHER = false; int lda;
    __device__ __forceinline__ const char* abase() const { return A; }
    __device__ __forceinline__ size_t aunit(const Unit& u) const { return (size_t)mrow(u.pm) * K * 2; }
    __device__ __forceinline__ unsigned aoffs0(int tid) const { int Rr, C; stage_rc(tid * 16, Rr, C); return (unsigned)(Rr * K + C) * 2u; }
    __device__ __forceinline__ void aoffs(const Unit&, int, unsigned (&)[2][2]) const {}
    __device__ __forceinline__ const char* bptr(const Unit& u) const { return Bt + (size_t)u.pn * BM * K * 2; }
};
struct MoeTab { int e[176]; int r0[176]; int cnt[32]; int ntiles; };
template <bool UP> struct MoeProb {
    int K; const char* A; const char* W; const unsigned* list; const LAS MoeTab* tab; int G, c;
    __device__ __forceinline__ bool next(int i, Unit& u) const {
        constexpr int NPN = UP ? 4 : 8;
        const int L = i * G + c; if (L >= __builtin_amdgcn_readfirstlane(tab->ntiles) * NPN) return false;
        const int tile = L / NPN; u.pm = tile; u.pn = L % NPN; u.e = __builtin_amdgcn_readfirstlane(tab->e[tile]); u.r0 = __builtin_amdgcn_readfirstlane(tab->r0[tile]); return true;
    }
    static constexpr bool GATHER = UP; int lda;
    __device__ __forceinline__ const char* abase() const { return A; }
    __device__ __forceinline__ size_t aunit(const Unit& u) const { return (size_t)u.pm * BM * DEXP * 2; }
    __device__ __forceinline__ unsigned aoffs0(int tid) const { int Rr, C; stage_rc(tid * 16, Rr, C); return (unsigned)(Rr * DEXP + C) * 2u; }
    __device__ __forceinline__ void aoffs(const Unit& u, int tid_, unsigned (&o)[2][2]) const {
        int tid = get_tid(); (void)tid_;
        const int n = __builtin_amdgcn_readfirstlane(tab->cnt[u.e]);
#pragma unroll
        for (int i = 0; i < 2; ++i) { int Rr, C; stage_rc(tid * 16 + i * 8192, Rr, C);
#pragma unroll
            for (int h = 0; h < 2; ++h) { const int li = u.r0 + h * HALF + Rr;
                const unsigned row = (li < n) ? (list[(size_t)u.e * R + li] >> 1) : (unsigned)PADF;
                o[h][i] = (row * (unsigned)DM + (unsigned)C) * 2u; } }
    }
    __device__ __forceinline__ const char* bptr(const Unit& u) const { return W + (size_t)u.e * (UP ? SZ_W13E : SZ_W2E) + (size_t)u.pn * BM * K * 2; }
};

struct EpiInProj {
    static constexpr bool PERM = true;
    bf16* Z; float* ZS;
    __device__ __forceinline__ void operator()(const f32x4 (&acc)[2][2][4][2], const Unit& u, int wr, int wc, int fr, int fq) const {
        const int row0 = mrow(u.pm) + wr * 64 + fr;
        if (u.pn < 23) {
            const int col0 = u.pn * BM + wc * 32 + 8 * fq;
#pragma unroll
            for (int ai = 0; ai < 2; ++ai)
#pragma unroll
                for (int m = 0; m < 4; ++m) { bf16* rowp = Z + (size_t)(row0 + ai * HALF + m * 16) * DINP + col0;
#pragma unroll
                    for (int bj = 0; bj < 2; ++bj) { const f32x4 v0 = acc[ai][bj][m][0], v1 = acc[ai][bj][m][1];
                        u32x4 w; w.x = cvtpk(v0[0], v0[1]); w.y = cvtpk(v0[2], v0[3]); w.z = cvtpk(v1[0], v1[1]); w.w = cvtpk(v1[2], v1[3]);
                        *(u32x4*)(rowp + bj * HALF) = w; } }
        } else {
            const int col0 = wc * 32 + 8 * fq;
#pragma unroll
            for (int ai = 0; ai < 2; ++ai)
#pragma unroll
                for (int m = 0; m < 4; ++m) { float* rowp = ZS + (size_t)(row0 + ai * HALF + m * 16) * 256 + col0;
#pragma unroll
                    for (int bj = 0; bj < 2; ++bj) { *(f32x4*)(rowp + bj * HALF) = acc[ai][bj][m][0]; *(f32x4*)(rowp + bj * HALF + 4) = acc[ai][bj][m][1]; } }
        }
    }
};
struct EpiOutProj {
    static constexpr bool PERM = false;
    float* H;
    __device__ __forceinline__ void operator()(const f32x4 (&acc)[2][2][4][2], const Unit& u, int wr, int wc, int fr, int fq) const {
        const int row0 = mrow(u.pm) + wr * 64 + fr, col0 = u.pn * BM + wc * 32 + 4 * fq;
#pragma unroll
        for (int ai = 0; ai < 2; ++ai) { float* base = H + (size_t)(row0 + ai * HALF) * DM + col0;
            f32x4 hv[4][2][2];
#pragma unroll
            for (int m = 0; m < 4; ++m)
#pragma unroll
                for (int bj = 0; bj < 2; ++bj)
#pragma unroll
                    for (int n = 0; n < 2; ++n) hv[m][bj][n] = *(const f32x4*)(base + (size_t)(m * 16) * DM + bj * HALF + n * 16);
#pragma unroll
            for (int m = 0; m < 4; ++m)
#pragma unroll
                for (int bj = 0; bj < 2; ++bj)
#pragma unroll
                    for (int n = 0; n < 2; ++n) *(f32x4*)(base + (size_t)(m * 16) * DM + bj * HALF + n * 16) = hv[m][bj][n] + acc[ai][bj][m][n];
            asm volatile("" ::: "memory"); }
    }
};
struct EpiMoeUp {
    static constexpr bool PERM = true;
    bf16* HID;
    __device__ __forceinline__ void operator()(const f32x4 (&acc)[2][2][4][2], const Unit& u, int wr, int wc, int fr, int fq) const {
        const int row0 = u.pm * BM + wr * 64 + fr, col0 = (u.pn * BM + wc * 32 + 8 * fq) >> 1;
#pragma unroll
        for (int ai = 0; ai < 2; ++ai)
#pragma unroll
            for (int m = 0; m < 4; ++m) { bf16* rowp = HID + (size_t)(row0 + ai * HALF + m * 16) * DEXP + col0;
#pragma unroll
                for (int bj = 0; bj < 2; ++bj) { const f32x4 a = acc[ai][bj][m][0], b = acc[ai][bj][m][1];
                    u32x2 w; w.x = cvtpk(siluf(a[0]) * b[0], siluf(a[1]) * b[1]); w.y = cvtpk(siluf(a[2]) * b[2], siluf(a[3]) * b[3]);
                    *(u32x2*)(rowp + bj * (HALF / 2)) = w; }
                asm volatile("" ::: "memory"); }
    }
};
struct EpiMoeDown {
    static constexpr bool PERM = true;
    bf16* Y0; bf16* Y1; const unsigned* list; const float* gate; const LAS MoeTab* tab;
    __device__ __forceinline__ void operator()(const f32x4 (&acc)[2][2][4][2], const Unit& u, int wr, int wc, int fr, int fq) const {
        const int n = __builtin_amdgcn_readfirstlane(tab->cnt[u.e]); const int col0 = u.pn * BM + wc * 32 + 8 * fq;
#pragma unroll
        for (int ai = 0; ai < 2; ++ai)
#pragma unroll
            for (int m = 0; m < 4; ++m) { const int li = u.r0 + ai * HALF + wr * 64 + m * 16 + fr;
                if (li < n) { const unsigned ent = list[(size_t)u.e * R + li]; const float g = gate[ent];
                    bf16* rowp = Y0 + (size_t)(ent & 1u) * ((size_t)R * DM) + (size_t)(ent >> 1) * DM + col0;
#pragma unroll
                    for (int bj = 0; bj < 2; ++bj) { const f32x4 v0 = acc[ai][bj][m][0] * g, v1 = acc[ai][bj][m][1] * g;
                        u32x4 w; w.x = cvtpk(v0[0], v0[1]); w.y = cvtpk(v0[2], v0[3]); w.z = cvtpk(v1[0], v1[1]); w.w = cvtpk(v1[2], v1[3]);
                        *(u32x4*)(rowp + bj * HALF) = w; } } }
    }
};
}

template <int MODE>
__device__ __forceinline__ void skinny_gemm(LAS unsigned char* lds, const bf16* A, const bf16* Bt, int K, int N, int bid, bf16* Zo, float* ZSo, float* Ho) {
    const int tid = get_tid(), lane = tid & 63, wave = __builtin_amdgcn_readfirstlane(tid >> 6), g = lane >> 4, c16 = lane & 15;
    if (bid >= N / 32) return;
    const int ksw = K / 32 / 8;
    f32x4 acc[4][2];
#pragma unroll
    for (int rt = 0; rt < 4; ++rt) { acc[rt][0] = zero4(); acc[rt][1] = zero4(); }
    const bf16* ap = A + (size_t)(PADF + c16) * K + 8 * g; const bf16* bp = Bt + (size_t)(32 * bid + c16) * K + 8 * g;
#pragma unroll 2
    for (int kk = 0; kk < ksw; ++kk) { const int ks = wave * ksw + kk;
        bf16x8 a[4], b[2];
#pragma unroll
        for (int rt = 0; rt < 4; ++rt) a[rt] = *(const bf16x8*)(ap + (size_t)rt * TP * K + 32 * ks);
#pragma unroll
        for (int ct = 0; ct < 2; ++ct) b[ct] = *(const bf16x8*)(bp + (size_t)(16 * ct) * K + 32 * ks);
#pragma unroll
        for (int rt = 0; rt < 4; ++rt)
#pragma unroll
            for (int ct = 0; ct < 2; ++ct) acc[rt][ct] = __builtin_amdgcn_mfma_f32_16x16x32_bf16(a[rt], b[ct], acc[rt][ct], 0, 0, 0); }
    LAS float* red = (LAS float*)lds;
#pragma unroll
    for (int rt = 0; rt < 4; ++rt)
#pragma unroll
        for (int ct = 0; ct < 2; ++ct)
#pragma unroll
            for (int r = 0; r < 4; ++r) red[wave * 2048 + (16 * rt + 4 * g + r) * 32 + 16 * ct + c16] = acc[rt][ct][r];
    __syncthreads();
    { const int rr = tid >> 3, c4 = 4 * (tid & 7); f32x4 sum = *(LAS f32x4*)(red + rr * 32 + c4);
#pragma unroll
      for (int w = 1; w < 8; ++w) sum = sum + *(LAS f32x4*)(red + w * 2048 + rr * 32 + c4);
      const size_t row = (size_t)(rr >> 4) * TP + PADF + (rr & 15); const int col = 32 * bid + c4;
      if (MODE == 0) { if (col < C_IK) { u32x2 w2; w2.x = cvtpk(sum[0], sum[1]); w2.y = cvtpk(sum[2], sum[3]); *(u32x2*)(Zo + row * DINP + col) = w2; }
                       else *(f32x4*)(ZSo + row * 256 + (col - C_IK)) = sum; }
      else { float* hp = Ho + row * DM + col; *(f32x4*)hp = *(const f32x4*)hp + sum; } }
    __syncthreads();
}

namespace fox {
constexpr int D = 128, NW = 8, QBLK = 32, KVBLK = 64, QB = NW * QBLK;
constexpr int SHM_V = KVBLK * D * 2, SHM_K = KVBLK * D * 2;
constexpr int LDS_BODY = 2 * SHM_V + 2 * SHM_K + NW * 64 * 4;
constexpr int BIAS_OFF = LDS_BODY;
constexpr int SCAN_OFF = BIAS_OFF + TP * 4;
constexpr int LDQ = DINP, LDO = DM;
constexpr float SCALE = 0.08838834764831845f, THR = 8.f;
constexpr int WBIG = 1 << 28;
#define KSWZ(row, colB) ((row) * 256 + ((colB) ^ (((row) & 7) << 4)))
#define SBAR() __builtin_amdgcn_sched_barrier(0)
__device__ __forceinline__ int v_st(int k, int c) { const int kk = (k & ~0xC) | ((k & 4) << 1) | ((k & 8) >> 1); return ((kk >> 3) * 4 + (c >> 5)) * 512 + ((kk & 7) * 32 + (c & 31)) * 2; }
__device__ __forceinline__ int v_rd_base(int lane) { return ((lane & 3) << 3) | (((lane >> 2) & 3) << 6) | (((lane >> 4) & 1) << 5) | (((lane >> 5) & 1) << 8); }
constexpr int v_rd_off(int d0, int ks, int half) { return d0 * 512 + ks * 4096 + half * 2048; }
__device__ __forceinline__ int crow(int r, int hi) { return (r & 3) + 8 * (r >> 2) + 4 * hi; }
__device__ __forceinline__ bf16x8 load8(const bf16* p) { return *reinterpret_cast<const bf16x8*>(p); }
__device__ __forceinline__ void mask_tile(f32x16& p0, f32x16& p1, int dq, unsigned W) {
    const float NEG = -__builtin_inff();
#pragma unroll
    for (int r = 0; r < 16; ++r) {
        const int c = (r & 3) + 8 * (r >> 2);
        if ((unsigned)(dq - c) >= W) p0[r] = NEG;
        if ((unsigned)(dq - c - 32) >= W) p1[r] = NEG;
    }
}
__device__ __forceinline__ void partialSM(f32x16& p0, f32x16& p1, float& m_reg, float& mn, float& alpha) {
    float pmax = p0[0]; for (int r = 1; r < 16; ++r) pmax = fmaxf(pmax, p0[r]); for (int r = 0; r < 16; ++r) pmax = fmaxf(pmax, p1[r]);
    { auto rr = __builtin_amdgcn_permlane32_swap(__float_as_uint(pmax), __float_as_uint(pmax), false, false);
      pmax = fmaxf(__uint_as_float(rr[0]), __uint_as_float(rr[1])); }
    constexpr float C2 = 1.4426950408889634f * SCALE;
    if (__builtin_expect(__all((pmax - m_reg) * SCALE <= THR), 1)) { mn = m_reg; alpha = 1.f; }
    else { mn = fmaxf(m_reg, pmax); alpha = __builtin_amdgcn_exp2f((m_reg - mn) * C2); m_reg = mn; }
    const float mnL = -mn * C2;
    for (int r = 0; r < 16; ++r) p0[r] = fmaf(p0[r], C2, mnL); for (int r = 0; r < 16; ++r) p1[r] = fmaf(p1[r], C2, mnL);
    for (int r = 0; r < 16; ++r) p0[r] = __builtin_amdgcn_exp2f(p0[r]);
}
__device__ __forceinline__ void finishSM(f32x16& p0, f32x16& p1, float alpha, float& l_reg, bf16x8& pa0, bf16x8& pa1, bf16x8& pa2, bf16x8& pa3) {
    for (int r = 0; r < 16; ++r) p1[r] = __builtin_amdgcn_exp2f(p1[r]);
    float ps = 0; for (int r = 0; r < 16; ++r) ps += p0[r]; for (int r = 0; r < 16; ++r) ps += p1[r];
    { auto rr = __builtin_amdgcn_permlane32_swap(__float_as_uint(ps), __float_as_uint(ps), false, false);
      ps = __uint_as_float(rr[0]) + __uint_as_float(rr[1]); }
    l_reg = l_reg * alpha + ps;
#define PK4(P, B_, OUT) do { unsigned a0 = cvtpk(P[B_+0], P[B_+1]), a1 = cvtpk(P[B_+2], P[B_+3]);                          \
        unsigned b0 = cvtpk(P[B_+4], P[B_+5]), b1 = cvtpk(P[B_+6], P[B_+7]);                                             \
        auto r0 = __builtin_amdgcn_permlane32_swap(a0, b0, false, false); auto r1 = __builtin_amdgcn_permlane32_swap(a1, b1, false, false); \
        u32x4 w = {r0[0], r1[0], r0[1], r1[1]}; OUT = *reinterpret_cast<bf16x8*>(&w); } while (0)
    PK4(p0, 0, pa0); PK4(p0, 8, pa1); PK4(p1, 0, pa2); PK4(p1, 8, pa3);
#undef PK4
}
template <int KB>
__device__ __forceinline__ void qkt(f32x16& p0, f32x16& p1, const char* K_lds, const float* biask  , int r32, int hi, const bf16x8* qr) {
#pragma unroll
    for (int a = 0; a < 4; ++a) { const f32x4 b0 = *(const f32x4*)(biask + 8 * a), b1 = *(const f32x4*)(biask + 32 + 8 * a);
#pragma unroll
        for (int j = 0; j < 4; ++j) { p0[4 * a + j] = b0[j]; p1[4 * a + j] = b1[j]; } }
    const char* kb[4];
#pragma unroll
    for (int dd = 0; dd < 4; ++dd) kb[dd] = K_lds + KB * SHM_K + KSWZ(r32, (dd * 16 + hi * 8) * 2);
#pragma unroll
    for (int d0 = 0; d0 < 8; ++d0) { const char* a = kb[d0 & 3] + (d0 >> 2) * 128;
        bf16x8 b0 = *reinterpret_cast<const bf16x8*>(a);
        bf16x8 b1 = *reinterpret_cast<const bf16x8*>(a + 32 * 256);
        p0 = __builtin_amdgcn_mfma_f32_32x32x16_bf16(b0, qr[d0], p0, 0, 0, 0);
        p1 = __builtin_amdgcn_mfma_f32_32x32x16_bf16(b1, qr[d0], p1, 0, 0, 0); }
}
template <int VB>
__device__ __forceinline__ void pv_tile(f32x16* o, int vb0, bf16x8 pa0, bf16x8 pa1, bf16x8 pa2, bf16x8 pa3) {
#define TRRD(dst, off) asm volatile("ds_read_b64_tr_b16 %0, %1 offset:%2" : "=&v"(dst) : "v"(vb0), "i"(off) : "memory")
#define PV_D0(d0) do { s16x4 l0, l1, l2, l3, h0, h1, h2, h3; constexpr int b_ = VB * SHM_V + v_rd_off(d0, 0, 0); \
        TRRD(l0, b_); TRRD(h0, b_ + 2048); TRRD(l1, b_ + 4096); TRRD(h1, b_ + 6144); TRRD(l2, b_ + 8192); TRRD(h2, b_ + 10240); TRRD(l3, b_ + 12288); TRRD(h3, b_ + 14336); \
        asm volatile("s_waitcnt lgkmcnt(0)" ::: "memory"); SBAR();   \
        o[d0] = __builtin_amdgcn_mfma_f32_32x32x16_bf16(pa0, (bf16x8){l0[0], l0[1], l0[2], l0[3], h0[0], h0[1], h0[2], h0[3]}, o[d0], 0, 0, 0);   \
        o[d0] = __builtin_amdgcn_mfma_f32_32x32x16_bf16(pa1, (bf16x8){l1[0], l1[1], l1[2], l1[3], h1[0], h1[1], h1[2], h1[3]}, o[d0], 0, 0, 0);   \
        o[d0] = __builtin_amdgcn_mfma_f32_32x32x16_bf16(pa2, (bf16x8){l2[0], l2[1], l2[2], l2[3], h2[0], h2[1], h2[2], h2[3]}, o[d0], 0, 0, 0);   \
        o[d0] = __builtin_amdgcn_mfma_f32_32x32x16_bf16(pa3, (bf16x8){l3[0], l3[1], l3[2], l3[3], h3[0], h3[1], h3[2], h3[3]}, o[d0], 0, 0, 0); } while (0)
    PV_D0(0); PV_D0(1); PV_D0(2); PV_D0(3);
#undef PV_D0
#undef TRRD
}
struct BlockRef { const bf16* Q; const bf16* K; const bf16* V; bf16* O; int P0; int jlo; };
struct Seam { bf16x8 qr[8]; bf16x8 st_v0, st_v1, st_k0, st_k1; };
#define ROW(p, k0, rr) ((p) + (unsigned)(((k0) + (rr)) * LDQ + sc))
#define VMW() asm volatile("s_waitcnt vmcnt(0)" ::: "memory")
#define VMWN(n) asm volatile("s_waitcnt vmcnt(%0)" :: "i"(n) : "memory")
#define SLOAD_H(Kp, Vp, k0) do { S.st_v0 = load8(ROW(Vp, k0, sr)); S.st_v1 = load8(ROW(Vp, k0, 32 + sr));              \
                         S.st_k0 = load8(ROW(Kp, k0, sr)); S.st_k1 = load8(ROW(Kp, k0, 32 + sr)); } while (0)
#define SWRITE_HK(bf) do { *(bf16x8*)(K_lds + (bf) * SHM_K + kws) = S.st_k0; *(bf16x8*)(K_lds + (bf) * SHM_K + kws + 32 * 256) = S.st_k1; } while (0)
#define SWRITE_HV(bf) do { *(bf16x8*)(V_lds + (bf) * SHM_V + vst0) = S.st_v0; *(bf16x8*)(V_lds + (bf) * SHM_V + vst1) = S.st_v1; } while (0)
#define SWRITE_H(bf) do { SWRITE_HV(bf); SWRITE_HK(bf); } while (0)
__device__ __forceinline__ void prime(const BlockRef& cur, char* lds, Seam& S) {
    int tid = get_tid();
    const int wid = __builtin_amdgcn_readfirstlane(tid >> 6), lane = tid & 63, r32 = lane & 31, hi = lane >> 5;
    const int sr = tid >> 4, sc = (tid & 15) * 8, kws = KSWZ(sr, sc * 2); char* K_lds = lds + 2 * SHM_V;
    const int kb0 = cur.jlo * KVBLK;
    for (int d0 = 0; d0 < 8; ++d0) S.qr[d0] = load8(cur.Q + (unsigned)((wid * QBLK + r32) * LDQ + d0 * 16 + hi * 8));
    SLOAD_H(cur.K, cur.V, kb0); VMW(); SWRITE_HK(0);
    __syncthreads();
}
__device__ __forceinline__ void block(const BlockRef& cur, const BlockRef& nxt, int skv, char* lds, Seam& S) {
    constexpr int W = WBIG;
    int tid = get_tid();
    const int wid = __builtin_amdgcn_readfirstlane(tid >> 6), lane = tid & 63, r32 = lane & 31, hi = lane >> 5;
    const int j_lo = cur.jlo;
    int j_hi = (cur.P0 + QB - 1) / KVBLK + 1; if (j_hi > skv / KVBLK) j_hi = skv / KVBLK;
    const int NT = j_hi - j_lo;
    const int kbn = nxt.jlo * KVBLK;
    const int qlo = cur.P0 + wid * QBLK, qm = qlo + r32 - 4 * hi;
    char* V_lds = lds; char* K_lds = lds + 2 * SHM_V;
    float* ws = (float*)(lds + 2 * SHM_V + 2 * SHM_K) + wid * 64; float* li_l = ws, * al_l = ws + 32;
    const float* biasb = (const float*)(lds + BIAS_OFF) + 4 * hi;
    float m_reg = -1e30f, l_reg = 0; f32x16 o[4] = {};
    const int sr = tid >> 4, sc = (tid & 15) * 8, vst0 = v_st(sr, sc), vst1 = v_st(32 + sr, sc), kws = KSWZ(sr, sc * 2);
    const int vb0 = (int)(uintptr_t)V_lds + v_rd_base(lane);
    const bf16* Kh = cur.K; const bf16* Vh = cur.V;
#define RESC(a) do { if (__any((a) < 1.f)) { if (hi == 0) al_l[r32] = (a); asm volatile("s_waitcnt lgkmcnt(0)" ::: "memory");              \
                     for (int d_ = 0; d_ < 4; ++d_) for (int r = 0; r < 16; ++r) o[d_][r] *= al_l[crow(r, hi)]; } } while (0)
#define KBASE(t) ((j_lo + (t)) * KVBLK)
#define MASKT(P0_, P1_, t) do { const int kb_ = KBASE(t); if (kb_ + KVBLK - 1 > qlo) mask_tile(P0_, P1_, qm - kb_, (unsigned)W); } while (0)
    constexpr int NQL = 8;
#define SEAM_K0() do { VMWN(NQL); SWRITE_HK(0); SBAR(); } while (0)
    f32x16 pA0, pA1, pB0, pB1; float mnA, mnB, alA, alB; bf16x8 pa0, pa1, pa2, pa3;
    SWRITE_HV(0); SBAR();
    if (NT > 1) { SLOAD_H(Kh, Vh, KBASE(1)); }
    SBAR(); qkt<0>(pA0, pA1, K_lds, biasb + KBASE(0), r32, hi, S.qr);
    MASKT(pA0, pA1, 0); partialSM(pA0, pA1, m_reg, mnA, alA);
    if (NT > 1) { VMW(); SWRITE_H(1); }
    __syncthreads();
#define HALF_STEP(PX0, PX1, mnX, alX, PY0, PY1, alY, t, KB, VB, SB) do {                                                      \
        SBAR(); qkt<KB>(PX0, PX1, K_lds, biasb + KBASE(t), r32, hi, S.qr);                                             \
        finishSM(PY0, PY1, alY, l_reg, pa0, pa1, pa2, pa3); SBAR();                                                           \
        if ((t) + 1 < NT) { SLOAD_H(Kh, Vh, KBASE((t) + 1)); SBAR(); }                                               \
        pv_tile<VB>(o, vb0, pa0, pa1, pa2, pa3); MASKT(PX0, PX1, (t)); partialSM(PX0, PX1, m_reg, mnX, alX);                                        \
        __syncthreads();                                                                                                      \
        if ((t) + 1 < NT) { VMW(); SWRITE_H(SB); }                                                                          \
        RESC(alX); __syncthreads(); } while (0)
    for (int t = 1; t + 1 < NT; t += 2) {
        HALF_STEP(pB0, pB1, mnB, alB, pA0, pA1, alA, t, 1, 0, 0);
        HALF_STEP(pA0, pA1, mnA, alA, pB0, pB1, alB, t + 1, 0, 1, 1);
    }
    const bool even = (NT & 1) == 0;
    if (even) { SBAR(); qkt<1>(pB0, pB1, K_lds, biasb + KBASE(NT - 1), r32, hi, S.qr); SBAR(); }
    SLOAD_H(nxt.K, nxt.V, kbn); SBAR();
#pragma unroll
    for (int d0 = 0; d0 < 8; ++d0) S.qr[d0] = load8(nxt.Q + (unsigned)((wid * QBLK + r32) * LDQ + d0 * 16 + hi * 8));
    SBAR();
    finishSM(pA0, pA1, alA, l_reg, pa0, pa1, pa2, pa3); SBAR();
    pv_tile<0>(o, vb0, pa0, pa1, pa2, pa3);
    if (even) { MASKT(pB0, pB1, NT - 1); partialSM(pB0, pB1, m_reg, mnB, alB); __syncthreads(); RESC(alB);
        finishSM(pB0, pB1, alB, l_reg, pa0, pa1, pa2, pa3); SBAR(); pv_tile<1>(o, vb0, pa0, pa1, pa2, pa3); }
    SBAR(); SEAM_K0();
    if (hi == 0) li_l[r32] = l_reg; asm volatile("s_waitcnt lgkmcnt(0)" ::: "memory");
    float rli[16];
#pragma unroll
    for (int r = 0; r < 16; ++r) rli[r] = __builtin_amdgcn_rcpf(li_l[crow(r, hi)]);
    bf16* Ow = cur.O + (unsigned)(wid * QBLK * LDO);
#pragma unroll
    for (int r = 0; r < 16; ++r) { const int orow = crow(r, hi);
#pragma unroll
        for (int d0 = 0; d0 < 4; ++d0) { const float v = o[d0][r] * rli[r];
            const float vn = __shfl_xor(v, 1);
            if ((r32 & 1) == 0) *(unsigned*)(Ow + (unsigned)(orow * LDO + d0 * 32 + r32)) = cvtpk(v, vn); } }
    __syncthreads();
#undef RESC
#undef KBASE
#undef MASKT
#undef SEAM_K0
#undef HALF_STEP
}
#undef ROW
#undef VMW
#undef VMWN
#undef SLOAD_H
#undef SWRITE_HK
#undef SWRITE_HV
#undef SWRITE_H

__device__ __forceinline__ void build_bias(char* lds, const float* zs_b  , int h) {
    int tid = get_tid();
    const int lane = tid & 63, wid = tid >> 6;
    float* bias = (float*)(lds + BIAS_OFF); float* wsum = (float*)(lds + SCAN_OFF);
    float loc[9]; float s = 0.f;
#pragma unroll
    for (int k = 0; k < 9; ++k) { const int t = tid * 9 + k; const float x = (t < TT) ? zs_b[(size_t)(PADF + t) * 256 + S_BF + h] : 0.f; s += x; loc[k] = s; }
    float incl = s;
#pragma unroll
    for (int o = 1; o < 64; o <<= 1) { const float y = __shfl_up(incl, o); if (lane >= o) incl += y; }
    if (lane == 63) wsum[wid] = incl;
    __syncthreads();
    float woff = 0.f;
    for (int w = 0; w < wid; ++w) woff += wsum[w];
    const float excl = woff + incl - s;
    constexpr float INVS = 1.0f / SCALE;
#pragma unroll
    for (int k = 0; k < 9; ++k) { const int t = tid * 9 + k; if (t < TT) bias[PADF + t] = -(excl + loc[k]) * INVS; }
    if (tid < PADF) bias[tid] = -__builtin_inff();
    __syncthreads();
}
__device__ __forceinline__ int prune_jlo(const char* lds, int q0v) {
    const float* bias = (const float*)(lds + BIAS_OFF);
    constexpr float PRUNE = 64.f;
    const float thr = bias[q0v] - PRUNE * (1.0f / SCALE);
    int j = 0; const int jmax = q0v / KVBLK;
    while (j < jmax && bias[KVBLK * j + KVBLK - 1] < thr) ++j;
    return j;
}
__device__ __forceinline__ void item(char* lds, const bf16* Z, const float* ZS, bf16* MIX, int it) {
    const int bh = it >> 3, x = it & 7, b = bh / 6, h = bh % 6;
    build_bias(lds, ZS + (size_t)b * TP * 256, h);
    const bf16* zb = Z + (size_t)b * TP * DINP;
    BlockRef b0, b1;
    b0.K = b1.K = zb + C_BK + h * 128; b0.V = b1.V = zb + C_BV + h * 128;
    const int q0 = 64 + 256 * x, q1 = 64 + 256 * (15 - x);
    b0.Q = zb + (size_t)q0 * DINP + C_BQ + h * 128; b1.Q = zb + (size_t)q1 * DINP + C_BQ + h * 128;
    b0.O = MIX + (size_t)(b * TP + q0) * DM + 768 + h * 128; b1.O = MIX + (size_t)(b * TP + q1) * DM + 768 + h * 128;
    b0.P0 = q0; b1.P0 = q1;
    b0.jlo = prune_jlo(lds, q0); b1.jlo = prune_jlo(lds, q1);
    Seam S;
    prime(b0, lds, S);
    block(b0, b1, TP, lds, S);
    block(b1, b1, TP, lds, S);
}
__device__ __forceinline__ void meta_unit(const bf16* Z, const float* ZS, bf16* MIX, int b) {
    int tid = get_tid();
    const int lane = tid & 63, wid = tid >> 6;
    for (int task = wid; task < 96; task += 8) {
        const int h = task >> 4, m = task & 15;
        const size_t rq = (size_t)b * TP + PADF + m;
        const unsigned qw = *(const unsigned*)(Z + rq * DINP + C_BQ + h * 128 + 2 * lane);
        const float q0 = bflo(qw), q1 = bfhi(qw);
        float lg[16]; float F = 0.f, Fk[16];
#pragma unroll
        for (int k = 0; k < 16; ++k) { F += ZS[((size_t)b * TP + PADF + k) * 256 + S_BF + h]; Fk[k] = F; }
        float Fm = 0.f;
#pragma unroll
        for (int k = 0; k < 16; ++k) if (k == m) Fm = Fk[k];
        float mx = -1e30f;
#pragma unroll
        for (int k = 0; k < 16; ++k) { const size_t rk = (size_t)b * TP + PADF + k;
            const unsigned kw = *(const unsigned*)(Z + rk * DINP + C_BK + h * 128 + 2 * lane);
            const float d = wave_sum(q0 * bflo(kw) + q1 * bfhi(kw));
            lg[k] = (k <= m) ? d * SCALE + Fm - Fk[k] : -__builtin_inff(); mx = fmaxf(mx, lg[k]); }
        float sum = 0.f, o0 = 0.f, o1 = 0.f;
#pragma unroll
        for (int k = 0; k < 16; ++k) { const float p = fexp_(lg[k] - mx); sum += p;
            const size_t rk = (size_t)b * TP + PADF + k;
            const unsigned vw = *(const unsigned*)(Z + rk * DINP + C_BV + h * 128 + 2 * lane);
            o0 += p * bflo(vw); o1 += p * bfhi(vw); }
        const float inv = 1.f / sum;
        *(unsigned*)(MIX + rq * DM + 768 + h * 128 + 2 * lane) = cvtpk(o0 * inv, o1 * inv);
    }
}
}

namespace dsa {
constexpr int NQ = 8, SCW = TP;
constexpr int SC_BYTES = NQ * SCW * 4;
constexpr int IDX_OFF = SC_BYTES;
constexpr int LDS_NEED = SC_BYTES + NQ * 256 * 2;
constexpr int KTOP = 256;
typedef short s16x2v __attribute__((ext_vector_type(2)));
__device__ __forceinline__ unsigned relu_pk(unsigned w) { s16x2v v = *reinterpret_cast<s16x2v*>(&w); v = __builtin_elementwise_max(v, (s16x2v){0, 0}); return *reinterpret_cast<unsigned*>(&v); }
__device__ __forceinline__ unsigned sortable(float f) { const unsigned u = __float_as_uint(f); return (u >> 31) ? ~u : (u | 0x80000000u); }
__device__ __forceinline__ unsigned mbcnt(unsigned long long m) { return __builtin_amdgcn_mbcnt_hi((unsigned)(m >> 32), __builtin_amdgcn_mbcnt_lo((unsigned)m, 0u)); }
__device__ __forceinline__ unsigned off_b(unsigned row, unsigned ch) { return 256u * row + 16u * (ch ^ (((row & 3) << 2) | ((row >> 2) & 3))); }

template <int NG>
__device__ __forceinline__ void select_topk(const LAS float* myc, LAS unsigned short* idx, int lane) {
    unsigned key[NG];
#pragma unroll
    for (int j = 0; j < NG; ++j) key[j] = sortable(myc[64 * j + lane]);
    unsigned tau = 0u;
    for (int bit = 31; bit >= 0; --bit) {
        const unsigned cand = tau | (1u << bit); int cnt = 0;
#pragma unroll
        for (int j0 = 0; j0 < NG; j0 += 8) { unsigned long long mk[8];
#pragma unroll
            for (int q = 0; q < 8; ++q) mk[q] = (j0 + q < NG) ? __ballot(key[j0 + q] >= cand) : 0ull;
            asm volatile("" : "+s"(mk[0]), "+s"(mk[1]), "+s"(mk[2]), "+s"(mk[3]), "+s"(mk[4]), "+s"(mk[5]), "+s"(mk[6]), "+s"(mk[7]));
#pragma unroll
            for (int q = 0; q < 8; ++q) cnt += __popcll(mk[q]); }
        if (cnt >= KTOP) tau = cand;
        if (cnt == KTOP) break;
    }
    int cgt = 0;
#pragma unroll
    for (int j = 0; j < NG; ++j) cgt += __popcll(__ballot(key[j] > tau));
    int eq_rem = KTOP - cgt, run = 0;
#pragma unroll
    for (int j = 0; j < NG; ++j) {
        const bool gt = key[j] > tau, eq = key[j] == tau;
        const unsigned long long m_eq = __ballot(eq);
        const bool take = gt || (eq && (int)mbcnt(m_eq) < eq_rem);
        const unsigned long long m = __ballot(take);
        if (take) idx[run + (int)mbcnt(m)] = (unsigned short)(64 * j + lane);
        run += __popcll(m); const int ne = __popcll(m_eq); eq_rem -= (ne < eq_rem) ? ne : eq_rem;
    }
}
__device__ __forceinline__ void unit(LAS unsigned char* lds, const bf16* Z, const float* ZS, const bf16* IKC, const bf16* KAC, const bf16* VAC, bf16* MIX, int b, int c, int sub) {
    int tid = get_tid();
    const int lane = tid & 63, wave = __builtin_amdgcn_readfirstlane(tid >> 6), g = lane >> 4, c16 = lane & 15;
    const int v0 = 64 * c + 8 * sub;
    const size_t rb = (size_t)b * TP;
    LAS float* sc = (LAS float*)lds;
    {
        bf16x8 A[NQ][2];
#pragma unroll
        for (int qi = 0; qi < NQ; ++qi) { const bf16* zq = Z + (rb + v0 + qi) * DINP + C_IQ + c16 * 64 + 8 * g;
            A[qi][0] = *(const bf16x8*)zq; A[qi][1] = *(const bf16x8*)(zq + 32); }
        u32x4 Aw[4];
        { const f32x4 w4 = *(const f32x4*)(ZS + (rb + v0 + (c16 & 7)) * 256 + S_IW + 4 * g);
          const unsigned w01 = cvtpk(w4[0], w4[1]), w23 = cvtpk(w4[2], w4[3]);
#pragma unroll
          for (int s2 = 0; s2 < 4; ++s2) { const bool ev = (c16 == 2 * s2), od = (c16 == 2 * s2 + 1);
              Aw[s2] = (u32x4){ev ? w01 : 0u, ev ? w23 : 0u, od ? w01 : 0u, od ? w23 : 0u}; } }
        const int ntile = 4 * (c + 1);
        const bf16* ikb = IKC + rb * 64 + c16 * 64 + 8 * g;
        const f32x4 Z4 = {0.f, 0.f, 0.f, 0.f};
#define DSA_BLD(dst0, dst1, tt) do { const int t_ = (tt) < ntile ? (tt) : ntile - 1; dst0 = *(const bf16x8*)(ikb + (size_t)t_ * 1024); dst1 = *(const bf16x8*)(ikb + (size_t)t_ * 1024 + 32); } while (0)
#define DSA_TILE(B0_, B1_, tt) do { f32x4 d[NQ]; \
            _Pragma("unroll") for (int qi = 0; qi < NQ; ++qi) { d[qi] = __builtin_amdgcn_mfma_f32_16x16x32_bf16(A[qi][0], B0_, Z4, 0, 0, 0); \
                d[qi] = __builtin_amdgcn_mfma_f32_16x16x32_bf16(A[qi][1], B1_, d[qi], 0, 0, 0); } \
            f32x4 D2 = Z4; \
            _Pragma("unroll") for (int s2 = 0; s2 < 4; ++s2) { const f32x4 x = d[2 * s2], y = d[2 * s2 + 1]; \
                u32x4 rw; rw.x = relu_pk(cvtpk(x[0], x[1])); rw.y = relu_pk(cvtpk(x[2], x[3])); rw.z = relu_pk(cvtpk(y[0], y[1])); rw.w = relu_pk(cvtpk(y[2], y[3])); \
                D2 = __builtin_amdgcn_mfma_f32_16x16x32_bf16(*reinterpret_cast<const bf16x8*>(&Aw[s2]), *reinterpret_cast<const bf16x8*>(&rw), D2, 0, 0, 0); } \
            const int key = 16 * (tt) + c16; \
            if (g < 2) { _Pragma("unroll") for (int r = 0; r < 4; ++r) sc[(4 * g + r) * SCW + key] = (key >= PADF) ? D2[r] : -__builtin_inff(); } } while (0)
        bf16x8 Ba0, Ba1, Bb0, Bb1, Bc0, Bc1;
        int t = wave;
        DSA_BLD(Ba0, Ba1, t); DSA_BLD(Bb0, Bb1, t + 8);
        for (; t < ntile; t += 24) {
            DSA_BLD(Bc0, Bc1, t + 16); DSA_TILE(Ba0, Ba1, t);
            if (t + 8 >= ntile) break;
            DSA_BLD(Ba0, Ba1, t + 24); DSA_TILE(Bb0, Bb1, t + 8);
            if (t + 16 >= ntile) break;
            DSA_BLD(Bb0, Bb1, t + 32); DSA_TILE(Bc0, Bc1, t + 16);
        }
#undef DSA_BLD
#undef DSA_TILE
    }
    { const int n_ = 64 * (c + 1), ng_ = (c + 1 <= 16) ? 16 : (c + 1 <= 32 ? 32 : (c + 1 <= 48 ? 48 : 65));
      for (int i = n_ + tid; i < 64 * ng_; i += 512) {
#pragma unroll
          for (int qi = 0; qi < NQ; ++qi) sc[qi * SCW + i] = -__builtin_inff(); } }
    __syncthreads();
    const int n = 64 * (c + 1), nreal = n - PADF, ngrp = c + 1;
    LAS unsigned short* idx = (LAS unsigned short*)(lds + IDX_OFF) + wave * 256;
    LAS float* myc = sc + wave * SCW;
    int nsel;
    if (nreal <= KTOP) { nsel = nreal; for (int s = lane; s < nsel; s += 64) idx[s] = (unsigned short)(PADF + s); }
    else { nsel = KTOP;
        if (ngrp <= 16) select_topk<16>(myc, idx, lane); else if (ngrp <= 32) select_topk<32>(myc, idx, lane);
        else if (ngrp <= 48) select_topk<48>(myc, idx, lane); else select_topk<65>(myc, idx, lane); }
    LDS_WAIT();
    {
        const size_t qrow = rb + v0 + wave;
        bf16x8 Bq[4];
#pragma unroll
        for (int kd = 0; kd < 4; ++kd) { Bq[kd] = (bf16x8){0, 0, 0, 0, 0, 0, 0, 0}; if (c16 < 6) Bq[kd] = *(const bf16x8*)(Z + qrow * DINP + C_AQ + c16 * 128 + 32 * kd + 8 * g); }
        f32x4 Dl[8][2];
        const int srow = 8 * (c16 >> 2) + (c16 & 3);
        const bf16* kab = KAC + rb * 128 + 8 * g;
        bf16x8 Ka[3][8];
        const f32x4 Z4 = {0.f, 0.f, 0.f, 0.f};
#define DSA_KLOAD(buf, ks_) do { int s0_ = 32 * (ks_) + srow, s1_ = s0_ + 4; s0_ = s0_ < nsel ? s0_ : nsel - 1; s1_ = s1_ < nsel ? s1_ : nsel - 1; \
            const bf16* k0_ = kab + (size_t)idx[s0_] * 128; const bf16* k1_ = kab + (size_t)idx[s1_] * 128; \
            _Pragma("unroll") for (int kd = 0; kd < 4; ++kd) { Ka[buf][kd] = *(const bf16x8*)(k0_ + 32 * kd); Ka[buf][4 + kd] = *(const bf16x8*)(k1_ + 32 * kd); } } while (0)
        DSA_KLOAD(0, 0); DSA_KLOAD(1, 1);
#pragma unroll
        for (int ks = 0; ks < 8; ++ks) {
            if (ks + 2 < 8) DSA_KLOAD((ks + 2) % 3, ks + 2);
            f32x4 d0 = Z4, d1 = Z4;
#pragma unroll
            for (int kd = 0; kd < 4; ++kd) { d0 = __builtin_amdgcn_mfma_f32_16x16x32_bf16(Ka[ks % 3][kd], Bq[kd], d0, 0, 0, 0); d1 = __builtin_amdgcn_mfma_f32_16x16x32_bf16(Ka[ks % 3][4 + kd], Bq[kd], d1, 0, 0, 0); }
            Dl[ks][0] = d0; Dl[ks][1] = d1;
        }
#undef DSA_KLOAD
        constexpr float C2 = 0.08838834764831845f * 1.4426950408889634f;
        float mx = -1e30f;
#pragma unroll
        for (int ks = 0; ks < 8; ++ks)
#pragma unroll
            for (int tt = 0; tt < 2; ++tt)
#pragma unroll
                for (int r = 0; r < 4; ++r) { const int slot = 32 * ks + 8 * g + 4 * tt + r; float x = Dl[ks][tt][r] * C2; x = (slot < nsel) ? x : -__builtin_inff(); Dl[ks][tt][r] = x; mx = fmaxf(mx, x); }
        mx = fmaxf(mx, __shfl_xor(mx, 16)); mx = fmaxf(mx, __shfl_xor(mx, 32));
        float sum = 0.f;
#pragma unroll
        for (int ks = 0; ks < 8; ++ks)
#pragma unroll
            for (int tt = 0; tt < 2; ++tt)
#pragma unroll
                for (int r = 0; r < 4; ++r) { const float p = __builtin_amdgcn_exp2f(Dl[ks][tt][r] - mx); Dl[ks][tt][r] = p; sum += p; }
        sum += __shfl_xor(sum, 16); sum += __shfl_xor(sum, 32);
        LAS unsigned char* stg = (LAS unsigned char*)myc;
        const unsigned stg_addr = (unsigned)(uintptr_t)stg;
        f32x4 O[8];
#pragma unroll
        for (int dt = 0; dt < 8; ++dt) O[dt] = Z4;
        const unsigned q4 = (unsigned)c16 >> 2, p4 = (unsigned)c16 & 3;
        const unsigned rd_base = stg_addr + (8u * g + q4) * 256u + 8u * p4;
        const bf16* vab = VAC + rb * 128 + (lane & 15) * 8;
        u32x4 Vr[2][8];
#define DSA_VLOAD(buf, ks_) do { _Pragma("unroll") for (int i = 0; i < 8; ++i) { int s_ = 32 * (ks_) + (lane >> 4) + 4 * i; s_ = s_ < nsel ? s_ : nsel - 1; Vr[buf][i] = *(const u32x4*)(vab + (size_t)idx[s_] * 128); } } while (0)
        DSA_VLOAD(0, 0); DSA_VLOAD(1, 1);
#pragma unroll
        for (int ks = 0; ks < 8; ++ks) {
            LAS unsigned char* sb = stg + (ks & 1) * 8192;
#pragma unroll
            for (int i = 0; i < 8; ++i) *(LAS u32x4*)(sb + ((lane >> 4) + 4 * i) * 256 + (lane & 15) * 16) = Vr[ks & 1][i];
            if (ks + 2 < 8) DSA_VLOAD(ks & 1, ks + 2);
            u32x4 pw; pw.x = cvtpk(Dl[ks][0][0], Dl[ks][0][1]); pw.y = cvtpk(Dl[ks][0][2], Dl[ks][0][3]); pw.z = cvtpk(Dl[ks][1][0], Dl[ks][1][1]); pw.w = cvtpk(Dl[ks][1][2], Dl[ks][1][3]);
            const bf16x8 Bp = *reinterpret_cast<const bf16x8*>(&pw);
            const unsigned ra = rd_base + (ks & 1) * 8192u;
            s16x4 l0, l1, l2, l3, l4, l5, l6, l7, h0, h1, h2, h3, h4, h5, h6, h7;
            asm volatile("s_waitcnt lgkmcnt(0)\n\t"
                "ds_read_b64_tr_b16 %0, %16\n\tds_read_b64_tr_b16 %8, %16 offset:1024\n\t"
                "ds_read_b64_tr_b16 %1, %16 offset:32\n\tds_read_b64_tr_b16 %9, %16 offset:1056\n\t"
                "ds_read_b64_tr_b16 %2, %16 offset:64\n\tds_read_b64_tr_b16 %10, %16 offset:1088\n\t"
                "ds_read_b64_tr_b16 %3, %16 offset:96\n\tds_read_b64_tr_b16 %11, %16 offset:1120\n\t"
                "ds_read_b64_tr_b16 %4, %16 offset:128\n\tds_read_b64_tr_b16 %12, %16 offset:1152\n\t"
                "ds_read_b64_tr_b16 %5, %16 offset:160\n\tds_read_b64_tr_b16 %13, %16 offset:1184\n\t"
                "ds_read_b64_tr_b16 %6, %16 offset:192\n\tds_read_b64_tr_b16 %14, %16 offset:1216\n\t"
                "ds_read_b64_tr_b16 %7, %16 offset:224\n\tds_read_b64_tr_b16 %15, %16 offset:1248\n\t"
                "s_waitcnt lgkmcnt(0)"
                : "=&v"(l0), "=&v"(l1), "=&v"(l2), "=&v"(l3), "=&v"(l4), "=&v"(l5), "=&v"(l6), "=&v"(l7), "=&v"(h0), "=&v"(h1), "=&v"(h2), "=&v"(h3), "=&v"(h4), "=&v"(h5), "=&v"(h6), "=&v"(h7)
                : "v"(ra) : "memory");
#define DSA_PV(dt, lo, hi2) O[dt] = __builtin_amdgcn_mfma_f32_16x16x32_bf16((bf16x8){lo[0], lo[1], lo[2], lo[3], hi2[0], hi2[1], hi2[2], hi2[3]}, Bp, O[dt], 0, 0, 0)
            DSA_PV(0, l0, h0); DSA_PV(1, l1, h1); DSA_PV(2, l2, h2); DSA_PV(3, l3, h3); DSA_PV(4, l4, h4); DSA_PV(5, l5, h5); DSA_PV(6, l6, h6); DSA_PV(7, l7, h7);
#undef DSA_PV
        }
#undef DSA_VLOAD
        if (c16 < 6) { const float inv = 1.f / sum; bf16* op = MIX + qrow * DM + c16 * 128 + 4 * g;
#pragma unroll
            for (int dt = 0; dt < 8; ++dt) { u32x2 w; w.x = cvtpk(O[dt][0] * inv, O[dt][1] * inv); w.y = cvtpk(O[dt][2] * inv, O[dt][3] * inv); *(u32x2*)(op + 16 * dt) = w; } }
    }
    __syncthreads();
}
}

namespace gla {
constexpr int LDT = 72;
constexpr int L_BL = 0;
constexpr int L_SEG = L_BL + 16384;
constexpr int L_QH = L_SEG + 2048;
constexpr int L_KH = L_QH + 64 * LDT * 2;
constexpr int L_SC = L_KH + 64 * LDT * 2;
constexpr int L_VT = L_SC + 64 * LDT * 2;
constexpr int L_ST = L_VT + 128 * LDT * 2;
constexpr int L_O = L_ST + 128 * LDT * 2;
constexpr int LDS_NEED = L_O + 64 * 132 * 4;
__device__ __forceinline__ bf16x8 ldfrag(const LAS bf16* base, int row, int k0) { return *(const LAS bf16x8*)(base + row * LDT + k0); }

__device__ __forceinline__ void cum_decay(LAS unsigned char* lds, const float* LA, size_t row0, int hd, bool chunk0) {
    int tid = get_tid();
    const int d = tid & 63, seg = tid >> 6;
    LAS float* bl = (LAS float*)(lds + L_BL); LAS float* sg = (LAS float*)(lds + L_SEG);
    float v[8]; float s = 0.f;
#pragma unroll
    for (int k = 0; k < 8; ++k) { const int i = 8 * seg + k; float x = LA[(row0 + i) * 256 + hd * 64 + d]; if (chunk0 && i < PADF) x = 0.f; s += x; v[k] = s; }
    sg[seg * 64 + d] = s;
    __syncthreads();
    float off = 0.f;
    for (int w = 0; w < seg; ++w) off += sg[w * 64 + d];
#pragma unroll
    for (int k = 0; k < 8; ++k) bl[(8 * seg + k) * 64 + d] = v[k] + off;
    __syncthreads();
}
__device__ __forceinline__ void load_vT(LAS unsigned char* lds, const bf16* Z, size_t row0, int hd) {
    int tid = get_tid(); LAS bf16* vT = (LAS bf16*)(lds + L_VT);
#pragma unroll
    for (int it = 0; it < 2; ++it) { const int pc = tid + 512 * it, i = pc >> 4, e0 = (pc & 15) * 8;
        const u32x4 w = *(const u32x4*)(Z + (row0 + i) * DINP + C_CV + hd * 128 + e0);
        const unsigned ww[4] = {w.x, w.y, w.z, w.w};
#pragma unroll
        for (int k = 0; k < 4; ++k) { vT[(e0 + 2 * k) * LDT + i] = (bf16)(ww[k] & 0xffffu); vT[(e0 + 2 * k + 1) * LDT + i] = (bf16)(ww[k] >> 16); } }
}
__device__ __forceinline__ void step1(LAS unsigned char* lds, const bf16* Z, const float* ZS, float* LA, const float* w2, const float* gb, float* KV, float* DVEC, int b, int c, int hd) {
    int tid = get_tid();
    const int lane = tid & 63, wave = tid >> 6, g = lane >> 4, c16 = lane & 15;
    const size_t row0 = (size_t)b * TP + 64 * c;
    LAS float* bl = (LAS float*)(lds + L_BL); LAS float* sg = (LAS float*)(lds + L_SEG); LAS bf16* kdT = (LAS bf16*)(lds + L_QH); LAS bf16* vT = (LAS bf16*)(lds + L_VT);
    LAS float* crs = (LAS float*)(lds + L_O);
    if (tid < 256) { const int i = tid >> 2; *(LAS f32x4*)(crs + i * 16 + 4 * (tid & 3)) = *(const f32x4*)(ZS + (row0 + i) * 256 + S_CR + 4 * (tid & 3)); }
    __syncthreads();
    { const int d = tid & 63, seg = tid >> 6, n = hd * 64 + d;
      float wc[16];
#pragma unroll
      for (int r = 0; r < 16; ++r) wc[r] = w2[r * 256 + n];
      const float gbn = gb[n];
      float v[8]; float s = 0.f;
#pragma unroll
      for (int k = 0; k < 8; ++k) { const int i = 8 * seg + k; float a = gbn;
#pragma unroll
          for (int r = 0; r < 16; ++r) a += crs[i * 16 + r] * wc[r];
          float x = logsigmoidf(a) * (1.f / 16.f); if (c == 0 && i < PADF) x = 0.f;
          LA[(row0 + i) * 256 + n] = x; s += x; v[k] = s; }
      sg[seg * 64 + d] = s;
      __syncthreads();
      float off = 0.f;
      for (int w = 0; w < seg; ++w) off += sg[w * 64 + d];
#pragma unroll
      for (int k = 0; k < 8; ++k) bl[(8 * seg + k) * 64 + d] = v[k] + off; }
    __syncthreads();
    { const int i = tid >> 3, d0 = (tid & 7) * 8;
      const u32x4 w = *(const u32x4*)(Z + (row0 + i) * DINP + C_CK + hd * 64 + d0); const unsigned ww[4] = {w.x, w.y, w.z, w.w};
#pragma unroll
      for (int k = 0; k < 8; ++k) { const int d = d0 + k; const float kk = (k & 1) ? bfhi(ww[k >> 1]) : bflo(ww[k >> 1]);
          kdT[d * LDT + i] = f2bf(kk * fexp_(bl[63 * 64 + d] - bl[i * 64 + d])); } }
    load_vT(lds, Z, row0, hd);
    __syncthreads();
    const int bh = b * 4 + hd;
    float* kvp = KV + ((size_t)bh * 65 + c) * 8192;
#pragma unroll
    for (int dt = 0; dt < 4; ++dt) { f32x4 acc = zero4();
#pragma unroll
        for (int ks = 0; ks < 2; ++ks) acc = __builtin_amdgcn_mfma_f32_16x16x32_bf16(ldfrag(kdT, 16 * dt + c16, 32 * ks + 8 * g), ldfrag(vT, 16 * wave + c16, 32 * ks + 8 * g), acc, 0, 0, 0);
#pragma unroll
        for (int r = 0; r < 4; ++r) kvp[(16 * dt + 4 * g + r) * 128 + 16 * wave + c16] = acc[r]; }
    if (tid < 64) DVEC[((size_t)bh * 65 + c) * 64 + tid] = fexp_(bl[63 * 64 + tid]);
    __syncthreads();
}
__device__ __forceinline__ void step2(const float* KV, const float* DVEC, float* SS, int u) {
    int tid = get_tid();
    const int bh = u >> 2, idx = (u & 3) * 2048 + tid * 4, d = idx >> 7;
    f32x4 S = zero4();
    *(f32x4*)(SS + ((size_t)bh * 66) * 8192 + idx) = S;
#pragma unroll 4
    for (int c = 0; c < 64; ++c) {
        const f32x4 kv = *(const f32x4*)(KV + ((size_t)bh * 65 + c) * 8192 + idx); const float dv = DVEC[((size_t)bh * 65 + c) * 64 + d];
        S = S * dv + kv;
        *(f32x4*)(SS + ((size_t)bh * 66 + c + 1) * 8192 + idx) = S;
    }
}
__device__ __forceinline__ void step3(LAS unsigned char* lds, const bf16* Z, const float* LA, const float* SS, const float* gon, bf16* MIX, int b, int c, int hd) {
    int tid = get_tid();
    const int lane = tid & 63, wave = tid >> 6, g = lane >> 4, c16 = lane & 15;
    const size_t row0 = (size_t)b * TP + 64 * c;
    LAS float* bl = (LAS float*)(lds + L_BL); LAS bf16* qh = (LAS bf16*)(lds + L_QH); LAS bf16* kh = (LAS bf16*)(lds + L_KH); LAS bf16* scb = (LAS bf16*)(lds + L_SC);
    LAS bf16* vT = (LAS bf16*)(lds + L_VT); LAS bf16* sT = (LAS bf16*)(lds + L_ST); LAS float* ol = (LAS float*)(lds + L_O);
    {
        const int bh = b * 4 + hd;
        cum_decay(lds, LA, row0, hd, c == 0);
        { const int i = tid >> 3, d0 = (tid & 7) * 8;
          const u32x4 wq = *(const u32x4*)(Z + (row0 + i) * DINP + C_CQ + hd * 64 + d0), wk = *(const u32x4*)(Z + (row0 + i) * DINP + C_CK + hd * 64 + d0);
          const unsigned q4[4] = {wq.x, wq.y, wq.z, wq.w}, k4[4] = {wk.x, wk.y, wk.z, wk.w};
          unsigned oq[4], ok[4];
#pragma unroll
          for (int k = 0; k < 4; ++k) { const float b0 = bl[i * 64 + d0 + 2 * k], b1 = bl[i * 64 + d0 + 2 * k + 1];
              oq[k] = cvtpk(bflo(q4[k]) * 0.125f * fexp_(b0), bfhi(q4[k]) * 0.125f * fexp_(b1));
              ok[k] = cvtpk(bflo(k4[k]) * fexp_(-b0), bfhi(k4[k]) * fexp_(-b1)); }
          *(LAS u32x4*)(qh + i * LDT + d0) = (u32x4){oq[0], oq[1], oq[2], oq[3]};
          *(LAS u32x4*)(kh + i * LDT + d0) = (u32x4){ok[0], ok[1], ok[2], ok[3]}; }
        load_vT(lds, Z, row0, hd);
        { const float* sp = SS + ((size_t)bh * 66 + c) * 8192;
#pragma unroll
          for (int it = 0; it < 4; ++it) { const int pc = tid + 512 * it, d = pc >> 5, e0 = (pc & 31) * 4; const f32x4 s4 = *(const f32x4*)(sp + d * 128 + e0);
#pragma unroll
              for (int k = 0; k < 4; ++k) sT[(e0 + k) * LDT + d] = f2bf(s4[k]); } }
        __syncthreads();
        { const int it = wave & 3;
#pragma unroll
          for (int jj = 0; jj < 2; ++jj) { const int jt = 2 * (wave >> 2) + jj; f32x4 acc = zero4();
              if (jt <= it) {
#pragma unroll
                  for (int ks = 0; ks < 2; ++ks) acc = __builtin_amdgcn_mfma_f32_16x16x32_bf16(ldfrag(qh, 16 * it + c16, 32 * ks + 8 * g), ldfrag(kh, 16 * jt + c16, 32 * ks + 8 * g), acc, 0, 0, 0); }
#pragma unroll
              for (int r = 0; r < 4; ++r) { const int i = 16 * it + 4 * g + r, j = 16 * jt + c16; scb[i * LDT + j] = f2bf((j <= i) ? acc[r] : 0.f); } } }
        __syncthreads();
#pragma unroll
        for (int it = 0; it < 4; ++it) { f32x4 acc = zero4();
#pragma unroll
            for (int ks = 0; ks < 2; ++ks) acc = __builtin_amdgcn_mfma_f32_16x16x32_bf16(ldfrag(scb, 16 * it + c16, 32 * ks + 8 * g), ldfrag(vT, 16 * wave + c16, 32 * ks + 8 * g), acc, 0, 0, 0);
#pragma unroll
            for (int ks = 0; ks < 2; ++ks) acc = __builtin_amdgcn_mfma_f32_16x16x32_bf16(ldfrag(qh, 16 * it + c16, 32 * ks + 8 * g), ldfrag(sT, 16 * wave + c16, 32 * ks + 8 * g), acc, 0, 0, 0);
#pragma unroll
            for (int r = 0; r < 4; ++r) ol[(16 * it + 4 * g + r) * 132 + 16 * wave + c16] = acc[r]; }
        __syncthreads();
#pragma unroll
        for (int k = 0; k < 8; ++k) { const int i = 8 * wave + k; const float x0 = ol[i * 132 + 2 * lane], x1 = ol[i * 132 + 2 * lane + 1];
            const float ss = wave_sum(x0 * x0 + x1 * x1); const float rstd = rsqrt_(ss * (1.f / 128.f) + EPS);
            if (!(c == 0 && i < PADF)) { const unsigned gw = *(const unsigned*)(Z + (row0 + i) * DINP + C_CG + hd * 128 + 2 * lane);
                const float y0 = x0 * rstd * gon[2 * lane] * siluf(bflo(gw)), y1 = x1 * rstd * gon[2 * lane + 1] * siluf(bfhi(gw));
                *(unsigned*)(MIX + (row0 + i) * DM + 1536 + hd * 128 + 2 * lane) = cvtpk(y0, y1); } }
        __syncthreads();
    }
}
}

struct Frame {
    LAS unsigned char* lds; char* ldsg;
    int tid, lane, wave, G, bid;
};
constexpr int PTAB_OFF = LDSCTL_OFF + 1024, P_OUT = 21, P_WS = 22;
__device__ __forceinline__ unsigned char* gptr(const Frame& F, int k) {
    const LAS unsigned* t = (const LAS unsigned*)(F.lds + PTAB_OFF) + 2 * k;
    const unsigned lo = __builtin_amdgcn_readfirstlane(t[0]), hi = __builtin_amdgcn_readfirstlane(t[1]);
    return (unsigned char*)(GAS unsigned char*)(((unsigned long long)hi << 32) | lo);
}
#define WS() gptr(F, P_WS)
#define INP(k) ((const float*)gptr(F, (k)))
#define CTL() ((unsigned*)(gptr(F, P_WS) + WS_CTL))
__device__ __forceinline__ int inmap(int n) {
    if (n < 2048) return n;
    if (n < 2112) return C_IK + (n - 2048);
    if (n < 2128) return C_IK + S_IW + (n - 2112);
    if (n < 4432) return C_BQ + (n - 2128);
    if (n < 4438) return C_IK + S_BF + (n - 4432);
    if (n < 4950) return C_CQ + (n - 4438);
    if (n < 5462) return C_CV + (n - 4950);
    if (n < 5478) return C_IK + S_CR + (n - 5462);
    return C_CG + (n - 5478);
}
struct TrItem { const float* W; bf16* WT; int K, N, map, k0, n0; };
__device__ __forceinline__ void tr_load(const TrItem& t, f32x4 (&v)[16], int lane) {
    const int cl = 4 * (lane & 15), rl = lane >> 4;
    const float* src = t.W + (size_t)(t.k0 + rl) * t.N + t.n0 + cl;
    if (t.map == 1) { const bool in0 = (t.n0 + cl) < t.N, in1 = (t.n0 + cl + 2) < t.N;
#pragma unroll
        for (int i = 0; i < 16; ++i) { const float* p = src + (size_t)(4 * i) * t.N; const f32x2 a = in0 ? *(const f32x2*)p : (f32x2){0.f, 0.f}, b = in1 ? *(const f32x2*)(p + 2) : (f32x2){0.f, 0.f}; v[i] = (f32x4){a[0], a[1], b[0], b[1]}; }
    } else {
#pragma unroll
        for (int i = 0; i < 16; ++i) v[i] = *(const f32x4*)(src + (size_t)(4 * i) * t.N); }
}
__device__ __forceinline__ void tr_store(const TrItem& t, const f32x4 (&v)[16], LAS float* scr, int lane) {
    constexpr int PITCH = 65;
    { const int cl = 4 * (lane & 15), rl = lane >> 4;
#pragma unroll
      for (int i = 0; i < 16; ++i) { LAS float* d = scr + (rl + 4 * i) * PITCH + cl; d[0] = v[i][0]; d[1] = v[i][1]; d[2] = v[i][2]; d[3] = v[i][3]; } }
    LDS_WAIT(); asm volatile("" ::: "memory");
    const int kc = lane & 7, nl = lane >> 3;
#pragma unroll
    for (int j = 0; j < 8; ++j) { const int n = nl + 8 * j, ng = t.n0 + n; const LAS float* sp = scr + (8 * kc) * PITCH + n;
        u32x4 o; o.x = cvtpk(sp[0 * PITCH], sp[1 * PITCH]); o.y = cvtpk(sp[2 * PITCH], sp[3 * PITCH]); o.z = cvtpk(sp[4 * PITCH], sp[5 * PITCH]); o.w = cvtpk(sp[6 * PITCH], sp[7 * PITCH]);
        int row = ng; if (t.map == 1) row = inmap(ng < t.N ? ng : 0); else if (t.map == 2) row = 8 * (ng >> 2) + (ng & 3); else if (t.map == 3) row = 8 * (ng >> 2) + 4 + (ng & 3);
        if (ng < t.N) *(u32x4*)(t.WT + (size_t)row * t.K + t.k0 + 8 * kc) = o; }
    LDS_WAIT(); asm volatile("" ::: "memory");
}
__device__ __forceinline__ void sincos_d(double ang, float& c, float& s) {
    const double q = __builtin_rint(ang * 0.63661977236758134308);
    double r = __builtin_fma(-q, 1.5707963267948966, ang); r = __builtin_fma(-q, 6.123233995736766e-17, r);
    const double r2 = r * r;
    const double sp = r + r * r2 * (-1.0 / 6 + r2 * (1.0 / 120 + r2 * (-1.0 / 5040 + r2 * (1.0 / 362880 + r2 * (-1.0 / 39916800 + r2 * (1.0 / 6227020800.0))))));
    const double cp = 1.0 + r2 * (-0.5 + r2 * (1.0 / 24 + r2 * (-1.0 / 720 + r2 * (1.0 / 40320 + r2 * (-1.0 / 3628800 + r2 * (1.0 / 479001600.0))))));
    const int n = (int)((long long)q & 3);
    const double sv = (n == 0) ? sp : (n == 1) ? cp : (n == 2) ? -sp : -cp;
    const double cv = (n == 0) ? cp : (n == 1) ? -sp : (n == 2) ? -cp : sp;
    c = (float)cv; s = (float)sv;
}
__device__ __forceinline__ void p_prologue(Frame& F, const float* w_in, const float* w_out, const float* e_w1, const float* e_w3, const float* e_w2, const float* rgw, const float* rew, const float* g2) {
    int htid = get_tid(); const int h_lane = htid & 63, h_wave = __builtin_amdgcn_readfirstlane(htid >> 6);
    LAS float* scr = (LAS float*)(F.lds + h_wave * 16640);
    const int gw = F.bid * 8 + h_wave, NGW = F.G * 8;
    unsigned char* ws = WS();
    constexpr int I_IN = 32 * 94, I_OUT = 32 * 32, I_W1 = NEXP * 32 * 8, I_W2 = NEXP * 8 * 32, I_L = I_IN + I_OUT + 2 * I_W1 + I_W2, I_ALL = DEPTH * I_L;
    auto decode = [&](int it) -> TrItem { TrItem t; const int l = it / I_L; int r = it % I_L; int nblk;
        if (r < I_IN) { t.W = w_in + (size_t)l * DM * DIN; t.K = DM; t.N = DIN; t.WT = (bf16*)(ws + WS_WIN + l * SZ_WIN); t.map = 1; nblk = 94; }
        else if ((r -= I_IN) < I_OUT) { t.W = w_out + (size_t)l * DM * DM; t.K = DM; t.N = DM; t.WT = (bf16*)(ws + WS_WOUT + l * SZ_WOUT); t.map = 0; nblk = 32; }
        else if ((r -= I_OUT) < I_W1) { const int e = r >> 8; r &= 255; t.W = e_w1 + ((size_t)l * NEXP + e) * DM * DEXP; t.K = DM; t.N = DEXP; t.WT = (bf16*)(ws + WS_W13 + l * SZ_W13 + e * SZ_W13E); t.map = 2; nblk = 8; }
        else if ((r -= I_W1) < I_W1) { const int e = r >> 8; r &= 255; t.W = e_w3 + ((size_t)l * NEXP + e) * DM * DEXP; t.K = DM; t.N = DEXP; t.WT = (bf16*)(ws + WS_W13 + l * SZ_W13 + e * SZ_W13E); t.map = 3; nblk = 8; }
        else { r -= I_W1; const int e = r >> 8; r &= 255; t.W = e_w2 + ((size_t)l * NEXP + e) * DEXP * DM; t.K = DEXP; t.N = DM; t.WT = (bf16*)(ws + WS_W2 + l * SZ_W2 + e * SZ_W2E); t.map = 0; nblk = 32; }
        t.k0 = 64 * (r / nblk); t.n0 = 64 * (r % nblk); return t; };
    { f32x4 va[16], vb[16]; int it = gw;
      if (it < I_ALL) { TrItem ta = decode(it), tb = ta; tr_load(ta, va, h_lane);
        for (;;) {
            const bool h1 = (it + NGW) < I_ALL; if (h1) { tb = decode(it + NGW); tr_load(tb, vb, h_lane); }
            tr_store(ta, va, scr, h_lane);
            if (!h1) break;
            const bool h2 = (it + 2 * NGW) < I_ALL; if (h2) { ta = decode(it + 2 * NGW); tr_load(ta, va, h_lane); }
            tr_store(tb, vb, scr, h_lane);
            if (!h2) break;
            it += 2 * NGW;
        } } }
    const int gt = F.bid * 512 + htid, NGT = F.G * 512;
    for (int i = gt; i < DEPTH * 154 * (DM / 8); i += NGT) { const int l = i / (154 * 256), rr = (i / 256) % 154, ch = i % 256;
        *(u32x4*)((bf16*)(ws + WS_WIN + l * SZ_WIN) + (size_t)(DIN + rr) * DM + ch * 8) = (u32x4){0u, 0u, 0u, 0u}; }
    for (int i = gt; i < TT * 64; i += NGT) { const int t = i >> 6, k = i & 63; double inv = 1.0; for (int j = 0; j < k; ++j) inv *= 0.86596432336006535;
        float c, s; sincos_d((double)t * inv, c, s); ((float*)(ws + WS_COS128))[i] = c; ((float*)(ws + WS_SIN128))[i] = s; }
    for (int i = gt; i < TT * 32; i += NGT) { const int t = i >> 5, k = i & 31; double inv = 1.0; for (int j = 0; j < k; ++j) inv *= 0.74989420933245583;
        float c, s; sincos_d((double)t * inv, c, s); ((float*)(ws + WS_COS64))[i] = c; ((float*)(ws + WS_SIN64))[i] = s; }
    for (int i = gt; i < NB * PADF * (DM / 8); i += NGT) { const int b = i / (PADF * 256), rr = (i / 256) % PADF, ch = i % 256; const size_t row = (size_t)b * TP + rr;
        *(u32x4*)((bf16*)(ws + WS_U) + row * DM + ch * 8) = (u32x4){0u, 0u, 0u, 0u}; *(u32x4*)((bf16*)(ws + WS_MIX) + row * DM + ch * 8) = (u32x4){0u, 0u, 0u, 0u}; }
    for (int i = gt; i < NB * PADF * (DINP / 8); i += NGT) { const int b = i / (PADF * 768), rr = (i / 768) % PADF, ch = i % 768; const size_t row = (size_t)b * TP + rr;
        *(u32x4*)((bf16*)(ws + WS_Z) + row * DINP + ch * 8) = (u32x4){0u, 0u, 0u, 0u}; }
    for (int i = gt; i < NB * PADF * 40; i += NGT) { const int b = i / (PADF * 40), rr = (i / 40) % PADF, ch = i % 40; const size_t row = (size_t)b * TP + rr;
        bf16* dst = (ch < 8) ? (bf16*)(ws + WS_IKC) + row * 64 + ch * 8 : (ch < 24 ? (bf16*)(ws + WS_KAC) + row * 128 + (ch - 8) * 8 : (bf16*)(ws + WS_VAC) + row * 128 + (ch - 24) * 8);
        *(u32x4*)dst = (u32x4){0u, 0u, 0u, 0u}; }
    for (int i = gt; i < NB * PADF * 64; i += NGT) { const int b = i / (PADF * 64), rr = (i / 64) % PADF, ch = i % 64; const size_t row = (size_t)b * TP + rr;
        *(f32x4*)((float*)(ws + WS_LA) + row * 256 + ch * 4) = zero4(); }
    for (int i = gt; i < DEPTH * 48 * DM; i += NGT) { const int l = i / (48 * DM), n = (i / DM) % 48, k = i % DM;
        float w = 0.f; if (n < 4) w = rgw[((size_t)l * DM + k) * 4 + n]; else if (n < 36) w = rew[((size_t)l * DM + k) * 32 + (n - 4)];
        w *= g2[(size_t)l * DM + k];
        const bf16 hi = f2bf(w); const bf16 lo = f2bf(w - bf2f(hi));
        bf16* wr = (bf16*)(ws + WS_WR + l * SZ_WR); wr[(size_t)n * DM + k] = hi; wr[(size_t)(48 + n) * DM + k] = lo; }
}
__device__ __forceinline__ void p_norm1(Frame& F, int l, const float* xin, const float* meta, const float* gain, size_t woff) {
    int htid = get_tid(); const int h_lane = htid & 63, h_wave = __builtin_amdgcn_readfirstlane(htid >> 6);
    const int gw = F.bid * 8 + h_wave, NGW = F.G * 8, lane = h_lane;
    float* H = (float*)(WS() + WS_H); bf16* U = (bf16*)(WS() + WS_U); const bf16* Y0 = (const bf16*)(WS() + WS_Y0); const bf16* Y1 = (const bf16*)(WS() + WS_Y1);
    for (int row = gw; row < R; row += NGW) {
        const int b = row / TP, v = row % TP;
        float* hr = H + (size_t)row * DM;
        if (v < PADF) { if (l == 0) {
#pragma unroll
                for (int j = 0; j < 8; ++j) *(f32x4*)(hr + 4 * (lane + 64 * j)) = zero4(); }
            continue; }
        const int t = v - PADF;
        f32x4 x[8]; float ss = 0.f;
#pragma unroll
        for (int j = 0; j < 8; ++j) { const int col = 4 * (lane + 64 * j);
            if (l == 0) { const float* src = (t < NMETA) ? meta + (size_t)t * DM : xin + ((size_t)b * SEQ + (t - NMETA)) * DM; x[j] = *(const f32x4*)(src + col); }
            else { x[j] = *(const f32x4*)(hr + col); const u32x2 a = *(const u32x2*)(Y0 + (size_t)row * DM + col), c = *(const u32x2*)(Y1 + (size_t)row * DM + col);
                x[j][0] += bflo(a.x) + bflo(c.x); x[j][1] += bfhi(a.x) + bfhi(c.x); x[j][2] += bflo(a.y) + bflo(c.y); x[j][3] += bfhi(a.y) + bfhi(c.y); }
            *(f32x4*)((char*)(hr + col) + woff) = x[j];
            ss += x[j][0] * x[j][0] + x[j][1] * x[j][1] + x[j][2] * x[j][2] + x[j][3] * x[j][3]; }
        ss = wave_sum(ss); const float rstd = rsqrt_(ss * (1.f / DM) + EPS);
#pragma unroll
        for (int j = 0; j < 8; ++j) { const int col = 4 * (lane + 64 * j); const f32x4 gg = *(const f32x4*)(gain + col);
            u32x2 w; w.x = cvtpk(x[j][0] * rstd * gg[0], x[j][1] * rstd * gg[1]); w.y = cvtpk(x[j][2] * rstd * gg[2], x[j][3] * rstd * gg[3]);
            *(u32x2*)((char*)(U + (size_t)row * DM + col) + woff) = w; }
    }
}
__device__ __forceinline__ void p_final(Frame& F) {
#ifdef PROBE_MASK
    float probe_delta = 0.f;
    { const volatile LAS unsigned long long* st = (const volatile LAS unsigned long long*)(F.lds + LDSCTL_OFF + 2048); unsigned long long tk = 0;
      for (int pz = 0; pz < 2 + 9 * DEPTH - 1; ++pz) { const int ty = (pz == 0) ? 0 : 1 + (pz - 1) % 9, ly = (pz == 0) ? 0 : (pz - 1) / 9;
          if (((PROBE_MASK >> ty) & 1) && ((PROBE_LAYERS >> ly) & 1)) tk += st[pz + 1] - st[pz]; }
      probe_delta = (PROBE_CONST) + (PROBE_ALPHA) * 0.01f * (float)tk; }
#endif
    int htid = get_tid(); const int h_lane = htid & 63, h_wave = __builtin_amdgcn_readfirstlane(htid >> 6);
    const int gw = F.bid * 8 + h_wave, NGW = F.G * 8, lane = h_lane;
    const float* H = (const float*)(WS() + WS_H); const bf16* Y0 = (const bf16*)(WS() + WS_Y0); const bf16* Y1 = (const bf16*)(WS() + WS_Y1);
    for (int o = gw; o < NB * SEQ; o += NGW) { const int b = o / SEQ, i = o % SEQ; const size_t row = (size_t)b * TP + PADF + NMETA + i;
#pragma unroll
        for (int j = 0; j < 8; ++j) { const int col = 4 * (lane + 64 * j); f32x4 x = *(const f32x4*)(H + row * DM + col);
            const u32x2 a = *(const u32x2*)(Y0 + row * DM + col), c = *(const u32x2*)(Y1 + row * DM + col);
            x[0] += bflo(a.x) + bflo(c.x); x[1] += bfhi(a.x) + bfhi(c.x); x[2] += bflo(a.y) + bflo(c.y); x[3] += bfhi(a.y) + bfhi(c.y);
#ifdef PROBE_MASK
            x = x + probe_delta;
#endif
            *(f32x4*)(((float*)gptr(F, P_OUT)) + (size_t)o * DM + col) = x; } }
}
__device__ __forceinline__ void unpack8(const u32x4 w, float (&x)[8]) { x[0] = bflo(w.x); x[1] = bfhi(w.x); x[2] = bflo(w.y); x[3] = bfhi(w.y); x[4] = bflo(w.z); x[5] = bfhi(w.z); x[6] = bflo(w.w); x[7] = bfhi(w.w); }
__device__ __forceinline__ u32x4 pack8f(const float (&x)[8]) { u32x4 w; w.x = cvtpk(x[0], x[1]); w.y = cvtpk(x[2], x[3]); w.z = cvtpk(x[4], x[5]); w.w = cvtpk(x[6], x[7]); return w; }
__device__ __forceinline__ void head128x(const bf16* p, bf16* dst, const float* gain, bool rope, bool raw, const float* cs, const float* sn, int lane) {
    const int c16 = lane & 15;
    const u32x4 w0 = *(const u32x4*)p;
    float x[8]; unpack8(w0, x);
    float ss = 0.f;
#pragma unroll
    for (int e = 0; e < 8; ++e) ss += x[e] * x[e];
    ss += __shfl_xor(ss, 1); ss += __shfl_xor(ss, 2); ss += __shfl_xor(ss, 4); ss += __shfl_xor(ss, 8);
    const float rstd = rsqrt_(ss * (1.f / 128.f) + EPS);
#pragma unroll
    for (int e = 0; e < 8; ++e) x[e] = x[e] * rstd * gain[8 * c16 + e];
    const int i0 = 8 * (c16 & 7);
#pragma unroll
    for (int e = 0; e < 8; ++e) { const float pr = __shfl_xor(x[e], 8); const float c = cs[i0 + e], s = sn[i0 + e];
        const float y = (c16 < 8) ? x[e] * c - pr * s : x[e] * c + pr * s; if (rope) x[e] = y; }
    *(u32x4*)dst = raw ? w0 : pack8f(x);
}
__device__ __forceinline__ void head128(bf16* p, const float* gain, bool rope, bool store, const float* cs, const float* sn, int lane, size_t woff = 0) {
    const int c16 = lane & 15;
    float x[8]; unpack8(*(const u32x4*)p, x);
    float ss = 0.f;
#pragma unroll
    for (int e = 0; e < 8; ++e) ss += x[e] * x[e];
    ss += __shfl_xor(ss, 1); ss += __shfl_xor(ss, 2); ss += __shfl_xor(ss, 4); ss += __shfl_xor(ss, 8);
    const float rstd = rsqrt_(ss * (1.f / 128.f) + EPS);
#pragma unroll
    for (int e = 0; e < 8; ++e) x[e] = x[e] * rstd * gain[8 * c16 + e];
    const int i0 = 8 * (c16 & 7);
#pragma unroll
    for (int e = 0; e < 8; ++e) { const float pr = __shfl_xor(x[e], 8); const float c = cs[i0 + e], s = sn[i0 + e];
        const float y = (c16 < 8) ? x[e] * c - pr * s : x[e] * c + pr * s; if (rope) x[e] = y; }
    if (store) *(u32x4*)((char*)p + woff) = pack8f(x);
}
struct PostP { const float *gaq, *gak, *gbq, *gbk, *fbias, *w2, *gb; };
template <int CTRL> __device__ __forceinline__ float dppf(float x) { return __builtin_bit_cast(float, __builtin_amdgcn_update_dpp(0, __builtin_bit_cast(int, x), CTRL, 0xF, 0xF, true)); }
__device__ __forceinline__ float row16_sum(float s) { s += dppf<0xB1>(s); s += dppf<0x4E>(s); s += dppf<0x124>(s); s += dppf<0x128>(s); return s; }
__device__ __forceinline__ u32x4 head_core(const u32x4 w, const float* gain, bool rope, const float* cs, const float* sn, int lane) {
    const int c16 = lane & 15;
    float x[8]; unpack8(w, x);
    float ss = 0.f;
#pragma unroll
    for (int e = 0; e < 8; ++e) ss += x[e] * x[e];
    ss = row16_sum(ss);
    const float rstd = rsqrt_(ss * (1.f / 128.f) + EPS);
    const f32x4 g0 = *(const f32x4*)(gain + 8 * c16), g1 = *(const f32x4*)(gain + 8 * c16 + 4);
#pragma unroll
    for (int e = 0; e < 8; ++e) x[e] = x[e] * rstd * (e < 4 ? g0[e] : g1[e - 4]);
    if (rope) { const int i0 = 8 * (c16 & 7);
        const f32x4 c0 = *(const f32x4*)(cs + i0), c1 = *(const f32x4*)(cs + i0 + 4), s0 = *(const f32x4*)(sn + i0), s1 = *(const f32x4*)(sn + i0 + 4);
#pragma unroll
        for (int e = 0; e < 8; ++e) { const float pr = dppf<0x128>(x[e]); const float c = e < 4 ? c0[e] : c1[e - 4], sv = e < 4 ? s0[e] : s1[e - 4];
            x[e] = (c16 < 8) ? x[e] * c - pr * sv : x[e] * c + pr * sv; } }
    return pack8f(x);
}
__device__ __forceinline__ void post_row(Frame& F, const PostP& pp, int row, size_t woff) {
    int htid = get_tid(); const int lane = htid & 63;
    const int v = row % TP;
    if (v < PADF) return;
    const int t = v - PADF;
    bf16* zr = (bf16*)(WS() + WS_Z) + (size_t)row * DINP; float* zs = (float*)(WS() + WS_ZS) + (size_t)row * 256;
    const float* c128 = (const float*)(WS() + WS_COS128) + t * 64; const float* s128 = (const float*)(WS() + WS_SIN128) + t * 64;
    const float* c64 = (const float*)(WS() + WS_COS64) + t * 32; const float* s64 = (const float*)(WS() + WS_SIN64) + t * 32;
    const u32x4 w0 = *(const u32x4*)(zr + 8 * lane), w1 = *(const u32x4*)(zr + 512 + 8 * lane), w2 = *(const u32x4*)(zr + C_IQ + 8 * lane), w3 = *(const u32x4*)(zr + C_IQ + 512 + 8 * lane);
    const u32x4 w4 = *(const u32x4*)(zr + C_BQ + 8 * lane), w5 = *(const u32x4*)(zr + C_BQ + 512 + 8 * lane), w6 = *(const u32x4*)(zr + C_BQ + 1024 + 8 * lane);
    const float xik = zs[S_IK + lane]; const float xiw = (lane < 16) ? zs[S_IW + lane] : 0.f; const float xbf = (lane < 6) ? zs[S_BF + lane] + pp.fbias[lane] : 0.f;
    *(u32x4*)((char*)(zr + 8 * lane) + woff) = head_core(w0, pp.gaq, true, c128, s128, lane);
    { bf16* kac = (bf16*)(WS() + WS_KAC) + (size_t)row * 128; bf16* vac = (bf16*)(WS() + WS_VAC) + (size_t)row * 128;
      bf16* dstp = (lane < 32) ? (bf16*)((char*)(zr + 512 + 8 * lane) + woff) : (lane < 48 ? kac + 8 * (lane - 32) : vac + 8 * (lane - 48));
      const u32x4 r1 = head_core(w1, lane < 32 ? pp.gaq : pp.gak, true, c128, s128, lane);
      *(u32x4*)dstp = (lane >= 48) ? w1 : r1; }
    { const int i0 = 8 * (lane & 3);
      const f32x4 c0 = *(const f32x4*)(c64 + i0), c1 = *(const f32x4*)(c64 + i0 + 4), s0 = *(const f32x4*)(s64 + i0), s1 = *(const f32x4*)(s64 + i0 + 4);
#pragma unroll
      for (int j = 0; j < 2; ++j) { float x[8]; unpack8(j ? w3 : w2, x);
#pragma unroll
          for (int e = 0; e < 8; ++e) { const float up = dppf<0x104>(x[e]), dn = dppf<0x114>(x[e]);
              const float pr = (lane & 4) ? dn : up; const float c = e < 4 ? c0[e] : c1[e - 4], sv = e < 4 ? s0[e] : s1[e - 4];
              x[e] = (lane & 4) ? x[e] * c + pr * sv : x[e] * c - pr * sv; }
          *(u32x4*)((char*)(zr + C_IQ + 512 * j + 8 * lane) + woff) = pack8f(x); } }
    *(u32x4*)((char*)(zr + C_BQ + 8 * lane) + woff) = head_core(w4, pp.gbq, false, c128, s128, lane);
    *(u32x4*)((char*)(zr + C_BQ + 512 + 8 * lane) + woff) = head_core(w5, lane < 32 ? pp.gbq : pp.gbk, false, c128, s128, lane);
    *(u32x4*)((char*)(zr + C_BQ + 1024 + 8 * lane) + woff) = head_core(w6, pp.gbk, false, c128, s128, lane);
    { const float pr = __shfl_xor(xik, 32); const int i = lane & 31; const float c = c64[i], sv = s64[i];
      const float y = (lane < 32) ? xik * c - pr * sv : xik * c + pr * sv; const float yn = dppf<0xB1>(y);
      if ((lane & 1) == 0) *(unsigned*)((bf16*)(WS() + WS_IKC) + (size_t)row * 64 + lane) = cvtpk(y, yn); }
    if (lane < 16) *(float*)((char*)(zs + S_IW + lane) + woff) = xiw * 0.03125f;
    if (lane < 6) *(float*)((char*)(zs + S_BF + lane) + woff) = logsigmoidf(xbf);
}
__device__ __forceinline__ void p_norm2(Frame& F, int l, const float* gain, const float* bg, const float* be, bool dup) {
    int htid = get_tid(); const int lane = htid & 63, wave = __builtin_amdgcn_readfirstlane(htid >> 6), g = lane >> 4, c16 = lane & 15;
    const int gw = F.bid * 8 + wave, NGW = F.G * 8;
    const float* H = (const float*)(WS() + WS_H); bf16* U = (bf16*)(WS() + WS_U);
    LAS float* lg = (LAS float*)(F.lds + wave * 4096); LAS float* rs = lg + 768;
    for (int rt = wave * F.G + F.bid; rt < R / 16 && wave < 5; rt += 8 * F.G) {
        const size_t row0 = (size_t)rt * 16; if ((int)(row0 % TP) < PADF) continue;
        const bf16* wr = (const bf16*)(WS() + WS_WR + l * SZ_WR);
        f32x4 acc[3] = {zero4(), zero4(), zero4()};
        const float* hrow = H + (row0 + c16) * DM + 8 * g;
        const bf16* wp0 = wr + (size_t)c16 * DM + 8 * g;
        float ss = 0.f;
#pragma unroll 8
        for (int ks = 0; ks < 64; ++ks) {
            const f32x4 a = *(const f32x4*)(hrow + 32 * ks), b = *(const f32x4*)(hrow + 32 * ks + 4);
            ss += (a[0] * a[0] + a[1] * a[1]) + (a[2] * a[2] + a[3] * a[3]) + (b[0] * b[0] + b[1] * b[1]) + (b[2] * b[2] + b[3] * b[3]);
            u32x4 hw; hw.x = cvtpk(a[0], a[1]); hw.y = cvtpk(a[2], a[3]); hw.z = cvtpk(b[0], b[1]); hw.w = cvtpk(b[2], b[3]);
            u32x4 lw; lw.x = cvtpk(a[0] - bflo(hw.x), a[1] - bfhi(hw.x)); lw.y = cvtpk(a[2] - bflo(hw.y), a[3] - bfhi(hw.y));
            lw.z = cvtpk(b[0] - bflo(hw.z), b[1] - bfhi(hw.z)); lw.w = cvtpk(b[2] - bflo(hw.w), b[3] - bfhi(hw.w));
            const bf16x8 Ah = *reinterpret_cast<const bf16x8*>(&hw), Al = *reinterpret_cast<const bf16x8*>(&lw);
#pragma unroll
            for (int ct = 0; ct < 3; ++ct) { const bf16* wp = wp0 + (size_t)(16 * ct) * DM + 32 * ks;
                const bf16x8 Bh = *(const bf16x8*)wp, Bl = *(const bf16x8*)(wp + (size_t)48 * DM);
                acc[ct] = __builtin_amdgcn_mfma_f32_16x16x32_bf16(Ah, Bh, acc[ct], 0, 0, 0);
                acc[ct] = __builtin_amdgcn_mfma_f32_16x16x32_bf16(Ah, Bl, acc[ct], 0, 0, 0);
                acc[ct] = __builtin_amdgcn_mfma_f32_16x16x32_bf16(Al, Bh, acc[ct], 0, 0, 0); } }
        ss += __shfl_xor(ss, 16); ss += __shfl_xor(ss, 32);
        if (g == 0) rs[c16] = rsqrt_(ss * (1.f / DM) + EPS);
#pragma unroll
        for (int ct = 0; ct < 3; ++ct)
#pragma unroll
            for (int r = 0; r < 4; ++r) lg[(4 * g + r) * 48 + 16 * ct + c16] = acc[ct][r];
        LDS_WAIT();
        if (lane < 16) { const size_t row = row0 + lane;
            const float rstd = rs[lane];
            float gl[4]; int gi = 0; float gm = -1e30f;
#pragma unroll
            for (int j = 0; j < 4; ++j) { gl[j] = lg[lane * 48 + j] * rstd + bg[j]; if (gl[j] > gm) { gm = gl[j]; gi = j; } }
            float gs = 0.f;
#pragma unroll
            for (int j = 0; j < 4; ++j) gs += fexp_(gl[j] - gm);
            const float gp = 1.f / gs;
            float el[8]; int e0 = 0, e1 = 0; float m0 = -1e30f, m1 = -1e30f;
#pragma unroll
            for (int j = 0; j < 8; ++j) el[j] = lg[lane * 48 + 4 + 8 * gi + j] * rstd + be[8 * gi + j];
#pragma unroll
            for (int j = 0; j < 8; ++j) { if (el[j] > m0) { m1 = m0; e1 = e0; m0 = el[j]; e0 = j; } else if (el[j] > m1) { m1 = el[j]; e1 = j; } }
            const float w1r = fexp_(m1 - m0); const float p0 = 1.f / (1.f + w1r), p1 = w1r / (1.f + w1r);
            unsigned* cnt = CTL() + CW_CNT + 1024 * l + (dup ? 16 : 0); unsigned* list = (unsigned*)(WS() + (dup ? WS_END : WS_LIST)); float* gate = (float*)(WS() + WS_GATE);
            const int x0 = gi * 8 + e0, x1 = gi * 8 + e1;
            const unsigned i0 = atomicAdd(cnt + 32 * x0, 1u), i1 = atomicAdd(cnt + 32 * x1, 1u);
            list[(size_t)x0 * R + i0] = (unsigned)row * 2u; list[(size_t)x1 * R + i1] = (unsigned)row * 2u + 1u;
            gate[row * 2] = gp * p0; gate[row * 2 + 1] = gp * p1; }
        LDS_WAIT();
    }
    const int rbeg = 65 * F.bid + (wave < 4 ? 4 * wave : 16 + (49 * (wave - 4)) / 4), rend = 65 * F.bid + (wave < 4 ? 4 * wave + 4 : 16 + (49 * (wave - 3)) / 4);
    const bool even_deal = (F.G * 65 == R);
    for (int row = even_deal ? rbeg : gw; row < (even_deal ? rend : R); row += even_deal ? 1 : NGW) { if ((row % TP) < PADF) continue;
        f32x4 x[8]; float ss = 0.f;
#pragma unroll
        for (int j = 0; j < 8; ++j) { x[j] = *(const f32x4*)(H + (size_t)row * DM + 4 * (lane + 64 * j)); ss += x[j][0] * x[j][0] + x[j][1] * x[j][1] + x[j][2] * x[j][2] + x[j][3] * x[j][3]; }
        ss = wave_sum(ss); const float rstd = rsqrt_(ss * (1.f / DM) + EPS);
#pragma unroll
        for (int j = 0; j < 8; ++j) { const int col = 4 * (lane + 64 * j); const f32x4 gg = *(const f32x4*)(gain + col);
            u32x2 w; w.x = cvtpk(x[j][0] * rstd * gg[0], x[j][1] * rstd * gg[1]); w.y = cvtpk(x[j][2] * rstd * gg[2], x[j][3] * rstd * gg[3]);
            *(u32x2*)(U + (size_t)row * DM + col) = w; } }
}
__device__ __forceinline__ void build_moetab(Frame& F, int l) {
    int htid = get_tid(); const int h_lane = htid & 63, h_wave = __builtin_amdgcn_readfirstlane(htid >> 6);
    LAS pg8::MoeTab* tab = (LAS pg8::MoeTab*)(F.lds + MOETAB_OFF);
    if (htid == 0) { int t = 0; const unsigned* cnt = CTL() + CW_CNT + 1024 * l;
        for (int e = 0; e < NEXP; ++e) { const int n = (int)__hip_atomic_load(cnt + 32 * e, __ATOMIC_RELAXED, __HIP_MEMORY_SCOPE_AGENT); tab->cnt[e] = n;
            for (int j = 0; j * 256 < n && t < 176; ++j) { tab->e[t] = e; tab->r0[t] = j * 256; ++t; } }
        tab->ntiles = t; }
    __syncthreads();
}

#define INPARG(i) args_in_dyn(args, (i))
constexpr int NPH = 2 + 9 * DEPTH;
struct Args { const float* in[21]; float* out; unsigned char* ws; int ph_lo, ph_hi; };
#define PHASE_FN static __device__ __forceinline__
#define MKFRAME Frame F; F.lds = lds; F.ldsg = (char*)lds; F.tid = 0; F.lane = 0; F.wave = 0; F.G = (int)gridDim.x; F.bid = (int)blockIdx.x
#define Z ((bf16*)(WS() + WS_Z))
#define ZS ((float*)(WS() + WS_ZS))
#define MIX ((bf16*)(WS() + WS_MIX))
#define U ((bf16*)(WS() + WS_U))
#define LA ((float*)(WS() + WS_LA))
#define KV ((float*)(WS() + WS_KV))
#define DVEC ((float*)(WS() + WS_DVEC))
#define SS ((float*)(WS() + WS_SS))
PHASE_FN void ph_prologue(LAS unsigned char* lds) { MKFRAME; p_prologue(F, INP(4), INP(13), INP(18), INP(19), INP(20), INP(14), INP(16), INP(3)); }
PHASE_FN void ph_norm1(LAS unsigned char* lds, int l, size_t woff) { MKFRAME; p_norm1(F, l, INP(0), INP(1), INP(2) + (size_t)l * DM, woff); }
PHASE_FN void ph_inproj(LAS unsigned char* lds, int l) { MKFRAME;
    pg8::DenseProb P; P.init(U, WS() + WS_WIN + l * SZ_WIN, 64 * 256, DINP, DM, F.G, F.bid);
    pg8::EpiInProj E{Z, ZS};
    pg8::gemm_phase(F.lds, P, E);
    skinny_gemm<0>(F.lds, U, (const bf16*)(WS() + WS_WIN + l * SZ_WIN), DM, DINP, F.bid, Z, ZS, nullptr);
}
PHASE_FN void ph_post(LAS unsigned char* lds, int l, size_t woff) { MKFRAME;
    PostP pp{INP(5) + l * 128, INP(6) + l * 128, INP(7) + l * 128, INP(8) + l * 128, INP(9) + l * 6, INP(10) + (size_t)l * 16 * 256, INP(11) + l * 256};
    for (int u = F.bid; u < (R / 64) * 4; u += F.G) gla::step1(F.lds, Z, ZS, LA, INP(10) + (size_t)l * 16 * 256, INP(11) + l * 256, KV, DVEC, (u >> 2) / 65, (u >> 2) % 65, u & 3);
    { const int gw = F.bid * 8 + (get_tid() >> 6);
      for (int row = gw; row < R; row += F.G * 8) post_row(F, pp, row, woff); }
}
#ifndef MIXM
#define MIXM 15
#endif
PHASE_FN void ph_mix(LAS unsigned char* lds, int l, int rep) { MKFRAME;
    volatile LAS unsigned* MISC = (volatile LAS unsigned*)(F.lds + MISC_OFF);
    if ((MIXM & 1) && F.bid < 64) gla::step2(KV, DVEC, SS, F.bid);
    if (MIXM & 2) { for (int it = F.G - 1 - F.bid; it < 192; it += F.G) fox::item(F.ldsg, Z, ZS, MIX, it); }
    if ((MIXM & 4) && F.bid < NB) fox::meta_unit(Z, ZS, MIX, F.bid);
    __syncthreads();
    unsigned nq = 0u; const bool t0 = (get_tid() == 0);
    unsigned* qhead = CTL() + CW_QUEUE + 64 * l + 32 * rep;
    if (t0) nq = atomicAdd(qhead, 1u);
    for (; MIXM & 8;) {
        if (t0) MISC[0] = nq;
        __syncthreads();
        const int q = (int)MISC[0];
        __syncthreads();
        if (q >= 65 * 32) break;
        if (t0) nq = atomicAdd(qhead, 1u);
        const int c = 64 - q / 32, b = (q % 32) / 8, sub = q % 8;
        if (c == 0 && sub < 6) continue;
        dsa::unit(F.lds, Z, ZS, (const bf16*)(WS() + WS_IKC), (const bf16*)(WS() + WS_KAC), (const bf16*)(WS() + WS_VAC), MIX, b, c, sub);
    }
}
PHASE_FN void ph_gla3(LAS unsigned char* lds, int l) { MKFRAME;
    for (int u = F.bid; u < (R / 64) * 4; u += F.G) gla::step3(F.lds, Z, LA, SS, INP(12) + l * 128, MIX, (u >> 2) / 65, (u >> 2) % 65, u & 3);
}
PHASE_FN void ph_outproj(LAS unsigned char* lds, int l, size_t woff) { MKFRAME;
    pg8::DenseProb P; P.init(MIX, WS() + WS_WOUT + l * SZ_WOUT, 64 * 256, DM, DM, F.G, F.bid);
    pg8::EpiOutProj E{(float*)(WS() + WS_H + woff)};
    pg8::gemm_phase(F.lds, P, E);
    skinny_gemm<1>(F.lds, MIX, (const bf16*)(WS() + WS_WOUT + l * SZ_WOUT), DM, DM, F.bid, nullptr, nullptr, (float*)(WS() + WS_H + woff));
}
PHASE_FN void ph_norm2(LAS unsigned char* lds, int l, bool dup) { MKFRAME;
    p_norm2(F, l, INP(3) + (size_t)l * DM, INP(15) + l * 4, INP(17) + l * 32, dup);
}
PHASE_FN void ph_moeup(LAS unsigned char* lds, int l) { MKFRAME;
    build_moetab(F, l);
    pg8::MoeProb<true> P; P.K = DM; P.lda = DM; P.A = (const char*)U; P.W = (const char*)(WS() + WS_W13 + l * SZ_W13); P.list = (const unsigned*)(WS() + WS_LIST);
    P.tab = (const LAS pg8::MoeTab*)(F.lds + MOETAB_OFF); P.G = F.G; P.c = F.bid;
    pg8::EpiMoeUp E{(bf16*)(WS() + WS_HID)};
    pg8::gemm_phase(F.lds, P, E);
}
PHASE_FN void ph_moedown(LAS unsigned char* lds, int l) { MKFRAME;
    build_moetab(F, l);
    pg8::MoeProb<false> P; P.K = DEXP; P.lda = DEXP; P.A = (const char*)(WS() + WS_HID); P.W = (const char*)(WS() + WS_W2 + l * SZ_W2); P.list = (const unsigned*)(WS() + WS_LIST);
    P.tab = (const LAS pg8::MoeTab*)(F.lds + MOETAB_OFF); P.G = F.G; P.c = F.bid;
    pg8::EpiMoeDown E{(bf16*)(WS() + WS_Y0), (bf16*)(WS() + WS_Y1), (const unsigned*)(WS() + WS_LIST), (const float*)(WS() + WS_GATE), (const LAS pg8::MoeTab*)(F.lds + MOETAB_OFF)};
    pg8::gemm_phase(F.lds, P, E);
}
PHASE_FN void ph_final(LAS unsigned char* lds) { MKFRAME; p_final(F); }
#undef Z
#undef ZS
#undef MIX
#undef U
#undef LA
#undef KV
#undef DVEC
#undef SS

__device__ __forceinline__ const float* args_in_dyn(const Args& a, int i) { const float* p = a.in[0];
#pragma unroll
    for (int k = 1; k < 21; ++k) p = (i == k) ? a.in[k] : p;
    return p; }
__global__ void __launch_bounds__(512, 2) fwd_kernel(Args args) {
    extern __shared__ __attribute__((aligned(16))) unsigned char lds_raw[];
    LAS unsigned char* lds = (LAS unsigned char*)lds_raw;
    const int tid = threadIdx.x;
    if ((tid & 63) == 0) *(volatile LAS unsigned*)(uintptr_t)(WAVETAB_OFF + 4 * ((unsigned)__builtin_amdgcn_s_getreg((5 << 11) | 4) & 63u)) = (unsigned)tid >> 6;
    if (tid < 23) { const unsigned long long v = (tid < 21) ? (unsigned long long)INPARG(tid) : (tid == 21 ? (unsigned long long)args.out : (unsigned long long)args.ws);
        LAS unsigned* t = (LAS unsigned*)(lds + PTAB_OFF) + 2 * tid; t[0] = (unsigned)v; t[1] = (unsigned)(v >> 32); }
    volatile LAS unsigned* MISC = (volatile LAS unsigned*)(lds + MISC_OFF);
    for (int u = tid; u < 256; u += 512) ((LAS unsigned*)(lds + LDSCTL_OFF))[u] = 0u;
    __syncthreads();
    const int lo = args.ph_lo, hi = args.ph_hi;
    const bool multi = (hi - lo) > 1;
    unsigned* barw = (unsigned*)(args.ws + WS_CTL) + CW_BAR;
    XcdBarrier bar; bar.bar = barw; bar.x = 0; bar.st = nullptr;
    if (multi) bar = xcd_barrier_post(barw, MISC + 8);
#define IN(k) (lo <= (k) && (k) < hi)
#define SEAM(k) do { if (IN(k) && IN((k) + 1)) xcd_barrier(bar); } while (0)
#ifndef DUP_MASK
#define DUP_MASK 0
#endif
#define NREP(ty) (((DUP_MASK >> (ty)) & 1) ? 2 : 1)
#define REPBAR(rep, ty) do { if ((rep) + 1 < NREP(ty) && multi) xcd_barrier(bar); } while (0)
    constexpr size_t DUPOFF = (size_t)774000128;
    for (int rep = 0; rep < NREP(0); ++rep) { if (IN(0)) ph_prologue(lds); REPBAR(rep, 0); }
    SEAM(0);
    for (int l = 0; l < DEPTH; ++l) {
        const int pb = 1 + 9 * l;
        for (int rep = 0; rep < NREP(1); ++rep) { if (IN(pb + 0)) ph_norm1(lds, l, rep ? DUPOFF : 0); REPBAR(rep, 1); }   SEAM(pb + 0);
        for (int rep = 0; rep < NREP(2); ++rep) { if (IN(pb + 1)) ph_inproj(lds, l); REPBAR(rep, 2); }  SEAM(pb + 1);
        for (int rep = 0; rep < NREP(3); ++rep) { if (IN(pb + 2)) ph_post(lds, l, rep ? DUPOFF : 0); REPBAR(rep, 3); }    SEAM(pb + 2);
        for (int rep = 0; rep < NREP(4); ++rep) { if (IN(pb + 3)) ph_mix(lds, l, rep); REPBAR(rep, 4); }     SEAM(pb + 3);
        for (int rep = 0; rep < NREP(5); ++rep) { if (IN(pb + 4)) ph_gla3(lds, l); REPBAR(rep, 5); }    SEAM(pb + 4);
        for (int rep = 0; rep < NREP(6); ++rep) { if (IN(pb + 5)) ph_outproj(lds, l, rep ? DUPOFF : 0); REPBAR(rep, 6); } SEAM(pb + 5);
        for (int rep = 0; rep < NREP(7); ++rep) { if (IN(pb + 6)) ph_norm2(lds, l, rep != 0); REPBAR(rep, 7); }   SEAM(pb + 6);
        for (int rep = 0; rep < NREP(8); ++rep) { if (IN(pb + 7)) ph_moeup(lds, l); REPBAR(rep, 8); }   SEAM(pb + 7);
        for (int rep = 0; rep < NREP(9); ++rep) { if (IN(pb + 8)) ph_moedown(lds, l); REPBAR(rep, 9); } SEAM(pb + 8);
    }
    if (IN(NPH - 1)) ph_final(lds);
#undef IN
#undef SEAM
}

extern "C" void kernel_launch(void* const* d_in, const int* in_sizes, int n_in, void* d_out, int out_size, void* d_ws, size_t ws_size, hipStream_t stream) {
    static int grid = 0;
    if (grid == 0) {
        if (n_in != 21 || out_size != NB * SEQ * DM || ws_size < (DUP_MASK ? (size_t)2147483648u : WS_END)) { fprintf(stderr, "kernel_launch: unexpected shapes (n_in %d out %d ws %zu need %zu)\n", n_in, out_size, ws_size, (size_t)WS_END); grid = -1; return; }
        int dev = 0, cus = 0, per_cu = 0;
        if (hipGetDevice(&dev) != hipSuccess || hipDeviceGetAttribute(&cus, hipDeviceAttributeMultiprocessorCount, dev) != hipSuccess) { grid = -1; return; }
        if (hipFuncSetAttribute((const void*)fwd_kernel, hipFuncAttributeMaxDynamicSharedMemorySize, LDS_BYTES) != hipSuccess) { fprintf(stderr, "kernel_launch: hipFuncSetAttribute failed\n"); grid = -1; return; }
        if (hipOccupancyMaxActiveBlocksPerMultiprocessor(&per_cu, (const void*)fwd_kernel, 512, LDS_BYTES) != hipSuccess || per_cu < 1) fprintf(stderr, "kernel_launch: occupancy query says %d\n", per_cu);
        (void)hipGetLastError();
        grid = cus;
    }
    if (grid < 0) return;
    (void)hipMemsetAsync((char*)d_ws + WS_CTL, 0, CTL_ZERO_BYTES, stream);
    Args a{};
    for (int i = 0; i < 21; ++i) a.in[i] = (const float*)d_in[i];
    a.out = (float*)d_out; a.ws = (unsigned char*)d_ws;
#if MK_N_LAUNCHES == 1
    a.ph_lo = 0; a.ph_hi = NPH;
    hipLaunchKernelGGL(fwd_kernel, dim3(grid), dim3(512), LDS_BYTES, stream, a);
#else
    for (int p = 0; p < NPH; ++p) { a.ph_lo = p; a.ph_hi = p + 1; hipLaunchKernelGGL(fwd_kernel, dim3(grid), dim3(512), LDS_BYTES, stream, a); }
#endif
}
```

```cpp
#include <hip/hip_runtime.h>
#include <cstdio>
#include <cstdint>

#ifndef MK_N_LAUNCHES
#define MK_N_LAUNCHES 1
#endif

#define GAS __attribute__((address_space(1)))
#define LAS __attribute__((address_space(3)))
typedef unsigned short bf16;
typedef unsigned u32x4 __attribute__((ext_vector_type(4)));
typedef unsigned u32x2 __attribute__((ext_vector_type(2)));
typedef float f32x4 __attribute__((ext_vector_type(4)));
typedef float f32x2 __attribute__((ext_vector_type(2)));
typedef float f32x16 __attribute__((ext_vector_type(16)));
typedef short bf16x8 __attribute__((ext_vector_type(8)));
typedef short s16x4 __attribute__((ext_vector_type(4)));
#define LDS_WAIT() asm volatile("s_waitcnt lgkmcnt(0)" ::: "memory")
#define VM_WAIT() asm volatile("s_waitcnt vmcnt(0)" ::: "memory")

constexpr int NB = 4, SEQ = 4096, NMETA = 16, TT = SEQ + NMETA;
constexpr int PADF = 48, TP = 4160;
constexpr int R = NB * TP;
constexpr int DM = 2048, DEPTH = 4;
constexpr int DIN = 5990, DINP = 6144;
constexpr int NEXP = 32, DEXP = 512;
constexpr float EPS = 1e-6f;
constexpr int C_AQ = 0, C_AK = 768, C_AV = 896, C_IQ = 1024, C_BQ = 2048, C_BK = 2816, C_BV = 3584, C_CQ = 4352, C_CK = 4608, C_CV = 4864, C_CG = 5376, C_IK = 5888;
constexpr int S_IK = 0, S_IW = 64, S_BF = 80, S_CR = 86;

constexpr size_t al256(size_t x) { return (x + 255) & ~(size_t)255; }
constexpr size_t WS_CTL = 0, CTL_ZERO_BYTES = 1u << 20;
constexpr size_t WS_COS128 = WS_CTL + CTL_ZERO_BYTES;
constexpr size_t WS_SIN128 = WS_COS128 + al256((size_t)TT * 64 * 4);
constexpr size_t WS_COS64 = WS_SIN128 + al256((size_t)TT * 64 * 4);
constexpr size_t WS_SIN64 = WS_COS64 + al256((size_t)TT * 32 * 4);
constexpr size_t WS_WIN = WS_SIN64 + al256((size_t)TT * 32 * 4);
constexpr size_t SZ_WIN = (size_t)DINP * DM * 2;
constexpr size_t WS_WOUT = WS_WIN + DEPTH * SZ_WIN;
constexpr size_t SZ_WOUT = (size_t)DM * DM * 2;
constexpr size_t WS_W13 = WS_WOUT + DEPTH * SZ_WOUT;
constexpr size_t SZ_W13E = (size_t)1024 * DM * 2, SZ_W13 = NEXP * SZ_W13E;
constexpr size_t WS_W2 = WS_W13 + DEPTH * SZ_W13;
constexpr size_t SZ_W2E = (size_t)DM * DEXP * 2, SZ_W2 = NEXP * SZ_W2E;
constexpr size_t WS_WR = WS_W2 + DEPTH * SZ_W2;
constexpr size_t SZ_WR = (size_t)2 * 48 * DM * 2;
constexpr size_t WS_H = WS_WR + DEPTH * SZ_WR;
constexpr size_t WS_U = WS_H + (size_t)R * DM * 4;
constexpr size_t WS_Z = WS_U + (size_t)R * DM * 2;
constexpr size_t WS_ZS = WS_Z + (size_t)R * DINP * 2;
constexpr size_t WS_LA = WS_ZS + (size_t)R * 256 * 4;
constexpr size_t WS_MIX = WS_LA + (size_t)R * 256 * 4;
constexpr int HID_TILES = 168;
constexpr size_t WS_HID = WS_MIX + (size_t)R * DM * 2;
constexpr size_t WS_Y0 = WS_HID + (size_t)HID_TILES * 256 * DEXP * 2;
constexpr size_t WS_Y1 = WS_Y0 + (size_t)R * DM * 2;
constexpr size_t WS_KV = WS_Y1 + (size_t)R * DM * 2;
constexpr size_t WS_DVEC = WS_KV + (size_t)16 * 65 * 64 * 128 * 4;
constexpr size_t WS_SS = WS_DVEC + al256((size_t)16 * 65 * 64 * 4);
constexpr size_t WS_LIST = WS_SS + (size_t)16 * 66 * 64 * 128 * 4;
constexpr size_t WS_GATE = WS_LIST + (size_t)NEXP * R * 4;
constexpr size_t WS_IKC = WS_GATE + (size_t)R * 2 * 4;
constexpr size_t WS_KAC = WS_IKC + (size_t)R * 64 * 2;
constexpr size_t WS_VAC = WS_KAC + (size_t)R * 128 * 2;
constexpr size_t WS_END = WS_VAC + (size_t)R * 128 * 2;

constexpr int CW_BAR = 4096;
constexpr int CW_CNT = 16384;
constexpr int CW_QUEUE = 20480;

constexpr int RING_BYTES = 131072;
constexpr int MOETAB_OFF = 131072;
constexpr int LDSCTL_OFF = 143360, MISC_OFF = LDSCTL_OFF + 320;
constexpr int LDS_BYTES = 147456;

constexpr int WAVETAB_OFF = LDSCTL_OFF + 1536;
__device__ __forceinline__ int get_tid() {
    const unsigned slot = (unsigned)__builtin_amdgcn_s_getreg((5 << 11) | 4) & 63u;
    const unsigned w = *(volatile LAS unsigned*)(uintptr_t)(WAVETAB_OFF + 4 * slot);
    unsigned lane; asm volatile("v_mbcnt_lo_u32_b32 %0, -1, 0\n\tv_mbcnt_hi_u32_b32 %0, -1, %0" : "=v"(lane));
    return (int)((unsigned)__builtin_amdgcn_readfirstlane(w) * 64u + lane);
}
typedef __bf16 bf16x2_t __attribute__((ext_vector_type(2)));
__device__ __forceinline__ unsigned cvtpk(float lo, float hi) { const bf16x2_t v = __builtin_convertvector((f32x2){lo, hi}, bf16x2_t); return __builtin_bit_cast(unsigned, v); }
__device__ __forceinline__ float bf2f(unsigned short b) { return __uint_as_float(((unsigned)b) << 16); }
__device__ __forceinline__ float bflo(unsigned w) { return __uint_as_float(w << 16); }
__device__ __forceinline__ float bfhi(unsigned w) { return __uint_as_float(w & 0xffff0000u); }
__device__ __forceinline__ bf16 f2bf(float f) { return (bf16)(cvtpk(f, 0.f) & 0xffffu); }
__device__ __forceinline__ float wave_sum(float v) {
#pragma unroll
    for (int o = 1; o < 64; o <<= 1) v += __shfl_xor(v, o);
    return v;
}
__device__ __forceinline__ f32x4 zero4() { float z = 0.f; asm volatile("" : "+v"(z)); return (f32x4){z, z, z, z}; }
__device__ __forceinline__ float logsigmoidf(float x) { const float e = __builtin_amdgcn_exp2f(-fabsf(x) * 1.4426950408889634f); return fminf(x, 0.f) - __builtin_amdgcn_logf(1.0f + e) * 0.6931471805599453f; }
__device__ __forceinline__ float fexp_(float x) { return __builtin_amdgcn_exp2f(x * 1.4426950408889634f); }
__device__ __forceinline__ float rsqrt_(float x) { return __builtin_amdgcn_rsqf(x); }
__device__ __forceinline__ float siluf(float x) { return x * __builtin_amdgcn_rcpf(1.f + __builtin_amdgcn_exp2f(-x * 1.4426950408889634f)); }

#define XB_TMO      128
#define XB_XCNT(j)  (256  + 64 * (j))
#define XB_XSUB(j)  (1280 + 64 * (j))
#define XB_XGEN(j)  (2304 + 64 * (j))
#define XB_TOP      3328
#define XB_TOPGEN   3392
#define XCD_BAR_WORDS 3456
#define XB_SPIN_CAP (1u << 18)
__device__ __forceinline__ unsigned xb_ld(unsigned* p)              { return __hip_atomic_load(p, __ATOMIC_RELAXED, __HIP_MEMORY_SCOPE_AGENT); }
__device__ __forceinline__ unsigned xb_add(unsigned* p, unsigned v) { return __hip_atomic_fetch_add(p, v, __ATOMIC_RELAXED, __HIP_MEMORY_SCOPE_AGENT); }
__device__ __forceinline__ unsigned xb_xcc_id() { return (unsigned)__builtin_amdgcn_s_getreg((3 << 11) | 20) & 0xFu; }
#define XB_SPIN(cond, bar) do { unsigned _sp = 0; while (cond) { __builtin_amdgcn_s_sleep(1); \
    if ((++_sp & 255u) == 0u) { if (xb_ld(&(bar)[XB_TMO])) break; if (_sp > XB_SPIN_CAP) { atomicAdd(&(bar)[XB_TMO], 1u); break; } } } } while (0)
struct XcdBarrier { unsigned* bar; unsigned x; volatile LAS unsigned* st; };
__device__ __forceinline__ XcdBarrier xcd_barrier_post(unsigned* bar, volatile LAS unsigned* st) {
    XcdBarrier b; b.bar = bar; b.x = xb_xcc_id(); b.st = st;
    if (get_tid() == 0) (void)xb_add(&bar[XB_XCNT(b.x)], 1u);
    return b;
}
__device__ __forceinline__ void xcd_barrier_complete(unsigned* bar, unsigned x, unsigned& nloc, unsigned& nx) {
    const unsigned G = gridDim.x * gridDim.y * gridDim.z;
    unsigned sum, cnt, mine, sp = 0u;
    for (;;) {
        sum = 0u; cnt = 0u; mine = 0u;
#pragma unroll
        for (unsigned j = 0; j < 16; ++j) { const unsigned c = xb_ld(&bar[XB_XCNT(j)]); sum += c; cnt += (c > 0u) ? 1u : 0u; mine = (j == x) ? c : mine; }
        if (sum == G) break;
        __builtin_amdgcn_s_sleep(1);
        if ((++sp & 255u) == 0u) { if (xb_ld(&bar[XB_TMO])) break; if (sp > XB_SPIN_CAP) { atomicAdd(&bar[XB_TMO], 1u); break; } }
    }
    nloc = mine > 0u ? mine : 1u; nx = cnt > 0u ? cnt : 1u;
}
__device__ __forceinline__ void xcd_barrier(const XcdBarrier& b) {
    asm volatile("s_waitcnt vmcnt(0)" ::: "memory");
    __syncthreads();
    if (get_tid() == 0) {
        unsigned* bar = b.bar; unsigned bx = b.x;
        asm volatile("" : "+s"(bar), "+s"(bx));
        __builtin_amdgcn_s_waitcnt(0);
        unsigned nloc = b.st[0], nx = b.st[1];
        if (nloc == 0u) { xcd_barrier_complete(bar, bx, nloc, nx); b.st[0] = nloc; b.st[1] = nx; }
        const unsigned old = xb_add(&bar[XB_XSUB(bx)], 1u);
        const unsigned gen = old / nloc;
        if (old + 1u == (gen + 1u) * nloc) {
            __builtin_amdgcn_fence(__ATOMIC_RELEASE, "agent");
            asm volatile("s_waitcnt vmcnt(0)" ::: "memory");
            const unsigned og = xb_add(&bar[XB_TOP], 1u);
            const unsigned tg = og / nx;
            if (og + 1u == (tg + 1u) * nx) xb_add(&bar[XB_TOPGEN], 1u);
            else XB_SPIN(xb_ld(&bar[XB_TOPGEN]) == tg, bar);
            __builtin_amdgcn_fence(__ATOMIC_ACQUIRE, "agent");
            xb_add(&bar[XB_XGEN(bx)], 1u);
            asm volatile("s_waitcnt vmcnt(0)" ::: "memory");
        } else {
            XB_SPIN(xb_ld(&bar[XB_XGEN(bx)]) == gen, bar);
            __builtin_amdgcn_fence(__ATOMIC_ACQUIRE, "agent");
            asm volatile("s_waitcnt vmcnt(0)" ::: "memory");
        }
    }
    __syncthreads();
}

namespace pg8 {
constexpr int BM = 256, BK = 64, HALF = 128, HTB = HALF * BK * 2, STAGE_BYTES = 8 * HTB;
__host__ __device__ __forceinline__ int lds_byte(int r, int c) { const int st = (r >> 4) * 2 + (c >> 5), rr = r & 15, cc = c & 31, ob = rr * 64 + cc * 2; return st * 1024 + (ob ^ (((ob >> 9) & 1) << 5)); }
__host__ __device__ __forceinline__ void stage_rc(int b, int& Rr, int& C) { const int st = b / 1024, sb = b % 1024, swz = sb ^ (((sb >> 9) & 1) << 5); Rr = (st >> 1) * 16 + swz / 64; C = (st & 1) * 32 + (swz % 64) / 2; }
__host__ __device__ __forceinline__ int perm32(int rho) { const int n = rho >> 4, i = rho & 15; return 8 * (i >> 2) + 4 * n + (i & 3); }
struct Unit { int pm, pn, e, r0; };

template <class Epi, class Prob>
__device__ __forceinline__ void gemm_phase(LAS unsigned char* lds, const Prob& P, const Epi& E) {
    int tid = get_tid();
    const int wid = __builtin_amdgcn_readfirstlane(tid >> 6), lane = tid & 63, wr = wid >> 2, wc = wid & 3, fr = lane & 15, fq = lane >> 4;
    const int K = P.K, nt = K / BK;
    unsigned voffB;
    { int Rr, C; stage_rc(tid * 16, Rr, C); const int Rb = Epi::PERM ? ((Rr & ~31) + perm32(Rr & 31)) : Rr; voffB = (unsigned)(Rb * K + C) * 2u; }
    const size_t hstep = (size_t)HALF * K * 2, qstepB = (size_t)64 * K * 2;
    const unsigned ldsw = (unsigned)wid * 1024u;
    const int aoff = lds_byte(wr * 64 + fr, fq * 8), boff = lds_byte(wc * 32 + fr, fq * 8);
#define PG8_SA(b, h) (((b) * 2 + (h)) * HTB)
#define PG8_SB(b, h) ((4 + (b) * 2 + (h)) * HTB)
#define PG8_STAGE1(bufoff, gbase, voff, qstep) do { _Pragma("unroll") for (int _i = 0; _i < 2; ++_i) \
        __builtin_amdgcn_global_load_lds((const unsigned*)((const char*)(gbase) + (size_t)_i * (qstep) + (voff)), (LAS unsigned*)(lds + (bufoff) + ldsw + _i * 8192), 16, 0, 0); } while (0)
#define PG8_STAGE2(bufoff, gbase, voff) do { _Pragma("unroll") for (int _i = 0; _i < 2; ++_i) \
        __builtin_amdgcn_global_load_lds((const unsigned*)((const char*)(gbase) + (voff)[_i]), (LAS unsigned*)(lds + (bufoff) + ldsw + _i * 8192), 16, 0, 0); } while (0)
#define PG8_STB(bufoff, gbase) PG8_STAGE1(bufoff, gbase, voffB, qstepB)
#define PG8_STA(bufoff, gbase, h) do { if constexpr (GA) PG8_STAGE2(bufoff, gbase, ao[h]); else PG8_STAGE1(bufoff, (gbase) + (size_t)(h) * hstepA, ao[0][0], qstepA); } while (0)
#define PG8_LDA(dst, b, h) do { _Pragma("unroll") for (int m = 0; m < 4; ++m) _Pragma("unroll") for (int k = 0; k < 2; ++k) dst[m][k] = *(const LAS bf16x8*)(lds + PG8_SA(b, h) + aoff + m * 2048 + k * 1024); } while (0)
#define PG8_LDB(dst, b, h) do { _Pragma("unroll") for (int n = 0; n < 2; ++n) _Pragma("unroll") for (int k = 0; k < 2; ++k) dst[n][k] = *(const LAS bf16x8*)(lds + PG8_SB(b, h) + boff + n * 2048 + k * 1024); } while (0)
#define PG8_MMA(ai, bj, At, Bt) do { __builtin_amdgcn_s_setprio(1); _Pragma("unroll") for (int m = 0; m < 4; ++m) _Pragma("unroll") for (int n = 0; n < 2; ++n) _Pragma("unroll") for (int k = 0; k < 2; ++k) \
        acc[ai][bj][m][n] = __builtin_amdgcn_mfma_f32_16x16x32_bf16(Bt[n][k], At[m][k], acc[ai][bj][m][n], 0, 0, 0); __builtin_amdgcn_s_setprio(0); } while (0)
#define PG8_WAIT_V(n) asm volatile("s_waitcnt vmcnt(" #n ")" ::: "memory")
#define PG8_WAIT_L(n) asm volatile("s_waitcnt lgkmcnt(" #n ")" ::: "memory")
#define PG8_BAR __builtin_amdgcn_s_barrier()
#define PG8_SCHED __builtin_amdgcn_sched_barrier(0)
    Unit cur, nxt; int ui = 0;
    if (!P.next(0, cur)) return;
    constexpr bool GA = Prob::GATHER;
    unsigned ao[2][2]; const size_t hstepA = (size_t)HALF * P.lda * 2, qstepA = (size_t)64 * P.lda * 2;
    const char* cA = P.abase();
    if constexpr (GA) P.aoffs(cur, tid, ao);
    else { ao[0][0] = P.aoffs0(tid); cA += P.aunit(cur); }
    const char* cB = P.bptr(cur);
    const size_t kstep = (size_t)(BK * 2);
    PG8_STB(PG8_SB(0, 0), cB); PG8_STB(PG8_SB(0, 1), cB + hstep); PG8_STA(PG8_SA(0, 0), cA, 0); PG8_STA(PG8_SA(0, 1), cA, 1);
    if (wr == 1) PG8_BAR;
    PG8_WAIT_V(2); PG8_BAR;
    PG8_STB(PG8_SB(1, 0), cB + kstep); PG8_STA(PG8_SA(1, 0), cA + kstep, 0); PG8_STB(PG8_SB(1, 1), cB + hstep + kstep);
    PG8_WAIT_V(6); PG8_BAR;
    f32x4 acc[2][2][4][2];
#pragma unroll
    for (int a = 0; a < 2; ++a)
#pragma unroll
        for (int b = 0; b < 2; ++b)
#pragma unroll
            for (int m = 0; m < 4; ++m)
#pragma unroll
                for (int n = 0; n < 2; ++n) acc[a][b][m][n] = zero4();
    bf16x8 At[4][2], B0[2][2], B1[2][2];
    for (;;) {
        const bool has_next = P.next(ui + 1, nxt);
        const char* nB = has_next ? P.bptr(nxt) : cB;
        const char* nA = (has_next && !GA) ? P.abase() + P.aunit(nxt) : cA;
        for (int t = 0; t < nt; t += 2) {
            const bool last = (t == nt - 2);
            const char* a1 = cA + (size_t)(t + 1) * kstep;
            const char* a2 = last ? nA : cA + (size_t)(t + 2) * kstep; const char* b2 = last ? nB : cB + (size_t)(t + 2) * kstep;
            const char* a3 = a2 + kstep; const char* b3 = b2 + kstep;
            PG8_LDB(B0, 0, 0); PG8_LDB(B1, 0, 1); PG8_SCHED; PG8_LDA(At, 0, 0); PG8_STA(PG8_SA(1, 1), a1, 1);
            if constexpr (GA) { if (last && has_next) P.aoffs(nxt, tid, ao); }
            PG8_WAIT_V(8); PG8_WAIT_L(0); PG8_BAR; PG8_MMA(0, 0, At, B0); PG8_MMA(0, 1, At, B1); PG8_BAR; PG8_SCHED;
            PG8_LDA(At, 0, 1); PG8_STB(PG8_SB(0, 0), b2); PG8_STB(PG8_SB(0, 1), b2 + hstep); PG8_STA(PG8_SA(0, 0), a2, 0);
            PG8_WAIT_V(8); PG8_WAIT_L(0); PG8_BAR; PG8_MMA(1, 0, At, B0); PG8_MMA(1, 1, At, B1); PG8_BAR; PG8_SCHED;
            PG8_LDB(B0, 1, 0); PG8_LDB(B1, 1, 1); PG8_SCHED; PG8_LDA(At, 1, 0); PG8_STA(PG8_SA(0, 1), a2, 1);
            PG8_WAIT_V(8); PG8_WAIT_L(0); PG8_BAR; PG8_MMA(0, 0, At, B0); PG8_MMA(0, 1, At, B1); PG8_BAR; PG8_SCHED;
            PG8_LDA(At, 1, 1); PG8_STB(PG8_SB(1, 0), b3); PG8_STB(PG8_SB(1, 1), b3 + hstep); PG8_STA(PG8_SA(1, 0), a3, 0);
            PG8_WAIT_V(8); PG8_WAIT_L(0); PG8_BAR; PG8_MMA(1, 0, At, B0); PG8_MMA(1, 1, At, B1); PG8_BAR; PG8_SCHED;
        }
        if (wr == 0) PG8_BAR;
        { const int tz = get_tid(); const int wz = tz >> 6, lz = tz & 63; E(acc, cur, wz >> 2, wz & 3, lz & 15, lz >> 4); }
        if (!has_next) break;
#pragma unroll
        for (int a = 0; a < 2; ++a)
#pragma unroll
            for (int b = 0; b < 2; ++b)
#pragma unroll
                for (int m = 0; m < 4; ++m)
#pragma unroll
                    for (int n = 0; n < 2; ++n) acc[a][b][m][n] = zero4();
        cur = nxt; cB = nB; cA = nA; ++ui;
        if (wr == 1) PG8_BAR;
    }
    PG8_WAIT_V(0);
    PG8_BAR;
#undef PG8_SA
#undef PG8_STAGE1
#undef PG8_STAGE2
#undef PG8_STB
#undef PG8_STA
#undef PG8_SB
#undef PG8_LDA
#undef PG8_LDB
#undef PG8_MMA
#undef PG8_WAIT_V
#undef PG8_WAIT_L
#undef PG8_BAR
#undef PG8_SCHED
}

__host__ __device__ __forceinline__ int mrow(int pm) { return (pm >> 4) * TP + 64 + (pm & 15) * 256; }
struct DenseProb {
    int K; const char* A; const char* Bt; int nM, nN, nwg, G, c;
    __device__ __forceinline__ void init(const void* A_, const void* Bt_, int M, int N, int K_, int G_, int c_) { A = (const char*)A_; Bt = (const char*)Bt_; K = K_; lda = K_; nM = M / BM; nN = N / BM; nwg = nM * nN; G = G_; c = c_; }
    __device__ __forceinline__ bool next(int i, Unit& u) const {
        const int L = i * G + c; if (L >= nwg) return false;
        int wgid = L; { const int q = nwg / 8, r = nwg % 8, xcd = wgid % 8, off = wgid / 8; wgid = (xcd < r ? xcd * (q + 1) : r * (q + 1) + (xcd - r) * q) + off; }
        const int nig = 8 * nN, gid = wgid / nig, fm = gid * 8, gsz = (nM - fm) < 8 ? (nM - fm) : 8;
        u.pm = fm + ((wgid % nig) % gsz); u.pn = (wgid % nig) / gsz; u.e = 0; u.r0 = 0; return true;
    }
    static constexpr bool GATHER = false; int lda;
    __device__ __forceinline__ const char* abase() const { return A; }
    __device__ __forceinline__ size_t aunit(const Unit& u) const { return (size_t)mrow(u.pm) * K * 2; }
    __device__ __forceinline__ unsigned aoffs0(int tid) const { int Rr, C; stage_rc(tid * 16, Rr, C); return (unsigned)(Rr * K + C) * 2u; }
    __device__ __forceinline__ void aoffs(const Unit&, int, unsigned (&)[2][2]) const {}
    __device__ __forceinline__ const char* bptr(const Unit& u) const { return Bt + (size_t)u.pn * BM * K * 2; }
};
struct MoeTab { int e[176]; int r0[176]; int cnt[32]; int ntiles; };
template <bool UP> struct MoeProb {
    int K; const char* A; const char* W; const unsigned* list; const LAS MoeTab* tab; int G, c;
    __device__ __forceinline__ bool next(int i, Unit& u) const {
        constexpr int NPN = UP ? 4 : 8;
        const int L = i * G + c; if (L >= __builtin_amdgcn_readfirstlane(tab->ntiles) * NPN) return false;
        const int tile = L / NPN; u.pm = tile; u.pn = L % NPN; u.e = __builtin_amdgcn_readfirstlane(tab->e[tile]); u.r0 = __builtin_amdgcn_readfirstlane(tab->r0[tile]); return true;
    }
    static constexpr bool GATHER = UP; int lda;
    __device__ __forceinline__ const char* abase() const { return A; }
    __device__ __forceinline__ size_t aunit(const Unit& u) const { return (size_t)u.pm * BM * DEXP * 2; }
    __device__ __forceinline__ unsigned aoffs0(int tid) const { int Rr, C; stage_rc(tid * 16, Rr, C); return (unsigned)(Rr * DEXP + C) * 2u; }
    __device__ __forceinline__ void aoffs(const Unit& u, int tid_, unsigned (&o)[2][2]) const {
        int tid = get_tid(); (void)tid_;
        const int n = __builtin_amdgcn_readfirstlane(tab->cnt[u.e]);
#pragma unroll
        for (int i = 0; i < 2; ++i) { int Rr, C; stage_rc(tid * 16 + i * 8192, Rr, C);
#pragma unroll
            for (int h = 0; h < 2; ++h) { const int li = u.r0 + h * HALF + Rr;
                const unsigned row = (li < n) ? (list[(size_t)u.e * R + li] >> 1) : (unsigned)PADF;
                o[h][i] = (row * (unsigned)DM + (unsigned)C) * 2u; } }
    }
    __device__ __forceinline__ const char* bptr(const Unit& u) const { return W + (size_t)u.e * (UP ? SZ_W13E : SZ_W2E) + (size_t)u.pn * BM * K * 2; }
};

struct EpiInProj {
    static constexpr bool PERM = true;
    bf16* Z; float* ZS;
    __device__ __forceinline__ void operator()(const f32x4 (&acc)[2][2][4][2], const Unit& u, int wr, int wc, int fr, int fq) const {
        const int row0 = mrow(u.pm) + wr * 64 + fr;
        if (u.pn < 23) {
            const int col0 = u.pn * BM + wc * 32 + 8 * fq;
#pragma unroll
            for (int ai = 0; ai < 2; ++ai)
#pragma unroll
                for (int m = 0; m < 4; ++m) { bf16* rowp = Z + (size_t)(row0 + ai * HALF + m * 16) * DINP + col0;
#pragma unroll
                    for (int bj = 0; bj < 2; ++bj) { const f32x4 v0 = acc[ai][bj][m][0], v1 = acc[ai][bj][m][1];
                        u32x4 w; w.x = cvtpk(v0[0], v0[1]); w.y = cvtpk(v0[2], v0[3]); w.z = cvtpk(v1[0], v1[1]); w.w = cvtpk(v1[2], v1[3]);
                        *(u32x4*)(rowp + bj * HALF) = w; } }
        } else {
            const int col0 = wc * 32 + 8 * fq;
#pragma unroll
            for (int ai = 0; ai < 2; ++ai)
#pragma unroll
                for (int m = 0; m < 4; ++m) { float* rowp = ZS + (size_t)(row0 + ai * HALF + m * 16) * 256 + col0;
#pragma unroll
                    for (int bj = 0; bj < 2; ++bj) { *(f32x4*)(rowp + bj * HALF) = acc[ai][bj][m][0]; *(f32x4*)(rowp + bj * HALF + 4) = acc[ai][bj][m][1]; } }
        }
    }
};
struct EpiOutProj {
    static constexpr bool PERM = false;
    float* H;
    __device__ __forceinline__ void operator()(const f32x4 (&acc)[2][2][4][2], const Unit& u, int wr, int wc, int fr, int fq) const {
        const int row0 = mrow(u.pm) + wr * 64 + fr, col0 = u.pn * BM + wc * 32 + 4 * fq;
#pragma unroll
        for (int ai = 0; ai < 2; ++ai) { float* base = H + (size_t)(row0 + ai * HALF) * DM + col0;
            f32x4 hv[4][2][2];
#pragma unroll
            for (int m = 0; m < 4; ++m)
#pragma unroll
                for (int bj = 0; bj < 2; ++bj)
#pragma unroll
                    for (int n = 0; n < 2; ++n) hv[m][bj][n] = *(const f32x4*)(base + (size_t)(m * 16) * DM + bj * HALF + n * 16);
#pragma unroll
            for (int m = 0; m < 4; ++m)
#pragma unroll
                for (int bj = 0; bj < 2; ++bj)
#pragma unroll
                    for (int n = 0; n < 2; ++n) *(f32x4*)(base + (size_t)(m * 16) * DM + bj * HALF + n * 16) = hv[m][bj][n] + acc[ai][bj][m][n];
            asm volatile("" ::: "memory"); }
    }
};
struct EpiMoeUp {
    static constexpr bool PERM = true;
    bf16* HID;
    __device__ __forceinline__ void operator()(const f32x4 (&acc)[2][2][4][2], const Unit& u, int wr, int wc, int fr, int fq) const {
        const int row0 = u.pm * BM + wr * 64 + fr, col0 = (u.pn * BM + wc * 32 + 8 * fq) >> 1;
#pragma unroll
        for (int ai = 0; ai < 2; ++ai)
#pragma unroll
            for (int m = 0; m < 4; ++m) { bf16* rowp = HID + (size_t)(row0 + ai * HALF + m * 16) * DEXP + col0;
#pragma unroll
                for (int bj = 0; bj < 2; ++bj) { const f32x4 a = acc[ai][bj][m][0], b = acc[ai][bj][m][1];
                    u32x2 w; w.x = cvtpk(siluf(a[0]) * b[0], siluf(a[1]) * b[1]); w.y = cvtpk(siluf(a[2]) * b[2], siluf(a[3]) * b[3]);
                    *(u32x2*)(rowp + bj * (HALF / 2)) = w; }
                asm volatile("" ::: "memory"); }
    }
};
struct EpiMoeDown {
    static constexpr bool PERM = true;
    bf16* Y0; bf16* Y1; const unsigned* list; const float* gate; const LAS MoeTab* tab;
    __device__ __forceinline__ void operator()(const f32x4 (&acc)[2][2][4][2], const Unit& u, int wr, int wc, int fr, int fq) const {
        const int n = __builtin_amdgcn_readfirstlane(tab->cnt[u.e]); const int col0 = u.pn * BM + wc * 32 + 8 * fq;
#pragma unroll
        for (int ai = 0; ai < 2; ++ai)
#pragma unroll
            for (int m = 0; m < 4; ++m) { const int li = u.r0 + ai * HALF + wr * 64 + m * 16 + fr;
                if (li < n) { const unsigned ent = list[(size_t)u.e * R + li]; const float g = gate[ent];
                    bf16* rowp = Y0 + (size_t)(ent & 1u) * ((size_t)R * DM) + (size_t)(ent >> 1) * DM + col0;
#pragma unroll
                    for (int bj = 0; bj < 2; ++bj) { const f32x4 v0 = acc[ai][bj][m][0] * g, v1 = acc[ai][bj][m][1] * g;
                        u32x4 w; w.x = cvtpk(v0[0], v0[1]); w.y = cvtpk(v0[2], v0[3]); w.z = cvtpk(v1[0], v1[1]); w.w = cvtpk(v1[2], v1[3]);
                        *(u32x4*)(rowp + bj * HALF) = w; } } }
    }
};
}

template <int MODE>
__device__ __forceinline__ void skinny_gemm(LAS unsigned char* lds, const bf16* A, const bf16* Bt, int K, int N, int bid, bf16* Zo, float* ZSo, float* Ho) {
    const int tid = get_tid(), lane = tid & 63, wave = __builtin_amdgcn_readfirstlane(tid >> 6), g = lane >> 4, c16 = lane & 15;
    if (bid >= N / 32) return;
    const int ksw = K / 32 / 8;
    f32x4 acc[4][2];
#pragma unroll
    for (int rt = 0; rt < 4; ++rt) { acc[rt][0] = zero4(); acc[rt][1] = zero4(); }
    const bf16* ap = A + (size_t)(PADF + c16) * K + 8 * g; const bf16* bp = Bt + (size_t)(32 * bid + c16) * K + 8 * g;
#pragma unroll 2
    for (int kk = 0; kk < ksw; ++kk) { const int ks = wave * ksw + kk;
        bf16x8 a[4], b[2];
#pragma unroll
        for (int rt = 0; rt < 4; ++rt) a[rt] = *(const bf16x8*)(ap + (size_t)rt * TP * K + 32 * ks);
#pragma unroll
        for (int ct = 0; ct < 2; ++ct) b[ct] = *(const bf16x8*)(bp + (size_t)(16 * ct) * K + 32 * ks);
#pragma unroll
        for (int rt = 0; rt < 4; ++rt)
#pragma unroll
            for (int ct = 0; ct < 2; ++ct) acc[rt][ct] = __builtin_amdgcn_mfma_f32_16x16x32_bf16(a[rt], b[ct], acc[rt][ct], 0, 0, 0); }
    LAS float* red = (LAS float*)lds;
#pragma unroll
    for (int rt = 0; rt < 4; ++rt)
#pragma unroll
        for (int ct = 0; ct < 2; ++ct)
#pragma unroll
            for (int r = 0; r < 4; ++r) red[wave * 2048 + (16 * rt + 4 * g + r) * 32 + 16 * ct + c16] = acc[rt][ct][r];
    __syncthreads();
    { const int rr = tid >> 3, c4 = 4 * (tid & 7); f32x4 sum = *(LAS f32x4*)(red + rr * 32 + c4);
#pragma unroll
      for (int w = 1; w < 8; ++w) sum = sum + *(LAS f32x4*)(red + w * 2048 + rr * 32 + c4);
      const size_t row = (size_t)(rr >> 4) * TP + PADF + (rr & 15); const int col = 32 * bid + c4;
      if (MODE == 0) { if (col < C_IK) { u32x2 w2; w2.x = cvtpk(sum[0], sum[1]); w2.y = cvtpk(sum[2], sum[3]); *(u32x2*)(Zo + row * DINP + col) = w2; }
                       else *(f32x4*)(ZSo + row * 256 + (col - C_IK)) = sum; }
      else { float* hp = Ho + row * DM + col; *(f32x4*)hp = *(const f32x4*)hp + sum; } }
    __syncthreads();
}

namespace fox {
constexpr int D = 128, NW = 8, QBLK = 32, KVBLK = 64, QB = NW * QBLK;
constexpr int SHM_V = KVBLK * D * 2, SHM_K = KVBLK * D * 2;
constexpr int LDS_BODY = 2 * SHM_V + 2 * SHM_K + NW * 64 * 4;
constexpr int BIAS_OFF = LDS_BODY;
constexpr int SCAN_OFF = BIAS_OFF + TP * 4;
constexpr int LDQ = DINP, LDO = DM;
constexpr float SCALE = 0.08838834764831845f, THR = 8.f;
constexpr int WBIG = 1 << 28;
#define KSWZ(row, colB) ((row) * 256 + ((colB) ^ (((row) & 7) << 4)))
#define SBAR() __builtin_amdgcn_sched_barrier(0)
__device__ __forceinline__ int v_st(int k, int c) { const int kk = (k & ~0xC) | ((k & 4) << 1) | ((k & 8) >> 1); return ((kk >> 3) * 4 + (c >> 5)) * 512 + ((kk & 7) * 32 + (c & 31)) * 2; }
__device__ __forceinline__ int v_rd_base(int lane) { return ((lane & 3) << 3) | (((lane >> 2) & 3) << 6) | (((lane >> 4) & 1) << 5) | (((lane >> 5) & 1) << 8); }
constexpr int v_rd_off(int d0, int ks, int half) { return d0 * 512 + ks * 4096 + half * 2048; }
__device__ __forceinline__ int crow(int r, int hi) { return (r & 3) + 8 * (r >> 2) + 4 * hi; }
__device__ __forceinline__ bf16x8 load8(const bf16* p) { return *reinterpret_cast<const bf16x8*>(p); }
__device__ __forceinline__ void mask_tile(f32x16& p0, f32x16& p1, int dq, unsigned W) {
    const float NEG = -__builtin_inff();
#pragma unroll
    for (int r = 0; r < 16; ++r) {
        const int c = (r & 3) + 8 * (r >> 2);
        if ((unsigned)(dq - c) >= W) p0[r] = NEG;
        if ((unsigned)(dq - c - 32) >= W) p1[r] = NEG;
    }
}
__device__ __forceinline__ void partialSM(f32x16& p0, f32x16& p1, float& m_reg, float& mn, float& alpha) {
    float pmax = p0[0]; for (int r = 1; r < 16; ++r) pmax = fmaxf(pmax, p0[r]); for (int r = 0; r < 16; ++r) pmax = fmaxf(pmax, p1[r]);
    { auto rr = __builtin_amdgcn_permlane32_swap(__float_as_uint(pmax), __float_as_uint(pmax), false, false);
      pmax = fmaxf(__uint_as_float(rr[0]), __uint_as_float(rr[1])); }
    constexpr float C2 = 1.4426950408889634f * SCALE;
    if (__builtin_expect(__all((pmax - m_reg) * SCALE <= THR), 1)) { mn = m_reg; alpha = 1.f; }
    else { mn = fmaxf(m_reg, pmax); alpha = __builtin_amdgcn_exp2f((m_reg - mn) * C2); m_reg = mn; }
    const float mnL = -mn * C2;
    for (int r = 0; r < 16; ++r) p0[r] = fmaf(p0[r], C2, mnL); for (int r = 0; r < 16; ++r) p1[r] = fmaf(p1[r], C2, mnL);
    for (int r = 0; r < 16; ++r) p0[r] = __builtin_amdgcn_exp2f(p0[r]);
}
__device__ __forceinline__ void finishSM(f32x16& p0, f32x16& p1, float alpha, float& l_reg, bf16x8& pa0, bf16x8& pa1, bf16x8& pa2, bf16x8& pa3) {
    for (int r = 0; r < 16; ++r) p1[r] = __builtin_amdgcn_exp2f(p1[r]);
    float ps = 0; for (int r = 0; r < 16; ++r) ps += p0[r]; for (int r = 0; r < 16; ++r) ps += p1[r];
    { auto rr = __builtin_amdgcn_permlane32_swap(__float_as_uint(ps), __float_as_uint(ps), false, false);
      ps = __uint_as_float(rr[0]) + __uint_as_float(rr[1]); }
    l_reg = l_reg * alpha + ps;
#define PK4(P, B_, OUT) do { unsigned a0 = cvtpk(P[B_+0], P[B_+1]), a1 = cvtpk(P[B_+2], P[B_+3]);                          \
        unsigned b0 = cvtpk(P[B_+4], P[B_+5]), b1 = cvtpk(P[B_+6], P[B_+7]);                                             \
        auto r0 = __builtin_amdgcn_permlane32_swap(a0, b0, false, false); auto r1 = __builtin_amdgcn_permlane32_swap(a1, b1, false, false); \
        u32x4 w = {r0[0], r1[0], r0[1], r1[1]}; OUT = *reinterpret_cast<bf16x8*>(&w); } while (0)
    PK4(p0, 0, pa0); PK4(p0, 8, pa1); PK4(p1, 0, pa2); PK4(p1, 8, pa3);
#undef PK4
}
template <int KB>
__device__ __forceinline__ void qkt(f32x16& p0, f32x16& p1, const char* K_lds, const float* biask  , int r32, int hi, const bf16x8* qr) {
#pragma unroll
    for (int a = 0; a < 4; ++a) { const f32x4 b0 = *(const f32x4*)(biask + 8 * a), b1 = *(const f32x4*)(biask + 32 + 8 * a);
#pragma unroll
        for (int j = 0; j < 4; ++j) { p0[4 * a + j] = b0[j]; p1[4 * a + j] = b1[j]; } }
    const char* kb[4];
#pragma unroll
    for (int dd = 0; dd < 4; ++dd) kb[dd] = K_lds + KB * SHM_K + KSWZ(r32, (dd * 16 + hi * 8) * 2);
#pragma unroll
    for (int d0 = 0; d0 < 8; ++d0) { const char* a = kb[d0 & 3] + (d0 >> 2) * 128;
        bf16x8 b0 = *reinterpret_cast<const bf16x8*>(a);
        bf16x8 b1 = *reinterpret_cast<const bf16x8*>(a + 32 * 256);
        p0 = __builtin_amdgcn_mfma_f32_32x32x16_bf16(b0, qr[d0], p0, 0, 0, 0);
        p1 = __builtin_amdgcn_mfma_f32_32x32x16_bf16(b1, qr[d0], p1, 0, 0, 0); }
}
template <int VB>
__device__ __forceinline__ void pv_tile(f32x16* o, int vb0, bf16x8 pa0, bf16x8 pa1, bf16x8 pa2, bf16x8 pa3) {
#define TRRD(dst, off) asm volatile("ds_read_b64_tr_b16 %0, %1 offset:%2" : "=&v"(dst) : "v"(vb0), "i"(off) : "memory")
#define PV_D0(d0) do { s16x4 l0, l1, l2, l3, h0, h1, h2, h3; constexpr int b_ = VB * SHM_V + v_rd_off(d0, 0, 0); \
        TRRD(l0, b_); TRRD(h0, b_ + 2048); TRRD(l1, b_ + 4096); TRRD(h1, b_ + 6144); TRRD(l2, b_ + 8192); TRRD(h2, b_ + 10240); TRRD(l3, b_ + 12288); TRRD(h3, b_ + 14336); \
        asm volatile("s_waitcnt lgkmcnt(0)" ::: "memory"); SBAR();   \
        o[d0] = __builtin_amdgcn_mfma_f32_32x32x16_bf16(pa0, (bf16x8){l0[0], l0[1], l0[2], l0[3], h0[0], h0[1], h0[2], h0[3]}, o[d0], 0, 0, 0);   \
        o[d0] = __builtin_amdgcn_mfma_f32_32x32x16_bf16(pa1, (bf16x8){l1[0], l1[1], l1[2], l1[3], h1[0], h1[1], h1[2], h1[3]}, o[d0], 0, 0, 0);   \
        o[d0] = __builtin_amdgcn_mfma_f32_32x32x16_bf16(pa2, (bf16x8){l2[0], l2[1], l2[2], l2[3], h2[0], h2[1], h2[2], h2[3]}, o[d0], 0, 0, 0);   \
        o[d0] = __builtin_amdgcn_mfma_f32_32x32x16_bf16(pa3, (bf16x8){l3[0], l3[1], l3[2], l3[3], h3[0], h3[1], h3[2], h3[3]}, o[d0], 0, 0, 0); } while (0)
    PV_D0(0); PV_D0(1); PV_D0(2); PV_D0(3);
#undef PV_D0
#undef TRRD
}
struct BlockRef { const bf16* Q; const bf16* K; const bf16* V; bf16* O; int P0; int jlo; };
struct Seam { bf16x8 qr[8]; bf16x8 st_v0, st_v1, st_k0, st_k1; };
#define ROW(p, k0, rr) ((p) + (unsigned)(((k0) + (rr)) * LDQ + sc))
#define VMW() asm volatile("s_waitcnt vmcnt(0)" ::: "memory")
#define VMWN(n) asm volatile("s_waitcnt vmcnt(%0)" :: "i"(n) : "memory")
#define SLOAD_H(Kp, Vp, k0) do { S.st_v0 = load8(ROW(Vp, k0, sr)); S.st_v1 = load8(ROW(Vp, k0, 32 + sr));              \
                         S.st_k0 = load8(ROW(Kp, k0, sr)); S.st_k1 = load8(ROW(Kp, k0, 32 + sr)); } while (0)
#define SWRITE_HK(bf) do { *(bf16x8*)(K_lds + (bf) * SHM_K + kws) = S.st_k0; *(bf16x8*)(K_lds + (bf) * SHM_K + kws + 32 * 256) = S.st_k1; } while (0)
#define SWRITE_HV(bf) do { *(bf16x8*)(V_lds + (bf) * SHM_V + vst0) = S.st_v0; *(bf16x8*)(V_lds + (bf) * SHM_V + vst1) = S.st_v1; } while (0)
#define SWRITE_H(bf) do { SWRITE_HV(bf); SWRITE_HK(bf); } while (0)
__device__ __forceinline__ void prime(const BlockRef& cur, char* lds, Seam& S) {
    int tid = get_tid();
    const int wid = __builtin_amdgcn_readfirstlane(tid >> 6), lane = tid & 63, r32 = lane & 31, hi = lane >> 5;
    const int sr = tid >> 4, sc = (tid & 15) * 8, kws = KSWZ(sr, sc * 2); char* K_lds = lds + 2 * SHM_V;
    const int kb0 = cur.jlo * KVBLK;
    for (int d0 = 0; d0 < 8; ++d0) S.qr[d0] = load8(cur.Q + (unsigned)((wid * QBLK + r32) * LDQ + d0 * 16 + hi * 8));
    SLOAD_H(cur.K, cur.V, kb0); VMW(); SWRITE_HK(0);
    __syncthreads();
}
__device__ __forceinline__ void block(const BlockRef& cur, const BlockRef& nxt, int skv, char* lds, Seam& S) {
    constexpr int W = WBIG;
    int tid = get_tid();
    const int wid = __builtin_amdgcn_readfirstlane(tid >> 6), lane = tid & 63, r32 = lane & 31, hi = lane >> 5;
    const int j_lo = cur.jlo;
    int j_hi = (cur.P0 + QB - 1) / KVBLK + 1; if (j_hi > skv / KVBLK) j_hi = skv / KVBLK;
    const int NT = j_hi - j_lo;
    const int kbn = nxt.jlo * KVBLK;
    const int qlo = cur.P0 + wid * QBLK, qm = qlo + r32 - 4 * hi;
    char* V_lds = lds; char* K_lds = lds + 2 * SHM_V;
    float* ws = (float*)(lds + 2 * SHM_V + 2 * SHM_K) + wid * 64; float* li_l = ws, * al_l = ws + 32;
    const float* biasb = (const float*)(lds + BIAS_OFF) + 4 * hi;
    float m_reg = -1e30f, l_reg = 0; f32x16 o[4] = {};
    const int sr = tid >> 4, sc = (tid & 15) * 8, vst0 = v_st(sr, sc), vst1 = v_st(32 + sr, sc), kws = KSWZ(sr, sc * 2);
    const int vb0 = (int)(uintptr_t)V_lds + v_rd_base(lane);
    const bf16* Kh = cur.K; const bf16* Vh = cur.V;
#define RESC(a) do { if (__any((a) < 1.f)) { if (hi == 0) al_l[r32] = (a); asm volatile("s_waitcnt lgkmcnt(0)" ::: "memory");              \
                     for (int d_ = 0; d_ < 4; ++d_) for (int r = 0; r < 16; ++r) o[d_][r] *= al_l[crow(r, hi)]; } } while (0)
#define KBASE(t) ((j_lo + (t)) * KVBLK)
#define MASKT(P0_, P1_, t) do { const int kb_ = KBASE(t); if (kb_ + KVBLK - 1 > qlo) mask_tile(P0_, P1_, qm - kb_, (unsigned)W); } while (0)
    constexpr int NQL = 8;
#define SEAM_K0() do { VMWN(NQL); SWRITE_HK(0); SBAR(); } while (0)
    f32x16 pA0, pA1, pB0, pB1; float mnA, mnB, alA, alB; bf16x8 pa0, pa1, pa2, pa3;
    SWRITE_HV(0); SBAR();
    if (NT > 1) { SLOAD_H(Kh, Vh, KBASE(1)); }
    SBAR(); qkt<0>(pA0, pA1, K_lds, biasb + KBASE(0), r32, hi, S.qr);
    MASKT(pA0, pA1, 0); partialSM(pA0, pA1, m_reg, mnA, alA);
    if (NT > 1) { VMW(); SWRITE_H(1); }
    __syncthreads();
#define HALF_STEP(PX0, PX1, mnX, alX, PY0, PY1, alY, t, KB, VB, SB) do {                                                      \
        SBAR(); qkt<KB>(PX0, PX1, K_lds, biasb + KBASE(t), r32, hi, S.qr);                                             \
        finishSM(PY0, PY1, alY, l_reg, pa0, pa1, pa2, pa3); SBAR();                                                           \
        if ((t) + 1 < NT) { SLOAD_H(Kh, Vh, KBASE((t) + 1)); SBAR(); }                                               \
        pv_tile<VB>(o, vb0, pa0, pa1, pa2, pa3); MASKT(PX0, PX1, (t)); partialSM(PX0, PX1, m_reg, mnX, alX);                                        \
        __syncthreads();                                                                                                      \
        if ((t) + 1 < NT) { VMW(); SWRITE_H(SB); }                                                                          \
        RESC(alX); __syncthreads(); } while (0)
    for (int t = 1; t + 1 < NT; t += 2) {
        HALF_STEP(pB0, pB1, mnB, alB, pA0, pA1, alA, t, 1, 0, 0);
        HALF_STEP(pA0, pA1, mnA, alA, pB0, pB1, alB, t + 1, 0, 1, 1);
    }
    const bool even = (NT & 1) == 0;
    if (even) { SBAR(); qkt<1>(pB0, pB1, K_lds, biasb + KBASE(NT - 1), r32, hi, S.qr); SBAR(); }
    SLOAD_H(nxt.K, nxt.V, kbn); SBAR();
#pragma unroll
    for (int d0 = 0; d0 < 8; ++d0) S.qr[d0] = load8(nxt.Q + (unsigned)((wid * QBLK + r32) * LDQ + d0 * 16 + hi * 8));
    SBAR();
    finishSM(pA0, pA1, alA, l_reg, pa0, pa1, pa2, pa3); SBAR();
    pv_tile<0>(o, vb0, pa0, pa1, pa2, pa3);
    if (even) { MASKT(pB0, pB1, NT - 1); partialSM(pB0, pB1, m_reg, mnB, alB); __syncthreads(); RESC(alB);
        finishSM(pB0, pB1, alB, l_reg, pa0, pa1, pa2, pa3); SBAR(); pv_tile<1>(o, vb0, pa0, pa1, pa2, pa3); }
    SBAR(); SEAM_K0();
    if (hi == 0) li_l[r32] = l_reg; asm volatile("s_waitcnt lgkmcnt(0)" ::: "memory");
    float rli[16];
#pragma unroll
    for (int r = 0; r < 16; ++r) rli[r] = __builtin_amdgcn_rcpf(li_l[crow(r, hi)]);
    bf16* Ow = cur.O + (unsigned)(wid * QBLK * LDO);
#pragma unroll
    for (int r = 0; r < 16; ++r) { const int orow = crow(r, hi);
#pragma unroll
        for (int d0 = 0; d0 < 4; ++d0) { const float v = o[d0][r] * rli[r];
            const float vn = __shfl_xor(v, 1);
            if ((r32 & 1) == 0) *(unsigned*)(Ow + (unsigned)(orow * LDO + d0 * 32 + r32)) = cvtpk(v, vn); } }
    __syncthreads();
#undef RESC
#undef KBASE
#undef MASKT
#undef SEAM_K0
#undef HALF_STEP
}
#undef ROW
#undef VMW
#undef VMWN
#undef SLOAD_H
#undef SWRITE_HK
#undef SWRITE_HV
#undef SWRITE_H

__device__ __forceinline__ void build_bias(char* lds, const float* zs_b  , int h) {
    int tid = get_tid();
    const int lane = tid & 63, wid = tid >> 6;
    float* bias = (float*)(lds + BIAS_OFF); float* wsum = (float*)(lds + SCAN_OFF);
    float loc[9]; float s = 0.f;
#pragma unroll
    for (int k = 0; k < 9; ++k) { const int t = tid * 9 + k; const float x = (t < TT) ? zs_b[(size_t)(PADF + t) * 256 + S_BF + h] : 0.f; s += x; loc[k] = s; }
    float incl = s;
#pragma unroll
    for (int o = 1; o < 64; o <<= 1) { const float y = __shfl_up(incl, o); if (lane >= o) incl += y; }
    if (lane == 63) wsum[wid] = incl;
    __syncthreads();
    float woff = 0.f;
    for (int w = 0; w < wid; ++w) woff += wsum[w];
    const float excl = woff + incl - s;
    constexpr float INVS = 1.0f / SCALE;
#pragma unroll
    for (int k = 0; k < 9; ++k) { const int t = tid * 9 + k; if (t < TT) bias[PADF + t] = -(excl + loc[k]) * INVS; }
    if (tid < PADF) bias[tid] = -__builtin_inff();
    __syncthreads();
}
__device__ __forceinline__ int prune_jlo(const char* lds, int q0v) {
    const float* bias = (const float*)(lds + BIAS_OFF);
    constexpr float PRUNE = 64.f;
    const float thr = bias[q0v] - PRUNE * (1.0f / SCALE);
    int j = 0; const int jmax = q0v / KVBLK;
    while (j < jmax && bias[KVBLK * j + KVBLK - 1] < thr) ++j;
    return j;
}
__device__ __forceinline__ void item(char* lds, const bf16* Z, const float* ZS, bf16* MIX, int it) {
    const int bh = it >> 3, x = it & 7, b = bh / 6, h = bh % 6;
    build_bias(lds, ZS + (size_t)b * TP * 256, h);
    const bf16* zb = Z + (size_t)b * TP * DINP;
    BlockRef b0, b1;
    b0.K = b1.K = zb + C_BK + h * 128; b0.V = b1.V = zb + C_BV + h * 128;
    const int q0 = 64 + 256 * x, q1 = 64 + 256 * (15 - x);
    b0.Q = zb + (size_t)q0 * DINP + C_BQ + h * 128; b1.Q = zb + (size_t)q1 * DINP + C_BQ + h * 128;
    b0.O = MIX + (size_t)(b * TP + q0) * DM + 768 + h * 128; b1.O = MIX + (size_t)(b * TP + q1) * DM + 768 + h * 128;
    b0.P0 = q0; b1.P0 = q1;
    b0.jlo = prune_jlo(lds, q0); b1.jlo = prune_jlo(lds, q1);
    Seam S;
    prime(b0, lds, S);
    block(b0, b1, TP, lds, S);
    block(b1, b1, TP, lds, S);
}
__device__ __forceinline__ void meta_unit(const bf16* Z, const float* ZS, bf16* MIX, int b) {
    int tid = get_tid();
    const int lane = tid & 63, wid = tid >> 6;
    for (int task = wid; task < 96; task += 8) {
        const int h = task >> 4, m = task & 15;
        const size_t rq = (size_t)b * TP + PADF + m;
        const unsigned qw = *(const unsigned*)(Z + rq * DINP + C_BQ + h * 128 + 2 * lane);
        const float q0 = bflo(qw), q1 = bfhi(qw);
        float lg[16]; float F = 0.f, Fk[16];
#pragma unroll
        for (int k = 0; k < 16; ++k) { F += ZS[((size_t)b * TP + PADF + k) * 256 + S_BF + h]; Fk[k] = F; }
        float Fm = 0.f;
#pragma unroll
        for (int k = 0; k < 16; ++k) if (k == m) Fm = Fk[k];
        float mx = -1e30f;
#pragma unroll
        for (int k = 0; k < 16; ++k) { const size_t rk = (size_t)b * TP + PADF + k;
            const unsigned kw = *(const unsigned*)(Z + rk * DINP + C_BK + h * 128 + 2 * lane);
            const float d = wave_sum(q0 * bflo(kw) + q1 * bfhi(kw));
            lg[k] = (k <= m) ? d * SCALE + Fm - Fk[k] : -__builtin_inff(); mx = fmaxf(mx, lg[k]); }
        float sum = 0.f, o0 = 0.f, o1 = 0.f;
#pragma unroll
        for (int k = 0; k < 16; ++k) { const float p = fexp_(lg[k] - mx); sum += p;
            const size_t rk = (size_t)b * TP + PADF + k;
            const unsigned vw = *(const unsigned*)(Z + rk * DINP + C_BV + h * 128 + 2 * lane);
            o0 += p * bflo(vw); o1 += p * bfhi(vw); }
        const float inv = 1.f / sum;
        *(unsigned*)(MIX + rq * DM + 768 + h * 128 + 2 * lane) = cvtpk(o0 * inv, o1 * inv);
    }
}
}

namespace dsa {
constexpr int NQ = 8, SCW = TP;
constexpr int SC_BYTES = NQ * SCW * 4;
constexpr int IDX_OFF = SC_BYTES;
constexpr int LDS_NEED = SC_BYTES + NQ * 256 * 2;
constexpr int KTOP = 256;
typedef short s16x2v __attribute__((ext_vector_type(2)));
__device__ __forceinline__ unsigned relu_pk(unsigned w) { s16x2v v = *reinterpret_cast<s16x2v*>(&w); v = __builtin_elementwise_max(v, (s16x2v){0, 0}); return *reinterpret_cast<unsigned*>(&v); }
__device__ __forceinline__ unsigned sortable(float f) { const unsigned u = __float_as_uint(f); return (u >> 31) ? ~u : (u | 0x80000000u); }
__device__ __forceinline__ unsigned mbcnt(unsigned long long m) { return __builtin_amdgcn_mbcnt_hi((unsigned)(m >> 32), __builtin_amdgcn_mbcnt_lo((unsigned)m, 0u)); }
__device__ __forceinline__ unsigned off_b(unsigned row, unsigned ch) { return 256u * row + 16u * (ch ^ (((row & 3) << 2) | ((row >> 2) & 3))); }

template <int NG>
__device__ __forceinline__ void select_topk(const LAS float* myc, LAS unsigned short* idx, int lane) {
    LAS unsigned short* dump = (LAS unsigned short*)myc;
    unsigned key[NG];
#pragma unroll
    for (int j = 0; j < NG; ++j) key[j] = sortable(myc[64 * j + lane]);
    unsigned tau = 0u;
    for (int bit = 31; bit >= 0; --bit) {
        const unsigned cand = tau | (1u << bit); int cnt = 0;
#pragma unroll
        for (int j0 = 0; j0 < NG; j0 += 8) { unsigned long long mk[8];
#pragma unroll
            for (int q = 0; q < 8; ++q) mk[q] = (j0 + q < NG) ? __ballot(key[j0 + q] >= cand) : 0ull;
            asm volatile("" : "+s"(mk[0]), "+s"(mk[1]), "+s"(mk[2]), "+s"(mk[3]), "+s"(mk[4]), "+s"(mk[5]), "+s"(mk[6]), "+s"(mk[7]));
#pragma unroll
            for (int q = 0; q < 8; ++q) cnt += __popcll(mk[q]); }
        if (cnt >= KTOP) tau = cand;
        if (cnt == KTOP) break;
    }
    int cgt = 0;
#pragma unroll
    for (int j = 0; j < NG; ++j) cgt += __popcll(__ballot(key[j] > tau));
    int eq_rem = KTOP - cgt, run = 0;
#pragma unroll
    for (int j = 0; j < NG; ++j) {
        const bool gt = key[j] > tau, eq = key[j] == tau;
        const unsigned long long m_eq = __ballot(eq);
        const bool take = gt || (eq && (int)mbcnt(m_eq) < eq_rem);
        const unsigned long long m = __ballot(take);
        LAS unsigned short* dstp = take ? idx + run + (int)mbcnt(m) : dump + lane;
        *dstp = (unsigned short)(64 * j + lane);
        run += __popcll(m); const int ne = __popcll(m_eq); eq_rem -= (ne < eq_rem) ? ne : eq_rem;
    }
}
__device__ __forceinline__ void unit(LAS unsigned char* lds, const bf16* Z, const float* ZS, const bf16* IKC, const bf16* KAC, const bf16* VAC, bf16* MIX, int b, int c, int sub) {
    int tid = get_tid();
    const int lane = tid & 63, wave = __builtin_amdgcn_readfirstlane(tid >> 6), g = lane >> 4, c16 = lane & 15;
    const int v0 = 64 * c + 8 * sub;
    const size_t rb = (size_t)b * TP;
    LAS float* sc = (LAS float*)lds;
    {
        bf16x8 A[NQ][2];
#pragma unroll
        for (int qi = 0; qi < NQ; ++qi) { const bf16* zq = Z + (rb + v0 + qi) * DINP + C_IQ + c16 * 64 + 8 * g;
            A[qi][0] = *(const bf16x8*)zq; A[qi][1] = *(const bf16x8*)(zq + 32); }
        u32x4 Aw[4];
        { const f32x4 w4 = *(const f32x4*)(ZS + (rb + v0 + (c16 & 7)) * 256 + S_IW + 4 * g);
          const unsigned w01 = cvtpk(w4[0], w4[1]), w23 = cvtpk(w4[2], w4[3]);
#pragma unroll
          for (int s2 = 0; s2 < 4; ++s2) { const bool ev = (c16 == 2 * s2), od = (c16 == 2 * s2 + 1);
              Aw[s2] = (u32x4){ev ? w01 : 0u, ev ? w23 : 0u, od ? w01 : 0u, od ? w23 : 0u}; } }
        const int ntile = 4 * (c + 1);
        const bf16* ikb = IKC + rb * 64 + c16 * 64 + 8 * g;
        const f32x4 Z4 = {0.f, 0.f, 0.f, 0.f};
#define DSA_BLD(dst0, dst1, tt) do { const int t_ = (tt) < ntile ? (tt) : ntile - 1; dst0 = *(const bf16x8*)(ikb + (size_t)t_ * 1024); dst1 = *(const bf16x8*)(ikb + (size_t)t_ * 1024 + 32); } while (0)
#define DSA_TILE(B0_, B1_, tt) do { f32x4 d[NQ]; \
            _Pragma("unroll") for (int qi = 0; qi < NQ; ++qi) { d[qi] = __builtin_amdgcn_mfma_f32_16x16x32_bf16(A[qi][0], B0_, Z4, 0, 0, 0); \
                d[qi] = __builtin_amdgcn_mfma_f32_16x16x32_bf16(A[qi][1], B1_, d[qi], 0, 0, 0); } \
            f32x4 D2 = Z4; \
            _Pragma("unroll") for (int s2 = 0; s2 < 4; ++s2) { const f32x4 x = d[2 * s2], y = d[2 * s2 + 1]; \
                u32x4 rw; rw.x = relu_pk(cvtpk(x[0], x[1])); rw.y = relu_pk(cvtpk(x[2], x[3])); rw.z = relu_pk(cvtpk(y[0], y[1])); rw.w = relu_pk(cvtpk(y[2], y[3])); \
                D2 = __builtin_amdgcn_mfma_f32_16x16x32_bf16(*reinterpret_cast<const bf16x8*>(&Aw[s2]), *reinterpret_cast<const bf16x8*>(&rw), D2, 0, 0, 0); } \
            const int key = 16 * (tt) + c16; \
            if (g < 2) { _Pragma("unroll") for (int r = 0; r < 4; ++r) sc[(4 * g + r) * SCW + key] = (key >= PADF) ? D2[r] : -__builtin_inff(); } } while (0)
        bf16x8 Ba0, Ba1, Bb0, Bb1, Bc0, Bc1;
        int t = wave;
        DSA_BLD(Ba0, Ba1, t); DSA_BLD(Bb0, Bb1, t + 8);
        for (; t < ntile; t += 24) {
            DSA_BLD(Bc0, Bc1, t + 16); DSA_TILE(Ba0, Ba1, t);
            if (t + 8 >= ntile) break;
            DSA_BLD(Ba0, Ba1, t + 24); DSA_TILE(Bb0, Bb1, t + 8);
            if (t + 16 >= ntile) break;
            DSA_BLD(Bb0, Bb1, t + 32); DSA_TILE(Bc0, Bc1, t + 16);
        }
#undef DSA_BLD
#undef DSA_TILE
    }
    { const int n_ = 64 * (c + 1), ng_ = (c + 1 <= 16) ? 16 : (c + 1 <= 32 ? 32 : (c + 1 <= 48 ? 48 : 65));
      for (int i = n_ + tid; i < 64 * ng_; i += 512) {
#pragma unroll
          for (int qi = 0; qi < NQ; ++qi) sc[qi * SCW + i] = -__builtin_inff(); } }
    __syncthreads();
    const int n = 64 * (c + 1), nreal = n - PADF, ngrp = c + 1;
    LAS unsigned short* idx = (LAS unsigned short*)(lds + IDX_OFF) + wave * 256;
    LAS float* myc = sc + wave * SCW;
    int nsel;
    if (nreal <= KTOP) { nsel = nreal; for (int s = lane; s < nsel; s += 64) idx[s] = (unsigned short)(PADF + s); }
    else { nsel = KTOP;
        if (ngrp <= 16) select_topk<16>(myc, idx, lane); else if (ngrp <= 32) select_topk<32>(myc, idx, lane);
        else if (ngrp <= 48) select_topk<48>(myc, idx, lane); else select_topk<65>(myc, idx, lane); }
    LDS_WAIT();
    {
        const size_t qrow = rb + v0 + wave;
        bf16x8 Bq[4];
#pragma unroll
        for (int kd = 0; kd < 4; ++kd) { Bq[kd] = (bf16x8){0, 0, 0, 0, 0, 0, 0, 0}; if (c16 < 6) Bq[kd] = *(const bf16x8*)(Z + qrow * DINP + C_AQ + c16 * 128 + 32 * kd + 8 * g); }
        f32x4 Dl[8][2];
        const int srow = 8 * (c16 >> 2) + (c16 & 3);
        const bf16* kab = KAC + rb * 128 + 8 * g;
        bf16x8 Ka[3][8];
        const f32x4 Z4 = {0.f, 0.f, 0.f, 0.f};
#define DSA_KLOAD(buf, ks_) do { int s0_ = 32 * (ks_) + srow, s1_ = s0_ + 4; s0_ = s0_ < nsel ? s0_ : nsel - 1; s1_ = s1_ < nsel ? s1_ : nsel - 1; \
            const bf16* k0_ = kab + (size_t)idx[s0_] * 128; const bf16* k1_ = kab + (size_t)idx[s1_] * 128; \
            _Pragma("unroll") for (int kd = 0; kd < 4; ++kd) { Ka[buf][kd] = *(const bf16x8*)(k0_ + 32 * kd); Ka[buf][4 + kd] = *(const bf16x8*)(k1_ + 32 * kd); } } while (0)
        DSA_KLOAD(0, 0); DSA_KLOAD(1, 1);
#pragma unroll
        for (int ks = 0; ks < 8; ++ks) {
            if (ks + 2 < 8) DSA_KLOAD((ks + 2) % 3, ks + 2);
            f32x4 d0 = Z4, d1 = Z4;
#pragma unroll
            for (int kd = 0; kd < 4; ++kd) { d0 = __builtin_amdgcn_mfma_f32_16x16x32_bf16(Ka[ks % 3][kd], Bq[kd], d0, 0, 0, 0); d1 = __builtin_amdgcn_mfma_f32_16x16x32_bf16(Ka[ks % 3][4 + kd], Bq[kd], d1, 0, 0, 0); }
            Dl[ks][0] = d0; Dl[ks][1] = d1;
        }
#undef DSA_KLOAD
        constexpr float C2 = 0.08838834764831845f * 1.4426950408889634f;
        float mx = -1e30f;
#pragma unroll
        for (int ks = 0; ks < 8; ++ks)
#pragma unroll
            for (int tt = 0; tt < 2; ++tt)
#pragma unroll
                for (int r = 0; r < 4; ++r) { const int slot = 32 * ks + 8 * g + 4 * tt + r; float x = Dl[ks][tt][r] * C2; x = (slot < nsel) ? x : -__builtin_inff(); Dl[ks][tt][r] = x; mx = fmaxf(mx, x); }
        mx = fmaxf(mx, __shfl_xor(mx, 16)); mx = fmaxf(mx, __shfl_xor(mx, 32));
        float sum = 0.f;
#pragma unroll
        for (int ks = 0; ks < 8; ++ks)
#pragma unroll
            for (int tt = 0; tt < 2; ++tt)
#pragma unroll
                for (int r = 0; r < 4; ++r) { const float p = __builtin_amdgcn_exp2f(Dl[ks][tt][r] - mx); Dl[ks][tt][r] = p; sum += p; }
        sum += __shfl_xor(sum, 16); sum += __shfl_xor(sum, 32);
        LAS unsigned char* stg = (LAS unsigned char*)myc;
        const unsigned stg_addr = (unsigned)(uintptr_t)stg;
        f32x4 O[8];
#pragma unroll
        for (int dt = 0; dt < 8; ++dt) O[dt] = Z4;
        const unsigned q4 = (unsigned)c16 >> 2, p4 = (unsigned)c16 & 3;
        const unsigned rd_base = stg_addr + (8u * g + q4) * 256u + 8u * p4;
        const bf16* vab = VAC + rb * 128 + (lane & 15) * 8;
        u32x4 Vr[2][8];
#define DSA_VLOAD(buf, ks_) do { _Pragma("unroll") for (int i = 0; i < 8; ++i) { int s_ = 32 * (ks_) + (lane >> 4) + 4 * i; s_ = s_ < nsel ? s_ : nsel - 1; Vr[buf][i] = *(const u32x4*)(vab + (size_t)idx[s_] * 128); } } while (0)
        DSA_VLOAD(0, 0); DSA_VLOAD(1, 1);
#pragma unroll
        for (int ks = 0; ks < 8; ++ks) {
            LAS unsigned char* sb = stg + (ks & 1) * 8192;
#pragma unroll
            for (int i = 0; i < 8; ++i) *(LAS u32x4*)(sb + ((lane >> 4) + 4 * i) * 256 + (lane & 15) * 16) = Vr[ks & 1][i];
            if (ks + 2 < 8) DSA_VLOAD(ks & 1, ks + 2);
            u32x4 pw; pw.x = cvtpk(Dl[ks][0][0], Dl[ks][0][1]); pw.y = cvtpk(Dl[ks][0][2], Dl[ks][0][3]); pw.z = cvtpk(Dl[ks][1][0], Dl[ks][1][1]); pw.w = cvtpk(Dl[ks][1][2], Dl[ks][1][3]);
            const bf16x8 Bp = *reinterpret_cast<const bf16x8*>(&pw);
            const unsigned ra = rd_base + (ks & 1) * 8192u;
            s16x4 l0, l1, l2, l3, l4, l5, l6, l7, h0, h1, h2, h3, h4, h5, h6, h7;
            asm volatile("s_waitcnt lgkmcnt(0)\n\t"
                "ds_read_b64_tr_b16 %0, %16\n\tds_read_b64_tr_b16 %8, %16 offset:1024\n\t"
                "ds_read_b64_tr_b16 %1, %16 offset:32\n\tds_read_b64_tr_b16 %9, %16 offset:1056\n\t"
                "ds_read_b64_tr_b16 %2, %16 offset:64\n\tds_read_b64_tr_b16 %10, %16 offset:1088\n\t"
                "ds_read_b64_tr_b16 %3, %16 offset:96\n\tds_read_b64_tr_b16 %11, %16 offset:1120\n\t"
                "ds_read_b64_tr_b16 %4, %16 offset:128\n\tds_read_b64_tr_b16 %12, %16 offset:1152\n\t"
                "ds_read_b64_tr_b16 %5, %16 offset:160\n\tds_read_b64_tr_b16 %13, %16 offset:1184\n\t"
                "ds_read_b64_tr_b16 %6, %16 offset:192\n\tds_read_b64_tr_b16 %14, %16 offset:1216\n\t"
                "ds_read_b64_tr_b16 %7, %16 offset:224\n\tds_read_b64_tr_b16 %15, %16 offset:1248\n\t"
                "s_waitcnt lgkmcnt(0)"
                : "=&v"(l0), "=&v"(l1), "=&v"(l2), "=&v"(l3), "=&v"(l4), "=&v"(l5), "=&v"(l6), "=&v"(l7), "=&v"(h0), "=&v"(h1), "=&v"(h2), "=&v"(h3), "=&v"(h4), "=&v"(h5), "=&v"(h6), "=&v"(h7)
                : "v"(ra) : "memory");
#define DSA_PV(dt, lo, hi2) O[dt] = __builtin_amdgcn_mfma_f32_16x16x32_bf16((bf16x8){lo[0], lo[1], lo[2], lo[3], hi2[0], hi2[1], hi2[2], hi2[3]}, Bp, O[dt], 0, 0, 0)
            DSA_PV(0, l0, h0); DSA_PV(1, l1, h1); DSA_PV(2, l2, h2); DSA_PV(3, l3, h3); DSA_PV(4, l4, h4); DSA_PV(5, l5, h5); DSA_PV(6, l6, h6); DSA_PV(7, l7, h7);
#undef DSA_PV
        }
#undef DSA_VLOAD
        if (c16 < 6) { const float inv = 1.f / sum; bf16* op = MIX + qrow * DM + c16 * 128 + 4 * g;
#pragma unroll
            for (int dt = 0; dt < 8; ++dt) { u32x2 w; w.x = cvtpk(O[dt][0] * inv, O[dt][1] * inv); w.y = cvtpk(O[dt][2] * inv, O[dt][3] * inv); *(u32x2*)(op + 16 * dt) = w; } }
    }
    __syncthreads();
}
}

namespace gla {
constexpr int LDT = 72;
constexpr int L_BL = 0;
constexpr int L_SEG = L_BL + 16384;
constexpr int L_QH = L_SEG + 2048;
constexpr int L_KH = L_QH + 64 * LDT * 2;
constexpr int L_SC = L_KH + 64 * LDT * 2;
constexpr int L_VT = L_SC + 64 * LDT * 2;
constexpr int L_ST = L_VT + 128 * LDT * 2;
constexpr int L_O = L_ST + 128 * LDT * 2;
constexpr int LDS_NEED = L_O + 64 * 132 * 4;
__device__ __forceinline__ bf16x8 ldfrag(const LAS bf16* base, int row, int k0) { return *(const LAS bf16x8*)(base + row * LDT + k0); }

__device__ __forceinline__ void cum_decay(LAS unsigned char* lds, const float* LA, size_t row0, int hd, bool chunk0) {
    int tid = get_tid();
    const int d = tid & 63, seg = tid >> 6;
    LAS float* bl = (LAS float*)(lds + L_BL); LAS float* sg = (LAS float*)(lds + L_SEG);
    float v[8]; float s = 0.f;
#pragma unroll
    for (int k = 0; k < 8; ++k) { const int i = 8 * seg + k; float x = LA[(row0 + i) * 256 + hd * 64 + d]; if (chunk0 && i < PADF) x = 0.f; s += x; v[k] = s; }
    sg[seg * 64 + d] = s;
    __syncthreads();
    float off = 0.f;
    for (int w = 0; w < seg; ++w) off += sg[w * 64 + d];
#pragma unroll
    for (int k = 0; k < 8; ++k) bl[(8 * seg + k) * 64 + d] = v[k] + off;
    __syncthreads();
}
__device__ __forceinline__ void load_vT(LAS unsigned char* lds, const bf16* Z, size_t row0, int hd) {
    int tid = get_tid(); LAS bf16* vT = (LAS bf16*)(lds + L_VT);
    u32x4 wv[2];
#pragma unroll
    for (int it = 0; it < 2; ++it) { const int pc = tid + 512 * it, i = pc >> 4, e0 = (pc & 15) * 8; wv[it] = *(const u32x4*)(Z + (row0 + i) * DINP + C_CV + hd * 128 + e0); }
#pragma unroll
    for (int it = 0; it < 2; ++it) { const int pc = tid + 512 * it, i = pc >> 4, e0 = (pc & 15) * 8;
        const unsigned ww[4] = {wv[it].x, wv[it].y, wv[it].z, wv[it].w};
#pragma unroll
        for (int k = 0; k < 4; ++k) { vT[(e0 + 2 * k) * LDT + i] = (bf16)(ww[k] & 0xffffu); vT[(e0 + 2 * k + 1) * LDT + i] = (bf16)(ww[k] >> 16); } }
}
__device__ __forceinline__ void step1(LAS unsigned char* lds, const bf16* Z, const float* ZS, float* LA, const float* w2, const float* gb, float* KV, float* DVEC, int b, int c, int hd) {
    int tid = get_tid();
    const int lane = tid & 63, wave = tid >> 6, g = lane >> 4, c16 = lane & 15;
    const size_t row0 = (size_t)b * TP + 64 * c;
    LAS float* bl = (LAS float*)(lds + L_BL); LAS float* sg = (LAS float*)(lds + L_SEG); LAS bf16* kdT = (LAS bf16*)(lds + L_QH); LAS bf16* vT = (LAS bf16*)(lds + L_VT);
    LAS float* crs = (LAS float*)(lds + L_O);
    if (tid < 256) { const int i = tid >> 2; *(LAS f32x4*)(crs + i * 16 + 4 * (tid & 3)) = *(const f32x4*)(ZS + (row0 + i) * 256 + S_CR + 4 * (tid & 3)); }
    __syncthreads();
    { const int d = tid & 63, seg = tid >> 6, n = hd * 64 + d;
      float wc[16];
#pragma unroll
      for (int r = 0; r < 16; ++r) wc[r] = w2[r * 256 + n];
      const float gbn = gb[n];
      float v[8]; float s = 0.f;
#pragma unroll
      for (int k = 0; k < 8; ++k) { const int i = 8 * seg + k; float a = gbn;
#pragma unroll
          for (int r = 0; r < 16; ++r) a += crs[i * 16 + r] * wc[r];
          float x = logsigmoidf(a) * (1.f / 16.f); if (c == 0 && i < PADF) x = 0.f;
          LA[(row0 + i) * 256 + n] = x; s += x; v[k] = s; }
      sg[seg * 64 + d] = s;
      __syncthreads();
      float off = 0.f;
      for (int w = 0; w < seg; ++w) off += sg[w * 64 + d];
#pragma unroll
      for (int k = 0; k < 8; ++k) bl[(8 * seg + k) * 64 + d] = v[k] + off; }
    __syncthreads();
    { const int i = tid >> 3, d0 = (tid & 7) * 8;
      const u32x4 w = *(const u32x4*)(Z + (row0 + i) * DINP + C_CK + hd * 64 + d0); const unsigned ww[4] = {w.x, w.y, w.z, w.w};
#pragma unroll
      for (int k = 0; k < 8; ++k) { const int d = d0 + k; const float kk = (k & 1) ? bfhi(ww[k >> 1]) : bflo(ww[k >> 1]);
          kdT[d * LDT + i] = f2bf(kk * fexp_(bl[63 * 64 + d] - bl[i * 64 + d])); } }
    load_vT(lds, Z, row0, hd);
    __syncthreads();
    const int bh = b * 4 + hd;
    float* kvp = KV + ((size_t)bh * 65 + c) * 8192;
#pragma unroll
    for (int dt = 0; dt < 4; ++dt) { f32x4 acc = zero4();
#pragma unroll
        for (int ks = 0; ks < 2; ++ks) acc = __builtin_amdgcn_mfma_f32_16x16x32_bf16(ldfrag(kdT, 16 * dt + c16, 32 * ks + 8 * g), ldfrag(vT, 16 * wave + c16, 32 * ks + 8 * g), acc, 0, 0, 0);
#pragma unroll
        for (int r = 0; r < 4; ++r) kvp[(16 * dt + 4 * g + r) * 128 + 16 * wave + c16] = acc[r]; }
    if (tid < 64) DVEC[((size_t)bh * 65 + c) * 64 + tid] = fexp_(bl[63 * 64 + tid]);
    __syncthreads();
}
__device__ __forceinline__ void step2(const float* KV, const float* DVEC, float* SS, int u) {
    int tid = get_tid();
    const int bh = u >> 2, idx = (u & 3) * 2048 + tid * 4, d = idx >> 7;
    f32x4 S = zero4();
    *(f32x4*)(SS + ((size_t)bh * 66) * 8192 + idx) = S;
#pragma unroll 4
    for (int c = 0; c < 64; ++c) {
        const f32x4 kv = *(const f32x4*)(KV + ((size_t)bh * 65 + c) * 8192 + idx); const float dv = DVEC[((size_t)bh * 65 + c) * 64 + d];
        S = S * dv + kv;
        *(f32x4*)(SS + ((size_t)bh * 66 + c + 1) * 8192 + idx) = S;
    }
}
__device__ __forceinline__ void step3(LAS unsigned char* lds, const bf16* Z, const float* LA, const float* SS, const float* gon, bf16* MIX, int b, int c, int hd) {
    int tid = get_tid();
    const int lane = tid & 63, wave = tid >> 6, g = lane >> 4, c16 = lane & 15;
    const size_t row0 = (size_t)b * TP + 64 * c;
    LAS float* bl = (LAS float*)(lds + L_BL); LAS bf16* qh = (LAS bf16*)(lds + L_QH); LAS bf16* kh = (LAS bf16*)(lds + L_KH); LAS bf16* scb = (LAS bf16*)(lds + L_SC);
    LAS bf16* vT = (LAS bf16*)(lds + L_VT); LAS bf16* sT = (LAS bf16*)(lds + L_ST); LAS float* ol = (LAS float*)(lds + L_O);
    {
        const int bh = b * 4 + hd;
        cum_decay(lds, LA, row0, hd, c == 0);
        { const int i = tid >> 3, d0 = (tid & 7) * 8;
          const u32x4 wq = *(const u32x4*)(Z + (row0 + i) * DINP + C_CQ + hd * 64 + d0), wk = *(const u32x4*)(Z + (row0 + i) * DINP + C_CK + hd * 64 + d0);
          const unsigned q4[4] = {wq.x, wq.y, wq.z, wq.w}, k4[4] = {wk.x, wk.y, wk.z, wk.w};
          unsigned oq[4], ok[4];
#pragma unroll
          for (int k = 0; k < 4; ++k) { const float b0 = bl[i * 64 + d0 + 2 * k], b1 = bl[i * 64 + d0 + 2 * k + 1];
              oq[k] = cvtpk(bflo(q4[k]) * 0.125f * fexp_(b0), bfhi(q4[k]) * 0.125f * fexp_(b1));
              ok[k] = cvtpk(bflo(k4[k]) * fexp_(-b0), bfhi(k4[k]) * fexp_(-b1)); }
          *(LAS u32x4*)(qh + i * LDT + d0) = (u32x4){oq[0], oq[1], oq[2], oq[3]};
          *(LAS u32x4*)(kh + i * LDT + d0) = (u32x4){ok[0], ok[1], ok[2], ok[3]}; }
        load_vT(lds, Z, row0, hd);
        { const float* sp = SS + ((size_t)bh * 66 + c) * 8192;
          f32x4 s4v[4];
#pragma unroll
          for (int it = 0; it < 4; ++it) { const int pc = tid + 512 * it, d = pc >> 5, e0 = (pc & 31) * 4; s4v[it] = *(const f32x4*)(sp + d * 128 + e0); }
#pragma unroll
          for (int it = 0; it < 4; ++it) { const int pc = tid + 512 * it, d = pc >> 5, e0 = (pc & 31) * 4;
#pragma unroll
              for (int k = 0; k < 4; ++k) sT[(e0 + k) * LDT + d] = f2bf(s4v[it][k]); } }
        __syncthreads();
        { const int it = wave & 3;
#pragma unroll
          for (int jj = 0; jj < 2; ++jj) { const int jt = 2 * (wave >> 2) + jj; f32x4 acc = zero4();
              if (jt <= it) {
#pragma unroll
                  for (int ks = 0; ks < 2; ++ks) acc = __builtin_amdgcn_mfma_f32_16x16x32_bf16(ldfrag(qh, 16 * it + c16, 32 * ks + 8 * g), ldfrag(kh, 16 * jt + c16, 32 * ks + 8 * g), acc, 0, 0, 0); }
#pragma unroll
              for (int r = 0; r < 4; ++r) { const int i = 16 * it + 4 * g + r, j = 16 * jt + c16; scb[i * LDT + j] = f2bf((j <= i) ? acc[r] : 0.f); } } }
        __syncthreads();
#pragma unroll
        for (int it = 0; it < 4; ++it) { f32x4 acc = zero4();
#pragma unroll
            for (int ks = 0; ks < 2; ++ks) acc = __builtin_amdgcn_mfma_f32_16x16x32_bf16(ldfrag(scb, 16 * it + c16, 32 * ks + 8 * g), ldfrag(vT, 16 * wave + c16, 32 * ks + 8 * g), acc, 0, 0, 0);
#pragma unroll
            for (int ks = 0; ks < 2; ++ks) acc = __builtin_amdgcn_mfma_f32_16x16x32_bf16(ldfrag(qh, 16 * it + c16, 32 * ks + 8 * g), ldfrag(sT, 16 * wave + c16, 32 * ks + 8 * g), acc, 0, 0, 0);
#pragma unroll
            for (int r = 0; r < 4; ++r) ol[(16 * it + 4 * g + r) * 132 + 16 * wave + c16] = acc[r]; }
        __syncthreads();
#pragma unroll
        for (int k = 0; k < 8; ++k) { const int i = 8 * wave + k; const float x0 = ol[i * 132 + 2 * lane], x1 = ol[i * 132 + 2 * lane + 1];
            const float ss = wave_sum(x0 * x0 + x1 * x1); const float rstd = rsqrt_(ss * (1.f / 128.f) + EPS);
            if (!(c == 0 && i < PADF)) { const unsigned gw = *(const unsigned*)(Z + (row0 + i) * DINP + C_CG + hd * 128 + 2 * lane);
                const float y0 = x0 * rstd * gon[2 * lane] * siluf(bflo(gw)), y1 = x1 * rstd * gon[2 * lane + 1] * siluf(bfhi(gw));
                *(unsigned*)(MIX + (row0 + i) * DM + 1536 + hd * 128 + 2 * lane) = cvtpk(y0, y1); } }
        __syncthreads();
    }
}
}

struct Frame {
    LAS unsigned char* lds; char* ldsg;
    int tid, lane, wave, G, bid;
};
constexpr int PTAB_OFF = LDSCTL_OFF + 1024, P_OUT = 21, P_WS = 22;
__device__ __forceinline__ unsigned char* gptr(const Frame& F, int k) {
    const LAS unsigned* t = (const LAS unsigned*)(F.lds + PTAB_OFF) + 2 * k;
    const unsigned lo = __builtin_amdgcn_readfirstlane(t[0]), hi = __builtin_amdgcn_readfirstlane(t[1]);
    return (unsigned char*)(GAS unsigned char*)(((unsigned long long)hi << 32) | lo);
}
#define WS() gptr(F, P_WS)
#define INP(k) ((const float*)gptr(F, (k)))
#define CTL() ((unsigned*)(gptr(F, P_WS) + WS_CTL))
__device__ __forceinline__ int inmap(int n) {
    if (n < 2048) return n;
    if (n < 2112) return C_IK + (n - 2048);
    if (n < 2128) return C_IK + S_IW + (n - 2112);
    if (n < 4432) return C_BQ + (n - 2128);
    if (n < 4438) return C_IK + S_BF + (n - 4432);
    if (n < 4950) return C_CQ + (n - 4438);
    if (n < 5462) return C_CV + (n - 4950);
    if (n < 5478) return C_IK + S_CR + (n - 5462);
    return C_CG + (n - 5478);
}
struct TrItem { const float* W; bf16* WT; int K, N, map, k0, n0; };
__device__ __forceinline__ void tr_load(const TrItem& t, f32x4 (&v)[16], int lane) {
    const int cl = 4 * (lane & 15), rl = lane >> 4;
    const float* src = t.W + (size_t)(t.k0 + rl) * t.N + t.n0 + cl;
    if (t.map == 1) { const bool in0 = (t.n0 + cl) < t.N, in1 = (t.n0 + cl + 2) < t.N;
#pragma unroll
        for (int i = 0; i < 16; ++i) { const float* p = src + (size_t)(4 * i) * t.N; const f32x2 a = in0 ? *(const f32x2*)p : (f32x2){0.f, 0.f}, b = in1 ? *(const f32x2*)(p + 2) : (f32x2){0.f, 0.f}; v[i] = (f32x4){a[0], a[1], b[0], b[1]}; }
    } else {
#pragma unroll
        for (int i = 0; i < 16; ++i) v[i] = *(const f32x4*)(src + (size_t)(4 * i) * t.N); }
}
__device__ __forceinline__ void tr_store(const TrItem& t, const f32x4 (&v)[16], LAS float* scr, int lane) {
    constexpr int PITCH = 65;
    { const int cl = 4 * (lane & 15), rl = lane >> 4;
#pragma unroll
      for (int i = 0; i < 16; ++i) { LAS float* d = scr + (rl + 4 * i) * PITCH + cl; d[0] = v[i][0]; d[1] = v[i][1]; d[2] = v[i][2]; d[3] = v[i][3]; } }
    LDS_WAIT(); asm volatile("" ::: "memory");
    const int kc = lane & 7, nl = lane >> 3;
#pragma unroll
    for (int j = 0; j < 8; ++j) { const int n = nl + 8 * j, ng = t.n0 + n; const LAS float* sp = scr + (8 * kc) * PITCH + n;
        u32x4 o; o.x = cvtpk(sp[0 * PITCH], sp[1 * PITCH]); o.y = cvtpk(sp[2 * PITCH], sp[3 * PITCH]); o.z = cvtpk(sp[4 * PITCH], sp[5 * PITCH]); o.w = cvtpk(sp[6 * PITCH], sp[7 * PITCH]);
        int row = ng; if (t.map == 1) row = inmap(ng < t.N ? ng : 0); else if (t.map == 2) row = 8 * (ng >> 2) + (ng & 3); else if (t.map == 3) row = 8 * (ng >> 2) + 4 + (ng & 3);
        if (ng < t.N) *(u32x4*)(t.WT + (size_t)row * t.K + t.k0 + 8 * kc) = o; }
    LDS_WAIT(); asm volatile("" ::: "memory");
}
__device__ __forceinline__ void sincos_d(double ang, float& c, float& s) {
    const double q = __builtin_rint(ang * 0.63661977236758134308);
    double r = __builtin_fma(-q, 1.5707963267948966, ang); r = __builtin_fma(-q, 6.123233995736766e-17, r);
    const double r2 = r * r;
    const double sp = r + r * r2 * (-1.0 / 6 + r2 * (1.0 / 120 + r2 * (-1.0 / 5040 + r2 * (1.0 / 362880 + r2 * (-1.0 / 39916800 + r2 * (1.0 / 6227020800.0))))));
    const double cp = 1.0 + r2 * (-0.5 + r2 * (1.0 / 24 + r2 * (-1.0 / 720 + r2 * (1.0 / 40320 + r2 * (-1.0 / 3628800 + r2 * (1.0 / 479001600.0))))));
    const int n = (int)((long long)q & 3);
    const double sv = (n == 0) ? sp : (n == 1) ? cp : (n == 2) ? -sp : -cp;
    const double cv = (n == 0) ? cp : (n == 1) ? -sp : (n == 2) ? -cp : sp;
    c = (float)cv; s = (float)sv;
}
__device__ __forceinline__ void p_prologue(Frame& F, const float* w_in, const float* w_out, const float* e_w1, const float* e_w3, const float* e_w2, const float* rgw, const float* rew, const float* g2) {
    int htid = get_tid(); const int h_lane = htid & 63, h_wave = __builtin_amdgcn_readfirstlane(htid >> 6);
    LAS float* scr = (LAS float*)(F.lds + h_wave * 16640);
    const int gw = F.bid * 8 + h_wave, NGW = F.G * 8;
    unsigned char* ws = WS();
    constexpr int I_IN = 32 * 94, I_OUT = 32 * 32, I_W1 = NEXP * 32 * 8, I_W2 = NEXP * 8 * 32, I_L = I_IN + I_OUT + 2 * I_W1 + I_W2, I_ALL = DEPTH * I_L;
    auto decode = [&](int it) -> TrItem { TrItem t; const int l = it / I_L; int r = it % I_L; int nblk;
        if (r < I_IN) { t.W = w_in + (size_t)l * DM * DIN; t.K = DM; t.N = DIN; t.WT = (bf16*)(ws + WS_WIN + l * SZ_WIN); t.map = 1; nblk = 94; }
        else if ((r -= I_IN) < I_OUT) { t.W = w_out + (size_t)l * DM * DM; t.K = DM; t.N = DM; t.WT = (bf16*)(ws + WS_WOUT + l * SZ_WOUT); t.map = 0; nblk = 32; }
        else if ((r -= I_OUT) < I_W1) { const int e = r >> 8; r &= 255; t.W = e_w1 + ((size_t)l * NEXP + e) * DM * DEXP; t.K = DM; t.N = DEXP; t.WT = (bf16*)(ws + WS_W13 + l * SZ_W13 + e * SZ_W13E); t.map = 2; nblk = 8; }
        else if ((r -= I_W1) < I_W1) { const int e = r >> 8; r &= 255; t.W = e_w3 + ((size_t)l * NEXP + e) * DM * DEXP; t.K = DM; t.N = DEXP; t.WT = (bf16*)(ws + WS_W13 + l * SZ_W13 + e * SZ_W13E); t.map = 3; nblk = 8; }
        else { r -= I_W1; const int e = r >> 8; r &= 255; t.W = e_w2 + ((size_t)l * NEXP + e) * DEXP * DM; t.K = DEXP; t.N = DM; t.WT = (bf16*)(ws + WS_W2 + l * SZ_W2 + e * SZ_W2E); t.map = 0; nblk = 32; }
        t.k0 = 64 * (r / nblk); t.n0 = 64 * (r % nblk); return t; };
    { f32x4 va[16], vb[16]; int it = gw;
      if (it < I_ALL) { TrItem ta = decode(it), tb = ta; tr_load(ta, va, h_lane);
        for (;;) {
            const bool h1 = (it + NGW) < I_ALL; if (h1) { tb = decode(it + NGW); tr_load(tb, vb, h_lane); }
            tr_store(ta, va, scr, h_lane);
            if (!h1) break;
            const bool h2 = (it + 2 * NGW) < I_ALL; if (h2) { ta = decode(it + 2 * NGW); tr_load(ta, va, h_lane); }
            tr_store(tb, vb, scr, h_lane);
            if (!h2) break;
            it += 2 * NGW;
        } } }
    const int gt = F.bid * 512 + htid, NGT = F.G * 512;
    for (int i = gt; i < DEPTH * 154 * (DM / 8); i += NGT) { const int l = i / (154 * 256), rr = (i / 256) % 154, ch = i % 256;
        *(u32x4*)((bf16*)(ws + WS_WIN + l * SZ_WIN) + (size_t)(DIN + rr) * DM + ch * 8) = (u32x4){0u, 0u, 0u, 0u}; }
    for (int i = gt; i < TT * 64; i += NGT) { const int t = i >> 6, k = i & 63; double inv = 1.0; for (int j = 0; j < k; ++j) inv *= 0.86596432336006535;
        float c, s; sincos_d((double)t * inv, c, s); ((float*)(ws + WS_COS128))[i] = c; ((float*)(ws + WS_SIN128))[i] = s; }
    for (int i = gt; i < TT * 32; i += NGT) { const int t = i >> 5, k = i & 31; double inv = 1.0; for (int j = 0; j < k; ++j) inv *= 0.74989420933245583;
        float c, s; sincos_d((double)t * inv, c, s); ((float*)(ws + WS_COS64))[i] = c; ((float*)(ws + WS_SIN64))[i] = s; }
    for (int i = gt; i < NB * PADF * (DM / 8); i += NGT) { const int b = i / (PADF * 256), rr = (i / 256) % PADF, ch = i % 256; const size_t row = (size_t)b * TP + rr;
        *(u32x4*)((bf16*)(ws + WS_U) + row * DM + ch * 8) = (u32x4){0u, 0u, 0u, 0u}; *(u32x4*)((bf16*)(ws + WS_MIX) + row * DM + ch * 8) = (u32x4){0u, 0u, 0u, 0u}; }
    for (int i = gt; i < NB * PADF * (DINP / 8); i += NGT) { const int b = i / (PADF * 768), rr = (i / 768) % PADF, ch = i % 768; const size_t row = (size_t)b * TP + rr;
        *(u32x4*)((bf16*)(ws + WS_Z) + row * DINP + ch * 8) = (u32x4){0u, 0u, 0u, 0u}; }
    for (int i = gt; i < NB * PADF * 40; i += NGT) { const int b = i / (PADF * 40), rr = (i / 40) % PADF, ch = i % 40; const size_t row = (size_t)b * TP + rr;
        bf16* dst = (ch < 8) ? (bf16*)(ws + WS_IKC) + row * 64 + ch * 8 : (ch < 24 ? (bf16*)(ws + WS_KAC) + row * 128 + (ch - 8) * 8 : (bf16*)(ws + WS_VAC) + row * 128 + (ch - 24) * 8);
        *(u32x4*)dst = (u32x4){0u, 0u, 0u, 0u}; }
    for (int i = gt; i < NB * PADF * 64; i += NGT) { const int b = i / (PADF * 64), rr = (i / 64) % PADF, ch = i % 64; const size_t row = (size_t)b * TP + rr;
        *(f32x4*)((float*)(ws + WS_LA) + row * 256 + ch * 4) = zero4(); }
    for (int i = gt; i < DEPTH * 48 * DM; i += NGT) { const int l = i / (48 * DM), n = (i / DM) % 48, k = i % DM;
        float w = 0.f; if (n < 4) w = rgw[((size_t)l * DM + k) * 4 + n]; else if (n < 36) w = rew[((size_t)l * DM + k) * 32 + (n - 4)];
        w *= g2[(size_t)l * DM + k];
        const bf16 hi = f2bf(w); const bf16 lo = f2bf(w - bf2f(hi));
        bf16* wr = (bf16*)(ws + WS_WR + l * SZ_WR); wr[(size_t)n * DM + k] = hi; wr[(size_t)(48 + n) * DM + k] = lo; }
}
__device__ __forceinline__ void p_norm1(Frame& F, int l, const float* xin, const float* meta, const float* gain, size_t woff) {
    int htid = get_tid(); const int h_lane = htid & 63, h_wave = __builtin_amdgcn_readfirstlane(htid >> 6);
    const int gw = F.bid * 8 + h_wave, NGW = F.G * 8, lane = h_lane;
    float* H = (float*)(WS() + WS_H); bf16* U = (bf16*)(WS() + WS_U); const bf16* Y0 = (const bf16*)(WS() + WS_Y0); const bf16* Y1 = (const bf16*)(WS() + WS_Y1);
    for (int row = gw; row < R; row += NGW) {
        const int b = row / TP, v = row % TP;
        float* hr = H + (size_t)row * DM;
        if (v < PADF) { if (l == 0) {
#pragma unroll
                for (int j = 0; j < 8; ++j) *(f32x4*)(hr + 4 * (lane + 64 * j)) = zero4(); }
            continue; }
        const int t = v - PADF;
        f32x4 x[8]; float ss = 0.f;
#pragma unroll
        for (int j = 0; j < 8; ++j) { const int col = 4 * (lane + 64 * j);
            if (l == 0) { const float* src = (t < NMETA) ? meta + (size_t)t * DM : xin + ((size_t)b * SEQ + (t - NMETA)) * DM; x[j] = *(const f32x4*)(src + col); }
            else { x[j] = *(const f32x4*)(hr + col); const u32x2 a = *(const u32x2*)(Y0 + (size_t)row * DM + col), c = *(const u32x2*)(Y1 + (size_t)row * DM + col);
                x[j][0] += bflo(a.x) + bflo(c.x); x[j][1] += bfhi(a.x) + bfhi(c.x); x[j][2] += bflo(a.y) + bflo(c.y); x[j][3] += bfhi(a.y) + bfhi(c.y); }
            *(f32x4*)((char*)(hr + col) + woff) = x[j];
            ss += x[j][0] * x[j][0] + x[j][1] * x[j][1] + x[j][2] * x[j][2] + x[j][3] * x[j][3]; }
        ss = wave_sum(ss); const float rstd = rsqrt_(ss * (1.f / DM) + EPS);
#pragma unroll
        for (int j = 0; j < 8; ++j) { const int col = 4 * (lane + 64 * j); const f32x4 gg = *(const f32x4*)(gain + col);
            u32x2 w; w.x = cvtpk(x[j][0] * rstd * gg[0], x[j][1] * rstd * gg[1]); w.y = cvtpk(x[j][2] * rstd * gg[2], x[j][3] * rstd * gg[3]);
            *(u32x2*)((char*)(U + (size_t)row * DM + col) + woff) = w; }
    }
}
__device__ __forceinline__ void p_final(Frame& F) {
#ifdef PROBE_MASK
    float probe_delta = 0.f;
    { const volatile LAS unsigned long long* st = (const volatile LAS unsigned long long*)(F.lds + LDSCTL_OFF + 2048); unsigned long long tk = 0;
      for (int pz = 0; pz < 2 + 9 * DEPTH - 1; ++pz) { const int ty = (pz == 0) ? 0 : 1 + (pz - 1) % 9, ly = (pz == 0) ? 0 : (pz - 1) / 9;
          if (((PROBE_MASK >> ty) & 1) && ((PROBE_LAYERS >> ly) & 1)) tk += st[pz + 1] - st[pz]; }
      probe_delta = (PROBE_CONST) + (PROBE_ALPHA) * 0.01f * (float)tk; }
#endif
    int htid = get_tid(); const int h_lane = htid & 63, h_wave = __builtin_amdgcn_readfirstlane(htid >> 6);
    const int gw = F.bid * 8 + h_wave, NGW = F.G * 8, lane = h_lane;
    const float* H = (const float*)(WS() + WS_H); const bf16* Y0 = (const bf16*)(WS() + WS_Y0); const bf16* Y1 = (const bf16*)(WS() + WS_Y1);
    for (int o = gw; o < NB * SEQ; o += NGW) { const int b = o / SEQ, i = o % SEQ; const size_t row = (size_t)b * TP + PADF + NMETA + i;
#pragma unroll
        for (int j = 0; j < 8; ++j) { const int col = 4 * (lane + 64 * j); f32x4 x = *(const f32x4*)(H + row * DM + col);
            const u32x2 a = *(const u32x2*)(Y0 + row * DM + col), c = *(const u32x2*)(Y1 + row * DM + col);
            x[0] += bflo(a.x) + bflo(c.x); x[1] += bfhi(a.x) + bfhi(c.x); x[2] += bflo(a.y) + bflo(c.y); x[3] += bfhi(a.y) + bfhi(c.y);
#ifdef PROBE_MASK
            x = x + probe_delta;
#endif
            *(f32x4*)(((float*)gptr(F, P_OUT)) + (size_t)o * DM + col) = x; } }
}
__device__ __forceinline__ void unpack8(const u32x4 w, float (&x)[8]) { x[0] = bflo(w.x); x[1] = bfhi(w.x); x[2] = bflo(w.y); x[3] = bfhi(w.y); x[4] = bflo(w.z); x[5] = bfhi(w.z); x[6] = bflo(w.w); x[7] = bfhi(w.w); }
__device__ __forceinline__ u32x4 pack8f(const float (&x)[8]) { u32x4 w; w.x = cvtpk(x[0], x[1]); w.y = cvtpk(x[2], x[3]); w.z = cvtpk(x[4], x[5]); w.w = cvtpk(x[6], x[7]); return w; }
__device__ __forceinline__ void head128x(const bf16* p, bf16* dst, const float* gain, bool rope, bool raw, const float* cs, const float* sn, int lane) {
    const int c16 = lane & 15;
    const u32x4 w0 = *(const u32x4*)p;
    float x[8]; unpack8(w0, x);
    float ss = 0.f;
#pragma unroll
    for (int e = 0; e < 8; ++e) ss += x[e] * x[e];
    ss += __shfl_xor(ss, 1); ss += __shfl_xor(ss, 2); ss += __shfl_xor(ss, 4); ss += __shfl_xor(ss, 8);
    const float rstd = rsqrt_(ss * (1.f / 128.f) + EPS);
#pragma unroll
    for (int e = 0; e < 8; ++e) x[e] = x[e] * rstd * gain[8 * c16 + e];
    const int i0 = 8 * (c16 & 7);
#pragma unroll
    for (int e = 0; e < 8; ++e) { const float pr = __shfl_xor(x[e], 8); const float c = cs[i0 + e], s = sn[i0 + e];
        const float y = (c16 < 8) ? x[e] * c - pr * s : x[e] * c + pr * s; if (rope) x[e] = y; }
    *(u32x4*)dst = raw ? w0 : pack8f(x);
}
__device__ __forceinline__ void head128(bf16* p, const float* gain, bool rope, bool store, const float* cs, const float* sn, int lane, size_t woff = 0) {
    const int c16 = lane & 15;
    float x[8]; unpack8(*(const u32x4*)p, x);
    float ss = 0.f;
#pragma unroll
    for (int e = 0; e < 8; ++e) ss += x[e] * x[e];
    ss += __shfl_xor(ss, 1); ss += __shfl_xor(ss, 2); ss += __shfl_xor(ss, 4); ss += __shfl_xor(ss, 8);
    const float rstd = rsqrt_(ss * (1.f / 128.f) + EPS);
#pragma unroll
    for (int e = 0; e < 8; ++e) x[e] = x[e] * rstd * gain[8 * c16 + e];
    const int i0 = 8 * (c16 & 7);
#pragma unroll
    for (int e = 0; e < 8; ++e) { const float pr = __shfl_xor(x[e], 8); const float c = cs[i0 + e], s = sn[i0 + e];
        const float y = (c16 < 8) ? x[e] * c - pr * s : x[e] * c + pr * s; if (rope) x[e] = y; }
    if (store) *(u32x4*)((char*)p + woff) = pack8f(x);
}
struct PostP { const float *gaq, *gak, *gbq, *gbk, *fbias, *w2, *gb; };
template <int CTRL> __device__ __forceinline__ float dppf(float x) { return __builtin_bit_cast(float, __builtin_amdgcn_update_dpp(0, __builtin_bit_cast(int, x), CTRL, 0xF, 0xF, true)); }
__device__ __forceinline__ float row16_sum(float s) { s += dppf<0xB1>(s); s += dppf<0x4E>(s); s += dppf<0x124>(s); s += dppf<0x128>(s); return s; }
__device__ __forceinline__ u32x4 head_core(const u32x4 w, const float* gain, bool rope, const float* cs, const float* sn, int lane) {
    const int c16 = lane & 15;
    float x[8]; unpack8(w, x);
    float ss = 0.f;
#pragma unroll
    for (int e = 0; e < 8; ++e) ss += x[e] * x[e];
    ss = row16_sum(ss);
    const float rstd = rsqrt_(ss * (1.f / 128.f) + EPS);
    const f32x4 g0 = *(const f32x4*)(gain + 8 * c16), g1 = *(const f32x4*)(gain + 8 * c16 + 4);
#pragma unroll
    for (int e = 0; e < 8; ++e) x[e] = x[e] * rstd * (e < 4 ? g0[e] : g1[e - 4]);
    if (rope) { const int i0 = 8 * (c16 & 7);
        const f32x4 c0 = *(const f32x4*)(cs + i0), c1 = *(const f32x4*)(cs + i0 + 4), s0 = *(const f32x4*)(sn + i0), s1 = *(const f32x4*)(sn + i0 + 4);
#pragma unroll
        for (int e = 0; e < 8; ++e) { const float pr = dppf<0x128>(x[e]); const float c = e < 4 ? c0[e] : c1[e - 4], sv = e < 4 ? s0[e] : s1[e - 4];
            x[e] = (c16 < 8) ? x[e] * c - pr * sv : x[e] * c + pr * sv; } }
    return pack8f(x);
}
__device__ __forceinline__ void post_row(Frame& F, const PostP& pp, int row, size_t woff) {
    int htid = get_tid(); const int lane = htid & 63;
    const int v = row % TP;
    if (v < PADF) return;
    const int t = v - PADF;
    bf16* zr = (bf16*)(WS() + WS_Z) + (size_t)row * DINP; float* zs = (float*)(WS() + WS_ZS) + (size_t)row * 256;
    const float* c128 = (const float*)(WS() + WS_COS128) + t * 64; const float* s128 = (const float*)(WS() + WS_SIN128) + t * 64;
    const float* c64 = (const float*)(WS() + WS_COS64) + t * 32; const float* s64 = (const float*)(WS() + WS_SIN64) + t * 32;
    const u32x4 w0 = *(const u32x4*)(zr + 8 * lane), w1 = *(const u32x4*)(zr + 512 + 8 * lane), w2 = *(const u32x4*)(zr + C_IQ + 8 * lane), w3 = *(const u32x4*)(zr + C_IQ + 512 + 8 * lane);
    const u32x4 w4 = *(const u32x4*)(zr + C_BQ + 8 * lane), w5 = *(const u32x4*)(zr + C_BQ + 512 + 8 * lane), w6 = *(const u32x4*)(zr + C_BQ + 1024 + 8 * lane);
    const float xik = zs[S_IK + lane]; const float xiw = (lane < 16) ? zs[S_IW + lane] : 0.f; const float xbf = (lane < 6) ? zs[S_BF + lane] + pp.fbias[lane] : 0.f;
    *(u32x4*)((char*)(zr + 8 * lane) + woff) = head_core(w0, pp.gaq, true, c128, s128, lane);
    { bf16* kac = (bf16*)(WS() + WS_KAC) + (size_t)row * 128; bf16* vac = (bf16*)(WS() + WS_VAC) + (size_t)row * 128;
      bf16* dstp = (lane < 32) ? (bf16*)((char*)(zr + 512 + 8 * lane) + woff) : (lane < 48 ? kac + 8 * (lane - 32) : vac + 8 * (lane - 48));
      const u32x4 r1 = head_core(w1, lane < 32 ? pp.gaq : pp.gak, true, c128, s128, lane);
      *(u32x4*)dstp = (lane >= 48) ? w1 : r1; }
    { const int i0 = 8 * (lane & 3);
      const f32x4 c0 = *(const f32x4*)(c64 + i0), c1 = *(const f32x4*)(c64 + i0 + 4), s0 = *(const f32x4*)(s64 + i0), s1 = *(const f32x4*)(s64 + i0 + 4);
#pragma unroll
      for (int j = 0; j < 2; ++j) { float x[8]; unpack8(j ? w3 : w2, x);
#pragma unroll
          for (int e = 0; e < 8; ++e) { const float up = dppf<0x104>(x[e]), dn = dppf<0x114>(x[e]);
              const float pr = (lane & 4) ? dn : up; const float c = e < 4 ? c0[e] : c1[e - 4], sv = e < 4 ? s0[e] : s1[e - 4];
              x[e] = (lane & 4) ? x[e] * c + pr * sv : x[e] * c - pr * sv; }
          *(u32x4*)((char*)(zr + C_IQ + 512 * j + 8 * lane) + woff) = pack8f(x); } }
    *(u32x4*)((char*)(zr + C_BQ + 8 * lane) + woff) = head_core(w4, pp.gbq, false, c128, s128, lane);
    *(u32x4*)((char*)(zr + C_BQ + 512 + 8 * lane) + woff) = head_core(w5, lane < 32 ? pp.gbq : pp.gbk, false, c128, s128, lane);
    *(u32x4*)((char*)(zr + C_BQ + 1024 + 8 * lane) + woff) = head_core(w6, pp.gbk, false, c128, s128, lane);
    { const float pr = __shfl_xor(xik, 32); const int i = lane & 31; const float c = c64[i], sv = s64[i];
      const float y = (lane < 32) ? xik * c - pr * sv : xik * c + pr * sv; const float yn = dppf<0xB1>(y);
      if ((lane & 1) == 0) *(unsigned*)((bf16*)(WS() + WS_IKC) + (size_t)row * 64 + lane) = cvtpk(y, yn); }
    if (lane < 16) *(float*)((char*)(zs + S_IW + lane) + woff) = xiw * 0.03125f;
    if (lane < 6) *(float*)((char*)(zs + S_BF + lane) + woff) = logsigmoidf(xbf);
}
__device__ __forceinline__ void p_norm2(Frame& F, int l, const float* gain, const float* bg, const float* be, bool dup) {
    int htid = get_tid(); const int lane = htid & 63, wave = __builtin_amdgcn_readfirstlane(htid >> 6), g = lane >> 4, c16 = lane & 15;
    const int gw = F.bid * 8 + wave, NGW = F.G * 8;
    const float* H = (const float*)(WS() + WS_H); bf16* U = (bf16*)(WS() + WS_U);
    LAS float* lg = (LAS float*)(F.lds + wave * 4096); LAS float* rs = lg + 768;
    for (int rt = wave * F.G + F.bid; rt < R / 16 && wave < 5; rt += 8 * F.G) {
        const size_t row0 = (size_t)rt * 16; if ((int)(row0 % TP) < PADF) continue;
        const bf16* wr = (const bf16*)(WS() + WS_WR + l * SZ_WR);
        f32x4 acc[3] = {zero4(), zero4(), zero4()};
        const float* hrow = H + (row0 + c16) * DM + 8 * g;
        const bf16* wp0 = wr + (size_t)c16 * DM + 8 * g;
        float ss = 0.f;
#pragma unroll 8
        for (int ks = 0; ks < 64; ++ks) {
            const f32x4 a = *(const f32x4*)(hrow + 32 * ks), b = *(const f32x4*)(hrow + 32 * ks + 4);
            ss += (a[0] * a[0] + a[1] * a[1]) + (a[2] * a[2] + a[3] * a[3]) + (b[0] * b[0] + b[1] * b[1]) + (b[2] * b[2] + b[3] * b[3]);
            u32x4 hw; hw.x = cvtpk(a[0], a[1]); hw.y = cvtpk(a[2], a[3]); hw.z = cvtpk(b[0], b[1]); hw.w = cvtpk(b[2], b[3]);
            u32x4 lw; lw.x = cvtpk(a[0] - bflo(hw.x), a[1] - bfhi(hw.x)); lw.y = cvtpk(a[2] - bflo(hw.y), a[3] - bfhi(hw.y));
            lw.z = cvtpk(b[0] - bflo(hw.z), b[1] - bfhi(hw.z)); lw.w = cvtpk(b[2] - bflo(hw.w), b[3] - bfhi(hw.w));
            const bf16x8 Ah = *reinterpret_cast<const bf16x8*>(&hw), Al = *reinterpret_cast<const bf16x8*>(&lw);
#pragma unroll
            for (int ct = 0; ct < 3; ++ct) { const bf16* wp = wp0 + (size_t)(16 * ct) * DM + 32 * ks;
                const bf16x8 Bh = *(const bf16x8*)wp, Bl = *(const bf16x8*)(wp + (size_t)48 * DM);
                acc[ct] = __builtin_amdgcn_mfma_f32_16x16x32_bf16(Ah, Bh, acc[ct], 0, 0, 0);
                acc[ct] = __builtin_amdgcn_mfma_f32_16x16x32_bf16(Ah, Bl, acc[ct], 0, 0, 0);
                acc[ct] = __builtin_amdgcn_mfma_f32_16x16x32_bf16(Al, Bh, acc[ct], 0, 0, 0); } }
        ss += __shfl_xor(ss, 16); ss += __shfl_xor(ss, 32);
        if (g == 0) rs[c16] = rsqrt_(ss * (1.f / DM) + EPS);
#pragma unroll
        for (int ct = 0; ct < 3; ++ct)
#pragma unroll
            for (int r = 0; r < 4; ++r) lg[(4 * g + r) * 48 + 16 * ct + c16] = acc[ct][r];
        LDS_WAIT();
        if (lane < 16) { const size_t row = row0 + lane;
            const float rstd = rs[lane];
            float gl[4]; int gi = 0; float gm = -1e30f;
#pragma unroll
            for (int j = 0; j < 4; ++j) { gl[j] = lg[lane * 48 + j] * rstd + bg[j]; if (gl[j] > gm) { gm = gl[j]; gi = j; } }
            float gs = 0.f;
#pragma unroll
            for (int j = 0; j < 4; ++j) gs += fexp_(gl[j] - gm);
            const float gp = 1.f / gs;
            float el[8]; int e0 = 0, e1 = 0; float m0 = -1e30f, m1 = -1e30f;
#pragma unroll
            for (int j = 0; j < 8; ++j) el[j] = lg[lane * 48 + 4 + 8 * gi + j] * rstd + be[8 * gi + j];
#pragma unroll
            for (int j = 0; j < 8; ++j) { if (el[j] > m0) { m1 = m0; e1 = e0; m0 = el[j]; e0 = j; } else if (el[j] > m1) { m1 = el[j]; e1 = j; } }
            const float w1r = fexp_(m1 - m0); const float p0 = 1.f / (1.f + w1r), p1 = w1r / (1.f + w1r);
            unsigned* cnt = CTL() + CW_CNT + 1024 * l + (dup ? 16 : 0); unsigned* list = (unsigned*)(WS() + (dup ? WS_END : WS_LIST)); float* gate = (float*)(WS() + WS_GATE);
            const int x0 = gi * 8 + e0, x1 = gi * 8 + e1;
            const unsigned i0 = atomicAdd(cnt + 32 * x0, 1u), i1 = atomicAdd(cnt + 32 * x1, 1u);
            list[(size_t)x0 * R + i0] = (unsigned)row * 2u; list[(size_t)x1 * R + i1] = (unsigned)row * 2u + 1u;
            gate[row * 2] = gp * p0; gate[row * 2 + 1] = gp * p1; }
        LDS_WAIT();
    }
    const int rbeg = 65 * F.bid + (wave < 4 ? 4 * wave : 16 + (49 * (wave - 4)) / 4), rend = 65 * F.bid + (wave < 4 ? 4 * wave + 4 : 16 + (49 * (wave - 3)) / 4);
    const bool even_deal = (F.G * 65 == R);
    for (int row = even_deal ? rbeg : gw; row < (even_deal ? rend : R); row += even_deal ? 1 : NGW) { if ((row % TP) < PADF) continue;
        f32x4 x[8]; float ss = 0.f;
#pragma unroll
        for (int j = 0; j < 8; ++j) { x[j] = *(const f32x4*)(H + (size_t)row * DM + 4 * (lane + 64 * j)); ss += x[j][0] * x[j][0] + x[j][1] * x[j][1] + x[j][2] * x[j][2] + x[j][3] * x[j][3]; }
        ss = wave_sum(ss); const float rstd = rsqrt_(ss * (1.f / DM) + EPS);
#pragma unroll
        for (int j = 0; j < 8; ++j) { const int col = 4 * (lane + 64 * j); const f32x4 gg = *(const f32x4*)(gain + col);
            u32x2 w; w.x = cvtpk(x[j][0] * rstd * gg[0], x[j][1] * rstd * gg[1]); w.y = cvtpk(x[j][2] * rstd * gg[2], x[j][3] * rstd * gg[3]);
            *(u32x2*)(U + (size_t)row * DM + col) = w; } }
}
__device__ __forceinline__ void build_moetab(Frame& F, int l) {
    int htid = get_tid(); const int h_lane = htid & 63, h_wave = __builtin_amdgcn_readfirstlane(htid >> 6);
    LAS pg8::MoeTab* tab = (LAS pg8::MoeTab*)(F.lds + MOETAB_OFF);
    if (htid == 0) { int t = 0; const unsigned* cnt = CTL() + CW_CNT + 1024 * l;
        for (int e = 0; e < NEXP; ++e) { const int n = (int)__hip_atomic_load(cnt + 32 * e, __ATOMIC_RELAXED, __HIP_MEMORY_SCOPE_AGENT); tab->cnt[e] = n;
            for (int j = 0; j * 256 < n && t < 176; ++j) { tab->e[t] = e; tab->r0[t] = j * 256; ++t; } }
        tab->ntiles = t; }
    __syncthreads();
}

#define INPARG(i) args_in_dyn(args, (i))
constexpr int NPH = 2 + 9 * DEPTH;
struct Args { const float* in[21]; float* out; unsigned char* ws; int ph_lo, ph_hi; };
#define PHASE_FN static __device__ __forceinline__
#define MKFRAME Frame F; F.lds = lds; F.ldsg = (char*)lds; F.tid = 0; F.lane = 0; F.wave = 0; F.G = (int)gridDim.x; F.bid = (int)blockIdx.x
#define Z ((bf16*)(WS() + WS_Z))
#define ZS ((float*)(WS() + WS_ZS))
#define MIX ((bf16*)(WS() + WS_MIX))
#define U ((bf16*)(WS() + WS_U))
#define LA ((float*)(WS() + WS_LA))
#define KV ((float*)(WS() + WS_KV))
#define DVEC ((float*)(WS() + WS_DVEC))
#define SS ((float*)(WS() + WS_SS))
PHASE_FN void ph_prologue(LAS unsigned char* lds) { MKFRAME; p_prologue(F, INP(4), INP(13), INP(18), INP(19), INP(20), INP(14), INP(16), INP(3)); }
PHASE_FN void ph_norm1(LAS unsigned char* lds, int l, size_t woff) { MKFRAME; p_norm1(F, l, INP(0), INP(1), INP(2) + (size_t)l * DM, woff); }
PHASE_FN void ph_inproj(LAS unsigned char* lds, int l) { MKFRAME;
    pg8::DenseProb P; P.init(U, WS() + WS_WIN + l * SZ_WIN, 64 * 256, DINP, DM, F.G, F.bid);
    pg8::EpiInProj E{Z, ZS};
    pg8::gemm_phase(F.lds, P, E);
    skinny_gemm<0>(F.lds, U, (const bf16*)(WS() + WS_WIN + l * SZ_WIN), DM, DINP, F.bid, Z, ZS, nullptr);
}
PHASE_FN void ph_post(LAS unsigned char* lds, int l, size_t woff) { MKFRAME;
    PostP pp{INP(5) + l * 128, INP(6) + l * 128, INP(7) + l * 128, INP(8) + l * 128, INP(9) + l * 6, INP(10) + (size_t)l * 16 * 256, INP(11) + l * 256};
    for (int u = F.bid; u < (R / 64) * 4; u += F.G) gla::step1(F.lds, Z, ZS, LA, INP(10) + (size_t)l * 16 * 256, INP(11) + l * 256, KV, DVEC, (u >> 2) / 65, (u >> 2) % 65, u & 3);
    { const int gw = F.bid * 8 + (get_tid() >> 6);
      for (int row = gw; row < R; row += F.G * 8) post_row(F, pp, row, woff); }
}
#ifndef MIXM
#define MIXM 15
#endif
PHASE_FN void ph_mix(LAS unsigned char* lds, int l, int rep) { MKFRAME;
    volatile LAS unsigned* MISC = (volatile LAS unsigned*)(F.lds + MISC_OFF);
    if ((MIXM & 1) && F.bid < 64) gla::step2(KV, DVEC, SS, F.bid);
    if (MIXM & 2) { for (int it = F.G - 1 - F.bid; it < 192; it += F.G) fox::item(F.ldsg, Z, ZS, MIX, it); }
    if ((MIXM & 4) && F.bid < NB) fox::meta_unit(Z, ZS, MIX, F.bid);
    __syncthreads();
    const bool t0 = (get_tid() == 0);
    unsigned* qbase = CTL() + CW_QUEUE + 64 * l + 32 * rep;
    const int home = (int)(xb_xcc_id() & 3u);
    for (int bi = 0; bi < NB && (MIXM & 8); ++bi) {
        const int b = (home + bi) & 3;
        unsigned nq = 0u;
        if (t0) nq = atomicAdd(qbase + 4 * b, 1u);
        for (;;) {
            if (t0) MISC[0] = nq;
            __syncthreads();
            const int q = (int)MISC[0];
            __syncthreads();
            if (q >= 65 * 8) break;
            if (t0) nq = atomicAdd(qbase + 4 * b, 1u);
            const int c = 64 - q / 8, sub = q % 8;
            if (c == 0 && sub < 6) continue;
            dsa::unit(F.lds, Z, ZS, (const bf16*)(WS() + WS_IKC), (const bf16*)(WS() + WS_KAC), (const bf16*)(WS() + WS_VAC), MIX, b, c, sub);
        }
    }
}
PHASE_FN void ph_gla3(LAS unsigned char* lds, int l) { MKFRAME;
    for (int u = F.bid; u < (R / 64) * 4; u += F.G) gla::step3(F.lds, Z, LA, SS, INP(12) + l * 128, MIX, (u >> 2) / 65, (u >> 2) % 65, u & 3);
}
PHASE_FN void ph_outproj(LAS unsigned char* lds, int l, size_t woff) { MKFRAME;
    pg8::DenseProb P; P.init(MIX, WS() + WS_WOUT + l * SZ_WOUT, 64 * 256, DM, DM, F.G, F.bid);
    pg8::EpiOutProj E{(float*)(WS() + WS_H + woff)};
    pg8::gemm_phase(F.lds, P, E);
    skinny_gemm<1>(F.lds, MIX, (const bf16*)(WS() + WS_WOUT + l * SZ_WOUT), DM, DM, F.bid, nullptr, nullptr, (float*)(WS() + WS_H + woff));
}
PHASE_FN void ph_norm2(LAS unsigned char* lds, int l, bool dup) { MKFRAME;
    p_norm2(F, l, INP(3) + (size_t)l * DM, INP(15) + l * 4, INP(17) + l * 32, dup);
}
PHASE_FN void ph_moeup(LAS unsigned char* lds, int l) { MKFRAME;
    build_moetab(F, l);
    pg8::MoeProb<true> P; P.K = DM; P.lda = DM; P.A = (const char*)U; P.W = (const char*)(WS() + WS_W13 + l * SZ_W13); P.list = (const unsigned*)(WS() + WS_LIST);
    P.tab = (const LAS pg8::MoeTab*)(F.lds + MOETAB_OFF); P.G = F.G; P.c = F.bid;
    pg8::EpiMoeUp E{(bf16*)(WS() + WS_HID)};
    pg8::gemm_phase(F.lds, P, E);
}
PHASE_FN void ph_moedown(LAS unsigned char* lds, int l) { MKFRAME;
    build_moetab(F, l);
    pg8::MoeProb<false> P; P.K = DEXP; P.lda = DEXP; P.A = (const char*)(WS() + WS_HID); P.W = (const char*)(WS() + WS_W2 + l * SZ_W2); P.list = (const unsigned*)(WS() + WS_LIST);
    P.tab = (const LAS pg8::MoeTab*)(F.lds + MOETAB_OFF); P.G = F.G; P.c = F.bid;
    pg8::EpiMoeDown E{(bf16*)(WS() + WS_Y0), (bf16*)(WS() + WS_Y1), (const unsigned*)(WS() + WS_LIST), (const float*)(WS() + WS_GATE), (const LAS pg8::MoeTab*)(F.lds + MOETAB_OFF)};
    pg8::gemm_phase(F.lds, P, E);
}
PHASE_FN void ph_final(LAS unsigned char* lds) { MKFRAME; p_final(F); }
#undef Z
#undef ZS
#undef MIX
#undef U
#undef LA
#undef KV
#undef DVEC
#undef SS

__device__ __forceinline__ const float* args_in_dyn(const Args& a, int i) { const float* p = a.in[0];
#pragma unroll
    for (int k = 1; k < 21; ++k) p = (i == k) ? a.in[k] : p;
    return p; }
__global__ void __launch_bounds__(512, 2) fwd_kernel(Args args) {
    extern __shared__ __attribute__((aligned(16))) unsigned char lds_raw[];
    LAS unsigned char* lds = (LAS unsigned char*)lds_raw;
    const int tid = threadIdx.x;
    if ((tid & 63) == 0) *(volatile LAS unsigned*)(uintptr_t)(WAVETAB_OFF + 4 * ((unsigned)__builtin_amdgcn_s_getreg((5 << 11) | 4) & 63u)) = (unsigned)tid >> 6;
    if (tid < 23) { const unsigned long long v = (tid < 21) ? (unsigned long long)INPARG(tid) : (tid == 21 ? (unsigned long long)args.out : (unsigned long long)args.ws);
        LAS unsigned* t = (LAS unsigned*)(lds + PTAB_OFF) + 2 * tid; t[0] = (unsigned)v; t[1] = (unsigned)(v >> 32); }
    volatile LAS unsigned* MISC = (volatile LAS unsigned*)(lds + MISC_OFF);
    for (int u = tid; u < 256; u += 512) ((LAS unsigned*)(lds + LDSCTL_OFF))[u] = 0u;
    __syncthreads();
    const int lo = args.ph_lo, hi = args.ph_hi;
    const bool multi = (hi - lo) > 1;
    unsigned* barw = (unsigned*)(args.ws + WS_CTL) + CW_BAR;
    XcdBarrier bar; bar.bar = barw; bar.x = 0; bar.st = nullptr;
    if (multi) bar = xcd_barrier_post(barw, MISC + 8);
#define IN(k) (lo <= (k) && (k) < hi)
#define SEAM(k) do { if (IN(k) && IN((k) + 1)) xcd_barrier(bar); } while (0)
#ifndef DUP_MASK
#define DUP_MASK 0
#endif
#define NREP(ty) (((DUP_MASK >> (ty)) & 1) ? 2 : 1)
#define REPBAR(rep, ty) do { if ((rep) + 1 < NREP(ty) && multi) xcd_barrier(bar); } while (0)
    constexpr size_t DUPOFF = (size_t)774000128;
    for (int rep = 0; rep < NREP(0); ++rep) { if (IN(0)) ph_prologue(lds); REPBAR(rep, 0); }
    SEAM(0);
    for (int l = 0; l < DEPTH; ++l) {
        const int pb = 1 + 9 * l;
        for (int rep = 0; rep < NREP(1); ++rep) { if (IN(pb + 0)) ph_norm1(lds, l, rep ? DUPOFF : 0); REPBAR(rep, 1); }   SEAM(pb + 0);
        for (int rep = 0; rep < NREP(2); ++rep) { if (IN(pb + 1)) ph_inproj(lds, l); REPBAR(rep, 2); }  SEAM(pb + 1);
        for (int rep = 0; rep < NREP(3); ++rep) { if (IN(pb + 2)) ph_post(lds, l, rep ? DUPOFF : 0); REPBAR(rep, 3); }    SEAM(pb + 2);
        for (int rep = 0; rep < NREP(4); ++rep) { if (IN(pb + 3)) ph_mix(lds, l, rep); REPBAR(rep, 4); }     SEAM(pb + 3);
        for (int rep = 0; rep < NREP(5); ++rep) { if (IN(pb + 4)) ph_gla3(lds, l); REPBAR(rep, 5); }    SEAM(pb + 4);
        for (int rep = 0; rep < NREP(6); ++rep) { if (IN(pb + 5)) ph_outproj(lds, l, rep ? DUPOFF : 0); REPBAR(rep, 6); } SEAM(pb + 5);
        for (int rep = 0; rep < NREP(7); ++rep) { if (IN(pb + 6)) ph_norm2(lds, l, rep != 0); REPBAR(rep, 7); }   SEAM(pb + 6);
        for (int rep = 0; rep < NREP(8); ++rep) { if (IN(pb + 7)) ph_moeup(lds, l); REPBAR(rep, 8); }   SEAM(pb + 7);
        for (int rep = 0; rep < NREP(9); ++rep) { if (IN(pb + 8)) ph_moedown(lds, l); REPBAR(rep, 9); } SEAM(pb + 8);
    }
    if (IN(NPH - 1)) ph_final(lds);
#undef IN
#undef SEAM
}

extern "C" void kernel_launch(void* const* d_in, const int* in_sizes, int n_in, void* d_out, int out_size, void* d_ws, size_t ws_size, hipStream_t stream) {
    static int grid = 0;
    if (grid == 0) {
        if (n_in != 21 || out_size != NB * SEQ * DM || ws_size < (DUP_MASK ? (size_t)2147483648u : WS_END)) { fprintf(stderr, "kernel_launch: unexpected shapes (n_in %d out %d ws %zu need %zu)\n", n_in, out_size, ws_size, (size_t)WS_END); grid = -1; return; }
        int dev = 0, cus = 0, per_cu = 0;
        if (hipGetDevice(&dev) != hipSuccess || hipDeviceGetAttribute(&cus, hipDeviceAttributeMultiprocessorCount, dev) != hipSuccess) { grid = -1; return; }
        if (hipFuncSetAttribute((const void*)fwd_kernel, hipFuncAttributeMaxDynamicSharedMemorySize, LDS_BYTES) != hipSuccess) { fprintf(stderr, "kernel_launch: hipFuncSetAttribute failed\n"); grid = -1; return; }
        if (hipOccupancyMaxActiveBlocksPerMultiprocessor(&per_cu, (const void*)fwd_kernel, 512, LDS_BYTES) != hipSuccess || per_cu < 1) fprintf(stderr, "kernel_launch: occupancy query says %d\n", per_cu);
        (void)hipGetLastError();
        grid = cus;
    }
    if (grid < 0) return;
    (void)hipMemsetAsync((char*)d_ws + WS_CTL, 0, CTL_ZERO_BYTES, stream);
    Args a{};
    for (int i = 0; i < 21; ++i) a.in[i] = (const float*)d_in[i];
    a.out = (float*)d_out; a.ws = (unsigned char*)d_ws;
#if MK_N_LAUNCHES == 1
    a.ph_lo = 0; a.ph_hi = NPH;
    hipLaunchKernelGGL(fwd_kernel, dim3(grid), dim3(512), LDS_BYTES, stream, a);
#else
    for (int p = 0; p < NPH; ++p) { a.ph_lo = p; a.ph_hi = p + 1; hipLaunchKernelGGL(fwd_kernel, dim3(grid), dim3(512), LDS_BYTES, stream, a); }
#endif
}
```
